# Optimizing an MI355X kernel written in HIP

```python
import jax, jax.numpy as jnp
from jax import lax
import numpy as np

D_MODEL = 1024
BATCH = 2
SEQ = 8192
DEPTH = 4

N_MIXERS = 2
N_POOL_LAYERS = (DEPTH + 1) // 2
N_SB_LAYERS = DEPTH // 2
POOL_WINDOWS = (2, 4, 8, 16)
N_POOL_GROUPS = len(POOL_WINDOWS)
POOL_GROUP_DIM = D_MODEL // N_POOL_GROUPS
SB_HEADS = 16
SB_HEAD_DIM = D_MODEL // SB_HEADS
SB_BLOCK = 128
N_GROUPS = 4
EXPERTS_PER_GROUP = 8
N_EXPERTS = N_GROUPS * EXPERTS_PER_GROUP
TOP_K_IN_GROUP = 2
D_EXPERT = D_MODEL // 4
RMS_EPS = 1e-6

kernel_name = 'hybrid_pool_stickbreak_hmoe'


def rms_norm(x, gain):
    xf = x.astype(jnp.float32)
    y = xf * lax.rsqrt(jnp.mean(xf * xf, axis=-1, keepdims=True) + RMS_EPS)
    return (y * gain.astype(jnp.float32)).astype(x.dtype)


def pool_mixer(h, w, b, scale):
    B_, S_, D_ = h.shape
    hf = h.astype(jnp.float32)
    cs = jnp.cumsum(hf, axis=1)
    cs0 = jnp.concatenate([jnp.zeros_like(cs[:, :1]), cs], axis=1)
    pos = jnp.arange(S_)
    pooled = []
    for g, win in enumerate(POOL_WINDOWS):
        sl = slice(g * POOL_GROUP_DIM, (g + 1) * POOL_GROUP_DIM)
        c_in = cs[:, :, sl]
        c_lo = jnp.pad(cs0[:, :S_ + 1 - win, sl], ((0, 0), (win - 1, 0), (0, 0)))
        count = jnp.minimum(pos + 1, win).astype(jnp.float32)
        pooled.append((c_in - c_lo) / count[None, :, None])
    pooled = jnp.stack(pooled, axis=2)
    diff = pooled - hf.reshape(B_, S_, N_POOL_GROUPS, POOL_GROUP_DIM)
    y = jnp.einsum('bsgc,gcd->bsgd', diff, w.astype(jnp.float32)) + b.astype(jnp.float32)
    return (y.reshape(B_, S_, D_) * scale.astype(jnp.float32)).astype(h.dtype)


def stick_breaking_attention(q, k, v):
    B_, H_, S_, Dh = q.shape
    n_blocks = S_ // SB_BLOCK
    qf = q.astype(jnp.float32) * (Dh ** -0.5)
    kf = k.astype(jnp.float32)
    vf = v.astype(jnp.float32)
    offs = jnp.arange(SB_BLOCK)

    def query_block(i):
        q_start = i * SB_BLOCK
        qb = lax.dynamic_slice_in_dim(qf, q_start, SB_BLOCK, axis=2)
        q_pos = q_start + offs

        def key_step(step, carry):
            acc, log_rem = carry
            k_start = (i - step) * SB_BLOCK
            kb = lax.dynamic_slice_in_dim(kf, k_start, SB_BLOCK, axis=2)
            vb = lax.dynamic_slice_in_dim(vf, k_start, SB_BLOCK, axis=2)
            mask = (k_start + offs)[None, :] < q_pos[:, None]
            z = jnp.einsum('bhqd,bhkd->bhqk', qb, kb)
            log_keep = jnp.where(mask, jax.nn.log_sigmoid(-z), 0.0)
            later = lax.cumsum(log_keep, axis=3, reverse=True) - log_keep + log_rem[..., None]
            a = jnp.where(mask, jnp.exp(jax.nn.log_sigmoid(z) + later), 0.0)
            acc = acc + jnp.einsum('bhqk,bhkd->bhqd', a, vb)
            log_rem = log_rem + jnp.sum(log_keep, axis=-1)
            return acc, log_rem

        init = (jnp.zeros((B_, H_, SB_BLOCK, Dh), jnp.float32),
                jnp.zeros((B_, H_, SB_BLOCK), jnp.float32))
        acc, _ = lax.fori_loop(0, i + 1, key_step, init)
        return acc

    out = lax.map(query_block, jnp.arange(n_blocks))
    out = jnp.transpose(out, (1, 2, 0, 3, 4)).reshape(B_, H_, S_, Dh)
    return out.astype(q.dtype)


def sb_mixer(h, w_qkv, q_gain, k_gain, w_o):
    B_, S_, D_ = h.shape
    qkv = jnp.einsum('bsd,de->bse', h, w_qkv)
    q, k, v = jnp.split(qkv, 3, axis=-1)
    q = rms_norm(q.reshape(B_, S_, SB_HEADS, SB_HEAD_DIM), q_gain)
    k = rms_norm(k.reshape(B_, S_, SB_HEADS, SB_HEAD_DIM), k_gain)
    v = v.reshape(B_, S_, SB_HEADS, SB_HEAD_DIM)
    o = stick_breaking_attention(q.transpose(0, 2, 1, 3), k.transpose(0, 2, 1, 3),
                                 v.transpose(0, 2, 1, 3))
    o = o.transpose(0, 2, 1, 3).reshape(B_, S_, D_)
    return jnp.einsum('bse,ed->bsd', o, w_o).astype(h.dtype)


def hierarchical_moe(h, w_group, b_group, w_router, b_router, w_gate, w_up, w_down):
    B_, S_, D_ = h.shape
    t = h.reshape(-1, D_)
    group_probs = jax.nn.softmax((t @ w_group + b_group).astype(jnp.float32), axis=-1)
    g_prob, g_idx = lax.top_k(group_probs, 1)
    expert_logits = (t @ w_router + b_router).astype(jnp.float32)
    expert_logits = expert_logits.reshape(-1, N_GROUPS, EXPERTS_PER_GROUP)
    in_group = jnp.take_along_axis(expert_logits, g_idx[:, :, None], axis=1)[:, 0]
    e_prob, e_idx = lax.top_k(jax.nn.softmax(in_group, axis=-1), TOP_K_IN_GROUP)
    e_prob = e_prob / jnp.sum(e_prob, axis=-1, keepdims=True)
    weights = g_prob * e_prob
    expert_ids = g_idx * EXPERTS_PER_GROUP + e_idx
    gate = jnp.sum(jax.nn.one_hot(expert_ids, N_EXPERTS, dtype=jnp.float32) * weights[..., None],
                   axis=1)
    hid = jax.nn.silu(jnp.einsum('td,edf->tef', t, w_gate)) * jnp.einsum('td,edf->tef', t, w_up)
    hid = hid * gate[:, :, None].astype(hid.dtype)
    y = jnp.einsum('tef,efd->td', hid, w_down)
    return y.reshape(B_, S_, D_).astype(h.dtype)


def setup_inputs(seed: int = 0) -> dict:
    key = jax.random.key(seed)
    ks = jax.random.split(key, 18)
    f32 = jnp.float32

    def normal(k, shape, scale):
        return jax.random.normal(k, shape, f32) * scale

    NP, NS, D = N_POOL_LAYERS, N_SB_LAYERS, D_MODEL
    return {
        'x': normal(ks[0], (BATCH, SEQ, D), 1.0),
        'pool_norm': 1.0 + normal(ks[1], (NP, D), 0.02),
        'pool_w': normal(ks[2], (NP, N_POOL_GROUPS, POOL_GROUP_DIM, POOL_GROUP_DIM), POOL_GROUP_DIM ** -0.5),
        'pool_b': normal(ks[3], (NP, N_POOL_GROUPS, POOL_GROUP_DIM), 0.01),
        'pool_scale': 0.5 + normal(ks[4], (NP, D), 0.05),
        'sb_norm': 1.0 + normal(ks[5], (NS, D), 0.02),
        'sb_w_qkv': normal(ks[6], (NS, D, 3 * D), D ** -0.5),
        'sb_q_gain': 1.0 + normal(ks[7], (NS, SB_HEAD_DIM), 0.02),
        'sb_k_gain': 1.0 + normal(ks[8], (NS, SB_HEAD_DIM), 0.02),
        'sb_w_o': normal(ks[9], (NS, D, D), D ** -0.5),
        'moe_norm': 1.0 + normal(ks[10], (DEPTH, D), 0.02),
        'moe_w_group': normal(ks[11], (DEPTH, D, N_GROUPS), D ** -0.5),
        'moe_b_group': normal(ks[12], (DEPTH, N_GROUPS), 0.01),
        'moe_w_router': normal(ks[13], (DEPTH, D, N_EXPERTS), D ** -0.5),
        'moe_b_router': normal(ks[14], (DEPTH, N_EXPERTS), 0.01),
        'moe_w_gate': normal(ks[15], (DEPTH, N_EXPERTS, D, D_EXPERT), D ** -0.5),
        'moe_w_up': normal(ks[16], (DEPTH, N_EXPERTS, D, D_EXPERT), D ** -0.5),
        'moe_w_down': normal(ks[17], (DEPTH, N_EXPERTS, D_EXPERT, D), D_EXPERT ** -0.5),
    }


def reference(x, pool_norm, pool_w, pool_b, pool_scale, sb_norm, sb_w_qkv, sb_q_gain, sb_k_gain,
              sb_w_o, moe_norm, moe_w_group, moe_b_group, moe_w_router, moe_b_router,
              moe_w_gate, moe_w_up, moe_w_down):
    for i in range(DEPTH):
        j = i // N_MIXERS
        if i % N_MIXERS == 0:
            h = rms_norm(x, pool_norm[j])
            x = x + pool_mixer(h, pool_w[j], pool_b[j], pool_scale[j]).astype(x.dtype)
        else:
            h = rms_norm(x, sb_norm[j])
            x = x + sb_mixer(h, sb_w_qkv[j], sb_q_gain[j], sb_k_gain[j], sb_w_o[j]).astype(x.dtype)
        h = rms_norm(x, moe_norm[i])
        x = x + hierarchical_moe(h, moe_w_group[i], moe_b_group[i], moe_w_router[i], moe_b_router[i],
                                 moe_w_gate[i], moe_w_up[i], moe_w_down[i]).astype(x.dtype)
    return x
```

```cpp
#include <hip/hip_runtime.h>
#include <stdint.h>

#define DI __device__ __forceinline__
typedef unsigned short bf16_t;
typedef short bf16x8 __attribute__((ext_vector_type(8)));
typedef float f32x4 __attribute__((ext_vector_type(4)));
typedef float f32x16 __attribute__((ext_vector_type(16)));
typedef unsigned u32x4 __attribute__((ext_vector_type(4)));
typedef unsigned u32x2 __attribute__((ext_vector_type(2)));

constexpr int T = 16384, DM = 1024, SEQ = 8192, NH = 16, HD = 64, DEPTH = 4, NE = 32, DE = 256;
constexpr float EPS = 1e-6f;
constexpr int NTHR = 512, NWAVE = 8;
constexpr int LIST_CAP = 16384;
constexpr int DUMMY_ROW = 2 * T;

constexpr size_t MiB = 1u << 20;
constexpr size_t WS_CTL = 0, CTL_BYTES = 1 * MiB;
constexpr size_t WS_WQKV = 1 * MiB;
constexpr size_t WS_WO = 13 * MiB;
constexpr size_t WS_WPOOL = 17 * MiB;
constexpr size_t WS_RSTD = 18 * MiB;
constexpr size_t WS_WGU = 20 * MiB;
constexpr size_t WS_WD = 148 * MiB;
constexpr size_t WS_XB = 212 * MiB;
constexpr size_t WS_LIST = 244 * MiB;
constexpr size_t WS_Q = 256 * MiB;
constexpr size_t WS_DIFF = WS_Q;
constexpr size_t WS_K = 288 * MiB, WS_V = 320 * MiB, WS_O = 352 * MiB;
constexpr size_t WS_YBUF = 288 * MiB;
constexpr size_t WS_HID = 354 * MiB;
constexpr size_t WS_END = 384 * MiB;
static_assert(WS_YBUF + (size_t)(2 * T + 1) * DM * 2 <= WS_HID, "ybuf");
static_assert(WS_HID + (size_t)(2 * T + NE * 256) * DE * 2 <= WS_END, "hid");
constexpr int CW_CNT = 1024;

struct Entry { int dst; float rstd; float w; int tok; };

struct Params {
    const float* x_in; const float* pool_norm; const float* pool_w; const float* pool_b; const float* pool_scale;
    const float* sb_norm; const float* sb_wqkv; const float* sb_qg; const float* sb_kg; const float* sb_wo;
    const float* moe_norm; const float* moe_wg; const float* moe_bg; const float* moe_wr; const float* moe_br;
    const float* moe_wgate; const float* moe_wup; const float* moe_wdown;
    float* x;
    unsigned char* ws;
};

DI unsigned cvt_pk_bf16(float lo, float hi) { unsigned r; asm volatile("v_cvt_pk_bf16_f32 %0, %1, %2" : "=v"(r) : "v"(lo), "v"(hi)); return r; }
DI float bf_lo(unsigned u) { return __uint_as_float(u << 16); }
DI float bf_hi(unsigned u) { return __uint_as_float(u & 0xffff0000u); }
DI float wave_sum(float v) {
#pragma unroll
    for (int o = 32; o >= 1; o >>= 1) v += __shfl_xor(v, o);
    return v;
}
DI int perm32(int rho) { const int n = rho >> 4, i = rho & 15; return 8 * (i >> 2) + 4 * n + (i & 3); }

DI void cvt_tiles(const float* src, int K, int N, size_t src_mstride, bf16_t* dst, size_t dst_mstride, const float* scale, int scale_div, int nmat, float* lds) {
    const int tk = K / 64, tn = N / 64, per = tk * tn, tid = threadIdx.x;
    for (int tile = blockIdx.x; tile < nmat * per; tile += gridDim.x) {
        const int mat = tile / per, rem = tile % per, k0 = (rem / tn) * 64, n0 = (rem % tn) * 64;
        const float* s = src + (size_t)mat * src_mstride;
        bf16_t* d = dst + (size_t)mat * dst_mstride;
        const float* sc = scale ? scale + (size_t)(mat / scale_div) * K : nullptr;
        __syncthreads();
#pragma unroll
        for (int it = 0; it < 8; ++it) {
            const int k = it * 8 + (tid >> 6), n = tid & 63;
            float v = s[(size_t)(k0 + k) * N + n0 + n];
            if (sc) v *= sc[k0 + k];
            lds[k * 65 + n] = v;
        }
        __syncthreads();
#pragma unroll
        for (int it = 0; it < 4; ++it) {
            const int kp = (tid & 31) * 2, n = (tid >> 5) + 16 * it;
            const unsigned w = cvt_pk_bf16(lds[kp * 65 + n], lds[(kp + 1) * 65 + n]);
            *(unsigned*)(d + (size_t)(n0 + n) * K + k0 + kp) = w;
        }
    }
}
DI void ph_prologue(const Params& p, float* lds) {
    cvt_tiles(p.sb_wqkv, 1024, 3072, (size_t)1024 * 3072, (bf16_t*)(p.ws + WS_WQKV), (size_t)3072 * 1024, p.sb_norm, 1, 2, lds);
    cvt_tiles(p.sb_wo, 1024, 1024, (size_t)1024 * 1024, (bf16_t*)(p.ws + WS_WO), (size_t)1024 * 1024, nullptr, 1, 2, lds);
    cvt_tiles(p.pool_w, 256, 256, (size_t)65536, (bf16_t*)(p.ws + WS_WPOOL), (size_t)65536, nullptr, 1, 8, lds);
    cvt_tiles(p.moe_wgate, 1024, 256, (size_t)1024 * 256, (bf16_t*)(p.ws + WS_WGU), (size_t)512 * 1024, p.moe_norm, 32, 128, lds);
    cvt_tiles(p.moe_wup, 1024, 256, (size_t)1024 * 256, (bf16_t*)(p.ws + WS_WGU) + (size_t)256 * 1024, (size_t)512 * 1024, p.moe_norm, 32, 128, lds);
    cvt_tiles(p.moe_wdown, 256, 1024, (size_t)256 * 1024, (bf16_t*)(p.ws + WS_WD), (size_t)1024 * 256, nullptr, 1, 128, lds);
}

template <bool FIRST, bool HAS_Y, bool WRITE_XB>
DI void ph_combine(const Params& p) {
    const int tid = threadIdx.x, wid = tid >> 6, lane = tid & 63;
    const bf16_t* yb = (const bf16_t*)(p.ws + WS_YBUF);
    bf16_t* xb = (bf16_t*)(p.ws + WS_XB);
    float* rstd = (float*)(p.ws + WS_RSTD);
    for (int t = blockIdx.x * NWAVE + wid; t < T; t += gridDim.x * NWAVE) {
        float ss = 0.f;
#pragma unroll
        for (int i = 0; i < 4; ++i) {
            const int c = lane * 4 + 256 * i;
            f32x4 v = FIRST ? *(const f32x4*)(p.x_in + (size_t)t * DM + c) : *(const f32x4*)(p.x + (size_t)t * DM + c);
            if (HAS_Y) {
                const u32x2 a = *(const u32x2*)(yb + (size_t)t * DM + c), b = *(const u32x2*)(yb + (size_t)(T + t) * DM + c);
                v[0] += bf_lo(a[0]) + bf_lo(b[0]); v[1] += bf_hi(a[0]) + bf_hi(b[0]); v[2] += bf_lo(a[1]) + bf_lo(b[1]); v[3] += bf_hi(a[1]) + bf_hi(b[1]);
            }
            *(f32x4*)(p.x + (size_t)t * DM + c) = v;
            if (WRITE_XB) { u32x2 w; w[0] = cvt_pk_bf16(v[0], v[1]); w[1] = cvt_pk_bf16(v[2], v[3]); *(u32x2*)(xb + (size_t)t * DM + c) = w; }
            ss += v[0] * v[0] + v[1] * v[1] + v[2] * v[2] + v[3] * v[3];
        }
        ss = wave_sum(ss);
        if (lane == 0) rstd[t] = rsqrtf(ss * (1.0f / DM) + EPS);
    }
}

DI void ph_pooldiff(const Params& p, int j) {
    const float* rstd = (const float*)(p.ws + WS_RSTD);
    const float* gain = p.pool_norm + j * DM;
    bf16_t* diff = (bf16_t*)(p.ws + WS_DIFF);
    for (int idx = blockIdx.x * NTHR + threadIdx.x; idx < T * 128; idx += gridDim.x * NTHR) {
        const int t = idx >> 7, c = (idx & 127) * 8, g = c >> 8, win = 2 << g, s = t & (SEQ - 1);
        const int cnt = (s + 1 < win) ? s + 1 : win;
        f32x4 a0 = {0.f, 0.f, 0.f, 0.f}, a1 = {0.f, 0.f, 0.f, 0.f}, o0, o1;
        for (int u = 0; u < cnt; ++u) {
            const float r = rstd[t - u];
            const f32x4 v0 = *(const f32x4*)(p.x + (size_t)(t - u) * DM + c), v1 = *(const f32x4*)(p.x + (size_t)(t - u) * DM + c + 4);
            if (u == 0) { o0 = v0 * r; o1 = v1 * r; }
            a0 += v0 * r; a1 += v1 * r;
        }
        const float inv = 1.0f / (float)cnt;
        const f32x4 g0 = *(const f32x4*)(gain + c), g1 = *(const f32x4*)(gain + c + 4);
        const f32x4 d0 = (a0 * inv - o0) * g0, d1 = (a1 * inv - o1) * g1;
        u32x4 w; w[0] = cvt_pk_bf16(d0[0], d0[1]); w[1] = cvt_pk_bf16(d0[2], d0[3]); w[2] = cvt_pk_bf16(d1[0], d1[1]); w[3] = cvt_pk_bf16(d1[2], d1[3]);
        *(u32x4*)(diff + (size_t)t * DM + c) = w;
    }
}

struct Unit { const bf16_t* A; const bf16_t* B; int pm, pn, e, nvalid, row0, lbase; };
template <int LDA_, int LDB_, int K_, int BH_, bool HEADMAP_> struct GCfg { static constexpr int LDA = LDA_, LDB = LDB_, K = K_, BH = BH_; static constexpr bool HEADMAP = HEADMAP_; };

template <class Cfg, class Sched, class Epi>
DI void gemm_phase(const Sched& S, const Epi& E) {
    const int tid = threadIdx.x, wid = __builtin_amdgcn_readfirstlane(tid >> 6), lane = tid & 63, wr = wid >> 2, wc = wid & 3, fr = lane & 15, fq = lane >> 4;
    for (int ui = 0;; ++ui) {
        Unit u;
        if (!S.next(ui, u)) break;
        unsigned aoff[2][4], boff[2][2];
#pragma unroll
        for (int ai = 0; ai < 2; ++ai)
#pragma unroll
            for (int m = 0; m < 4; ++m) aoff[ai][m] = (unsigned)S.arow(u, 128 * ai + 64 * wr + 16 * m + fr) * (unsigned)(Cfg::LDA * 2) + (unsigned)fq * 16u;
#pragma unroll
        for (int bj = 0; bj < 2; ++bj)
#pragma unroll
            for (int n = 0; n < 2; ++n) boff[bj][n] = (unsigned)(bj * Cfg::BH + (Cfg::HEADMAP ? 64 : 32) * wc + perm32(16 * n + fr)) * (unsigned)(Cfg::LDB * 2) + (unsigned)fq * 16u;
        f32x4 acc[2][2][4][2];
#pragma unroll
        for (int a = 0; a < 2; ++a)
#pragma unroll
            for (int b = 0; b < 2; ++b)
#pragma unroll
                for (int m = 0; m < 4; ++m)
#pragma unroll
                    for (int n = 0; n < 2; ++n) acc[a][b][m][n] = (f32x4){0.f, 0.f, 0.f, 0.f};
        const char* Ab = (const char*)u.A; const char* Bb = (const char*)u.B;
#pragma unroll 1
        for (int k0 = 0; k0 < Cfg::K; k0 += 32) {
            bf16x8 af[2][4], bf[2][2];
#pragma unroll
            for (int ai = 0; ai < 2; ++ai)
#pragma unroll
                for (int m = 0; m < 4; ++m) af[ai][m] = *(const bf16x8*)(Ab + aoff[ai][m] + k0 * 2);
#pragma unroll
            for (int bj = 0; bj < 2; ++bj)
#pragma unroll
                for (int n = 0; n < 2; ++n) bf[bj][n] = *(const bf16x8*)(Bb + boff[bj][n] + k0 * 2);
#pragma unroll
            for (int ai = 0; ai < 2; ++ai)
#pragma unroll
                for (int bj = 0; bj < 2; ++bj)
#pragma unroll
                    for (int m = 0; m < 4; ++m)
#pragma unroll
                        for (int n = 0; n < 2; ++n) acc[ai][bj][m][n] = __builtin_amdgcn_mfma_f32_16x16x32_bf16(bf[bj][n], af[ai][m], acc[ai][bj][m][n], 0, 0, 0);
        }
        E(acc, u, wr, wc, fr, fq);
    }
}

struct SchedPool {
    const bf16_t* diff; const bf16_t* w;
    DI bool next(int i, Unit& u) const { const int L = i * gridDim.x + blockIdx.x; if (L >= 256) return false; u.pm = L >> 2; u.pn = L & 3; u.A = diff + 256 * u.pn; u.B = w + (size_t)u.pn * 65536; return true; }
    DI int arow(const Unit& u, int r) const { return u.pm * 256 + r; }
};
struct SchedDense {
    const bf16_t* A; const bf16_t* B; int npn, ldb;
    DI bool next(int i, Unit& u) const { const int L = i * gridDim.x + blockIdx.x; if (L >= 64 * npn) return false; u.pm = L / npn; u.pn = L % npn; u.A = A; u.B = B + (size_t)u.pn * 256 * ldb; return true; }
    DI int arow(const Unit& u, int r) const { return u.pm * 256 + r; }
};

struct EpiPool {
    float* x; bf16_t* xb; const float* pb; const float* ps;
    DI void operator()(const f32x4 (&acc)[2][2][4][2], const Unit& u, int wr, int wc, int fr, int fq) const {
#pragma unroll
        for (int ai = 0; ai < 2; ++ai)
#pragma unroll
            for (int m = 0; m < 4; ++m) {
                const int t = u.pm * 256 + 128 * ai + 64 * wr + 16 * m + fr;
#pragma unroll
                for (int bj = 0; bj < 2; ++bj) {
                    const int c = 256 * u.pn + 128 * bj + 32 * wc + 8 * fq;
                    float* xp = x + (size_t)t * DM + c;
                    f32x4 v0 = *(const f32x4*)xp, v1 = *(const f32x4*)(xp + 4);
                    v0 += (acc[ai][bj][m][0] + *(const f32x4*)(pb + c)) * *(const f32x4*)(ps + c);
                    v1 += (acc[ai][bj][m][1] + *(const f32x4*)(pb + c + 4)) * *(const f32x4*)(ps + c + 4);
                    *(f32x4*)xp = v0; *(f32x4*)(xp + 4) = v1;
                    u32x4 w; w[0] = cvt_pk_bf16(v0[0], v0[1]); w[1] = cvt_pk_bf16(v0[2], v0[3]); w[2] = cvt_pk_bf16(v1[0], v1[1]); w[3] = cvt_pk_bf16(v1[2], v1[3]);
                    *(u32x4*)(xb + (size_t)t * DM + c) = w;
                }
            }
    }
};
struct EpiWo {
    float* x; bf16_t* xb;
    DI void operator()(const f32x4 (&acc)[2][2][4][2], const Unit& u, int wr, int wc, int fr, int fq) const {
#pragma unroll
        for (int ai = 0; ai < 2; ++ai)
#pragma unroll
            for (int m = 0; m < 4; ++m) {
                const int t = u.pm * 256 + 128 * ai + 64 * wr + 16 * m + fr;
#pragma unroll
                for (int bj = 0; bj < 2; ++bj) {
                    const int c = 256 * u.pn + 128 * bj + 32 * wc + 8 * fq;
                    float* xp = x + (size_t)t * DM + c;
                    f32x4 v0 = *(const f32x4*)xp, v1 = *(const f32x4*)(xp + 4);
                    v0 += acc[ai][bj][m][0]; v1 += acc[ai][bj][m][1];
                    *(f32x4*)xp = v0; *(f32x4*)(xp + 4) = v1;
                    u32x4 w; w[0] = cvt_pk_bf16(v0[0], v0[1]); w[1] = cvt_pk_bf16(v0[2], v0[3]); w[2] = cvt_pk_bf16(v1[0], v1[1]); w[3] = cvt_pk_bf16(v1[2], v1[3]);
                    *(u32x4*)(xb + (size_t)t * DM + c) = w;
                }
            }
    }
};
struct EpiQKV {
    bf16_t* q; bf16_t* k; bf16_t* v; const float* rstd; const float* qg; const float* kg;
    DI void operator()(const f32x4 (&acc)[2][2][4][2], const Unit& u, int wr, int wc, int fr, int fq) const {
        const int which = u.pn >> 2, head = (u.pn & 3) * 4 + wc;
        bf16_t* out = which == 0 ? q : (which == 1 ? k : v);
        const float* gn = which == 0 ? qg : kg;
        const float post = which == 0 ? 0.125f : 1.0f;
        f32x4 g[2][2];
#pragma unroll
        for (int bj = 0; bj < 2; ++bj)
#pragma unroll
            for (int n = 0; n < 2; ++n) g[bj][n] = (which < 2) ? *(const f32x4*)(gn + 32 * bj + 8 * fq + 4 * n) * post : (f32x4){1.f, 1.f, 1.f, 1.f};
#pragma unroll
        for (int ai = 0; ai < 2; ++ai)
#pragma unroll
            for (int m = 0; m < 4; ++m) {
                const int t = u.pm * 256 + 128 * ai + 64 * wr + 16 * m + fr;
                const float rs = rstd[t];
                f32x4 v4[2][2]; float ss = 0.f;
#pragma unroll
                for (int bj = 0; bj < 2; ++bj)
#pragma unroll
                    for (int n = 0; n < 2; ++n) { v4[bj][n] = acc[ai][bj][m][n] * rs; const f32x4 s = v4[bj][n] * v4[bj][n]; ss += (s[0] + s[1]) + (s[2] + s[3]); }
                ss += __shfl_xor(ss, 16); ss += __shfl_xor(ss, 32);
                const float r2 = (which < 2) ? rsqrtf(ss * (1.0f / HD) + EPS) : 1.0f;
#pragma unroll
                for (int bj = 0; bj < 2; ++bj) {
                    const f32x4 a = v4[bj][0] * r2 * g[bj][0], b = v4[bj][1] * r2 * g[bj][1];
                    u32x4 w; w[0] = cvt_pk_bf16(a[0], a[1]); w[1] = cvt_pk_bf16(a[2], a[3]); w[2] = cvt_pk_bf16(b[0], b[1]); w[3] = cvt_pk_bf16(b[2], b[3]);
                    *(u32x4*)(out + (size_t)t * DM + head * HD + 32 * bj + 8 * fq) = w;
                }
            }
    }
};

DI float softplus_f(float z) { return fmaxf(z, 0.f) + __logf(1.0f + __expf(-fabsf(z))); }
DI void ph_attn(const Params& p) {
    const int tid = threadIdx.x, wid = tid >> 6, lane = tid & 63, l31 = lane & 31, h2 = lane >> 5;
    const bf16_t* Q = (const bf16_t*)(p.ws + WS_Q); const bf16_t* K = (const bf16_t*)(p.ws + WS_K); const bf16_t* V = (const bf16_t*)(p.ws + WS_V);
    bf16_t* O = (bf16_t*)(p.ws + WS_O);
    for (int it = 0; it < 4 * ((2 * NH * 256 / 32 - (int)blockIdx.x + (int)gridDim.x - 1) / (int)gridDim.x); ++it) {
        const int tsk = (blockIdx.x + (it >> 2) * gridDim.x) * 32 + (it & 3) * 8 + wid;
        const int bh = tsk >> 8, qb = tsk & 255, b = bh >> 4, h = bh & 15;
        const size_t tb = (size_t)b * SEQ;
        const int q0 = qb * 32;
        bf16x8 qf[4];
#pragma unroll
        for (int s = 0; s < 4; ++s) qf[s] = *(const bf16x8*)(Q + (tb + q0 + l31) * DM + h * HD + 16 * s + 8 * h2);
        f32x16 o0, o1;
#pragma unroll
        for (int r = 0; r < 16; ++r) { o0[r] = 0.f; o1[r] = 0.f; }
        float R = 0.f;
        for (int kt = qb; kt >= 0; --kt) {
            const int k0 = kt * 32;
            f32x16 z;
#pragma unroll
            for (int r = 0; r < 16; ++r) z[r] = 0.f;
#pragma unroll
            for (int s = 0; s < 4; ++s) {
                const bf16x8 kf = *(const bf16x8*)(K + (tb + k0 + l31) * DM + h * HD + 16 * s + 8 * h2);
                z = __builtin_amdgcn_mfma_f32_32x32x16_bf16(kf, qf[s], z, 0, 0, 0);
            }
            const bool diag = (kt == qb);
            float sp[16], gs[4], ot[4];
#pragma unroll
            for (int r = 0; r < 16; ++r) {
                const int kl = (r & 3) + 8 * (r >> 2) + 4 * h2;
                const bool valid = !diag || (kl < l31);
                sp[r] = valid ? softplus_f(z[r]) : 0.f;
            }
#pragma unroll
            for (int bb = 0; bb < 4; ++bb) { gs[bb] = (sp[4 * bb] + sp[4 * bb + 1]) + (sp[4 * bb + 2] + sp[4 * bb + 3]); ot[bb] = __shfl_xor(gs[bb], 32); }
            const float tot_own = (gs[0] + gs[1]) + (gs[2] + gs[3]);
            const float tot_oth = __shfl_xor(tot_own, 32);
            float later[4];
            {
                float own_tail = 0.f, oth_tail = 0.f;
#pragma unroll
                for (int bb = 3; bb >= 0; --bb) {
                    later[bb] = own_tail + oth_tail + (h2 == 0 ? ot[bb] : 0.f);
                    own_tail += gs[bb]; oth_tail += ot[bb];
                }
            }
            float a[16];
#pragma unroll
            for (int bb = 0; bb < 4; ++bb) {
                const float base = R + later[bb];
                const float s3 = base + sp[4 * bb + 3], s2 = s3 + sp[4 * bb + 2], s1 = s2 + sp[4 * bb + 1], s0 = s1 + sp[4 * bb];
                const float S[4] = {s0, s1, s2, s3};
#pragma unroll
                for (int i = 0; i < 4; ++i) {
                    const int r = 4 * bb + i, kl = (r & 3) + 8 * (r >> 2) + 4 * h2;
                    const bool valid = !diag || (kl < l31);
                    a[r] = valid ? __expf(z[r] - S[i]) : 0.f;
                }
            }
            R += (h2 == 0) ? (tot_own + tot_oth) : (tot_oth + tot_own);
#pragma unroll
            for (int s = 0; s < 2; ++s) {
                u32x4 pw;
#pragma unroll
                for (int i = 0; i < 4; ++i) pw[i] = cvt_pk_bf16(a[8 * s + 2 * i], a[8 * s + 2 * i + 1]);
                const bf16x8 pa = __builtin_bit_cast(bf16x8, pw);
#pragma unroll
                for (int db = 0; db < 2; ++db) {
                    bf16x8 vf;
#pragma unroll
                    for (int jj = 0; jj < 8; ++jj) {
                        const int key = k0 + 16 * s + 8 * (jj >> 2) + 4 * h2 + (jj & 3);
                        vf[jj] = (short)V[(tb + key) * DM + h * HD + 32 * db + l31];
                    }
                    if (db == 0) o0 = __builtin_amdgcn_mfma_f32_32x32x16_bf16(vf, pa, o0, 0, 0, 0);
                    else o1 = __builtin_amdgcn_mfma_f32_32x32x16_bf16(vf, pa, o1, 0, 0, 0);
                }
            }
            if (__all(R > 104.0f)) break;
        }
#pragma unroll
        for (int db = 0; db < 2; ++db)
#pragma unroll
            for (int rb = 0; rb < 4; ++rb) {
                const f32x16& o = db == 0 ? o0 : o1;
                u32x2 w; w[0] = cvt_pk_bf16(o[4 * rb], o[4 * rb + 1]); w[1] = cvt_pk_bf16(o[4 * rb + 2], o[4 * rb + 3]);
                *(u32x2*)(O + (tb + q0 + l31) * DM + h * HD + 32 * db + 8 * rb + 4 * h2) = w;
            }
    }
}

DI void ph_router(const Params& p, int li) {
    const int tid = threadIdx.x, wid = tid >> 6, lane = tid & 63;
    const float* gain = p.moe_norm + li * DM;
    const float* wg = p.moe_wg + (size_t)li * DM * 4;
    const float* wrt = p.moe_wr + (size_t)li * DM * 32;
    const float* bg = p.moe_bg + li * 4;
    const float* br = p.moe_br + li * 32;
    unsigned* cnt = (unsigned*)(p.ws + WS_CTL) + CW_CNT + 32 * li;
    Entry* list = (Entry*)(p.ws + WS_LIST);
    for (int t = blockIdx.x * NWAVE + wid; t < T; t += gridDim.x * NWAVE) {
        float hv[16]; float ss = 0.f;
#pragma unroll
        for (int i = 0; i < 4; ++i) {
            const f32x4 v = *(const f32x4*)(p.x + (size_t)t * DM + lane * 4 + 256 * i);
#pragma unroll
            for (int e = 0; e < 4; ++e) { hv[4 * i + e] = v[e]; ss += v[e] * v[e]; }
        }
        ss = wave_sum(ss);
        const float rs = rsqrtf(ss * (1.0f / DM) + EPS);
        float lg[36];
#pragma unroll
        for (int n = 0; n < 36; ++n) lg[n] = 0.f;
#pragma unroll
        for (int i = 0; i < 4; ++i)
#pragma unroll
            for (int e = 0; e < 4; ++e) {
                const int k = lane * 4 + 256 * i + e;
                const float hk = hv[4 * i + e] * rs * gain[k];
                const f32x4 g4 = *(const f32x4*)(wg + (size_t)k * 4);
#pragma unroll
                for (int n = 0; n < 4; ++n) lg[n] += hk * g4[n];
#pragma unroll
                for (int q = 0; q < 8; ++q) {
                    const f32x4 r4 = *(const f32x4*)(wrt + (size_t)k * 32 + 4 * q);
#pragma unroll
                    for (int n = 0; n < 4; ++n) lg[4 + 4 * q + n] += hk * r4[n];
                }
            }
#pragma unroll
        for (int n = 0; n < 36; ++n) lg[n] = wave_sum(lg[n]);
        float gl[4];
#pragma unroll
        for (int n = 0; n < 4; ++n) gl[n] = lg[n] + bg[n];
        int g = 0; float gm = gl[0];
#pragma unroll
        for (int n = 1; n < 4; ++n) if (gl[n] > gm) { gm = gl[n]; g = n; }
        float den = 0.f;
#pragma unroll
        for (int n = 0; n < 4; ++n) den += __expf(gl[n] - gm);
        const float gprob = 1.0f / den;
        float el[8];
#pragma unroll
        for (int n = 0; n < 8; ++n) {
            float v = 0.f;
#pragma unroll
            for (int gg = 0; gg < 4; ++gg) v = (g == gg) ? lg[4 + 8 * gg + n] + br[8 * gg + n] : v;
            el[n] = v;
        }
        int e1 = 0; float m1 = el[0];
#pragma unroll
        for (int n = 1; n < 8; ++n) if (el[n] > m1) { m1 = el[n]; e1 = n; }
        int e2 = -1; float m2 = -3.0e38f;
#pragma unroll
        for (int n = 0; n < 8; ++n) if (n != e1 && (e2 < 0 || el[n] > m2)) { m2 = el[n]; e2 = n; }
        const float ex = __expf(m2 - m1);
        const float w1 = gprob / (1.0f + ex), w2 = gprob * ex / (1.0f + ex);
        if (lane == 0) {
            const int ea = 8 * g + e1, eb = 8 * g + e2;
            const unsigned pa = atomicAdd(&cnt[ea], 1u), pb = atomicAdd(&cnt[eb], 1u);
            Entry A; A.dst = t; A.rstd = rs; A.w = w1; A.tok = t;
            Entry B; B.dst = T + t; B.rstd = rs; B.w = w2; B.tok = t;
            list[(size_t)ea * LIST_CAP + pa] = A;
            list[(size_t)eb * LIST_CAP + pb] = B;
        }
    }
}

struct SchedMoe {
    const unsigned* cnt; const Entry* list; const bf16_t* A; const bf16_t* W; int npn; bool gather; size_t w_estride; int w_pnrows, ldb;
    DI bool next(int i, Unit& u) const {
        const int L = i * gridDim.x + blockIdx.x;
        const int rt = L / npn; u.pn = L % npn;
        int acc = 0, e = 0, found = 0, j = 0, nv = 0;
        for (int ee = 0; ee < NE; ++ee) {
            const int c = (int)cnt[ee], nt = (c + 255) >> 8;
            if (!found && rt < acc + nt) { found = 1; e = ee; j = rt - acc; nv = c - 256 * j; }
            acc += nt;
        }
        if (!found) return false;
        u.e = e; u.nvalid = nv > 256 ? 256 : nv; u.row0 = 256 * rt; u.lbase = e * LIST_CAP + 256 * j; u.pm = rt;
        u.A = gather ? A : A + (size_t)u.row0 * DE;
        u.B = W + (size_t)e * w_estride + (size_t)u.pn * w_pnrows * ldb;
        return true;
    }
    DI int arow(const Unit& u, int r) const { if (!gather) return r; return (r < u.nvalid) ? list[u.lbase + r].tok : 0; }
};
struct EpiGU {
    bf16_t* hid; const Entry* list;
    DI void operator()(const f32x4 (&acc)[2][2][4][2], const Unit& u, int wr, int wc, int fr, int fq) const {
#pragma unroll
        for (int ai = 0; ai < 2; ++ai)
#pragma unroll
            for (int m = 0; m < 4; ++m) {
                const int r = 128 * ai + 64 * wr + 16 * m + fr;
                float rs = 0.f, w = 0.f;
                if (r < u.nvalid) { const Entry en = list[u.lbase + r]; rs = en.rstd; w = en.w; }
                unsigned pk[4];
#pragma unroll
                for (int n = 0; n < 2; ++n) {
                    float hv[4];
#pragma unroll
                    for (int e = 0; e < 4; ++e) { const float g = acc[ai][0][m][n][e] * rs, up = acc[ai][1][m][n][e] * rs; hv[e] = g / (1.0f + __expf(-g)) * up * w; }
                    pk[2 * n] = cvt_pk_bf16(hv[0], hv[1]); pk[2 * n + 1] = cvt_pk_bf16(hv[2], hv[3]);
                }
                u32x4 wv; wv[0] = pk[0]; wv[1] = pk[1]; wv[2] = pk[2]; wv[3] = pk[3];
                *(u32x4*)(hid + (size_t)(u.row0 + r) * DE + 128 * u.pn + 32 * wc + 8 * fq) = wv;
            }
    }
};
struct EpiDown {
    bf16_t* yb; const Entry* list;
    DI void operator()(const f32x4 (&acc)[2][2][4][2], const Unit& u, int wr, int wc, int fr, int fq) const {
#pragma unroll
        for (int ai = 0; ai < 2; ++ai)
#pragma unroll
            for (int m = 0; m < 4; ++m) {
                const int r = 128 * ai + 64 * wr + 16 * m + fr;
                const int dst = (r < u.nvalid) ? list[u.lbase + r].dst : DUMMY_ROW;
#pragma unroll
                for (int bj = 0; bj < 2; ++bj) {
                    const f32x4 a = acc[ai][bj][m][0], b = acc[ai][bj][m][1];
                    u32x4 w; w[0] = cvt_pk_bf16(a[0], a[1]); w[1] = cvt_pk_bf16(a[2], a[3]); w[2] = cvt_pk_bf16(b[0], b[1]); w[3] = cvt_pk_bf16(b[2], b[3]);
                    *(u32x4*)(yb + (size_t)dst * DM + 256 * u.pn + 128 * bj + 32 * wc + 8 * fq) = w;
                }
            }
    }
};

DI void ph_poolgemm(const Params& p, int j) {
    SchedPool S; S.diff = (const bf16_t*)(p.ws + WS_DIFF); S.w = (const bf16_t*)(p.ws + WS_WPOOL) + (size_t)j * 4 * 65536;
    EpiPool E; E.x = p.x; E.xb = (bf16_t*)(p.ws + WS_XB); E.pb = p.pool_b + j * DM; E.ps = p.pool_scale + j * DM;
    gemm_phase<GCfg<1024, 256, 256, 128, false>>(S, E);
}
DI void ph_qkv(const Params& p, int j) {
    SchedDense S; S.A = (const bf16_t*)(p.ws + WS_XB); S.B = (const bf16_t*)(p.ws + WS_WQKV) + (size_t)j * 3072 * 1024; S.npn = 12; S.ldb = 1024;
    EpiQKV E; E.q = (bf16_t*)(p.ws + WS_Q); E.k = (bf16_t*)(p.ws + WS_K); E.v = (bf16_t*)(p.ws + WS_V); E.rstd = (const float*)(p.ws + WS_RSTD); E.qg = p.sb_qg + j * HD; E.kg = p.sb_kg + j * HD;
    gemm_phase<GCfg<1024, 1024, 1024, 32, true>>(S, E);
}
DI void ph_wo(const Params& p, int j) {
    SchedDense S; S.A = (const bf16_t*)(p.ws + WS_O); S.B = (const bf16_t*)(p.ws + WS_WO) + (size_t)j * 1024 * 1024; S.npn = 4; S.ldb = 1024;
    EpiWo E; E.x = p.x; E.xb = (bf16_t*)(p.ws + WS_XB);
    gemm_phase<GCfg<1024, 1024, 1024, 128, false>>(S, E);
}
DI void ph_gu(const Params& p, int li) {
    SchedMoe S; S.cnt = (const unsigned*)(p.ws + WS_CTL) + CW_CNT + 32 * li; S.list = (const Entry*)(p.ws + WS_LIST); S.A = (const bf16_t*)(p.ws + WS_XB);
    S.W = (const bf16_t*)(p.ws + WS_WGU) + (size_t)li * NE * 512 * 1024; S.npn = 2; S.gather = true; S.w_estride = (size_t)512 * 1024; S.w_pnrows = 128; S.ldb = 1024;
    EpiGU E; E.hid = (bf16_t*)(p.ws + WS_HID); E.list = S.list;
    gemm_phase<GCfg<1024, 1024, 1024, 256, false>>(S, E);
}
DI void ph_down(const Params& p, int li) {
    SchedMoe S; S.cnt = (const unsigned*)(p.ws + WS_CTL) + CW_CNT + 32 * li; S.list = (const Entry*)(p.ws + WS_LIST); S.A = (const bf16_t*)(p.ws + WS_HID);
    S.W = (const bf16_t*)(p.ws + WS_WD) + (size_t)li * NE * 1024 * 256; S.npn = 4; S.gather = false; S.w_estride = (size_t)1024 * 256; S.w_pnrows = 256; S.ldb = 256;
    EpiDown E; E.yb = (bf16_t*)(p.ws + WS_YBUF); E.list = S.list;
    gemm_phase<GCfg<256, 256, 256, 128, false>>(S, E);
}

enum { PH_PRO = 0, PH_COMB_FIRST, PH_COMB, PH_COMB_XB, PH_DIFF, PH_POOLG, PH_QKV, PH_ATTN, PH_WO, PH_ROUTER, PH_GU, PH_DOWN, PH_FINAL };

template <int PH>
__global__ void __launch_bounds__(NTHR, 2) k_phase(Params p, int arg) {
    __shared__ float lds[64 * 65];
    if (PH == PH_PRO) ph_prologue(p, lds);
    else if (PH == PH_COMB_FIRST) ph_combine<true, false, false>(p);
    else if (PH == PH_COMB) ph_combine<false, true, false>(p);
    else if (PH == PH_COMB_XB) ph_combine<false, true, true>(p);
    else if (PH == PH_DIFF) ph_pooldiff(p, arg);
    else if (PH == PH_POOLG) ph_poolgemm(p, arg);
    else if (PH == PH_QKV) ph_qkv(p, arg);
    else if (PH == PH_ATTN) ph_attn(p);
    else if (PH == PH_WO) ph_wo(p, arg);
    else if (PH == PH_ROUTER) ph_router(p, arg);
    else if (PH == PH_GU) ph_gu(p, arg);
    else if (PH == PH_DOWN) ph_down(p, arg);
    else if (PH == PH_FINAL) ph_combine<false, true, false>(p);
}

extern "C" void kernel_launch(void* const* d_in, const int* in_sizes, int n_in, void* d_out, int out_size, void* d_ws, size_t ws_size, hipStream_t stream) {
    if (ws_size < WS_END || n_in < 18) return;
    Params p{};
    p.x_in = (const float*)d_in[0]; p.pool_norm = (const float*)d_in[1]; p.pool_w = (const float*)d_in[2]; p.pool_b = (const float*)d_in[3]; p.pool_scale = (const float*)d_in[4];
    p.sb_norm = (const float*)d_in[5]; p.sb_wqkv = (const float*)d_in[6]; p.sb_qg = (const float*)d_in[7]; p.sb_kg = (const float*)d_in[8]; p.sb_wo = (const float*)d_in[9];
    p.moe_norm = (const float*)d_in[10]; p.moe_wg = (const float*)d_in[11]; p.moe_bg = (const float*)d_in[12]; p.moe_wr = (const float*)d_in[13]; p.moe_br = (const float*)d_in[14];
    p.moe_wgate = (const float*)d_in[15]; p.moe_wup = (const float*)d_in[16]; p.moe_wdown = (const float*)d_in[17];
    p.x = (float*)d_out; p.ws = (unsigned char*)d_ws;
    (void)hipMemsetAsync((char*)d_ws + WS_CTL, 0, CTL_BYTES, stream);
    const dim3 g(256), b(NTHR);
#define RUN(PH, a) hipLaunchKernelGGL(k_phase<PH>, g, b, 0, stream, p, (a))
    RUN(PH_PRO, 0);
    for (int i = 0; i < DEPTH; ++i) {
        const int j = i >> 1;
        if ((i & 1) == 0) {
            if (i == 0) RUN(PH_COMB_FIRST, 0); else RUN(PH_COMB, 0);
            RUN(PH_DIFF, j);
            RUN(PH_POOLG, j);
        } else {
            RUN(PH_COMB_XB, 0);
            RUN(PH_QKV, j);
            RUN(PH_ATTN, 0);
            RUN(PH_WO, j);
        }
        RUN(PH_ROUTER, i);
        RUN(PH_GU, i);
        RUN(PH_DOWN, i);
    }
    RUN(PH_FINAL, 0);
#undef RUN
}
```

```cpp
#include <hip/hip_runtime.h>
#include <stdint.h>

#define DI __device__ __forceinline__
typedef unsigned short bf16_t;
typedef short bf16x8 __attribute__((ext_vector_type(8)));
typedef float f32x4 __attribute__((ext_vector_type(4)));
typedef float f32x16 __attribute__((ext_vector_type(16)));
typedef unsigned u32x4 __attribute__((ext_vector_type(4)));
typedef unsigned u32x2 __attribute__((ext_vector_type(2)));

constexpr int T = 16384, DM = 1024, SEQ = 8192, NH = 16, HD = 64, DEPTH = 4, NE = 32, DE = 256;
constexpr float EPS = 1e-6f;
constexpr int NTHR = 512, NWAVE = 8;
constexpr int LIST_CAP = 16384;
constexpr int DUMMY_ROW = 2 * T;

constexpr size_t MiB = 1u << 20;
constexpr size_t WS_CTL = 0, CTL_BYTES = 1 * MiB;
constexpr size_t WS_WQKV = 1 * MiB;
constexpr size_t WS_WO = 13 * MiB;
constexpr size_t WS_WPOOL = 17 * MiB;
constexpr size_t WS_RSTD = 18 * MiB;
constexpr size_t WS_WGU = 20 * MiB;
constexpr size_t WS_WD = 148 * MiB;
constexpr size_t WS_XB = 212 * MiB;
constexpr size_t WS_LIST = 244 * MiB;
constexpr size_t WS_Q = 256 * MiB;
constexpr size_t WS_DIFF = WS_Q;
constexpr size_t WS_K = 288 * MiB, WS_V = 320 * MiB, WS_O = 352 * MiB;
constexpr size_t WS_YBUF = 288 * MiB;
constexpr size_t WS_HID = 354 * MiB;
constexpr size_t WS_END = 384 * MiB;
static_assert(WS_V - WS_K == WS_K - WS_Q, "Q, K, V equally spaced");
static_assert(WS_YBUF + (size_t)(2 * T + 1) * DM * 2 <= WS_HID, "ybuf");
static_assert(WS_HID + (size_t)(2 * T + NE * 256) * DE * 2 <= WS_END, "hid");
constexpr int CW_CNT = 1024;

struct Entry { int dst; float rstd; float w; int tok; };

struct Params {
    const float* x_in; const float* pool_norm; const float* pool_w; const float* pool_b; const float* pool_scale;
    const float* sb_norm; const float* sb_wqkv; const float* sb_qg; const float* sb_kg; const float* sb_wo;
    const float* moe_norm; const float* moe_wg; const float* moe_bg; const float* moe_wr; const float* moe_br;
    const float* moe_wgate; const float* moe_wup; const float* moe_wdown;
    float* x;
    unsigned char* ws;
};

typedef const unsigned long long __attribute__((address_space(4)))* KArgPtr;
DI Params load_params() {
    KArgPtr q = (KArgPtr)__builtin_amdgcn_kernarg_segment_ptr(); asm volatile("" : "+s"(q));
    Params p;
    p.x_in = (const float*)q[0]; p.pool_norm = (const float*)q[1]; p.pool_w = (const float*)q[2]; p.pool_b = (const float*)q[3]; p.pool_scale = (const float*)q[4];
    p.sb_norm = (const float*)q[5]; p.sb_wqkv = (const float*)q[6]; p.sb_qg = (const float*)q[7]; p.sb_kg = (const float*)q[8]; p.sb_wo = (const float*)q[9];
    p.moe_norm = (const float*)q[10]; p.moe_wg = (const float*)q[11]; p.moe_bg = (const float*)q[12]; p.moe_wr = (const float*)q[13]; p.moe_br = (const float*)q[14];
    p.moe_wgate = (const float*)q[15]; p.moe_wup = (const float*)q[16]; p.moe_wdown = (const float*)q[17];
    p.x = (float*)q[18]; p.ws = (unsigned char*)q[19];
    return p;
}
#define LOAD_PARAMS() const Params p = load_params()
DI int tid_() { int t = threadIdx.x; asm volatile("" : "+v"(t)); return t; }
DI int bid_() { int b = blockIdx.x; asm volatile("" : "+s"(b)); return b; }

DI unsigned cvt_pk_bf16(float lo, float hi) { unsigned r; asm volatile("v_cvt_pk_bf16_f32 %0, %1, %2" : "=v"(r) : "v"(lo), "v"(hi)); return r; }
DI float bf_lo(unsigned u) { return __uint_as_float(u << 16); }
DI float bf_hi(unsigned u) { return __uint_as_float(u & 0xffff0000u); }
DI float shflx(float v, int lane, int m) { return __int_as_float(__builtin_amdgcn_ds_bpermute((lane ^ m) << 2, __float_as_int(v))); }
DI float wave_sum(float v, int lane) {
#pragma unroll
    for (int o = 32; o >= 1; o >>= 1) v += shflx(v, lane, o);
    return v;
}
DI int perm32(int rho) { const int n = rho >> 4, i = rho & 15; return 8 * (i >> 2) + 4 * n + (i & 3); }

DI void cvt_tiles(const float* src, int K, int N, size_t src_mstride, bf16_t* dst, size_t dst_mstride, const float* scale, int scale_div, int nmat, float* lds, int tid, int bid) {
    const int tk = K / 64, tn = N / 64, per = tk * tn;
    for (int tile = bid; tile < nmat * per; tile += gridDim.x) {
        const int mat = tile / per, rem = tile % per, k0 = (rem / tn) * 64, n0 = (rem % tn) * 64;
        const float* s = src + (size_t)mat * src_mstride;
        bf16_t* d = dst + (size_t)mat * dst_mstride;
        const float* sc = scale ? scale + (size_t)(mat / scale_div) * K : nullptr;
        __syncthreads();
#pragma unroll
        for (int it = 0; it < 8; ++it) {
            const int k = it * 8 + (tid >> 6), n = tid & 63;
            float v = s[(size_t)(k0 + k) * N + n0 + n];
            if (sc) v *= sc[k0 + k];
            lds[k * 65 + n] = v;
        }
        __syncthreads();
#pragma unroll
        for (int it = 0; it < 4; ++it) {
            const int kp = (tid & 31) * 2, n = (tid >> 5) + 16 * it;
            const unsigned w = cvt_pk_bf16(lds[kp * 65 + n], lds[(kp + 1) * 65 + n]);
            *(unsigned*)(d + (size_t)(n0 + n) * K + k0 + kp) = w;
        }
    }
}
DI void ph_prologue(float* lds) {
    LOAD_PARAMS();
    const int tid = tid_(), bid = bid_();
    cvt_tiles(p.sb_wqkv, 1024, 3072, (size_t)1024 * 3072, (bf16_t*)(p.ws + WS_WQKV), (size_t)3072 * 1024, p.sb_norm, 1, 2, lds, tid, bid);
    cvt_tiles(p.sb_wo, 1024, 1024, (size_t)1024 * 1024, (bf16_t*)(p.ws + WS_WO), (size_t)1024 * 1024, nullptr, 1, 2, lds, tid, bid);
    cvt_tiles(p.pool_w, 256, 256, (size_t)65536, (bf16_t*)(p.ws + WS_WPOOL), (size_t)65536, nullptr, 1, 8, lds, tid, bid);
    cvt_tiles(p.moe_wgate, 1024, 256, (size_t)1024 * 256, (bf16_t*)(p.ws + WS_WGU), (size_t)512 * 1024, p.moe_norm, 32, 128, lds, tid, bid);
    cvt_tiles(p.moe_wup, 1024, 256, (size_t)1024 * 256, (bf16_t*)(p.ws + WS_WGU) + (size_t)256 * 1024, (size_t)512 * 1024, p.moe_norm, 32, 128, lds, tid, bid);
    cvt_tiles(p.moe_wdown, 256, 1024, (size_t)256 * 1024, (bf16_t*)(p.ws + WS_WD), (size_t)1024 * 256, nullptr, 1, 128, lds, tid, bid);
}

DI void ph_combine(bool first, bool has_y, bool write_xb) {
    LOAD_PARAMS();
    const float* src = first ? p.x_in : p.x;
    const int tid = tid_(), bid = bid_(), wid = tid >> 6, lane = tid & 63;
    const bf16_t* yb = (const bf16_t*)(p.ws + WS_YBUF);
    bf16_t* xb = (bf16_t*)(p.ws + WS_XB);
    float* rstd = (float*)(p.ws + WS_RSTD);
    for (int t = bid * NWAVE + wid; t < T; t += gridDim.x * NWAVE) {
        float ss = 0.f;
#pragma unroll
        for (int i = 0; i < 4; ++i) {
            const int c = lane * 4 + 256 * i;
            f32x4 v = *(const f32x4*)(src + (size_t)t * DM + c);
            if (has_y) {
                const u32x2 a = *(const u32x2*)(yb + (size_t)t * DM + c), b = *(const u32x2*)(yb + (size_t)(T + t) * DM + c);
                v[0] += bf_lo(a[0]) + bf_lo(b[0]); v[1] += bf_hi(a[0]) + bf_hi(b[0]); v[2] += bf_lo(a[1]) + bf_lo(b[1]); v[3] += bf_hi(a[1]) + bf_hi(b[1]);
            }
            *(f32x4*)(p.x + (size_t)t * DM + c) = v;
            if (write_xb) { u32x2 w; w[0] = cvt_pk_bf16(v[0], v[1]); w[1] = cvt_pk_bf16(v[2], v[3]); *(u32x2*)(xb + (size_t)t * DM + c) = w; }
            ss += v[0] * v[0] + v[1] * v[1] + v[2] * v[2] + v[3] * v[3];
        }
        ss = wave_sum(ss, lane);
        if (lane == 0) rstd[t] = rsqrtf(ss * (1.0f / DM) + EPS);
    }
}

DI void ph_pooldiff(int j) {
    LOAD_PARAMS();
    const float* rstd = (const float*)(p.ws + WS_RSTD);
    const float* gain = p.pool_norm + j * DM;
    bf16_t* diff = (bf16_t*)(p.ws + WS_DIFF);
    for (int idx = bid_() * NTHR + tid_(); idx < T * 128; idx += gridDim.x * NTHR) {
        const int t = idx >> 7, c = (idx & 127) * 8, g = c >> 8, win = 2 << g, s = t & (SEQ - 1);
        const int cnt = (s + 1 < win) ? s + 1 : win;
        f32x4 a0 = {0.f, 0.f, 0.f, 0.f}, a1 = {0.f, 0.f, 0.f, 0.f}, o0, o1;
        for (int u = 0; u < cnt; ++u) {
            const float r = rstd[t - u];
            const f32x4 v0 = *(const f32x4*)(p.x + (size_t)(t - u) * DM + c), v1 = *(const f32x4*)(p.x + (size_t)(t - u) * DM + c + 4);
            if (u == 0) { o0 = v0 * r; o1 = v1 * r; }
            a0 += v0 * r; a1 += v1 * r;
        }
        const float inv = 1.0f / (float)cnt;
        const f32x4 g0 = *(const f32x4*)(gain + c), g1 = *(const f32x4*)(gain + c + 4);
        const f32x4 d0 = (a0 * inv - o0) * g0, d1 = (a1 * inv - o1) * g1;
        u32x4 w; w[0] = cvt_pk_bf16(d0[0], d0[1]); w[1] = cvt_pk_bf16(d0[2], d0[3]); w[2] = cvt_pk_bf16(d1[0], d1[1]); w[3] = cvt_pk_bf16(d1[2], d1[3]);
        *(u32x4*)(diff + (size_t)t * DM + c) = w;
    }
}

struct Unit { const bf16_t* A; const bf16_t* B; int pm, pn, e, nvalid, row0, lbase; };
template <int LDA_, int LDB_, int K_, int BH_, bool HEADMAP_> struct GCfg { static constexpr int LDA = LDA_, LDB = LDB_, K = K_, BH = BH_; static constexpr bool HEADMAP = HEADMAP_; };

template <class Cfg, class Sched, class Epi>
DI void gemm_phase(const Sched& S, const Epi& E) {
    const int tid = tid_(), wid = __builtin_amdgcn_readfirstlane(tid >> 6), lane = tid & 63, wr = wid >> 2, wc = wid & 3, fr = lane & 15, fq = lane >> 4;
    for (int ui = 0;; ++ui) {
        Unit u;
        if (!S.next(ui, u)) break;
        unsigned aoff[2][4], boff[2][2];
#pragma unroll
        for (int ai = 0; ai < 2; ++ai)
#pragma unroll
            for (int m = 0; m < 4; ++m) aoff[ai][m] = (unsigned)S.arow(u, 128 * ai + 64 * wr + 16 * m + fr) * (unsigned)(Cfg::LDA * 2) + (unsigned)fq * 16u;
#pragma unroll
        for (int bj = 0; bj < 2; ++bj)
#pragma unroll
            for (int n = 0; n < 2; ++n) boff[bj][n] = (unsigned)(bj * Cfg::BH + (Cfg::HEADMAP ? 64 : 32) * wc + perm32(16 * n + fr)) * (unsigned)(Cfg::LDB * 2) + (unsigned)fq * 16u;
        f32x4 acc[2][2][4][2];
#pragma unroll
        for (int a = 0; a < 2; ++a)
#pragma unroll
            for (int b = 0; b < 2; ++b)
#pragma unroll
                for (int m = 0; m < 4; ++m)
#pragma unroll
                    for (int n = 0; n < 2; ++n) acc[a][b][m][n] = (f32x4){0.f, 0.f, 0.f, 0.f};
        const char* Ab = (const char*)u.A; const char* Bb = (const char*)u.B;
#pragma unroll 1
        for (int k0 = 0; k0 < Cfg::K; k0 += 32) {
            bf16x8 af[2][4], bf[2][2];
#pragma unroll
            for (int ai = 0; ai < 2; ++ai)
#pragma unroll
                for (int m = 0; m < 4; ++m) af[ai][m] = *(const bf16x8*)(Ab + aoff[ai][m] + k0 * 2);
#pragma unroll
            for (int bj = 0; bj < 2; ++bj)
#pragma unroll
                for (int n = 0; n < 2; ++n) bf[bj][n] = *(const bf16x8*)(Bb + boff[bj][n] + k0 * 2);
#pragma unroll
            for (int ai = 0; ai < 2; ++ai)
#pragma unroll
                for (int bj = 0; bj < 2; ++bj)
#pragma unroll
                    for (int m = 0; m < 4; ++m)
#pragma unroll
                        for (int n = 0; n < 2; ++n) acc[ai][bj][m][n] = __builtin_amdgcn_mfma_f32_16x16x32_bf16(bf[bj][n], af[ai][m], acc[ai][bj][m][n], 0, 0, 0);
        }
        E(acc, u, wr, wc, fr, fq);
    }
}

struct SchedPool {
    const bf16_t* diff; const bf16_t* w; int bid;
    DI bool next(int i, Unit& u) const { const int L = i * gridDim.x + bid; if (L >= 256) return false; u.pm = L >> 2; u.pn = L & 3; u.A = diff + 256 * u.pn; u.B = w + (size_t)u.pn * 65536; return true; }
    DI int arow(const Unit& u, int r) const { return u.pm * 256 + r; }
};
struct SchedDense {
    const bf16_t* A; const bf16_t* B; int npn, ldb, bid;
    DI bool next(int i, Unit& u) const { const int L = i * gridDim.x + bid; if (L >= 64 * npn) return false; u.pm = L / npn; u.pn = L % npn; u.A = A; u.B = B + (size_t)u.pn * 256 * ldb; return true; }
    DI int arow(const Unit& u, int r) const { return u.pm * 256 + r; }
};

struct EpiPool {
    float* x; bf16_t* xb; const float* pb; const float* ps;
    DI void operator()(const f32x4 (&acc)[2][2][4][2], const Unit& u, int wr, int wc, int fr, int fq) const {
#pragma unroll
        for (int ai = 0; ai < 2; ++ai)
#pragma unroll
            for (int m = 0; m < 4; ++m) {
                const int t = u.pm * 256 + 128 * ai + 64 * wr + 16 * m + fr;
#pragma unroll
                for (int bj = 0; bj < 2; ++bj) {
                    const int c = 256 * u.pn + 128 * bj + 32 * wc + 8 * fq;
                    float* xp = x + (size_t)t * DM + c;
                    f32x4 v0 = *(const f32x4*)xp, v1 = *(const f32x4*)(xp + 4);
                    v0 += (acc[ai][bj][m][0] + *(const f32x4*)(pb + c)) * *(const f32x4*)(ps + c);
                    v1 += (acc[ai][bj][m][1] + *(const f32x4*)(pb + c + 4)) * *(const f32x4*)(ps + c + 4);
                    *(f32x4*)xp = v0; *(f32x4*)(xp + 4) = v1;
                    u32x4 w; w[0] = cvt_pk_bf16(v0[0], v0[1]); w[1] = cvt_pk_bf16(v0[2], v0[3]); w[2] = cvt_pk_bf16(v1[0], v1[1]); w[3] = cvt_pk_bf16(v1[2], v1[3]);
                    *(u32x4*)(xb + (size_t)t * DM + c) = w;
                }
            }
    }
};
struct EpiWo {
    float* x; bf16_t* xb;
    DI void operator()(const f32x4 (&acc)[2][2][4][2], const Unit& u, int wr, int wc, int fr, int fq) const {
#pragma unroll
        for (int ai = 0; ai < 2; ++ai)
#pragma unroll
            for (int m = 0; m < 4; ++m) {
                const int t = u.pm * 256 + 128 * ai + 64 * wr + 16 * m + fr;
#pragma unroll
                for (int bj = 0; bj < 2; ++bj) {
                    const int c = 256 * u.pn + 128 * bj + 32 * wc + 8 * fq;
                    float* xp = x + (size_t)t * DM + c;
                    f32x4 v0 = *(const f32x4*)xp, v1 = *(const f32x4*)(xp + 4);
                    v0 += acc[ai][bj][m][0]; v1 += acc[ai][bj][m][1];
                    *(f32x4*)xp = v0; *(f32x4*)(xp + 4) = v1;
                    u32x4 w; w[0] = cvt_pk_bf16(v0[0], v0[1]); w[1] = cvt_pk_bf16(v0[2], v0[3]); w[2] = cvt_pk_bf16(v1[0], v1[1]); w[3] = cvt_pk_bf16(v1[2], v1[3]);
                    *(u32x4*)(xb + (size_t)t * DM + c) = w;
                }
            }
    }
};
struct EpiQKV {
    bf16_t* q; const float* rstd; const float* qg; const float* kg;
    DI void operator()(const f32x4 (&acc)[2][2][4][2], const Unit& u, int wr, int wc, int fr, int fq) const {
        const int which = u.pn >> 2, head = (u.pn & 3) * 4 + wc;
        bf16_t* out = q + (size_t)which * ((WS_K - WS_Q) / 2);
        const float* gn = which == 0 ? qg : kg;
        const float post = which == 0 ? 0.125f : 1.0f;
        f32x4 g[2][2];
#pragma unroll
        for (int bj = 0; bj < 2; ++bj)
#pragma unroll
            for (int n = 0; n < 2; ++n) g[bj][n] = (which < 2) ? *(const f32x4*)(gn + 32 * bj + 8 * fq + 4 * n) * post : (f32x4){1.f, 1.f, 1.f, 1.f};
#pragma unroll
        for (int ai = 0; ai < 2; ++ai)
#pragma unroll
            for (int m = 0; m < 4; ++m) {
                const int t = u.pm * 256 + 128 * ai + 64 * wr + 16 * m + fr;
                const float rs = rstd[t];
                f32x4 v4[2][2]; float ss = 0.f;
#pragma unroll
                for (int bj = 0; bj < 2; ++bj)
#pragma unroll
                    for (int n = 0; n < 2; ++n) { v4[bj][n] = acc[ai][bj][m][n] * rs; const f32x4 s = v4[bj][n] * v4[bj][n]; ss += (s[0] + s[1]) + (s[2] + s[3]); }
                ss += shflx(ss, fr + 16 * fq, 16); ss += shflx(ss, fr + 16 * fq, 32);
                const float r2 = (which < 2) ? rsqrtf(ss * (1.0f / HD) + EPS) : 1.0f;
#pragma unroll
                for (int bj = 0; bj < 2; ++bj) {
                    const f32x4 a = v4[bj][0] * r2 * g[bj][0], b = v4[bj][1] * r2 * g[bj][1];
                    u32x4 w; w[0] = cvt_pk_bf16(a[0], a[1]); w[1] = cvt_pk_bf16(a[2], a[3]); w[2] = cvt_pk_bf16(b[0], b[1]); w[3] = cvt_pk_bf16(b[2], b[3]);
                    *(u32x4*)(out + (size_t)t * DM + head * HD + 32 * bj + 8 * fq) = w;
                }
            }
    }
};

DI float softplus_f(float z) { return fmaxf(z, 0.f) + __logf(1.0f + __expf(-fabsf(z))); }
DI void ph_attn() {
    LOAD_PARAMS();
    const int tid = tid_(), bid = bid_(), wid = tid >> 6, lane = tid & 63, l31 = lane & 31, h2 = lane >> 5;
    const bf16_t* Q = (const bf16_t*)(p.ws + WS_Q); const bf16_t* K = (const bf16_t*)(p.ws + WS_K); const bf16_t* V = (const bf16_t*)(p.ws + WS_V);
    bf16_t* O = (bf16_t*)(p.ws + WS_O);
    for (int it = 0; it < 4 * ((2 * NH * 256 / 32 - bid + (int)gridDim.x - 1) / (int)gridDim.x); ++it) {
        const int tsk = (bid + (it >> 2) * gridDim.x) * 32 + (it & 3) * 8 + wid;
        const int bh = tsk >> 8, qb = tsk & 255, b = bh >> 4, h = bh & 15;
        const size_t tb = (size_t)b * SEQ;
        const int q0 = qb * 32;
        bf16x8 qf[4];
#pragma unroll
        for (int s = 0; s < 4; ++s) qf[s] = *(const bf16x8*)(Q + (tb + q0 + l31) * DM + h * HD + 16 * s + 8 * h2);
        f32x16 o0, o1;
#pragma unroll
        for (int r = 0; r < 16; ++r) { o0[r] = 0.f; o1[r] = 0.f; }
        float R = 0.f;
        for (int kt = qb; kt >= 0; --kt) {
            const int k0 = kt * 32;
            f32x16 z;
#pragma unroll
            for (int r = 0; r < 16; ++r) z[r] = 0.f;
#pragma unroll
            for (int s = 0; s < 4; ++s) {
                const bf16x8 kf = *(const bf16x8*)(K + (tb + k0 + l31) * DM + h * HD + 16 * s + 8 * h2);
                z = __builtin_amdgcn_mfma_f32_32x32x16_bf16(kf, qf[s], z, 0, 0, 0);
            }
            const bool diag = (kt == qb);
            float sp[16], gs[4], ot[4];
#pragma unroll
            for (int r = 0; r < 16; ++r) {
                const int kl = (r & 3) + 8 * (r >> 2) + 4 * h2;
                const bool valid = !diag || (kl < l31);
                sp[r] = valid ? softplus_f(z[r]) : 0.f;
            }
#pragma unroll
            for (int bb = 0; bb < 4; ++bb) { gs[bb] = (sp[4 * bb] + sp[4 * bb + 1]) + (sp[4 * bb + 2] + sp[4 * bb + 3]); ot[bb] = shflx(gs[bb], lane, 32); }
            const float tot_own = (gs[0] + gs[1]) + (gs[2] + gs[3]);
            const float tot_oth = shflx(tot_own, lane, 32);
            float later[4];
            {
                float own_tail = 0.f, oth_tail = 0.f;
#pragma unroll
                for (int bb = 3; bb >= 0; --bb) {
                    later[bb] = own_tail + oth_tail + (h2 == 0 ? ot[bb] : 0.f);
                    own_tail += gs[bb]; oth_tail += ot[bb];
                }
            }
            float a[16];
#pragma unroll
            for (int bb = 0; bb < 4; ++bb) {
                const float base = R + later[bb];
                const float s3 = base + sp[4 * bb + 3], s2 = s3 + sp[4 * bb + 2], s1 = s2 + sp[4 * bb + 1], s0 = s1 + sp[4 * bb];
                const float S[4] = {s0, s1, s2, s3};
#pragma unroll
                for (int i = 0; i < 4; ++i) {
                    const int r = 4 * bb + i, kl = (r & 3) + 8 * (r >> 2) + 4 * h2;
                    const bool valid = !diag || (kl < l31);
                    a[r] = valid ? __expf(z[r] - S[i]) : 0.f;
                }
            }
            R += (h2 == 0) ? (tot_own + tot_oth) : (tot_oth + tot_own);
#pragma unroll
            for (int s = 0; s < 2; ++s) {
                u32x4 pw;
#pragma unroll
                for (int i = 0; i < 4; ++i) pw[i] = cvt_pk_bf16(a[8 * s + 2 * i], a[8 * s + 2 * i + 1]);
                const bf16x8 pa = __builtin_bit_cast(bf16x8, pw);
#pragma unroll
                for (int db = 0; db < 2; ++db) {
                    bf16x8 vf;
#pragma unroll
                    for (int jj = 0; jj < 8; ++jj) {
                        const int key = k0 + 16 * s + 8 * (jj >> 2) + 4 * h2 + (jj & 3);
                        vf[jj] = (short)V[(tb + key) * DM + h * HD + 32 * db + l31];
                    }
                    if (db == 0) o0 = __builtin_amdgcn_mfma_f32_32x32x16_bf16(vf, pa, o0, 0, 0, 0);
                    else o1 = __builtin_amdgcn_mfma_f32_32x32x16_bf16(vf, pa, o1, 0, 0, 0);
                }
            }
            if (__all(R > 104.0f)) break;
        }
#pragma unroll
        for (int db = 0; db < 2; ++db)
#pragma unroll
            for (int rb = 0; rb < 4; ++rb) {
                const f32x16& o = db == 0 ? o0 : o1;
                u32x2 w; w[0] = cvt_pk_bf16(o[4 * rb], o[4 * rb + 1]); w[1] = cvt_pk_bf16(o[4 * rb + 2], o[4 * rb + 3]);
                *(u32x2*)(O + (tb + q0 + l31) * DM + h * HD + 32 * db + 8 * rb + 4 * h2) = w;
            }
    }
}

DI void ph_router(int li) {
    LOAD_PARAMS();
    const int tid = tid_(), bid = bid_(), wid = tid >> 6, lane = tid & 63;
    const float* gain = p.moe_norm + li * DM;
    const float* wg = p.moe_wg + (size_t)li * DM * 4;
    const float* wrt = p.moe_wr + (size_t)li * DM * 32;
    const float* bg = p.moe_bg + li * 4;
    const float* br = p.moe_br + li * 32;
    unsigned* cnt = (unsigned*)(p.ws + WS_CTL) + CW_CNT + 32 * li;
    Entry* list = (Entry*)(p.ws + WS_LIST);
    for (int t = bid * NWAVE + wid; t < T; t += gridDim.x * NWAVE) {
        float hv[16]; float ss = 0.f;
#pragma unroll
        for (int i = 0; i < 4; ++i) {
            const f32x4 v = *(const f32x4*)(p.x + (size_t)t * DM + lane * 4 + 256 * i);
#pragma unroll
            for (int e = 0; e < 4; ++e) { hv[4 * i + e] = v[e]; ss += v[e] * v[e]; }
        }
        ss = wave_sum(ss, lane);
        const float rs = rsqrtf(ss * (1.0f / DM) + EPS);
        float lg[36];
#pragma unroll
        for (int n = 0; n < 36; ++n) lg[n] = 0.f;
#pragma unroll
        for (int i = 0; i < 4; ++i) {
            const int kb = lane * 4 + 256 * i;
            const float* wgb = wg + (size_t)kb * 4; const float* wrb = wrt + (size_t)kb * 32;
            asm volatile("" : "+v"(wgb), "+v"(wrb));
            const f32x4 gn4 = *(const f32x4*)(gain + kb);
#pragma unroll
            for (int e = 0; e < 4; ++e) {
                const float hk = hv[4 * i + e] * rs * gn4[e];
                const f32x4 g4 = *(const f32x4*)(wgb + e * 4);
#pragma unroll
                for (int n = 0; n < 4; ++n) lg[n] += hk * g4[n];
#pragma unroll
                for (int q = 0; q < 8; ++q) {
                    const f32x4 r4 = *(const f32x4*)(wrb + e * 32 + 4 * q);
#pragma unroll
                    for (int n = 0; n < 4; ++n) lg[4 + 4 * q + n] += hk * r4[n];
                }
            }
        }
#pragma unroll
        for (int n = 0; n < 36; ++n) lg[n] = wave_sum(lg[n], lane);
        float gl[4];
#pragma unroll
        for (int n = 0; n < 4; ++n) gl[n] = lg[n] + bg[n];
        int g = 0; float gm = gl[0];
#pragma unroll
        for (int n = 1; n < 4; ++n) if (gl[n] > gm) { gm = gl[n]; g = n; }
        float den = 0.f;
#pragma unroll
        for (int n = 0; n < 4; ++n) den += __expf(gl[n] - gm);
        const float gprob = 1.0f / den;
        float el[8];
#pragma unroll
        for (int n = 0; n < 8; ++n) {
            float v = 0.f;
#pragma unroll
            for (int gg = 0; gg < 4; ++gg) v = (g == gg) ? lg[4 + 8 * gg + n] + br[8 * gg + n] : v;
            el[n] = v;
        }
        int e1 = 0; float m1 = el[0];
#pragma unroll
        for (int n = 1; n < 8; ++n) if (el[n] > m1) { m1 = el[n]; e1 = n; }
        int e2 = -1; float m2 = -3.0e38f;
#pragma unroll
        for (int n = 0; n < 8; ++n) if (n != e1 && (e2 < 0 || el[n] > m2)) { m2 = el[n]; e2 = n; }
        const float ex = __expf(m2 - m1);
        const float w1 = gprob / (1.0f + ex), w2 = gprob * ex / (1.0f + ex);
        if (lane == 0) {
            const int ea = 8 * g + e1, eb = 8 * g + e2;
            const unsigned pa = atomicAdd(&cnt[ea], 1u), pb = atomicAdd(&cnt[eb], 1u);
            Entry A; A.dst = t; A.rstd = rs; A.w = w1; A.tok = t;
            Entry B; B.dst = T + t; B.rstd = rs; B.w = w2; B.tok = t;
            list[(size_t)ea * LIST_CAP + pa] = A;
            list[(size_t)eb * LIST_CAP + pb] = B;
        }
    }
}

struct SchedMoe {
    const unsigned* cnt; const Entry* list; const bf16_t* A; const bf16_t* W; int npn; bool gather; size_t w_estride; int w_pnrows, ldb, bid;
    DI bool next(int i, Unit& u) const {
        const int L = i * gridDim.x + bid;
        const int rt = L / npn; u.pn = L % npn;
        int acc = 0, e = 0, found = 0, j = 0, nv = 0;
        for (int ee = 0; ee < NE; ++ee) {
            const int c = (int)cnt[ee], nt = (c + 255) >> 8;
            if (!found && rt < acc + nt) { found = 1; e = ee; j = rt - acc; nv = c - 256 * j; }
            acc += nt;
        }
        if (!found) return false;
        u.e = e; u.nvalid = nv > 256 ? 256 : nv; u.row0 = 256 * rt; u.lbase = e * LIST_CAP + 256 * j; u.pm = rt;
        u.A = gather ? A : A + (size_t)u.row0 * DE;
        u.B = W + (size_t)e * w_estride + (size_t)u.pn * w_pnrows * ldb;
        return true;
    }
    DI int arow(const Unit& u, int r) const { if (!gather) return r; return (r < u.nvalid) ? list[u.lbase + r].tok : 0; }
};
struct EpiGU {
    bf16_t* hid; const Entry* list;
    DI void operator()(const f32x4 (&acc)[2][2][4][2], const Unit& u, int wr, int wc, int fr, int fq) const {
#pragma unroll
        for (int ai = 0; ai < 2; ++ai)
#pragma unroll
            for (int m = 0; m < 4; ++m) {
                const int r = 128 * ai + 64 * wr + 16 * m + fr;
                float rs = 0.f, w = 0.f;
                if (r < u.nvalid) { const Entry en = list[u.lbase + r]; rs = en.rstd; w = en.w; }
                unsigned pk[4];
#pragma unroll
                for (int n = 0; n < 2; ++n) {
                    float hv[4];
#pragma unroll
                    for (int e = 0; e < 4; ++e) { const float g = acc[ai][0][m][n][e] * rs, up = acc[ai][1][m][n][e] * rs; hv[e] = g / (1.0f + __expf(-g)) * up * w; }
                    pk[2 * n] = cvt_pk_bf16(hv[0], hv[1]); pk[2 * n + 1] = cvt_pk_bf16(hv[2], hv[3]);
                }
                u32x4 wv; wv[0] = pk[0]; wv[1] = pk[1]; wv[2] = pk[2]; wv[3] = pk[3];
                *(u32x4*)(hid + (size_t)(u.row0 + r) * DE + 128 * u.pn + 32 * wc + 8 * fq) = wv;
            }
    }
};
struct EpiDown {
    bf16_t* yb; const Entry* list;
    DI void operator()(const f32x4 (&acc)[2][2][4][2], const Unit& u, int wr, int wc, int fr, int fq) const {
#pragma unroll
        for (int ai = 0; ai < 2; ++ai)
#pragma unroll
            for (int m = 0; m < 4; ++m) {
                const int r = 128 * ai + 64 * wr + 16 * m + fr;
                const int dst = (r < u.nvalid) ? list[u.lbase + r].dst : DUMMY_ROW;
#pragma unroll
                for (int bj = 0; bj < 2; ++bj) {
                    const f32x4 a = acc[ai][bj][m][0], b = acc[ai][bj][m][1];
                    u32x4 w; w[0] = cvt_pk_bf16(a[0], a[1]); w[1] = cvt_pk_bf16(a[2], a[3]); w[2] = cvt_pk_bf16(b[0], b[1]); w[3] = cvt_pk_bf16(b[2], b[3]);
                    *(u32x4*)(yb + (size_t)dst * DM + 256 * u.pn + 128 * bj + 32 * wc + 8 * fq) = w;
                }
            }
    }
};

DI void ph_poolgemm(int j) {
    LOAD_PARAMS();
    SchedPool S; S.bid = bid_(); S.diff = (const bf16_t*)(p.ws + WS_DIFF); S.w = (const bf16_t*)(p.ws + WS_WPOOL) + (size_t)j * 4 * 65536;
    EpiPool E; E.x = p.x; E.xb = (bf16_t*)(p.ws + WS_XB); E.pb = p.pool_b + j * DM; E.ps = p.pool_scale + j * DM;
    gemm_phase<GCfg<1024, 256, 256, 128, false>>(S, E);
}
DI void ph_qkv(int j) {
    LOAD_PARAMS();
    SchedDense S; S.bid = bid_(); S.A = (const bf16_t*)(p.ws + WS_XB); S.B = (const bf16_t*)(p.ws + WS_WQKV) + (size_t)j * 3072 * 1024; S.npn = 12; S.ldb = 1024;
    EpiQKV E; E.q = (bf16_t*)(p.ws + WS_Q); E.rstd = (const float*)(p.ws + WS_RSTD); E.qg = p.sb_qg + j * HD; E.kg = p.sb_kg + j * HD;
    gemm_phase<GCfg<1024, 1024, 1024, 32, true>>(S, E);
}
DI void ph_wo(int j) {
    LOAD_PARAMS();
    SchedDense S; S.bid = bid_(); S.A = (const bf16_t*)(p.ws + WS_O); S.B = (const bf16_t*)(p.ws + WS_WO) + (size_t)j * 1024 * 1024; S.npn = 4; S.ldb = 1024;
    EpiWo E; E.x = p.x; E.xb = (bf16_t*)(p.ws + WS_XB);
    gemm_phase<GCfg<1024, 1024, 1024, 128, false>>(S, E);
}
DI void ph_gu(int li) {
    LOAD_PARAMS();
    SchedMoe S; S.bid = bid_(); S.cnt = (const unsigned*)(p.ws + WS_CTL) + CW_CNT + 32 * li; S.list = (const Entry*)(p.ws + WS_LIST); S.A = (const bf16_t*)(p.ws + WS_XB);
    S.W = (const bf16_t*)(p.ws + WS_WGU) + (size_t)li * NE * 512 * 1024; S.npn = 2; S.gather = true; S.w_estride = (size_t)512 * 1024; S.w_pnrows = 128; S.ldb = 1024;
    EpiGU E; E.hid = (bf16_t*)(p.ws + WS_HID); E.list = S.list;
    gemm_phase<GCfg<1024, 1024, 1024, 256, false>>(S, E);
}
DI void ph_down(int li) {
    LOAD_PARAMS();
    SchedMoe S; S.bid = bid_(); S.cnt = (const unsigned*)(p.ws + WS_CTL) + CW_CNT + 32 * li; S.list = (const Entry*)(p.ws + WS_LIST); S.A = (const bf16_t*)(p.ws + WS_HID);
    S.W = (const bf16_t*)(p.ws + WS_WD) + (size_t)li * NE * 1024 * 256; S.npn = 4; S.gather = false; S.w_estride = (size_t)1024 * 256; S.w_pnrows = 256; S.ldb = 256;
    EpiDown E; E.yb = (bf16_t*)(p.ws + WS_YBUF); E.list = S.list;
    gemm_phase<GCfg<256, 256, 256, 128, false>>(S, E);
}

#define XB_TMO      128
#define XB_XCNT(j)  (256  + 64 * (j))
#define XB_XSUB(j)  (1280 + 64 * (j))
#define XB_XGEN(j)  (2304 + 64 * (j))
#define XB_TOP      3328
#define XB_TOPGEN   3392
#define XCD_BAR_WORDS 3456
#define XB_SPIN_CAP (1u << 18)
#define LAS __attribute__((address_space(3)))

__device__ __forceinline__ unsigned xb_ld(unsigned* p)              { return __hip_atomic_load(p, __ATOMIC_RELAXED, __HIP_MEMORY_SCOPE_AGENT); }
__device__ __forceinline__ unsigned xb_add(unsigned* p, unsigned v) { return __hip_atomic_fetch_add(p, v, __ATOMIC_RELAXED, __HIP_MEMORY_SCOPE_AGENT); }
__device__ __forceinline__ unsigned xb_xcc_id() { return (unsigned)__builtin_amdgcn_s_getreg((3 << 11) | 20) & 0xFu; }
#define XB_SPIN(cond, bar) do { unsigned _sp = 0; while (cond) { __builtin_amdgcn_s_sleep(1); \
    if ((++_sp & 255u) == 0u) { if (xb_ld(&(bar)[XB_TMO])) break; if (_sp > XB_SPIN_CAP) { atomicAdd(&(bar)[XB_TMO], 1u); break; } } } } while (0)

struct XcdBarrier {
    unsigned* bar; unsigned x;
    volatile LAS unsigned* st;
};

__device__ __forceinline__ XcdBarrier xcd_barrier_post(unsigned* bar, volatile LAS unsigned* st) {
    XcdBarrier b; b.bar = bar; b.x = xb_xcc_id(); b.st = st;
    if (threadIdx.x == 0) (void)xb_add(&bar[XB_XCNT(b.x)], 1u);
    return b;
}
__device__ __forceinline__ void xcd_barrier_complete(unsigned* bar, unsigned x, unsigned& nloc, unsigned& nx) {
    const unsigned G = gridDim.x * gridDim.y * gridDim.z;
    unsigned sum, cnt, mine, sp = 0u;
    for (;;) {
        sum = 0u; cnt = 0u; mine = 0u;
#pragma unroll
        for (unsigned j = 0; j < 16; ++j) { const unsigned c = xb_ld(&bar[XB_XCNT(j)]); sum += c; cnt += (c > 0u) ? 1u : 0u; mine = (j == x) ? c : mine; }
        if (sum == G) break;
        __builtin_amdgcn_s_sleep(1);
        if ((++sp & 255u) == 0u) { if (xb_ld(&bar[XB_TMO])) break; if (sp > XB_SPIN_CAP) { atomicAdd(&bar[XB_TMO], 1u); break; } }
    }
    nloc = mine > 0u ? mine : 1u; nx = cnt > 0u ? cnt : 1u;
}

__device__ __forceinline__ void xcd_barrier(const XcdBarrier& b) {
    asm volatile("s_waitcnt vmcnt(0)" ::: "memory");
    __syncthreads();
    if (threadIdx.x == 0) {
        unsigned* bar = b.bar; unsigned bx = b.x;
        asm volatile("" : "+s"(bar), "+s"(bx));
        __builtin_amdgcn_s_waitcnt(0);
        unsigned nloc = b.st[0], nx = b.st[1];
        if (nloc == 0u) { xcd_barrier_complete(bar, bx, nloc, nx); b.st[0] = nloc; b.st[1] = nx; }
        const unsigned old = xb_add(&bar[XB_XSUB(bx)], 1u);
        const unsigned gen = old / nloc;
        if (old + 1u == (gen + 1u) * nloc) {
            __builtin_amdgcn_fence(__ATOMIC_RELEASE, "agent");
            asm volatile("s_waitcnt vmcnt(0)" ::: "memory");
            const unsigned og = xb_add(&bar[XB_TOP], 1u);
            const unsigned tg = og / nx;
            if (og + 1u == (tg + 1u) * nx) xb_add(&bar[XB_TOPGEN], 1u);
            else XB_SPIN(xb_ld(&bar[XB_TOPGEN]) == tg, bar);
            __builtin_amdgcn_fence(__ATOMIC_ACQUIRE, "agent");
            xb_add(&bar[XB_XGEN(bx)], 1u);
            asm volatile("s_waitcnt vmcnt(0)" ::: "memory");
        } else {
            XB_SPIN(xb_ld(&bar[XB_XGEN(bx)]) == gen, bar);
            __builtin_amdgcn_fence(__ATOMIC_ACQUIRE, "agent");
            asm volatile("s_waitcnt vmcnt(0)" ::: "memory");
        }
    }
    __syncthreads();
}
constexpr int CW_BAR = 4096;

__global__ void __launch_bounds__(NTHR, 2) fwd(Params pk) {
    __shared__ float lds[64 * 65];
    __shared__ uint4 xb_words;
    if (threadIdx.x == 0) xb_words = make_uint4(0u, 0u, 0u, 0u);
    __syncthreads();
    XcdBarrier bar;
    { LOAD_PARAMS(); bar = xcd_barrier_post((unsigned*)(p.ws + WS_CTL) + CW_BAR, (volatile LAS unsigned*)&xb_words); }
    ph_prologue(lds);
    for (int i = 0; i < DEPTH; ++i) {
        const int j = i >> 1;
        if ((i & 1) == 0) {
            ph_combine(i == 0, i != 0, false);
            xcd_barrier(bar);
            ph_pooldiff(j);
            xcd_barrier(bar);
            ph_poolgemm(j);
        } else {
            ph_combine(false, true, true);
            xcd_barrier(bar);
            ph_qkv(j);
            xcd_barrier(bar);
            ph_attn();
            xcd_barrier(bar);
            ph_wo(j);
        }
        xcd_barrier(bar);
        ph_router(i);
        xcd_barrier(bar);
        ph_gu(i);
        xcd_barrier(bar);
        ph_down(i);
        xcd_barrier(bar);
    }
    ph_combine(false, true, false);
}

extern "C" void kernel_launch(void* const* d_in, const int* in_sizes, int n_in, void* d_out, int out_size, void* d_ws, size_t ws_size, hipStream_t stream) {
    if (ws_size < WS_END || n_in < 18) return;
    Params p{};
    p.x_in = (const float*)d_in[0]; p.pool_norm = (const float*)d_in[1]; p.pool_w = (const float*)d_in[2]; p.pool_b = (const float*)d_in[3]; p.pool_scale = (const float*)d_in[4];
    p.sb_norm = (const float*)d_in[5]; p.sb_wqkv = (const float*)d_in[6]; p.sb_qg = (const float*)d_in[7]; p.sb_kg = (const float*)d_in[8]; p.sb_wo = (const float*)d_in[9];
    p.moe_norm = (const float*)d_in[10]; p.moe_wg = (const float*)d_in[11]; p.moe_bg = (const float*)d_in[12]; p.moe_wr = (const float*)d_in[13]; p.moe_br = (const float*)d_in[14];
    p.moe_wgate = (const float*)d_in[15]; p.moe_wup = (const float*)d_in[16]; p.moe_wdown = (const float*)d_in[17];
    p.x = (float*)d_out; p.ws = (unsigned char*)d_ws;
    static int grid = 0;
    if (!grid) {
        int dev = 0, cus = 0, per_cu = 0;
        (void)hipGetDevice(&dev);
        (void)hipDeviceGetAttribute(&cus, hipDeviceAttributeMultiprocessorCount, dev);
        (void)hipOccupancyMaxActiveBlocksPerMultiprocessor(&per_cu, fwd, NTHR, 0);
        grid = cus * (per_cu < 1 ? per_cu : 1);
    }
    if (grid <= 0) return;
    (void)hipMemsetAsync((char*)d_ws + WS_CTL, 0, CTL_BYTES, stream);
    hipLaunchKernelGGL(fwd, dim3(grid), dim3(NTHR), 0, stream, p);
}
```

```cpp
#include <hip/hip_runtime.h>
#include <stdint.h>

#define DI __device__ __forceinline__
typedef unsigned short bf16_t;
typedef short bf16x8 __attribute__((ext_vector_type(8)));
typedef float f32x4 __attribute__((ext_vector_type(4)));
typedef float f32x16 __attribute__((ext_vector_type(16)));
typedef unsigned u32x4 __attribute__((ext_vector_type(4)));
typedef unsigned u32x2 __attribute__((ext_vector_type(2)));

constexpr int T = 16384, DM = 1024, SEQ = 8192, NH = 16, HD = 64, DEPTH = 4, NE = 32, DE = 256;
constexpr float EPS = 1e-6f;
constexpr int NTHR = 512, NWAVE = 8;
constexpr int LIST_CAP = 16384;
constexpr int DUMMY_ROW = 2 * T;

constexpr size_t MiB = 1u << 20;
constexpr size_t WS_CTL = 0, CTL_BYTES = 1 * MiB;
constexpr size_t WS_WQKV = 1 * MiB;
constexpr size_t WS_WO = 13 * MiB;
constexpr size_t WS_WPOOL = 17 * MiB;
constexpr size_t WS_RSTD = 18 * MiB;
constexpr size_t WS_WGU = 20 * MiB;
constexpr size_t WS_WD = 148 * MiB;
constexpr size_t WS_XB = 212 * MiB;
constexpr size_t WS_LIST = 244 * MiB;
constexpr size_t WS_Q = 256 * MiB;
constexpr size_t WS_DIFF = WS_Q;
constexpr size_t WS_K = 288 * MiB, WS_V = 320 * MiB, WS_O = 352 * MiB;
constexpr size_t WS_YBUF = 288 * MiB;
constexpr size_t WS_HID = 354 * MiB;
constexpr size_t WS_END = 384 * MiB;
static_assert(WS_V - WS_K == WS_K - WS_Q, "Q, K, V equally spaced");
static_assert(WS_YBUF + (size_t)(2 * T + 1) * DM * 2 <= WS_HID, "ybuf");
static_assert(WS_HID + (size_t)(2 * T + NE * 256) * DE * 2 <= WS_END, "hid");
constexpr int CW_CNT = 1024;

struct Entry { int dst; float rstd; float w; int tok; };

struct Params {
    const float* x_in; const float* pool_norm; const float* pool_w; const float* pool_b; const float* pool_scale;
    const float* sb_norm; const float* sb_wqkv; const float* sb_qg; const float* sb_kg; const float* sb_wo;
    const float* moe_norm; const float* moe_wg; const float* moe_bg; const float* moe_wr; const float* moe_br;
    const float* moe_wgate; const float* moe_wup; const float* moe_wdown;
    float* x;
    unsigned char* ws;
};

typedef const unsigned long long __attribute__((address_space(4)))* KArgPtr;
DI Params load_params() {
    KArgPtr q = (KArgPtr)__builtin_amdgcn_kernarg_segment_ptr(); asm volatile("" : "+s"(q));
    Params p;
    p.x_in = (const float*)q[0]; p.pool_norm = (const float*)q[1]; p.pool_w = (const float*)q[2]; p.pool_b = (const float*)q[3]; p.pool_scale = (const float*)q[4];
    p.sb_norm = (const float*)q[5]; p.sb_wqkv = (const float*)q[6]; p.sb_qg = (const float*)q[7]; p.sb_kg = (const float*)q[8]; p.sb_wo = (const float*)q[9];
    p.moe_norm = (const float*)q[10]; p.moe_wg = (const float*)q[11]; p.moe_bg = (const float*)q[12]; p.moe_wr = (const float*)q[13]; p.moe_br = (const float*)q[14];
    p.moe_wgate = (const float*)q[15]; p.moe_wup = (const float*)q[16]; p.moe_wdown = (const float*)q[17];
    p.x = (float*)q[18]; p.ws = (unsigned char*)q[19];
    return p;
}
#define LOAD_PARAMS() const Params p = load_params()
DI int tid_() { int t = threadIdx.x; asm volatile("" : "+v"(t)); return t; }
DI int bid_() { int b = blockIdx.x; asm volatile("" : "+s"(b)); return b; }

DI unsigned cvt_pk_bf16(float lo, float hi) { unsigned r; asm volatile("v_cvt_pk_bf16_f32 %0, %1, %2" : "=v"(r) : "v"(lo), "v"(hi)); return r; }
DI float bf_lo(unsigned u) { return __uint_as_float(u << 16); }
DI float bf_hi(unsigned u) { return __uint_as_float(u & 0xffff0000u); }
DI float shflx(float v, int lane, int m) { return __int_as_float(__builtin_amdgcn_ds_bpermute((lane ^ m) << 2, __float_as_int(v))); }
DI float wave_sum(float v, int lane) {
#pragma unroll
    for (int o = 32; o >= 1; o >>= 1) v += shflx(v, lane, o);
    return v;
}
DI int perm32(int rho) { const int n = rho >> 4, i = rho & 15; return 8 * (i >> 2) + 4 * n + (i & 3); }

DI void cvt_tiles(const float* src, int K, int N, size_t src_mstride, bf16_t* dst, size_t dst_mstride, const float* scale, int scale_div, int nmat, float* lds, int tid, int bid) {
    const int tk = K / 64, tn = N / 64, per = tk * tn;
    for (int tile = bid; tile < nmat * per; tile += gridDim.x) {
        const int mat = tile / per, rem = tile % per, k0 = (rem / tn) * 64, n0 = (rem % tn) * 64;
        const float* s = src + (size_t)mat * src_mstride;
        bf16_t* d = dst + (size_t)mat * dst_mstride;
        const float* sc = scale ? scale + (size_t)(mat / scale_div) * K : nullptr;
        __syncthreads();
#pragma unroll
        for (int it = 0; it < 8; ++it) {
            const int k = it * 8 + (tid >> 6), n = tid & 63;
            float v = s[(size_t)(k0 + k) * N + n0 + n];
            if (sc) v *= sc[k0 + k];
            lds[k * 65 + n] = v;
        }
        __syncthreads();
#pragma unroll
        for (int it = 0; it < 4; ++it) {
            const int kp = (tid & 31) * 2, n = (tid >> 5) + 16 * it;
            const unsigned w = cvt_pk_bf16(lds[kp * 65 + n], lds[(kp + 1) * 65 + n]);
            *(unsigned*)(d + (size_t)(n0 + n) * K + k0 + kp) = w;
        }
    }
}
DI void ph_prologue(float* lds) {
    LOAD_PARAMS();
    const int tid = tid_(), bid = bid_();
    cvt_tiles(p.sb_wqkv, 1024, 3072, (size_t)1024 * 3072, (bf16_t*)(p.ws + WS_WQKV), (size_t)3072 * 1024, p.sb_norm, 1, 2, lds, tid, bid);
    cvt_tiles(p.sb_wo, 1024, 1024, (size_t)1024 * 1024, (bf16_t*)(p.ws + WS_WO), (size_t)1024 * 1024, nullptr, 1, 2, lds, tid, bid);
    cvt_tiles(p.pool_w, 256, 256, (size_t)65536, (bf16_t*)(p.ws + WS_WPOOL), (size_t)65536, nullptr, 1, 8, lds, tid, bid);
    cvt_tiles(p.moe_wgate, 1024, 256, (size_t)1024 * 256, (bf16_t*)(p.ws + WS_WGU), (size_t)512 * 1024, p.moe_norm, 32, 128, lds, tid, bid);
    cvt_tiles(p.moe_wup, 1024, 256, (size_t)1024 * 256, (bf16_t*)(p.ws + WS_WGU) + (size_t)256 * 1024, (size_t)512 * 1024, p.moe_norm, 32, 128, lds, tid, bid);
    cvt_tiles(p.moe_wdown, 256, 1024, (size_t)256 * 1024, (bf16_t*)(p.ws + WS_WD), (size_t)1024 * 256, nullptr, 1, 128, lds, tid, bid);
}

DI void ph_combine(bool first, bool has_y, bool write_xb) {
    LOAD_PARAMS();
    const float* src = first ? p.x_in : p.x;
    const int tid = tid_(), bid = bid_(), wid = tid >> 6, lane = tid & 63;
    const bf16_t* yb = (const bf16_t*)(p.ws + WS_YBUF);
    bf16_t* xb = (bf16_t*)(p.ws + WS_XB);
    float* rstd = (float*)(p.ws + WS_RSTD);
    for (int t = bid * NWAVE + wid; t < T; t += gridDim.x * NWAVE) {
        float ss = 0.f;
#pragma unroll
        for (int i = 0; i < 4; ++i) {
            const int c = lane * 4 + 256 * i;
            f32x4 v = *(const f32x4*)(src + (size_t)t * DM + c);
            if (has_y) {
                const u32x2 a = *(const u32x2*)(yb + (size_t)t * DM + c), b = *(const u32x2*)(yb + (size_t)(T + t) * DM + c);
                v[0] += bf_lo(a[0]) + bf_lo(b[0]); v[1] += bf_hi(a[0]) + bf_hi(b[0]); v[2] += bf_lo(a[1]) + bf_lo(b[1]); v[3] += bf_hi(a[1]) + bf_hi(b[1]);
            }
            *(f32x4*)(p.x + (size_t)t * DM + c) = v;
            if (write_xb) { u32x2 w; w[0] = cvt_pk_bf16(v[0], v[1]); w[1] = cvt_pk_bf16(v[2], v[3]); *(u32x2*)(xb + (size_t)t * DM + c) = w; }
            ss += v[0] * v[0] + v[1] * v[1] + v[2] * v[2] + v[3] * v[3];
        }
        ss = wave_sum(ss, lane);
        if (lane == 0) rstd[t] = rsqrtf(ss * (1.0f / DM) + EPS);
    }
}

DI void ph_pooldiff(int j) {
    LOAD_PARAMS();
    const float* rstd = (const float*)(p.ws + WS_RSTD);
    const float* gain = p.pool_norm + j * DM;
    bf16_t* diff = (bf16_t*)(p.ws + WS_DIFF);
    for (int idx = bid_() * NTHR + tid_(); idx < T * 128; idx += gridDim.x * NTHR) {
        const int t = idx >> 7, c = (idx & 127) * 8, g = c >> 8, win = 2 << g, s = t & (SEQ - 1);
        const int cnt = (s + 1 < win) ? s + 1 : win;
        f32x4 a0 = {0.f, 0.f, 0.f, 0.f}, a1 = {0.f, 0.f, 0.f, 0.f}, o0, o1;
        for (int u = 0; u < cnt; ++u) {
            const float r = rstd[t - u];
            const f32x4 v0 = *(const f32x4*)(p.x + (size_t)(t - u) * DM + c), v1 = *(const f32x4*)(p.x + (size_t)(t - u) * DM + c + 4);
            if (u == 0) { o0 = v0 * r; o1 = v1 * r; }
            a0 += v0 * r; a1 += v1 * r;
        }
        const float inv = 1.0f / (float)cnt;
        const f32x4 g0 = *(const f32x4*)(gain + c), g1 = *(const f32x4*)(gain + c + 4);
        const f32x4 d0 = (a0 * inv - o0) * g0, d1 = (a1 * inv - o1) * g1;
        u32x4 w; w[0] = cvt_pk_bf16(d0[0], d0[1]); w[1] = cvt_pk_bf16(d0[2], d0[3]); w[2] = cvt_pk_bf16(d1[0], d1[1]); w[3] = cvt_pk_bf16(d1[2], d1[3]);
        *(u32x4*)(diff + (size_t)t * DM + c) = w;
    }
}

struct Unit { const bf16_t* A; const bf16_t* B; int pm, pn, e, nvalid, row0, lbase; };
template <int LDA_, int LDB_, int K_, int BH_, bool HEADMAP_> struct GCfg { static constexpr int LDA = LDA_, LDB = LDB_, K = K_, BH = BH_; static constexpr bool HEADMAP = HEADMAP_; };

#define LAS __attribute__((address_space(3)))
constexpr int BK = 64, HTB = 128 * BK * 2  , STAGE_BYTES = 8 * HTB;
DI int lds_byte(int r, int c) { const int st = (r >> 4) * 2 + (c >> 5), rr = r & 15, cc = c & 31, ob = rr * 64 + cc * 2; return st * 1024 + (ob ^ (((ob >> 9) & 1) << 5)); }
DI void stage_rc(int b, int& R, int& C) { const int st = b / 1024, sb = b % 1024, swz = sb ^ (((sb >> 9) & 1) << 5); R = (st >> 1) * 16 + swz / 64; C = (st & 1) * 32 + (swz % 64) / 2; }

template <class Cfg, class Sched, class Epi>
DI void gemm_phase(LAS unsigned char* lds, const Sched& S, const Epi& E) {
    const int tid = tid_(), wid = __builtin_amdgcn_readfirstlane(tid >> 6), lane = tid & 63, wr = wid >> 2, wc = wid & 3, fr = lane & 15, fq = lane >> 4;
    constexpr int nt = Cfg::K / BK;
    static_assert(Cfg::K % 128 == 0 && Cfg::K >= 256, "K");
    unsigned voffA[2][2], voffB[2];
    int R0, C0, R1, C1; stage_rc(tid * 16, R0, C0); stage_rc(tid * 16 + 8192, R1, C1);
    voffB[0] = (unsigned)(((Cfg::HEADMAP ? 64 * (R0 >> 5) : (R0 & ~31)) + perm32(R0 & 31)) * Cfg::LDB + C0) * 2u;
    voffB[1] = (unsigned)(((Cfg::HEADMAP ? 64 * (R1 >> 5) : (R1 & ~31)) + perm32(R1 & 31)) * Cfg::LDB + C1) * 2u;
    constexpr size_t kstep = (size_t)(BK * 2);
    constexpr size_t bhstep = (size_t)Cfg::BH * Cfg::LDB * 2;
    const unsigned ldsw = (unsigned)wid * 1024u;
    const int aoff = lds_byte(wr * 64 + fr, fq * 8), boff = lds_byte(wc * 32 + fr, fq * 8);
#define PG8_SA(b, h) (((b) * 2 + (h)) * HTB)
#define PG8_SB(b, h) ((4 + (b) * 2 + (h)) * HTB)
#define PG8_STAGE(bufoff, gbase, voff) do { _Pragma("unroll") for (int _i = 0; _i < 2; ++_i) \
        __builtin_amdgcn_global_load_lds((const unsigned*)((const char*)(gbase) + (voff)[_i]), (LAS unsigned*)(lds + (bufoff) + ldsw + _i * 8192), 16, 0, 0); } while (0)
#define PG8_LDA(dst, b, h) do { _Pragma("unroll") for (int m = 0; m < 4; ++m) _Pragma("unroll") for (int k = 0; k < 2; ++k) dst[m][k] = *(const LAS bf16x8*)(lds + PG8_SA(b, h) + aoff + m * 2048 + k * 1024); } while (0)
#define PG8_LDB(dst, b, h) do { _Pragma("unroll") for (int n = 0; n < 2; ++n) _Pragma("unroll") for (int k = 0; k < 2; ++k) dst[n][k] = *(const LAS bf16x8*)(lds + PG8_SB(b, h) + boff + n * 2048 + k * 1024); } while (0)
#define PG8_MMA(ai, bj, At, Bt) do { __builtin_amdgcn_s_setprio(1); _Pragma("unroll") for (int m = 0; m < 4; ++m) _Pragma("unroll") for (int n = 0; n < 2; ++n) _Pragma("unroll") for (int k = 0; k < 2; ++k) \
        acc[ai][bj][m][n] = __builtin_amdgcn_mfma_f32_16x16x32_bf16(Bt[n][k], At[m][k], acc[ai][bj][m][n], 0, 0, 0); __builtin_amdgcn_s_setprio(0); } while (0)
#define PG8_WAIT_V(n) asm volatile("s_waitcnt vmcnt(" #n ")" ::: "memory")
#define PG8_WAIT_L(n) asm volatile("s_waitcnt lgkmcnt(" #n ")" ::: "memory")
#define PG8_BAR __builtin_amdgcn_s_barrier()
#define PG8_SCHED __builtin_amdgcn_sched_barrier(0)
#define PG8_AROWS(uidx, un) do { voffA[0][0] = (unsigned)S.arow(uidx, un, R0) * (unsigned)(Cfg::LDA * 2) + (unsigned)(C0 * 2); voffA[0][1] = (unsigned)S.arow(uidx, un, R1) * (unsigned)(Cfg::LDA * 2) + (unsigned)(C1 * 2); \
        voffA[1][0] = (unsigned)S.arow(uidx, un, 128 + R0) * (unsigned)(Cfg::LDA * 2) + (unsigned)(C0 * 2); voffA[1][1] = (unsigned)S.arow(uidx, un, 128 + R1) * (unsigned)(Cfg::LDA * 2) + (unsigned)(C1 * 2); } while (0)
    Unit cur, nxt; int ui = 0;
    if (!S.next(0, cur)) return;
    f32x4 acc[2][2][4][2];
#pragma unroll
    for (int a = 0; a < 2; ++a)
#pragma unroll
        for (int b = 0; b < 2; ++b)
#pragma unroll
            for (int m = 0; m < 4; ++m)
#pragma unroll
                for (int n = 0; n < 2; ++n) acc[a][b][m][n] = (f32x4){0.f, 0.f, 0.f, 0.f};
    bf16x8 At[4][2], B0[2][2], B1[2][2];
    PG8_AROWS(0, cur);
    const char* cA = (const char*)cur.A; const char* cB = (const char*)cur.B;
    PG8_STAGE(PG8_SB(0, 0), cB, voffB); PG8_STAGE(PG8_SB(0, 1), cB + bhstep, voffB); PG8_STAGE(PG8_SA(0, 0), cA, voffA[0]); PG8_STAGE(PG8_SA(0, 1), cA, voffA[1]);
    if (wr == 1) PG8_BAR;
    PG8_WAIT_V(2); PG8_BAR;
    PG8_STAGE(PG8_SB(1, 0), cB + kstep, voffB); PG8_STAGE(PG8_SA(1, 0), cA + kstep, voffA[0]); PG8_STAGE(PG8_SB(1, 1), cB + bhstep + kstep, voffB);
    PG8_WAIT_V(6); PG8_BAR;
    for (;;) {
        const bool has_next = S.next(ui + 1, nxt);
        const char* nA = has_next ? (const char*)nxt.A : cA; const char* nB = has_next ? (const char*)nxt.B : cB;
#pragma unroll 1
        for (int t = 0; t < nt; t += 2) {
            const bool last = (t == nt - 2);
            const char* a1 = cA + (size_t)(t + 1) * kstep;
            const char* a2 = last ? nA : cA + (size_t)(t + 2) * kstep; const char* b2 = last ? nB : cB + (size_t)(t + 2) * kstep;
            const char* a3 = a2 + kstep; const char* b3 = b2 + kstep;
            PG8_LDB(B0, 0, 0); PG8_LDB(B1, 0, 1); PG8_SCHED; PG8_LDA(At, 0, 0); PG8_STAGE(PG8_SA(1, 1), a1, voffA[1]);
            if (last && has_next) PG8_AROWS(ui + 1, nxt);
            PG8_WAIT_V(8); PG8_WAIT_L(0); PG8_BAR; PG8_MMA(0, 0, At, B0); PG8_MMA(0, 1, At, B1); PG8_BAR; PG8_SCHED;
            PG8_LDA(At, 0, 1); PG8_STAGE(PG8_SB(0, 0), b2, voffB); PG8_STAGE(PG8_SB(0, 1), b2 + bhstep, voffB); PG8_STAGE(PG8_SA(0, 0), a2, voffA[0]);
            PG8_WAIT_V(8); PG8_WAIT_L(0); PG8_BAR; PG8_MMA(1, 0, At, B0); PG8_MMA(1, 1, At, B1); PG8_BAR; PG8_SCHED;
            PG8_LDB(B0, 1, 0); PG8_LDB(B1, 1, 1); PG8_SCHED; PG8_LDA(At, 1, 0); PG8_STAGE(PG8_SA(0, 1), a2, voffA[1]);
            PG8_WAIT_V(8); PG8_WAIT_L(0); PG8_BAR; PG8_MMA(0, 0, At, B0); PG8_MMA(0, 1, At, B1); PG8_BAR; PG8_SCHED;
            PG8_LDA(At, 1, 1); PG8_STAGE(PG8_SB(1, 0), b3, voffB); PG8_STAGE(PG8_SB(1, 1), b3 + bhstep, voffB); PG8_STAGE(PG8_SA(1, 0), a3, voffA[0]);
            PG8_WAIT_V(8); PG8_WAIT_L(0); PG8_BAR; PG8_MMA(1, 0, At, B0); PG8_MMA(1, 1, At, B1); PG8_BAR; PG8_SCHED;
        }
        if (wr == 0) PG8_BAR;
        E(acc, cur, wr, wc, fr, fq);
        if (!has_next) break;
#pragma unroll
        for (int a = 0; a < 2; ++a)
#pragma unroll
            for (int b = 0; b < 2; ++b)
#pragma unroll
                for (int m = 0; m < 4; ++m)
#pragma unroll
                    for (int n = 0; n < 2; ++n) acc[a][b][m][n] = (f32x4){0.f, 0.f, 0.f, 0.f};
        cur = nxt; cA = nA; cB = nB; ++ui;
        if (wr == 1) PG8_BAR;
    }
    PG8_WAIT_V(0);
    PG8_BAR;
#undef PG8_SA
#undef PG8_SB
#undef PG8_STAGE
#undef PG8_LDA
#undef PG8_LDB
#undef PG8_MMA
#undef PG8_WAIT_V
#undef PG8_WAIT_L
#undef PG8_BAR
#undef PG8_SCHED
#undef PG8_AROWS
}

struct SchedPool {
    const bf16_t* diff; const bf16_t* w; int bid;
    DI bool next(int i, Unit& u) const { const int L = i * gridDim.x + bid; if (L >= 256) return false; u.pm = L >> 2; u.pn = L & 3; u.A = diff + 256 * u.pn; u.B = w + (size_t)u.pn * 65536; return true; }
    DI int arow(int, const Unit& u, int r) const { return u.pm * 256 + r; }
};
struct SchedDense {
    const bf16_t* A; const bf16_t* B; int npn, ldb, bid;
    DI bool next(int i, Unit& u) const { const int L = i * gridDim.x + bid; if (L >= 64 * npn) return false; u.pm = L / npn; u.pn = L % npn; u.A = A; u.B = B + (size_t)u.pn * 256 * ldb; return true; }
    DI int arow(int, const Unit& u, int r) const { return u.pm * 256 + r; }
};

struct EpiPool {
    float* x; bf16_t* xb; const float* pb; const float* ps;
    DI void operator()(const f32x4 (&acc)[2][2][4][2], const Unit& u, int wr, int wc, int fr, int fq) const {
#pragma unroll
        for (int ai = 0; ai < 2; ++ai)
#pragma unroll
            for (int m = 0; m < 4; ++m) {
                const int t = u.pm * 256 + 128 * ai + 64 * wr + 16 * m + fr;
#pragma unroll
                for (int bj = 0; bj < 2; ++bj) {
                    const int c = 256 * u.pn + 128 * bj + 32 * wc + 8 * fq;
                    float* xp = x + (size_t)t * DM + c;
                    f32x4 v0 = *(const f32x4*)xp, v1 = *(const f32x4*)(xp + 4);
                    v0 += (acc[ai][bj][m][0] + *(const f32x4*)(pb + c)) * *(const f32x4*)(ps + c);
                    v1 += (acc[ai][bj][m][1] + *(const f32x4*)(pb + c + 4)) * *(const f32x4*)(ps + c + 4);
                    *(f32x4*)xp = v0; *(f32x4*)(xp + 4) = v1;
                    u32x4 w; w[0] = cvt_pk_bf16(v0[0], v0[1]); w[1] = cvt_pk_bf16(v0[2], v0[3]); w[2] = cvt_pk_bf16(v1[0], v1[1]); w[3] = cvt_pk_bf16(v1[2], v1[3]);
                    *(u32x4*)(xb + (size_t)t * DM + c) = w;
                }
            }
    }
};
struct EpiWo {
    float* x; bf16_t* xb;
    DI void operator()(const f32x4 (&acc)[2][2][4][2], const Unit& u, int wr, int wc, int fr, int fq) const {
#pragma unroll
        for (int ai = 0; ai < 2; ++ai)
#pragma unroll
            for (int m = 0; m < 4; ++m) {
                const int t = u.pm * 256 + 128 * ai + 64 * wr + 16 * m + fr;
#pragma unroll
                for (int bj = 0; bj < 2; ++bj) {
                    const int c = 256 * u.pn + 128 * bj + 32 * wc + 8 * fq;
                    float* xp = x + (size_t)t * DM + c;
                    f32x4 v0 = *(const f32x4*)xp, v1 = *(const f32x4*)(xp + 4);
                    v0 += acc[ai][bj][m][0]; v1 += acc[ai][bj][m][1];
                    *(f32x4*)xp = v0; *(f32x4*)(xp + 4) = v1;
                    u32x4 w; w[0] = cvt_pk_bf16(v0[0], v0[1]); w[1] = cvt_pk_bf16(v0[2], v0[3]); w[2] = cvt_pk_bf16(v1[0], v1[1]); w[3] = cvt_pk_bf16(v1[2], v1[3]);
                    *(u32x4*)(xb + (size_t)t * DM + c) = w;
                }
            }
    }
};
struct EpiQKV {
    bf16_t* q; const float* rstd; const float* qg; const float* kg;
    DI void operator()(const f32x4 (&acc)[2][2][4][2], const Unit& u, int wr, int wc, int fr, int fq) const {
        const int which = u.pn >> 2, head = (u.pn & 3) * 4 + wc;
        bf16_t* out = q + (size_t)which * ((WS_K - WS_Q) / 2);
        const float* gn = which == 0 ? qg : kg;
        const float post = which == 0 ? 0.125f : 1.0f;
        f32x4 g[2][2];
#pragma unroll
        for (int bj = 0; bj < 2; ++bj)
#pragma unroll
            for (int n = 0; n < 2; ++n) g[bj][n] = (which < 2) ? *(const f32x4*)(gn + 32 * bj + 8 * fq + 4 * n) * post : (f32x4){1.f, 1.f, 1.f, 1.f};
#pragma unroll
        for (int ai = 0; ai < 2; ++ai)
#pragma unroll
            for (int m = 0; m < 4; ++m) {
                const int t = u.pm * 256 + 128 * ai + 64 * wr + 16 * m + fr;
                const float rs = rstd[t];
                f32x4 v4[2][2]; float ss = 0.f;
#pragma unroll
                for (int bj = 0; bj < 2; ++bj)
#pragma unroll
                    for (int n = 0; n < 2; ++n) { v4[bj][n] = acc[ai][bj][m][n] * rs; const f32x4 s = v4[bj][n] * v4[bj][n]; ss += (s[0] + s[1]) + (s[2] + s[3]); }
                ss += shflx(ss, fr + 16 * fq, 16); ss += shflx(ss, fr + 16 * fq, 32);
                const float r2 = (which < 2) ? rsqrtf(ss * (1.0f / HD) + EPS) : 1.0f;
#pragma unroll
                for (int bj = 0; bj < 2; ++bj) {
                    const f32x4 a = v4[bj][0] * r2 * g[bj][0], b = v4[bj][1] * r2 * g[bj][1];
                    u32x4 w; w[0] = cvt_pk_bf16(a[0], a[1]); w[1] = cvt_pk_bf16(a[2], a[3]); w[2] = cvt_pk_bf16(b[0], b[1]); w[3] = cvt_pk_bf16(b[2], b[3]);
                    *(u32x4*)(out + (size_t)t * DM + head * HD + 32 * bj + 8 * fq) = w;
                }
            }
    }
};

DI float softplus_f(float z) { return fmaxf(z, 0.f) + __logf(1.0f + __expf(-fabsf(z))); }
DI void ph_attn() {
    LOAD_PARAMS();
    const int tid = tid_(), bid = bid_(), wid = tid >> 6, lane = tid & 63, l31 = lane & 31, h2 = lane >> 5;
    const bf16_t* Q = (const bf16_t*)(p.ws + WS_Q); const bf16_t* K = (const bf16_t*)(p.ws + WS_K); const bf16_t* V = (const bf16_t*)(p.ws + WS_V);
    bf16_t* O = (bf16_t*)(p.ws + WS_O);
    for (int it = 0; it < 4 * ((2 * NH * 256 / 32 - bid + (int)gridDim.x - 1) / (int)gridDim.x); ++it) {
        const int tsk = (bid + (it >> 2) * gridDim.x) * 32 + (it & 3) * 8 + wid;
        const int bh = tsk >> 8, qb = tsk & 255, b = bh >> 4, h = bh & 15;
        const size_t tb = (size_t)b * SEQ;
        const int q0 = qb * 32;
        bf16x8 qf[4];
#pragma unroll
        for (int s = 0; s < 4; ++s) qf[s] = *(const bf16x8*)(Q + (tb + q0 + l31) * DM + h * HD + 16 * s + 8 * h2);
        f32x16 o0, o1;
#pragma unroll
        for (int r = 0; r < 16; ++r) { o0[r] = 0.f; o1[r] = 0.f; }
        float R = 0.f;
        for (int kt = qb; kt >= 0; --kt) {
            const int k0 = kt * 32;
            f32x16 z;
#pragma unroll
            for (int r = 0; r < 16; ++r) z[r] = 0.f;
#pragma unroll
            for (int s = 0; s < 4; ++s) {
                const bf16x8 kf = *(const bf16x8*)(K + (tb + k0 + l31) * DM + h * HD + 16 * s + 8 * h2);
                z = __builtin_amdgcn_mfma_f32_32x32x16_bf16(kf, qf[s], z, 0, 0, 0);
            }
            const bool diag = (kt == qb);
            float sp[16], gs[4], ot[4];
#pragma unroll
            for (int r = 0; r < 16; ++r) {
                const int kl = (r & 3) + 8 * (r >> 2) + 4 * h2;
                const bool valid = !diag || (kl < l31);
                sp[r] = valid ? softplus_f(z[r]) : 0.f;
            }
#pragma unroll
            for (int bb = 0; bb < 4; ++bb) { gs[bb] = (sp[4 * bb] + sp[4 * bb + 1]) + (sp[4 * bb + 2] + sp[4 * bb + 3]); ot[bb] = shflx(gs[bb], lane, 32); }
            const float tot_own = (gs[0] + gs[1]) + (gs[2] + gs[3]);
            const float tot_oth = shflx(tot_own, lane, 32);
            float later[4];
            {
                float own_tail = 0.f, oth_tail = 0.f;
#pragma unroll
                for (int bb = 3; bb >= 0; --bb) {
                    later[bb] = own_tail + oth_tail + (h2 == 0 ? ot[bb] : 0.f);
                    own_tail += gs[bb]; oth_tail += ot[bb];
                }
            }
            float a[16];
#pragma unroll
            for (int bb = 0; bb < 4; ++bb) {
                const float base = R + later[bb];
                const float s3 = base + sp[4 * bb + 3], s2 = s3 + sp[4 * bb + 2], s1 = s2 + sp[4 * bb + 1], s0 = s1 + sp[4 * bb];
                const float S[4] = {s0, s1, s2, s3};
#pragma unroll
                for (int i = 0; i < 4; ++i) {
                    const int r = 4 * bb + i, kl = (r & 3) + 8 * (r >> 2) + 4 * h2;
                    const bool valid = !diag || (kl < l31);
                    a[r] = valid ? __expf(z[r] - S[i]) : 0.f;
                }
            }
            R += (h2 == 0) ? (tot_own + tot_oth) : (tot_oth + tot_own);
#pragma unroll
            for (int s = 0; s < 2; ++s) {
                u32x4 pw;
#pragma unroll
                for (int i = 0; i < 4; ++i) pw[i] = cvt_pk_bf16(a[8 * s + 2 * i], a[8 * s + 2 * i + 1]);
                const bf16x8 pa = __builtin_bit_cast(bf16x8, pw);
#pragma unroll
                for (int db = 0; db < 2; ++db) {
                    bf16x8 vf;
#pragma unroll
                    for (int jj = 0; jj < 8; ++jj) {
                        const int key = k0 + 16 * s + 8 * (jj >> 2) + 4 * h2 + (jj & 3);
                        vf[jj] = (short)V[(tb + key) * DM + h * HD + 32 * db + l31];
                    }
                    if (db == 0) o0 = __builtin_amdgcn_mfma_f32_32x32x16_bf16(vf, pa, o0, 0, 0, 0);
                    else o1 = __builtin_amdgcn_mfma_f32_32x32x16_bf16(vf, pa, o1, 0, 0, 0);
                }
            }
            if (__all(R > 104.0f)) break;
        }
#pragma unroll
        for (int db = 0; db < 2; ++db)
#pragma unroll
            for (int rb = 0; rb < 4; ++rb) {
                const f32x16& o = db == 0 ? o0 : o1;
                u32x2 w; w[0] = cvt_pk_bf16(o[4 * rb], o[4 * rb + 1]); w[1] = cvt_pk_bf16(o[4 * rb + 2], o[4 * rb + 3]);
                *(u32x2*)(O + (tb + q0 + l31) * DM + h * HD + 32 * db + 8 * rb + 4 * h2) = w;
            }
    }
}

DI void ph_router(int li) {
    LOAD_PARAMS();
    const int tid = tid_(), bid = bid_(), wid = tid >> 6, lane = tid & 63;
    const float* gain = p.moe_norm + li * DM;
    const float* wg = p.moe_wg + (size_t)li * DM * 4;
    const float* wrt = p.moe_wr + (size_t)li * DM * 32;
    const float* bg = p.moe_bg + li * 4;
    const float* br = p.moe_br + li * 32;
    unsigned* cnt = (unsigned*)(p.ws + WS_CTL) + CW_CNT + 32 * li;
    Entry* list = (Entry*)(p.ws + WS_LIST);
    for (int t = bid * NWAVE + wid; t < T; t += gridDim.x * NWAVE) {
        float hv[16]; float ss = 0.f;
#pragma unroll
        for (int i = 0; i < 4; ++i) {
            const f32x4 v = *(const f32x4*)(p.x + (size_t)t * DM + lane * 4 + 256 * i);
#pragma unroll
            for (int e = 0; e < 4; ++e) { hv[4 * i + e] = v[e]; ss += v[e] * v[e]; }
        }
        ss = wave_sum(ss, lane);
        const float rs = rsqrtf(ss * (1.0f / DM) + EPS);
        float lg[36];
#pragma unroll
        for (int n = 0; n < 36; ++n) lg[n] = 0.f;
#pragma unroll
        for (int i = 0; i < 4; ++i) {
            const int kb = lane * 4 + 256 * i;
            const float* wgb = wg + (size_t)kb * 4; const float* wrb = wrt + (size_t)kb * 32;
            asm volatile("" : "+v"(wgb), "+v"(wrb));
            const f32x4 gn4 = *(const f32x4*)(gain + kb);
#pragma unroll
            for (int e = 0; e < 4; ++e) {
                const float hk = hv[4 * i + e] * rs * gn4[e];
                const f32x4 g4 = *(const f32x4*)(wgb + e * 4);
#pragma unroll
                for (int n = 0; n < 4; ++n) lg[n] += hk * g4[n];
#pragma unroll
                for (int q = 0; q < 8; ++q) {
                    const f32x4 r4 = *(const f32x4*)(wrb + e * 32 + 4 * q);
#pragma unroll
                    for (int n = 0; n < 4; ++n) lg[4 + 4 * q + n] += hk * r4[n];
                }
            }
        }
#pragma unroll
        for (int n = 0; n < 36; ++n) lg[n] = wave_sum(lg[n], lane);
        float gl[4];
#pragma unroll
        for (int n = 0; n < 4; ++n) gl[n] = lg[n] + bg[n];
        int g = 0; float gm = gl[0];
#pragma unroll
        for (int n = 1; n < 4; ++n) if (gl[n] > gm) { gm = gl[n]; g = n; }
        float den = 0.f;
#pragma unroll
        for (int n = 0; n < 4; ++n) den += __expf(gl[n] - gm);
        const float gprob = 1.0f / den;
        float el[8];
#pragma unroll
        for (int n = 0; n < 8; ++n) {
            float v = 0.f;
#pragma unroll
            for (int gg = 0; gg < 4; ++gg) v = (g == gg) ? lg[4 + 8 * gg + n] + br[8 * gg + n] : v;
            el[n] = v;
        }
        int e1 = 0; float m1 = el[0];
#pragma unroll
        for (int n = 1; n < 8; ++n) if (el[n] > m1) { m1 = el[n]; e1 = n; }
        int e2 = -1; float m2 = -3.0e38f;
#pragma unroll
        for (int n = 0; n < 8; ++n) if (n != e1 && (e2 < 0 || el[n] > m2)) { m2 = el[n]; e2 = n; }
        const float ex = __expf(m2 - m1);
        const float w1 = gprob / (1.0f + ex), w2 = gprob * ex / (1.0f + ex);
        if (lane == 0) {
            const int ea = 8 * g + e1, eb = 8 * g + e2;
            const unsigned pa = atomicAdd(&cnt[ea], 1u), pb = atomicAdd(&cnt[eb], 1u);
            Entry A; A.dst = t; A.rstd = rs; A.w = w1; A.tok = t;
            Entry B; B.dst = T + t; B.rstd = rs; B.w = w2; B.tok = t;
            list[(size_t)ea * LIST_CAP + pa] = A;
            list[(size_t)eb * LIST_CAP + pb] = B;
        }
    }
}

constexpr int MOE_MAXU = 4;
constexpr int LDS_ROWTAB = STAGE_BYTES;
constexpr int LDS_UTAB = LDS_ROWTAB + MOE_MAXU * 1024;
constexpr int LDS_XBW = LDS_UTAB + MOE_MAXU * 32;
constexpr int LDS_BYTES = 147456;
static_assert(LDS_XBW + 16 <= LDS_BYTES, "LDS map");
struct SchedMoe {
    LAS unsigned char* lds; const bf16_t* A; const bf16_t* W; bool gather; size_t w_estride; int w_pnrows, ldb;
    DI void build(const unsigned* cnt, const Entry* list, int npn, int bid, int tid) {
        LAS int* ut = (LAS int*)(lds + LDS_UTAB); LAS unsigned* rt = (LAS unsigned*)(lds + LDS_ROWTAB);
        for (int i = 0; i < MOE_MAXU; ++i) {
            const int L = i * gridDim.x + bid, rtile = L / npn, pn = L % npn;
            int acc = 0, e = 0, found = 0, j = 0, nv = 0;
            for (int ee = 0; ee < NE; ++ee) {
                const int c = (int)cnt[ee], ntl = (c + 255) >> 8;
                if (!found && rtile < acc + ntl) { found = 1; e = ee; j = rtile - acc; nv = c - 256 * j; }
                acc += ntl;
            }
            nv = nv > 256 ? 256 : nv;
            if (tid == 0) { ut[i * 8 + 0] = found; ut[i * 8 + 1] = e; ut[i * 8 + 2] = nv; ut[i * 8 + 3] = 256 * rtile; ut[i * 8 + 4] = e * LIST_CAP + 256 * j; ut[i * 8 + 5] = pn; }
            if (gather && found && tid < 256) rt[i * 256 + tid] = (tid < nv) ? (unsigned)list[e * LIST_CAP + 256 * j + tid].tok : 0u;
        }
        asm volatile("s_waitcnt vmcnt(0) lgkmcnt(0)" ::: "memory");
        __syncthreads();
    }
    DI bool next(int i, Unit& u) const {
        if (i >= MOE_MAXU) return false;
        const LAS int* ut = (const LAS int*)(lds + LDS_UTAB) + i * 8;
        const int found = __builtin_amdgcn_readfirstlane(ut[0]);
        if (!found) return false;
        u.e = __builtin_amdgcn_readfirstlane(ut[1]); u.nvalid = __builtin_amdgcn_readfirstlane(ut[2]); u.row0 = __builtin_amdgcn_readfirstlane(ut[3]);
        u.lbase = __builtin_amdgcn_readfirstlane(ut[4]); u.pn = __builtin_amdgcn_readfirstlane(ut[5]); u.pm = u.row0 >> 8;
        u.A = gather ? A : A + (size_t)u.row0 * DE;
        u.B = W + (size_t)u.e * w_estride + (size_t)u.pn * w_pnrows * ldb;
        return true;
    }
    DI int arow(int ui, const Unit&, int r) const { if (!gather) return r; return (int)((const LAS unsigned*)(lds + LDS_ROWTAB))[ui * 256 + r]; }
};
struct EpiGU {
    bf16_t* hid; const Entry* list;
    DI void operator()(const f32x4 (&acc)[2][2][4][2], const Unit& u, int wr, int wc, int fr, int fq) const {
#pragma unroll
        for (int ai = 0; ai < 2; ++ai)
#pragma unroll
            for (int m = 0; m < 4; ++m) {
                const int r = 128 * ai + 64 * wr + 16 * m + fr;
                float rs = 0.f, w = 0.f;
                if (r < u.nvalid) { const Entry en = list[u.lbase + r]; rs = en.rstd; w = en.w; }
                unsigned pk[4];
#pragma unroll
                for (int n = 0; n < 2; ++n) {
                    float hv[4];
#pragma unroll
                    for (int e = 0; e < 4; ++e) { const float g = acc[ai][0][m][n][e] * rs, up = acc[ai][1][m][n][e] * rs; hv[e] = g / (1.0f + __expf(-g)) * up * w; }
                    pk[2 * n] = cvt_pk_bf16(hv[0], hv[1]); pk[2 * n + 1] = cvt_pk_bf16(hv[2], hv[3]);
                }
                u32x4 wv; wv[0] = pk[0]; wv[1] = pk[1]; wv[2] = pk[2]; wv[3] = pk[3];
                *(u32x4*)(hid + (size_t)(u.row0 + r) * DE + 128 * u.pn + 32 * wc + 8 * fq) = wv;
            }
    }
};
struct EpiDown {
    bf16_t* yb; const Entry* list;
    DI void operator()(const f32x4 (&acc)[2][2][4][2], const Unit& u, int wr, int wc, int fr, int fq) const {
#pragma unroll
        for (int ai = 0; ai < 2; ++ai)
#pragma unroll
            for (int m = 0; m < 4; ++m) {
                const int r = 128 * ai + 64 * wr + 16 * m + fr;
                const int dst = (r < u.nvalid) ? list[u.lbase + r].dst : DUMMY_ROW;
#pragma unroll
                for (int bj = 0; bj < 2; ++bj) {
                    const f32x4 a = acc[ai][bj][m][0], b = acc[ai][bj][m][1];
                    u32x4 w; w[0] = cvt_pk_bf16(a[0], a[1]); w[1] = cvt_pk_bf16(a[2], a[3]); w[2] = cvt_pk_bf16(b[0], b[1]); w[3] = cvt_pk_bf16(b[2], b[3]);
                    *(u32x4*)(yb + (size_t)dst * DM + 256 * u.pn + 128 * bj + 32 * wc + 8 * fq) = w;
                }
            }
    }
};

DI void ph_poolgemm(LAS unsigned char* lds, int j) {
    LOAD_PARAMS();
    SchedPool S; S.bid = bid_(); S.diff = (const bf16_t*)(p.ws + WS_DIFF); S.w = (const bf16_t*)(p.ws + WS_WPOOL) + (size_t)j * 4 * 65536;
    EpiPool E; E.x = p.x; E.xb = (bf16_t*)(p.ws + WS_XB); E.pb = p.pool_b + j * DM; E.ps = p.pool_scale + j * DM;
    gemm_phase<GCfg<1024, 256, 256, 128, false>>(lds, S, E);
}
DI void ph_qkv(LAS unsigned char* lds, int j) {
    LOAD_PARAMS();
    SchedDense S; S.bid = bid_(); S.A = (const bf16_t*)(p.ws + WS_XB); S.B = (const bf16_t*)(p.ws + WS_WQKV) + (size_t)j * 3072 * 1024; S.npn = 12; S.ldb = 1024;
    EpiQKV E; E.q = (bf16_t*)(p.ws + WS_Q); E.rstd = (const float*)(p.ws + WS_RSTD); E.qg = p.sb_qg + j * HD; E.kg = p.sb_kg + j * HD;
    gemm_phase<GCfg<1024, 1024, 1024, 32, true>>(lds, S, E);
}
DI void ph_wo(LAS unsigned char* lds, int j) {
    LOAD_PARAMS();
    SchedDense S; S.bid = bid_(); S.A = (const bf16_t*)(p.ws + WS_O); S.B = (const bf16_t*)(p.ws + WS_WO) + (size_t)j * 1024 * 1024; S.npn = 4; S.ldb = 1024;
    EpiWo E; E.x = p.x; E.xb = (bf16_t*)(p.ws + WS_XB);
    gemm_phase<GCfg<1024, 1024, 1024, 128, false>>(lds, S, E);
}
DI void ph_gu(LAS unsigned char* lds, int li) {
    LOAD_PARAMS();
    const Entry* list = (const Entry*)(p.ws + WS_LIST);
    SchedMoe S; S.lds = lds; S.A = (const bf16_t*)(p.ws + WS_XB);
    S.W = (const bf16_t*)(p.ws + WS_WGU) + (size_t)li * NE * 512 * 1024; S.gather = true; S.w_estride = (size_t)512 * 1024; S.w_pnrows = 128; S.ldb = 1024;
    S.build((const unsigned*)(p.ws + WS_CTL) + CW_CNT + 32 * li, list, 2, bid_(), tid_());
    EpiGU E; E.hid = (bf16_t*)(p.ws + WS_HID); E.list = list;
    gemm_phase<GCfg<1024, 1024, 1024, 256, false>>(lds, S, E);
}
DI void ph_down(LAS unsigned char* lds, int li) {
    LOAD_PARAMS();
    const Entry* list = (const Entry*)(p.ws + WS_LIST);
    SchedMoe S; S.lds = lds; S.A = (const bf16_t*)(p.ws + WS_HID);
    S.W = (const bf16_t*)(p.ws + WS_WD) + (size_t)li * NE * 1024 * 256; S.gather = false; S.w_estride = (size_t)1024 * 256; S.w_pnrows = 256; S.ldb = 256;
    S.build((const unsigned*)(p.ws + WS_CTL) + CW_CNT + 32 * li, list, 4, bid_(), tid_());
    EpiDown E; E.yb = (bf16_t*)(p.ws + WS_YBUF); E.list = list;
    gemm_phase<GCfg<256, 256, 256, 128, false>>(lds, S, E);
}

#define XB_TMO      128
#define XB_XCNT(j)  (256  + 64 * (j))
#define XB_XSUB(j)  (1280 + 64 * (j))
#define XB_XGEN(j)  (2304 + 64 * (j))
#define XB_TOP      3328
#define XB_TOPGEN   3392
#define XCD_BAR_WORDS 3456
#define XB_SPIN_CAP (1u << 18)

__device__ __forceinline__ unsigned xb_ld(unsigned* p)              { return __hip_atomic_load(p, __ATOMIC_RELAXED, __HIP_MEMORY_SCOPE_AGENT); }
__device__ __forceinline__ unsigned xb_add(unsigned* p, unsigned v) { return __hip_atomic_fetch_add(p, v, __ATOMIC_RELAXED, __HIP_MEMORY_SCOPE_AGENT); }
__device__ __forceinline__ unsigned xb_xcc_id() { return (unsigned)__builtin_amdgcn_s_getreg((3 << 11) | 20) & 0xFu; }
#define XB_SPIN(cond, bar) do { unsigned _sp = 0; while (cond) { __builtin_amdgcn_s_sleep(1); \
    if ((++_sp & 255u) == 0u) { if (xb_ld(&(bar)[XB_TMO])) break; if (_sp > XB_SPIN_CAP) { atomicAdd(&(bar)[XB_TMO], 1u); break; } } } } while (0)

struct XcdBarrier {
    unsigned* bar; unsigned x;
    volatile LAS unsigned* st;
};

__device__ __forceinline__ XcdBarrier xcd_barrier_post(unsigned* bar, volatile LAS unsigned* st) {
    XcdBarrier b; b.bar = bar; b.x = xb_xcc_id(); b.st = st;
    if (threadIdx.x == 0) (void)xb_add(&bar[XB_XCNT(b.x)], 1u);
    return b;
}
__device__ __forceinline__ void xcd_barrier_complete(unsigned* bar, unsigned x, unsigned& nloc, unsigned& nx) {
    const unsigned G = gridDim.x * gridDim.y * gridDim.z;
    unsigned sum, cnt, mine, sp = 0u;
    for (;;) {
        sum = 0u; cnt = 0u; mine = 0u;
#pragma unroll
        for (unsigned j = 0; j < 16; ++j) { const unsigned c = xb_ld(&bar[XB_XCNT(j)]); sum += c; cnt += (c > 0u) ? 1u : 0u; mine = (j == x) ? c : mine; }
        if (sum == G) break;
        __builtin_amdgcn_s_sleep(1);
        if ((++sp & 255u) == 0u) { if (xb_ld(&bar[XB_TMO])) break; if (sp > XB_SPIN_CAP) { atomicAdd(&bar[XB_TMO], 1u); break; } }
    }
    nloc = mine > 0u ? mine : 1u; nx = cnt > 0u ? cnt : 1u;
}

__device__ __forceinline__ void xcd_barrier(const XcdBarrier& b) {
    asm volatile("s_waitcnt vmcnt(0)" ::: "memory");
    __syncthreads();
    if (threadIdx.x == 0) {
        unsigned* bar = b.bar; unsigned bx = b.x;
        asm volatile("" : "+s"(bar), "+s"(bx));
        __builtin_amdgcn_s_waitcnt(0);
        unsigned nloc = b.st[0], nx = b.st[1];
        if (nloc == 0u) { xcd_barrier_complete(bar, bx, nloc, nx); b.st[0] = nloc; b.st[1] = nx; }
        const unsigned old = xb_add(&bar[XB_XSUB(bx)], 1u);
        const unsigned gen = old / nloc;
        if (old + 1u == (gen + 1u) * nloc) {
            __builtin_amdgcn_fence(__ATOMIC_RELEASE, "agent");
            asm volatile("s_waitcnt vmcnt(0)" ::: "memory");
            const unsigned og = xb_add(&bar[XB_TOP], 1u);
            const unsigned tg = og / nx;
            if (og + 1u == (tg + 1u) * nx) xb_add(&bar[XB_TOPGEN], 1u);
            else XB_SPIN(xb_ld(&bar[XB_TOPGEN]) == tg, bar);
            __builtin_amdgcn_fence(__ATOMIC_ACQUIRE, "agent");
            xb_add(&bar[XB_XGEN(bx)], 1u);
            asm volatile("s_waitcnt vmcnt(0)" ::: "memory");
        } else {
            XB_SPIN(xb_ld(&bar[XB_XGEN(bx)]) == gen, bar);
            __builtin_amdgcn_fence(__ATOMIC_ACQUIRE, "agent");
            asm volatile("s_waitcnt vmcnt(0)" ::: "memory");
        }
    }
    __syncthreads();
}
constexpr int CW_BAR = 4096;

extern __shared__ __attribute__((aligned(16))) unsigned char smem_raw[];
__global__ void __launch_bounds__(NTHR, 2) fwd(Params pk) {
    LAS unsigned char* smem = (LAS unsigned char*)smem_raw;
    float* lds = (float*)smem_raw;
    if (threadIdx.x < 4) ((LAS unsigned*)(smem + LDS_XBW))[threadIdx.x] = 0u;
    __syncthreads();
    XcdBarrier bar;
    { LOAD_PARAMS(); bar = xcd_barrier_post((unsigned*)(p.ws + WS_CTL) + CW_BAR, (volatile LAS unsigned*)(smem + LDS_XBW)); }
    ph_prologue(lds);
    for (int i = 0; i < DEPTH; ++i) {
        const int j = i >> 1;
        if ((i & 1) == 0) {
            ph_combine(i == 0, i != 0, false);
            xcd_barrier(bar);
            ph_pooldiff(j);
            xcd_barrier(bar);
            ph_poolgemm(smem, j);
        } else {
            ph_combine(false, true, true);
            xcd_barrier(bar);
            ph_qkv(smem, j);
            xcd_barrier(bar);
            ph_attn();
            xcd_barrier(bar);
            ph_wo(smem, j);
        }
        xcd_barrier(bar);
        ph_router(i);
        xcd_barrier(bar);
        ph_gu(smem, i);
        xcd_barrier(bar);
        ph_down(smem, i);
        xcd_barrier(bar);
    }
    ph_combine(false, true, false);
}

extern "C" void kernel_launch(void* const* d_in, const int* in_sizes, int n_in, void* d_out, int out_size, void* d_ws, size_t ws_size, hipStream_t stream) {
    if (ws_size < WS_END || n_in < 18) return;
    Params p{};
    p.x_in = (const float*)d_in[0]; p.pool_norm = (const float*)d_in[1]; p.pool_w = (const float*)d_in[2]; p.pool_b = (const float*)d_in[3]; p.pool_scale = (const float*)d_in[4];
    p.sb_norm = (const float*)d_in[5]; p.sb_wqkv = (const float*)d_in[6]; p.sb_qg = (const float*)d_in[7]; p.sb_kg = (const float*)d_in[8]; p.sb_wo = (const float*)d_in[9];
    p.moe_norm = (const float*)d_in[10]; p.moe_wg = (const float*)d_in[11]; p.moe_bg = (const float*)d_in[12]; p.moe_wr = (const float*)d_in[13]; p.moe_br = (const float*)d_in[14];
    p.moe_wgate = (const float*)d_in[15]; p.moe_wup = (const float*)d_in[16]; p.moe_wdown = (const float*)d_in[17];
    p.x = (float*)d_out; p.ws = (unsigned char*)d_ws;
    static int grid = 0;
    if (!grid) {
        int dev = 0, cus = 0, per_cu = 0;
        if (hipGetDevice(&dev) != hipSuccess || hipDeviceGetAttribute(&cus, hipDeviceAttributeMultiprocessorCount, dev) != hipSuccess) { grid = -1; return; }
        if (hipFuncSetAttribute((const void*)fwd, hipFuncAttributeMaxDynamicSharedMemorySize, LDS_BYTES) != hipSuccess) { grid = -1; return; }
        if (hipOccupancyMaxActiveBlocksPerMultiprocessor(&per_cu, (const void*)fwd, NTHR, LDS_BYTES) != hipSuccess || per_cu < 1) { (void)hipGetLastError(); }
        grid = cus;
    }
    if (grid <= 0) return;
    (void)hipMemsetAsync((char*)d_ws + WS_CTL, 0, CTL_BYTES, stream);
    hipLaunchKernelGGL(fwd, dim3(grid), dim3(NTHR), LDS_BYTES, stream, p);
}
```

```cpp
#include <hip/hip_runtime.h>
#include <stdint.h>

#define DI __device__ __forceinline__
#define LAS __attribute__((address_space(3)))
typedef unsigned short bf16_t;
typedef short bf16x8 __attribute__((ext_vector_type(8)));
typedef float f32x4 __attribute__((ext_vector_type(4)));
typedef float f32x16 __attribute__((ext_vector_type(16)));
typedef unsigned u32x4 __attribute__((ext_vector_type(4)));
typedef unsigned u32x2 __attribute__((ext_vector_type(2)));

constexpr int T = 16384, DM = 1024, SEQ = 8192, NH = 16, HD = 64, DEPTH = 4, NE = 32, DE = 256;
constexpr float EPS = 1e-6f;
constexpr int NTHR = 512, NWAVE = 8;
constexpr int LIST_CAP = 16384;
constexpr int DUMMY_ROW = 2 * T;

constexpr size_t MiB = 1u << 20;
constexpr size_t WS_CTL = 0, CTL_BYTES = 1 * MiB;
constexpr size_t WS_WQKV = 1 * MiB;
constexpr size_t WS_WO = 13 * MiB;
constexpr size_t WS_WPOOL = 17 * MiB;
constexpr size_t WS_RSTD = 18 * MiB;
constexpr size_t WS_WRH = 19 * MiB, WS_WRL = WS_WRH + 512 * 1024;
constexpr size_t WS_WGU = 20 * MiB;
constexpr size_t WS_WD = 148 * MiB;
constexpr size_t WS_XB = 212 * MiB;
constexpr size_t WS_XB1 = 384 * MiB;
constexpr size_t WS_NEED = 416 * MiB;
constexpr size_t WS_LIST = 244 * MiB;
constexpr size_t WS_Q = 256 * MiB;
constexpr size_t WS_DIFF = WS_Q;
constexpr size_t WS_K = 288 * MiB, WS_V = 320 * MiB, WS_O = 352 * MiB;
constexpr size_t WS_YBUF = 288 * MiB;
constexpr size_t WS_HID = 354 * MiB;
constexpr size_t WS_END = 384 * MiB;
static_assert(WS_V - WS_K == WS_K - WS_Q, "Q, K, V equally spaced");
static_assert(WS_YBUF + (size_t)(2 * T + 1) * DM * 2 <= WS_HID, "ybuf");
static_assert(WS_HID + (size_t)(2 * T + NE * 256) * DE * 2 <= WS_END, "hid");
constexpr int CW_CNT = 1024;

struct Entry { int dst; float rstd; float w; int tok; };

struct Params {
    const float* x_in; const float* pool_norm; const float* pool_w; const float* pool_b; const float* pool_scale;
    const float* sb_norm; const float* sb_wqkv; const float* sb_qg; const float* sb_kg; const float* sb_wo;
    const float* moe_norm; const float* moe_wg; const float* moe_bg; const float* moe_wr; const float* moe_br;
    const float* moe_wgate; const float* moe_wup; const float* moe_wdown;
    float* x;
    unsigned char* ws;
};

typedef const unsigned long long __attribute__((address_space(4)))* KArgPtr;
DI Params load_params() {
    KArgPtr q = (KArgPtr)__builtin_amdgcn_kernarg_segment_ptr(); asm volatile("" : "+s"(q));
    Params p;
    p.x_in = (const float*)q[0]; p.pool_norm = (const float*)q[1]; p.pool_w = (const float*)q[2]; p.pool_b = (const float*)q[3]; p.pool_scale = (const float*)q[4];
    p.sb_norm = (const float*)q[5]; p.sb_wqkv = (const float*)q[6]; p.sb_qg = (const float*)q[7]; p.sb_kg = (const float*)q[8]; p.sb_wo = (const float*)q[9];
    p.moe_norm = (const float*)q[10]; p.moe_wg = (const float*)q[11]; p.moe_bg = (const float*)q[12]; p.moe_wr = (const float*)q[13]; p.moe_br = (const float*)q[14];
    p.moe_wgate = (const float*)q[15]; p.moe_wup = (const float*)q[16]; p.moe_wdown = (const float*)q[17];
    p.x = (float*)q[18]; p.ws = (unsigned char*)q[19];
    return p;
}
#define LOAD_PARAMS() const Params p = load_params()
DI int tid_() { int t = threadIdx.x; asm volatile("" : "+v"(t)); return t; }
DI int bid_() { int b = blockIdx.x; asm volatile("" : "+s"(b)); return b; }

DI unsigned cvt_pk_bf16(float lo, float hi) { unsigned r; asm volatile("v_cvt_pk_bf16_f32 %0, %1, %2" : "=v"(r) : "v"(lo), "v"(hi)); return r; }
DI float bf_lo(unsigned u) { return __uint_as_float(u << 16); }
DI float bf_hi(unsigned u) { return __uint_as_float(u & 0xffff0000u); }
DI float shflx(float v, int lane, int m) { return __int_as_float(__builtin_amdgcn_ds_bpermute((lane ^ m) << 2, __float_as_int(v))); }
DI float wave_sum(float v, int lane) {
#pragma unroll
    for (int o = 32; o >= 1; o >>= 1) v += shflx(v, lane, o);
    return v;
}
DI int perm32(int rho) { const int n = rho >> 4, i = rho & 15; return 8 * (i >> 2) + 4 * n + (i & 3); }

struct CvtTile { const float* src; bf16_t* dst; const float* scale; int K, N; };
DI CvtTile cvt_locate(const Params& p, int g) {
    int K, N, sdiv = 1; const float* sb; bf16_t* db; const float* scb = nullptr; size_t sms, dms;
    if (g < 384) { K = 1024; N = 3072; sb = p.sb_wqkv; db = (bf16_t*)(p.ws + WS_WQKV); scb = p.sb_norm; sms = (size_t)1024 * 3072; dms = sms; }
    else if ((g -= 384) < 128) { K = 1024; N = 1024; sb = p.sb_wo; db = (bf16_t*)(p.ws + WS_WO); sms = (size_t)1024 * 1024; dms = sms; }
    else if ((g -= 128) < 32) { K = 256; N = 256; sb = p.pool_w; db = (bf16_t*)(p.ws + WS_WPOOL); sms = 65536; dms = 65536; }
    else if ((g -= 32) < 2048) { K = 1024; N = 256; sb = p.moe_wgate; db = (bf16_t*)(p.ws + WS_WGU); scb = p.moe_norm; sdiv = 32; sms = (size_t)1024 * 256; dms = (size_t)512 * 1024; }
    else if ((g -= 2048) < 2048) { K = 1024; N = 256; sb = p.moe_wup; db = (bf16_t*)(p.ws + WS_WGU) + (size_t)256 * 1024; scb = p.moe_norm; sdiv = 32; sms = (size_t)1024 * 256; dms = (size_t)512 * 1024; }
    else { g -= 2048; K = 256; N = 1024; sb = p.moe_wdown; db = (bf16_t*)(p.ws + WS_WD); sms = (size_t)256 * 1024; dms = sms; }
    const int tn = N / 256, per = (K / 64) * tn, mat = g / per, rem = g % per, k0 = (rem / tn) * 64, n0 = (rem % tn) * 256;
    CvtTile t; t.K = K; t.N = N;
    t.src = sb + (size_t)mat * sms + (size_t)k0 * N + n0;
    t.dst = db + (size_t)mat * dms + (size_t)n0 * K + k0;
    t.scale = scb ? scb + (size_t)(mat / sdiv) * K + k0 : nullptr;
    return t;
}
constexpr int CVT_TILES = 384 + 128 + 32 + 2048 + 2048 + 2048;
DI void ph_prologue(LAS unsigned char* ldsb) {
    LOAD_PARAMS();
    const int tid = tid_(), bid = bid_();
    LAS float* lds = (LAS float*)ldsb;
    const int n4 = tid & 63, kq = tid >> 6;
    f32x4 regs[8]; float scl[8];
    int g = bid;
    CvtTile cur{};
    if (g < CVT_TILES) {
        cur = cvt_locate(p, g);
#pragma unroll
        for (int i = 0; i < 8; ++i) { regs[i] = *(const f32x4*)(cur.src + (size_t)(kq + 8 * i) * cur.N + 4 * n4); scl[i] = cur.scale ? cur.scale[kq + 8 * i] : 1.0f; }
    }
    for (; g < CVT_TILES; g += gridDim.x) {
        __syncthreads();
#pragma unroll
        for (int i = 0; i < 8; ++i) { const int k = kq + 8 * i; *(LAS f32x4*)(lds + k * 256 + ((4 * n4) ^ (4 * ((k >> 3) & 7)))) = regs[i] * scl[i]; }
        __syncthreads();
        const CvtTile now = cur;
        if (g + (int)gridDim.x < CVT_TILES) {
            cur = cvt_locate(p, g + gridDim.x);
#pragma unroll
            for (int i = 0; i < 8; ++i) { regs[i] = *(const f32x4*)(cur.src + (size_t)(kq + 8 * i) * cur.N + 4 * n4); scl[i] = cur.scale ? cur.scale[kq + 8 * i] : 1.0f; }
        }
#pragma unroll
        for (int it = 0; it < 4; ++it) {
            const int q = tid + 512 * it, ko = q & 7, n = q >> 3;
            float v[8];
#pragma unroll
            for (int j = 0; j < 8; ++j) v[j] = lds[(8 * ko + j) * 256 + (n ^ (4 * ko))];
            u32x4 w; w[0] = cvt_pk_bf16(v[0], v[1]); w[1] = cvt_pk_bf16(v[2], v[3]); w[2] = cvt_pk_bf16(v[4], v[5]); w[3] = cvt_pk_bf16(v[6], v[7]);
            *(u32x4*)(now.dst + (size_t)n * now.K + 8 * ko) = w;
        }
    }
    bf16_t* wh = (bf16_t*)(p.ws + WS_WRH); bf16_t* wl = (bf16_t*)(p.ws + WS_WRL);
    for (int idx = bid * NTHR + tid; idx < DEPTH * 48 * DM; idx += gridDim.x * NTHR) {
        const int l = idx / (48 * DM), n = (idx / DM) % 48, k = idx % DM;
        float v = 0.f;
        if (n < 4) v = p.moe_wg[((size_t)l * DM + k) * 4 + n]; else if (n < 36) v = p.moe_wr[((size_t)l * DM + k) * 32 + (n - 4)];
        v *= p.moe_norm[l * DM + k];
        const unsigned h = cvt_pk_bf16(v, 0.f), lo = cvt_pk_bf16(v - bf_lo(h), 0.f);
        wh[idx] = (bf16_t)(h & 0xffffu); wl[idx] = (bf16_t)(lo & 0xffffu);
    }
}

DI void unpack8(const u32x4 u, float (&f)[8]) {
#pragma unroll
    for (int i = 0; i < 4; ++i) { f[2 * i] = bf_lo(u[i]); f[2 * i + 1] = bf_hi(u[i]); }
}
template <bool FINAL>
DI void ph_combine(int src_buf) {
    LOAD_PARAMS();
    const int tid = tid_(), bid = bid_(), wid = tid >> 6, lane = tid & 63;
    const bf16_t* xs = (const bf16_t*)(p.ws + (src_buf ? WS_XB1 : WS_XB));
    bf16_t* xd = (bf16_t*)(p.ws + (src_buf ? WS_XB : WS_XB1));
    const bf16_t* yb = (const bf16_t*)(p.ws + WS_YBUF);
    float* rstd = (float*)(p.ws + WS_RSTD);
    for (int t = bid * NWAVE + wid; t < T; t += gridDim.x * NWAVE) {
        float ss = 0.f;
#pragma unroll
        for (int i = 0; i < 2; ++i) {
            const size_t o = (size_t)t * DM + lane * 8 + 512 * i;
            float a[8], b[8], c[8];
            unpack8(*(const u32x4*)(xs + o), a); unpack8(*(const u32x4*)(yb + o), b); unpack8(*(const u32x4*)(yb + (size_t)T * DM + o), c);
#pragma unroll
            for (int e = 0; e < 8; ++e) a[e] += b[e] + c[e];
            if (FINAL) {
                *(f32x4*)(p.x + o) = (f32x4){a[0], a[1], a[2], a[3]}; *(f32x4*)(p.x + o + 4) = (f32x4){a[4], a[5], a[6], a[7]};
            } else {
                u32x4 w; w[0] = cvt_pk_bf16(a[0], a[1]); w[1] = cvt_pk_bf16(a[2], a[3]); w[2] = cvt_pk_bf16(a[4], a[5]); w[3] = cvt_pk_bf16(a[6], a[7]);
                *(u32x4*)(xd + o) = w;
                float r[8]; unpack8(w, r);
#pragma unroll
                for (int e = 0; e < 8; ++e) ss += r[e] * r[e];
            }
        }
        if (!FINAL) { ss = wave_sum(ss, lane); if (lane == 0) rstd[t] = rsqrtf(ss * (1.0f / DM) + EPS); }
    }
}

constexpr int PF_ROWS = 47, PF_TOK = 32;
DI void ph_poolfuse(LAS unsigned char* ldsb, int j, bool first) {
    LOAD_PARAMS();
    const int tid = tid_(), bid = bid_(), wid = tid >> 6, lane = tid & 63;
    const bf16_t* xs = (const bf16_t*)(p.ws + WS_XB1);
    bf16_t* xd = (bf16_t*)(p.ws + WS_XB);
    const bf16_t* yb = (const bf16_t*)(p.ws + WS_YBUF);
    const float* gain = p.pool_norm + j * DM;
    bf16_t* diff = (bf16_t*)(p.ws + WS_DIFF);
    LAS unsigned char* ht = ldsb;
    for (int tile = bid; tile < T / PF_TOK; tile += gridDim.x) {
        const int t0 = tile * PF_TOK, s0 = t0 & (SEQ - 1);
        for (int rr = wid; rr < PF_ROWS; rr += NWAVE) {
            const int t = t0 - 15 + rr;
            if (s0 == 0 && rr < 15) {
#pragma unroll
                for (int i = 0; i < 2; ++i) *(LAS u32x4*)(ht + rr * 2048 + (lane * 8 + 512 * i) * 2) = (u32x4){0u, 0u, 0u, 0u};
                continue;
            }
            float v[2][8]; u32x4 w[2]; float ss = 0.f;
#pragma unroll
            for (int i = 0; i < 2; ++i) {
                const size_t o = (size_t)t * DM + lane * 8 + 512 * i;
                if (first) {
                    const f32x4 a = *(const f32x4*)(p.x_in + o), b = *(const f32x4*)(p.x_in + o + 4);
#pragma unroll
                    for (int e = 0; e < 4; ++e) { v[i][e] = a[e]; v[i][4 + e] = b[e]; }
                } else {
                    float b[8], c[8];
                    unpack8(*(const u32x4*)(xs + o), v[i]); unpack8(*(const u32x4*)(yb + o), b); unpack8(*(const u32x4*)(yb + (size_t)T * DM + o), c);
#pragma unroll
                    for (int e = 0; e < 8; ++e) v[i][e] += b[e] + c[e];
                }
                w[i][0] = cvt_pk_bf16(v[i][0], v[i][1]); w[i][1] = cvt_pk_bf16(v[i][2], v[i][3]); w[i][2] = cvt_pk_bf16(v[i][4], v[i][5]); w[i][3] = cvt_pk_bf16(v[i][6], v[i][7]);
                if (rr >= 15) *(u32x4*)(xd + o) = w[i];
                unpack8(w[i], v[i]);
#pragma unroll
                for (int e = 0; e < 8; ++e) ss += v[i][e] * v[i][e];
            }
            ss = wave_sum(ss, lane);
            const float rs = rsqrtf(ss * (1.0f / DM) + EPS);
#pragma unroll
            for (int i = 0; i < 2; ++i) {
                u32x4 hw; hw[0] = cvt_pk_bf16(v[i][0] * rs, v[i][1] * rs); hw[1] = cvt_pk_bf16(v[i][2] * rs, v[i][3] * rs); hw[2] = cvt_pk_bf16(v[i][4] * rs, v[i][5] * rs); hw[3] = cvt_pk_bf16(v[i][6] * rs, v[i][7] * rs);
                *(LAS u32x4*)(ht + rr * 2048 + (lane * 8 + 512 * i) * 2) = hw;
            }
        }
        __syncthreads();
        {
            const int c = 2 * tid, win = 2 << (c >> 8);
            const float g0 = gain[c], g1 = gain[c + 1];
            float S0 = 0.f, S1 = 0.f;
            const LAS unsigned char* col = ht + c * 2;
#pragma unroll 4
            for (int rr = 0; rr < PF_ROWS; ++rr) {
                const unsigned hv = *(const LAS unsigned*)(col + rr * 2048);
                const float h0 = bf_lo(hv), h1 = bf_hi(hv);
                S0 += h0; S1 += h1;
                if (rr >= win) { const unsigned ov = *(const LAS unsigned*)(col + (rr - win) * 2048); S0 -= bf_lo(ov); S1 -= bf_hi(ov); }
                if (rr >= 15) {
                    const int s = s0 + rr - 15;
                    const float inv = 1.0f / (float)((s + 1 < win) ? s + 1 : win);
                    *(unsigned*)(diff + (size_t)(t0 + rr - 15) * DM + c) = cvt_pk_bf16((S0 * inv - h0) * g0, (S1 * inv - h1) * g1);
                }
            }
        }
        __syncthreads();
    }
}

struct Unit { const bf16_t* A; const bf16_t* B; int pm, pn, e, nvalid, row0, lbase; };
template <int LDA_, int LDB_, int K_, int BH_, bool HEADMAP_> struct GCfg { static constexpr int LDA = LDA_, LDB = LDB_, K = K_, BH = BH_; static constexpr bool HEADMAP = HEADMAP_; };

constexpr int BK = 64, HTB = 128 * BK * 2  , STAGE_BYTES = 8 * HTB;
DI int lds_byte(int r, int c) { const int st = (r >> 4) * 2 + (c >> 5), rr = r & 15, cc = c & 31, ob = rr * 64 + cc * 2; return st * 1024 + (ob ^ (((ob >> 9) & 1) << 5)); }
DI void stage_rc(int b, int& R, int& C) { const int st = b / 1024, sb = b % 1024, swz = sb ^ (((sb >> 9) & 1) << 5); R = (st >> 1) * 16 + swz / 64; C = (st & 1) * 32 + (swz % 64) / 2; }

template <class Cfg, class Sched, class Epi>
DI void gemm_phase(LAS unsigned char* lds, const Sched& S, const Epi& E) {
    const int tid = tid_(), wid = __builtin_amdgcn_readfirstlane(tid >> 6), lane = tid & 63, wr = wid >> 2, wc = wid & 3, fr = lane & 15, fq = lane >> 4;
    constexpr int nt = Cfg::K / BK;
    static_assert(Cfg::K % 128 == 0 && Cfg::K >= 256, "K");
    unsigned voffA[2][2], voffB[2];
    int R0, C0, R1, C1; stage_rc(tid * 16, R0, C0); stage_rc(tid * 16 + 8192, R1, C1);
    voffB[0] = (unsigned)(((Cfg::HEADMAP ? 64 * (R0 >> 5) : (R0 & ~31)) + perm32(R0 & 31)) * Cfg::LDB + C0) * 2u;
    voffB[1] = (unsigned)(((Cfg::HEADMAP ? 64 * (R1 >> 5) : (R1 & ~31)) + perm32(R1 & 31)) * Cfg::LDB + C1) * 2u;
    constexpr size_t kstep = (size_t)(BK * 2);
    constexpr size_t bhstep = (size_t)Cfg::BH * Cfg::LDB * 2;
    const unsigned ldsw = (unsigned)wid * 1024u;
    const int aoff = lds_byte(wr * 64 + fr, fq * 8), boff = lds_byte(wc * 32 + fr, fq * 8);
#define PG8_SA(b, h) (((b) * 2 + (h)) * HTB)
#define PG8_SB(b, h) ((4 + (b) * 2 + (h)) * HTB)
#define PG8_STAGE(bufoff, gbase, voff) do { _Pragma("unroll") for (int _i = 0; _i < 2; ++_i) \
        __builtin_amdgcn_global_load_lds((const unsigned*)((const char*)(gbase) + (voff)[_i]), (LAS unsigned*)(lds + (bufoff) + ldsw + _i * 8192), 16, 0, 0); } while (0)
#define PG8_LDA(dst, b, h) do { _Pragma("unroll") for (int m = 0; m < 4; ++m) _Pragma("unroll") for (int k = 0; k < 2; ++k) dst[m][k] = *(const LAS bf16x8*)(lds + PG8_SA(b, h) + aoff + m * 2048 + k * 1024); } while (0)
#define PG8_LDB(dst, b, h) do { _Pragma("unroll") for (int n = 0; n < 2; ++n) _Pragma("unroll") for (int k = 0; k < 2; ++k) dst[n][k] = *(const LAS bf16x8*)(lds + PG8_SB(b, h) + boff + n * 2048 + k * 1024); } while (0)
#define PG8_MMA(ai, bj, At, Bt) do { __builtin_amdgcn_s_setprio(1); _Pragma("unroll") for (int m = 0; m < 4; ++m) _Pragma("unroll") for (int n = 0; n < 2; ++n) _Pragma("unroll") for (int k = 0; k < 2; ++k) \
        acc[ai][bj][m][n] = __builtin_amdgcn_mfma_f32_16x16x32_bf16(Bt[n][k], At[m][k], acc[ai][bj][m][n], 0, 0, 0); __builtin_amdgcn_s_setprio(0); } while (0)
#define PG8_WAIT_V(n) asm volatile("s_waitcnt vmcnt(" #n ")" ::: "memory")
#define PG8_WAIT_L(n) asm volatile("s_waitcnt lgkmcnt(" #n ")" ::: "memory")
#define PG8_BAR __builtin_amdgcn_s_barrier()
#define PG8_SCHED __builtin_amdgcn_sched_barrier(0)
#define PG8_AROWS(uidx, un) do { voffA[0][0] = (unsigned)S.arow(uidx, un, R0) * (unsigned)(Cfg::LDA * 2) + (unsigned)(C0 * 2); voffA[0][1] = (unsigned)S.arow(uidx, un, R1) * (unsigned)(Cfg::LDA * 2) + (unsigned)(C1 * 2); \
        voffA[1][0] = (unsigned)S.arow(uidx, un, 128 + R0) * (unsigned)(Cfg::LDA * 2) + (unsigned)(C0 * 2); voffA[1][1] = (unsigned)S.arow(uidx, un, 128 + R1) * (unsigned)(Cfg::LDA * 2) + (unsigned)(C1 * 2); } while (0)
    Unit cur, nxt; int ui = 0;
    if (!S.next(0, cur)) return;
    f32x4 acc[2][2][4][2];
#pragma unroll
    for (int a = 0; a < 2; ++a)
#pragma unroll
        for (int b = 0; b < 2; ++b)
#pragma unroll
            for (int m = 0; m < 4; ++m)
#pragma unroll
                for (int n = 0; n < 2; ++n) acc[a][b][m][n] = (f32x4){0.f, 0.f, 0.f, 0.f};
    bf16x8 At[4][2], B0[2][2], B1[2][2];
    PG8_AROWS(0, cur);
    const char* cA = (const char*)cur.A; const char* cB = (const char*)cur.B;
    PG8_STAGE(PG8_SB(0, 0), cB, voffB); PG8_STAGE(PG8_SB(0, 1), cB + bhstep, voffB); PG8_STAGE(PG8_SA(0, 0), cA, voffA[0]); PG8_STAGE(PG8_SA(0, 1), cA, voffA[1]);
    if (wr == 1) PG8_BAR;
    PG8_WAIT_V(2); PG8_BAR;
    PG8_STAGE(PG8_SB(1, 0), cB + kstep, voffB); PG8_STAGE(PG8_SA(1, 0), cA + kstep, voffA[0]); PG8_STAGE(PG8_SB(1, 1), cB + bhstep + kstep, voffB);
    PG8_WAIT_V(6); PG8_BAR;
    for (;;) {
        const bool has_next = S.next(ui + 1, nxt);
        const char* nA = has_next ? (const char*)nxt.A : cA; const char* nB = has_next ? (const char*)nxt.B : cB;
#pragma unroll 1
        for (int t = 0; t < nt; t += 2) {
            const bool last = (t == nt - 2);
            const char* a1 = cA + (size_t)(t + 1) * kstep;
            const char* a2 = last ? nA : cA + (size_t)(t + 2) * kstep; const char* b2 = last ? nB : cB + (size_t)(t + 2) * kstep;
            const char* a3 = a2 + kstep; const char* b3 = b2 + kstep;
            PG8_LDB(B0, 0, 0); PG8_LDB(B1, 0, 1); PG8_SCHED; PG8_LDA(At, 0, 0); PG8_STAGE(PG8_SA(1, 1), a1, voffA[1]);
            if (last && has_next) PG8_AROWS(ui + 1, nxt);
            PG8_WAIT_V(8); PG8_WAIT_L(0); PG8_BAR; PG8_MMA(0, 0, At, B0); PG8_MMA(0, 1, At, B1); PG8_BAR; PG8_SCHED;
            PG8_LDA(At, 0, 1); PG8_STAGE(PG8_SB(0, 0), b2, voffB); PG8_STAGE(PG8_SB(0, 1), b2 + bhstep, voffB); PG8_STAGE(PG8_SA(0, 0), a2, voffA[0]);
            PG8_WAIT_V(8); PG8_WAIT_L(0); PG8_BAR; PG8_MMA(1, 0, At, B0); PG8_MMA(1, 1, At, B1); PG8_BAR; PG8_SCHED;
            PG8_LDB(B0, 1, 0); PG8_LDB(B1, 1, 1); PG8_SCHED; PG8_LDA(At, 1, 0); PG8_STAGE(PG8_SA(0, 1), a2, voffA[1]);
            PG8_WAIT_V(8); PG8_WAIT_L(0); PG8_BAR; PG8_MMA(0, 0, At, B0); PG8_MMA(0, 1, At, B1); PG8_BAR; PG8_SCHED;
            PG8_LDA(At, 1, 1); PG8_STAGE(PG8_SB(1, 0), b3, voffB); PG8_STAGE(PG8_SB(1, 1), b3 + bhstep, voffB); PG8_STAGE(PG8_SA(1, 0), a3, voffA[0]);
            PG8_WAIT_V(8); PG8_WAIT_L(0); PG8_BAR; PG8_MMA(1, 0, At, B0); PG8_MMA(1, 1, At, B1); PG8_BAR; PG8_SCHED;
        }
        if (wr == 0) PG8_BAR;
        E(acc, cur, wr, wc, fr, fq);
        if (!has_next) break;
#pragma unroll
        for (int a = 0; a < 2; ++a)
#pragma unroll
            for (int b = 0; b < 2; ++b)
#pragma unroll
                for (int m = 0; m < 4; ++m)
#pragma unroll
                    for (int n = 0; n < 2; ++n) acc[a][b][m][n] = (f32x4){0.f, 0.f, 0.f, 0.f};
        cur = nxt; cA = nA; cB = nB; ++ui;
        if (wr == 1) PG8_BAR;
    }
    PG8_WAIT_V(0);
    PG8_BAR;
#undef PG8_SA
#undef PG8_SB
#undef PG8_STAGE
#undef PG8_LDA
#undef PG8_LDB
#undef PG8_MMA
#undef PG8_WAIT_V
#undef PG8_WAIT_L
#undef PG8_BAR
#undef PG8_SCHED
#undef PG8_AROWS
}

struct SchedPool {
    const bf16_t* diff; const bf16_t* w; int bid;
    DI bool next(int i, Unit& u) const { const int L = i * gridDim.x + bid; if (L >= 256) return false; u.pm = L >> 2; u.pn = L & 3; u.A = diff + 256 * u.pn; u.B = w + (size_t)u.pn * 65536; return true; }
    DI int arow(int, const Unit& u, int r) const { return u.pm * 256 + r; }
};
struct SchedDense {
    const bf16_t* A; const bf16_t* B; int npn, ldb, bid;
    DI bool next(int i, Unit& u) const { const int L = i * gridDim.x + bid; if (L >= 64 * npn) return false; u.pm = L / npn; u.pn = L % npn; u.A = A; u.B = B + (size_t)u.pn * 256 * ldb; return true; }
    DI int arow(int, const Unit& u, int r) const { return u.pm * 256 + r; }
};

struct EpiPool {
    bf16_t* x; const float* pb; const float* ps;
    DI void operator()(const f32x4 (&acc)[2][2][4][2], const Unit& u, int wr, int wc, int fr, int fq) const {
#pragma unroll
        for (int ai = 0; ai < 2; ++ai)
#pragma unroll
            for (int m = 0; m < 4; ++m) {
                const int t = u.pm * 256 + 128 * ai + 64 * wr + 16 * m + fr;
#pragma unroll
                for (int bj = 0; bj < 2; ++bj) {
                    const int c = 256 * u.pn + 128 * bj + 32 * wc + 8 * fq;
                    bf16_t* xp = x + (size_t)t * DM + c;
                    float xv[8]; unpack8(*(const u32x4*)xp, xv);
                    const f32x4 v0 = (acc[ai][bj][m][0] + *(const f32x4*)(pb + c)) * *(const f32x4*)(ps + c);
                    const f32x4 v1 = (acc[ai][bj][m][1] + *(const f32x4*)(pb + c + 4)) * *(const f32x4*)(ps + c + 4);
                    u32x4 w; w[0] = cvt_pk_bf16(xv[0] + v0[0], xv[1] + v0[1]); w[1] = cvt_pk_bf16(xv[2] + v0[2], xv[3] + v0[3]); w[2] = cvt_pk_bf16(xv[4] + v1[0], xv[5] + v1[1]); w[3] = cvt_pk_bf16(xv[6] + v1[2], xv[7] + v1[3]);
                    *(u32x4*)xp = w;
                }
            }
    }
};
struct EpiWo {
    bf16_t* x;
    DI void operator()(const f32x4 (&acc)[2][2][4][2], const Unit& u, int wr, int wc, int fr, int fq) const {
#pragma unroll
        for (int ai = 0; ai < 2; ++ai)
#pragma unroll
            for (int m = 0; m < 4; ++m) {
                const int t = u.pm * 256 + 128 * ai + 64 * wr + 16 * m + fr;
#pragma unroll
                for (int bj = 0; bj < 2; ++bj) {
                    const int c = 256 * u.pn + 128 * bj + 32 * wc + 8 * fq;
                    bf16_t* xp = x + (size_t)t * DM + c;
                    float xv[8]; unpack8(*(const u32x4*)xp, xv);
                    const f32x4 v0 = acc[ai][bj][m][0], v1 = acc[ai][bj][m][1];
                    u32x4 w; w[0] = cvt_pk_bf16(xv[0] + v0[0], xv[1] + v0[1]); w[1] = cvt_pk_bf16(xv[2] + v0[2], xv[3] + v0[3]); w[2] = cvt_pk_bf16(xv[4] + v1[0], xv[5] + v1[1]); w[3] = cvt_pk_bf16(xv[6] + v1[2], xv[7] + v1[3]);
                    *(u32x4*)xp = w;
                }
            }
    }
};
struct EpiQKV {
    bf16_t* q; const float* rstd; const float* qg; const float* kg;
    DI void operator()(const f32x4 (&acc)[2][2][4][2], const Unit& u, int wr, int wc, int fr, int fq) const {
        const int which = u.pn >> 2, head = (u.pn & 3) * 4 + wc;
        bf16_t* out = q + (size_t)which * ((WS_K - WS_Q) / 2);
        const float* gn = which == 0 ? qg : kg;
        const float post = which == 0 ? 0.125f : 1.0f;
        f32x4 g[2][2];
#pragma unroll
        for (int bj = 0; bj < 2; ++bj)
#pragma unroll
            for (int n = 0; n < 2; ++n) g[bj][n] = (which < 2) ? *(const f32x4*)(gn + 32 * bj + 8 * fq + 4 * n) * post : (f32x4){1.f, 1.f, 1.f, 1.f};
#pragma unroll
        for (int ai = 0; ai < 2; ++ai)
#pragma unroll
            for (int m = 0; m < 4; ++m) {
                const int t = u.pm * 256 + 128 * ai + 64 * wr + 16 * m + fr;
                const float rs = rstd[t];
                f32x4 v4[2][2]; float ss = 0.f;
#pragma unroll
                for (int bj = 0; bj < 2; ++bj)
#pragma unroll
                    for (int n = 0; n < 2; ++n) { v4[bj][n] = acc[ai][bj][m][n] * rs; const f32x4 s = v4[bj][n] * v4[bj][n]; ss += (s[0] + s[1]) + (s[2] + s[3]); }
                ss += shflx(ss, fr + 16 * fq, 16); ss += shflx(ss, fr + 16 * fq, 32);
                const float r2 = (which < 2) ? rsqrtf(ss * (1.0f / HD) + EPS) : 1.0f;
#pragma unroll
                for (int bj = 0; bj < 2; ++bj) {
                    const f32x4 a = v4[bj][0] * r2 * g[bj][0], b = v4[bj][1] * r2 * g[bj][1];
                    u32x4 w; w[0] = cvt_pk_bf16(a[0], a[1]); w[1] = cvt_pk_bf16(a[2], a[3]); w[2] = cvt_pk_bf16(b[0], b[1]); w[3] = cvt_pk_bf16(b[2], b[3]);
                    *(u32x4*)(out + (size_t)t * DM + head * HD + 32 * bj + 8 * fq) = w;
                }
            }
    }
};

DI float softplus_f(float z) { return fmaxf(z, 0.f) + __logf(1.0f + __expf(-fabsf(z))); }
typedef short v4i16_t __attribute__((ext_vector_type(4)));
constexpr int AT_VPITCH = 192;
constexpr int AT_VTILE = 32 * AT_VPITCH;
DI void ph_attn(LAS unsigned char* ldsb) {
    LOAD_PARAMS();
    const int tid = tid_(), bid = bid_(), wid = tid >> 6, lane = tid & 63, l31 = lane & 31, h2 = lane >> 5;
    const bf16_t* Q = (const bf16_t*)(p.ws + WS_Q); const bf16_t* K = (const bf16_t*)(p.ws + WS_K); const bf16_t* V = (const bf16_t*)(p.ws + WS_V);
    bf16_t* O = (bf16_t*)(p.ws + WS_O);
    LAS unsigned char* vl = ldsb + wid * AT_VTILE;
    LAS unsigned char* vw = vl + (lane >> 3) * AT_VPITCH + (lane & 7) * 16;
    const LAS unsigned char* vr = vl + (4 * h2 + ((lane & 15) >> 2)) * AT_VPITCH + (16 * ((lane >> 4) & 1) + 4 * (lane & 3)) * 2;
    for (int it = 0; it < 4 * ((2 * NH * 256 / 32 - bid + (int)gridDim.x - 1) / (int)gridDim.x); ++it) {
        const int tsk = (bid + (it >> 2) * gridDim.x) * 32 + (it & 3) * 8 + wid;
        const int bh = tsk >> 8, qb = tsk & 255, b = bh >> 4, h = bh & 15;
        const size_t tb = (size_t)b * SEQ;
        const int q0 = qb * 32;
        bf16x8 qf[4];
#pragma unroll
        for (int s = 0; s < 4; ++s) qf[s] = *(const bf16x8*)(Q + (tb + q0 + l31) * DM + h * HD + 16 * s + 8 * h2);
        f32x16 o0, o1;
#pragma unroll
        for (int r = 0; r < 16; ++r) { o0[r] = 0.f; o1[r] = 0.f; }
        float R = 0.f;
        const bf16_t* kp = K + (tb + q0 + l31) * DM + h * HD + 8 * h2;
        const bf16_t* vp = V + (tb + q0 + (lane >> 3)) * DM + h * HD + (lane & 7) * 8;
        bf16x8 kn[4]; u32x4 vn[4];
#pragma unroll
        for (int s = 0; s < 4; ++s) { kn[s] = *(const bf16x8*)(kp + 16 * s); vn[s] = *(const u32x4*)(vp + (size_t)8 * s * DM); }
        for (int kt = qb; kt >= 0; --kt) {
            bf16x8 kf[4];
#pragma unroll
            for (int s = 0; s < 4; ++s) { kf[s] = kn[s]; *(LAS u32x4*)(vw + 8 * s * AT_VPITCH) = vn[s]; }
            if (kt > 0) {
                kp -= (size_t)32 * DM; vp -= (size_t)32 * DM;
#pragma unroll
                for (int s = 0; s < 4; ++s) { kn[s] = *(const bf16x8*)(kp + 16 * s); vn[s] = *(const u32x4*)(vp + (size_t)8 * s * DM); }
            }
            f32x16 z;
#pragma unroll
            for (int r = 0; r < 16; ++r) z[r] = 0.f;
#pragma unroll
            for (int s = 0; s < 4; ++s) z = __builtin_amdgcn_mfma_f32_32x32x16_bf16(kf[s], qf[s], z, 0, 0, 0);
            const bool diag = (kt == qb);
            float sp[16], gs[4], ot[4];
#pragma unroll
            for (int r = 0; r < 16; ++r) {
                const int kl = (r & 3) + 8 * (r >> 2) + 4 * h2;
                const bool valid = !diag || (kl < l31);
                sp[r] = valid ? softplus_f(z[r]) : 0.f;
            }
#pragma unroll
            for (int bb = 0; bb < 4; ++bb) { gs[bb] = (sp[4 * bb] + sp[4 * bb + 1]) + (sp[4 * bb + 2] + sp[4 * bb + 3]); ot[bb] = shflx(gs[bb], lane, 32); }
            const float tot_own = (gs[0] + gs[1]) + (gs[2] + gs[3]);
            const float tot_oth = shflx(tot_own, lane, 32);
            float later[4];
            {
                float own_tail = 0.f, oth_tail = 0.f;
#pragma unroll
                for (int bb = 3; bb >= 0; --bb) {
                    later[bb] = own_tail + oth_tail + (h2 == 0 ? ot[bb] : 0.f);
                    own_tail += gs[bb]; oth_tail += ot[bb];
                }
            }
            float a[16];
#pragma unroll
            for (int bb = 0; bb < 4; ++bb) {
                const float base = R + later[bb];
                const float s3 = base + sp[4 * bb + 3], s2 = s3 + sp[4 * bb + 2], s1 = s2 + sp[4 * bb + 1], s0 = s1 + sp[4 * bb];
                const float S[4] = {s0, s1, s2, s3};
#pragma unroll
                for (int i = 0; i < 4; ++i) {
                    const int r = 4 * bb + i, kl = (r & 3) + 8 * (r >> 2) + 4 * h2;
                    const bool valid = !diag || (kl < l31);
                    a[r] = valid ? __expf(z[r] - S[i]) : 0.f;
                }
            }
            R += (h2 == 0) ? (tot_own + tot_oth) : (tot_oth + tot_own);
#pragma unroll
            for (int s = 0; s < 2; ++s) {
                u32x4 pw;
#pragma unroll
                for (int i = 0; i < 4; ++i) pw[i] = cvt_pk_bf16(a[8 * s + 2 * i], a[8 * s + 2 * i + 1]);
                const bf16x8 pa = __builtin_bit_cast(bf16x8, pw);
#pragma unroll
                for (int db = 0; db < 2; ++db) {
                    const v4i16_t lo4 = __builtin_amdgcn_ds_read_tr16_b64_v4i16((LAS v4i16_t*)(vr + (16 * s) * AT_VPITCH + 64 * db));
                    const v4i16_t hi4 = __builtin_amdgcn_ds_read_tr16_b64_v4i16((LAS v4i16_t*)(vr + (16 * s + 8) * AT_VPITCH + 64 * db));
                    bf16x8 vf; vf[0] = lo4[0]; vf[1] = lo4[1]; vf[2] = lo4[2]; vf[3] = lo4[3]; vf[4] = hi4[0]; vf[5] = hi4[1]; vf[6] = hi4[2]; vf[7] = hi4[3];
                    if (db == 0) o0 = __builtin_amdgcn_mfma_f32_32x32x16_bf16(vf, pa, o0, 0, 0, 0);
                    else o1 = __builtin_amdgcn_mfma_f32_32x32x16_bf16(vf, pa, o1, 0, 0, 0);
                }
            }
            if (__all(R > 104.0f)) break;
        }
#pragma unroll
        for (int db = 0; db < 2; ++db)
#pragma unroll
            for (int rb = 0; rb < 4; ++rb) {
                const f32x16& o = db == 0 ? o0 : o1;
                u32x2 w; w[0] = cvt_pk_bf16(o[4 * rb], o[4 * rb + 1]); w[1] = cvt_pk_bf16(o[4 * rb + 2], o[4 * rb + 3]);
                *(u32x2*)(O + (tb + q0 + l31) * DM + h * HD + 32 * db + 8 * rb + 4 * h2) = w;
            }
    }
}

constexpr int RT_PART = 0;
constexpr int RT_SSQ = RT_PART + 2 * 4 * 16 * 52 * 4;
constexpr int RT_LCNT = RT_SSQ + 2 * 4 * 16 * 4;
constexpr int RT_GB = RT_LCNT + 128;
DI void ph_router(LAS unsigned char* lds, int li) {
    LOAD_PARAMS();
    const bf16_t* xcur = (const bf16_t*)(p.ws + ((li & 1) ? WS_XB1 : WS_XB));
    const int tid = tid_(), bid = bid_(), wid = tid >> 6, lane = tid & 63, fr = lane & 15, fq = lane >> 4;
    const bf16_t* wh = (const bf16_t*)(p.ws + WS_WRH) + (size_t)li * 48 * DM;
    const bf16_t* wl = (const bf16_t*)(p.ws + WS_WRL) + (size_t)li * 48 * DM;
    const float* bg = p.moe_bg + li * 4;
    const float* br = p.moe_br + li * 32;
    unsigned* cnt = (unsigned*)(p.ws + WS_CTL) + CW_CNT + 32 * li;
    Entry* list = (Entry*)(p.ws + WS_LIST);
    LAS float* part = (LAS float*)(lds + RT_PART); LAS float* ssq = (LAS float*)(lds + RT_SSQ);
    LAS int* lcnt = (LAS int*)(lds + RT_LCNT); LAS int* gb = (LAS int*)(lds + RT_GB);
    const int tb = wid & 3, kh = wid >> 2;
    for (int chunk = bid; chunk < T / 64; chunk += gridDim.x) {
        const int t = chunk * 64 + tb * 16 + fr;
        const bf16_t* xr = xcur + (size_t)t * DM + kh * 512 + fq * 8;
        const bf16_t* whr = wh + (size_t)fr * DM + kh * 512 + fq * 8;
        const bf16_t* wlr = wl + (size_t)fr * DM + kh * 512 + fq * 8;
        f32x4 acc[3]; float ss = 0.f;
#pragma unroll
        for (int nb = 0; nb < 3; ++nb) acc[nb] = (f32x4){0.f, 0.f, 0.f, 0.f};
#pragma unroll 4
        for (int ks = 0; ks < 16; ++ks) {
            const u32x4 xw = *(const u32x4*)(xr + ks * 32);
            float xf[8]; unpack8(xw, xf);
#pragma unroll
            for (int e = 0; e < 8; ++e) ss += xf[e] * xf[e];
            const bf16x8 xh = __builtin_bit_cast(bf16x8, xw);
#pragma unroll
            for (int nb = 0; nb < 3; ++nb) {
                const bf16x8 wH = *(const bf16x8*)(whr + (size_t)nb * 16 * DM + ks * 32), wL = *(const bf16x8*)(wlr + (size_t)nb * 16 * DM + ks * 32);
                acc[nb] = __builtin_amdgcn_mfma_f32_16x16x32_bf16(wH, xh, acc[nb], 0, 0, 0);
                acc[nb] = __builtin_amdgcn_mfma_f32_16x16x32_bf16(wL, xh, acc[nb], 0, 0, 0);
            }
        }
        ss += shflx(ss, lane, 16); ss += shflx(ss, lane, 32);
#pragma unroll
        for (int nb = 0; nb < 3; ++nb) *(LAS f32x4*)(part + ((kh * 4 + tb) * 16 + fr) * 52 + 16 * nb + 4 * fq) = acc[nb];
        if (fq == 0) ssq[(kh * 4 + tb) * 16 + fr] = ss;
        if (tid < 32) lcnt[tid] = 0;
        __syncthreads();
        int ea = 0, eb = 0, la = 0, lb = 0; float w1 = 0.f, w2 = 0.f, rs = 0.f;
        if (tid < 64) {
            const LAS float* p0 = part + tid * 52; const LAS float* p1 = part + (64 + tid) * 52;
            rs = rsqrtf((ssq[tid] + ssq[64 + tid]) * (1.0f / DM) + EPS);
            float lg[36];
#pragma unroll
            for (int q = 0; q < 9; ++q) { const f32x4 u = *(const LAS f32x4*)(p0 + 4 * q), v = *(const LAS f32x4*)(p1 + 4 * q);
#pragma unroll
                for (int e = 0; e < 4; ++e) lg[4 * q + e] = (u[e] + v[e]) * rs; }
            float gl[4];
#pragma unroll
            for (int n = 0; n < 4; ++n) gl[n] = lg[n] + bg[n];
            int g = 0; float gm = gl[0];
#pragma unroll
            for (int n = 1; n < 4; ++n) if (gl[n] > gm) { gm = gl[n]; g = n; }
            float den = 0.f;
#pragma unroll
            for (int n = 0; n < 4; ++n) den += __expf(gl[n] - gm);
            const float gprob = 1.0f / den;
            float el[8];
#pragma unroll
            for (int n = 0; n < 8; ++n) {
                float v = 0.f;
#pragma unroll
                for (int gg = 0; gg < 4; ++gg) v = (g == gg) ? lg[4 + 8 * gg + n] + br[8 * gg + n] : v;
                el[n] = v;
            }
            int e1 = 0; float m1 = el[0];
#pragma unroll
            for (int n = 1; n < 8; ++n) if (el[n] > m1) { m1 = el[n]; e1 = n; }
            int e2 = -1; float m2 = -3.0e38f;
#pragma unroll
            for (int n = 0; n < 8; ++n) if (n != e1 && (e2 < 0 || el[n] > m2)) { m2 = el[n]; e2 = n; }
            const float ex = __expf(m2 - m1);
            w1 = gprob / (1.0f + ex); w2 = gprob * ex / (1.0f + ex);
            ea = 8 * g + e1; eb = 8 * g + e2;
            la = __hip_atomic_fetch_add(lcnt + ea, 1, __ATOMIC_RELAXED, __HIP_MEMORY_SCOPE_WORKGROUP);
            lb = __hip_atomic_fetch_add(lcnt + eb, 1, __ATOMIC_RELAXED, __HIP_MEMORY_SCOPE_WORKGROUP);
        }
        __syncthreads();
        if (tid < 32) { const int c = lcnt[tid]; gb[tid] = c ? (int)atomicAdd(&cnt[tid], (unsigned)c) : 0; }
        __syncthreads();
        if (tid < 64) {
            const int tt = chunk * 64 + tid;
            Entry A; A.dst = tt; A.rstd = rs; A.w = w1; A.tok = tt;
            Entry B; B.dst = T + tt; B.rstd = rs; B.w = w2; B.tok = tt;
            list[(size_t)ea * LIST_CAP + gb[ea] + la] = A;
            list[(size_t)eb * LIST_CAP + gb[eb] + lb] = B;
        }
        __syncthreads();
    }
}

constexpr int MOE_MAXU = 4;
constexpr int LDS_ROWTAB = STAGE_BYTES;
constexpr int LDS_UTAB = LDS_ROWTAB + MOE_MAXU * 1024;
constexpr int LDS_XBW = LDS_UTAB + MOE_MAXU * 32;
constexpr int LDS_BYTES = 147456;
static_assert(LDS_XBW + 16 <= LDS_BYTES, "LDS map");
struct SchedMoe {
    LAS unsigned char* lds; const bf16_t* A; const bf16_t* W; bool gather; size_t w_estride; int w_pnrows, ldb;
    DI void build(const unsigned* cnt, const Entry* list, int npn, int lo, int hi, int first, int stride, int tid) {
        LAS int* ut = (LAS int*)(lds + LDS_UTAB); LAS unsigned* rt = (LAS unsigned*)(lds + LDS_ROWTAB);
        for (int i = 0; i < MOE_MAXU; ++i) {
            const int L = lo + first + i * stride;
            int found = 0, e = 0, j = 0, nv = 0, rtile = 0, pn = 0;
            if (first >= 0 && L < hi) {
                rtile = L / npn; pn = L % npn;
                int acc = 0;
                for (int ee = 0; ee < NE; ++ee) {
                    const int c = (int)cnt[ee], ntl = (c + 255) >> 8;
                    if (!found && rtile < acc + ntl) { found = 1; e = ee; j = rtile - acc; nv = c - 256 * j; }
                    acc += ntl;
                }
            }
            nv = nv > 256 ? 256 : nv;
            if (tid == 0) { ut[i * 8 + 0] = found; ut[i * 8 + 1] = e; ut[i * 8 + 2] = nv; ut[i * 8 + 3] = 256 * rtile; ut[i * 8 + 4] = e * LIST_CAP + 256 * j; ut[i * 8 + 5] = pn; }
            if (gather && found && tid < 256) rt[i * 256 + tid] = (tid < nv) ? (unsigned)list[e * LIST_CAP + 256 * j + tid].tok : 0u;
        }
        asm volatile("s_waitcnt vmcnt(0) lgkmcnt(0)" ::: "memory");
        __syncthreads();
    }
    DI bool next(int i, Unit& u) const {
        if (i >= MOE_MAXU) return false;
        const LAS int* ut = (const LAS int*)(lds + LDS_UTAB) + i * 8;
        const int found = __builtin_amdgcn_readfirstlane(ut[0]);
        if (!found) return false;
        u.e = __builtin_amdgcn_readfirstlane(ut[1]); u.nvalid = __builtin_amdgcn_readfirstlane(ut[2]); u.row0 = __builtin_amdgcn_readfirstlane(ut[3]);
        u.lbase = __builtin_amdgcn_readfirstlane(ut[4]); u.pn = __builtin_amdgcn_readfirstlane(ut[5]); u.pm = u.row0 >> 8;
        u.A = gather ? A : A + (size_t)u.row0 * DE;
        u.B = W + (size_t)u.e * w_estride + (size_t)u.pn * w_pnrows * ldb;
        return true;
    }
    DI int arow(int ui, const Unit&, int r) const { if (!gather) return r; return (int)((const LAS unsigned*)(lds + LDS_ROWTAB))[ui * 256 + r]; }
};
struct EpiGU {
    bf16_t* hid; const Entry* list;
    DI void operator()(const f32x4 (&acc)[2][2][4][2], const Unit& u, int wr, int wc, int fr, int fq) const {
#pragma unroll
        for (int ai = 0; ai < 2; ++ai)
#pragma unroll
            for (int m = 0; m < 4; ++m) {
                const int r = 128 * ai + 64 * wr + 16 * m + fr;
                float rs = 0.f, w = 0.f;
                if (r < u.nvalid) { const Entry en = list[u.lbase + r]; rs = en.rstd; w = en.w; }
                unsigned pk[4];
#pragma unroll
                for (int n = 0; n < 2; ++n) {
                    float hv[4];
#pragma unroll
                    for (int e = 0; e < 4; ++e) { const float g = acc[ai][0][m][n][e] * rs, up = acc[ai][1][m][n][e] * rs; hv[e] = g / (1.0f + __expf(-g)) * up * w; }
                    pk[2 * n] = cvt_pk_bf16(hv[0], hv[1]); pk[2 * n + 1] = cvt_pk_bf16(hv[2], hv[3]);
                }
                u32x4 wv; wv[0] = pk[0]; wv[1] = pk[1]; wv[2] = pk[2]; wv[3] = pk[3];
                *(u32x4*)(hid + (size_t)(u.row0 + r) * DE + 128 * u.pn + 32 * wc + 8 * fq) = wv;
            }
    }
};
struct EpiDown {
    bf16_t* yb; const Entry* list;
    DI void operator()(const f32x4 (&acc)[2][2][4][2], const Unit& u, int wr, int wc, int fr, int fq) const {
#pragma unroll
        for (int ai = 0; ai < 2; ++ai)
#pragma unroll
            for (int m = 0; m < 4; ++m) {
                const int r = 128 * ai + 64 * wr + 16 * m + fr;
                const int dst = (r < u.nvalid) ? list[u.lbase + r].dst : DUMMY_ROW;
#pragma unroll
                for (int bj = 0; bj < 2; ++bj) {
                    const f32x4 a = acc[ai][bj][m][0], b = acc[ai][bj][m][1];
                    u32x4 w; w[0] = cvt_pk_bf16(a[0], a[1]); w[1] = cvt_pk_bf16(a[2], a[3]); w[2] = cvt_pk_bf16(b[0], b[1]); w[3] = cvt_pk_bf16(b[2], b[3]);
                    *(u32x4*)(yb + (size_t)dst * DM + 256 * u.pn + 128 * bj + 32 * wc + 8 * fq) = w;
                }
            }
    }
};

DI void ph_poolgemm(LAS unsigned char* lds, int j) {
    LOAD_PARAMS();
    SchedPool S; S.bid = bid_(); S.diff = (const bf16_t*)(p.ws + WS_DIFF); S.w = (const bf16_t*)(p.ws + WS_WPOOL) + (size_t)j * 4 * 65536;
    EpiPool E; E.x = (bf16_t*)(p.ws + WS_XB); E.pb = p.pool_b + j * DM; E.ps = p.pool_scale + j * DM;
    gemm_phase<GCfg<1024, 256, 256, 128, false>>(lds, S, E);
}
DI void ph_qkv(LAS unsigned char* lds, int j) {
    LOAD_PARAMS();
    SchedDense S; S.bid = bid_(); S.A = (const bf16_t*)(p.ws + WS_XB1); S.B = (const bf16_t*)(p.ws + WS_WQKV) + (size_t)j * 3072 * 1024; S.npn = 12; S.ldb = 1024;
    EpiQKV E; E.q = (bf16_t*)(p.ws + WS_Q); E.rstd = (const float*)(p.ws + WS_RSTD); E.qg = p.sb_qg + j * HD; E.kg = p.sb_kg + j * HD;
    gemm_phase<GCfg<1024, 1024, 1024, 32, true>>(lds, S, E);
}
DI void ph_wo(LAS unsigned char* lds, int j) {
    LOAD_PARAMS();
    SchedDense S; S.bid = bid_(); S.A = (const bf16_t*)(p.ws + WS_O); S.B = (const bf16_t*)(p.ws + WS_WO) + (size_t)j * 1024 * 1024; S.npn = 4; S.ldb = 1024;
    EpiWo E; E.x = (bf16_t*)(p.ws + WS_XB1);
    gemm_phase<GCfg<1024, 1024, 1024, 128, false>>(lds, S, E);
}
struct MoePlan { int NT, R1, nB; };
DI MoePlan moe_plan(const unsigned* cnt) {
    int nt = 0;
    for (int e = 0; e < NE; ++e) nt += ((int)cnt[e] + 255) >> 8;
    MoePlan m; m.NT = nt; const int G = gridDim.x; m.R1 = nt < G / 2 ? nt : G / 2;
    const int late = 2 * (nt - m.R1); m.nB = late < G ? late : G;
    return m;
}
DI void ph_gu(LAS unsigned char* lds, int li, int stage) {
    LOAD_PARAMS();
    const Entry* list = (const Entry*)(p.ws + WS_LIST);
    const unsigned* cnt = (const unsigned*)(p.ws + WS_CTL) + CW_CNT + 32 * li;
    const MoePlan m = moe_plan(cnt);
    const int bid = bid_();
    if (stage == 2 || (stage == 1 && bid >= m.nB)) return;
    SchedMoe S; S.lds = lds; S.A = (const bf16_t*)(p.ws + ((li & 1) ? WS_XB1 : WS_XB));
    S.W = (const bf16_t*)(p.ws + WS_WGU) + (size_t)li * NE * 512 * 1024; S.gather = true; S.w_estride = (size_t)512 * 1024; S.w_pnrows = 128; S.ldb = 1024;
    if (stage == 0) S.build(cnt, list, 2, 0, 2 * m.R1, bid, gridDim.x, tid_());
    else S.build(cnt, list, 2, 2 * m.R1, 2 * m.NT, bid, gridDim.x, tid_());
    EpiGU E; E.hid = (bf16_t*)(p.ws + WS_HID); E.list = list;
    gemm_phase<GCfg<1024, 1024, 1024, 256, false>>(lds, S, E);
}
DI void ph_down(LAS unsigned char* lds, int li, int stage) {
    LOAD_PARAMS();
    const Entry* list = (const Entry*)(p.ws + WS_LIST);
    const unsigned* cnt = (const unsigned*)(p.ws + WS_CTL) + CW_CNT + 32 * li;
    const MoePlan m = moe_plan(cnt);
    const int bid = bid_(), G = gridDim.x;
    if (stage == 0 || (stage == 1 && bid < m.nB)) return;
    SchedMoe S; S.lds = lds; S.A = (const bf16_t*)(p.ws + WS_HID);
    S.W = (const bf16_t*)(p.ws + WS_WD) + (size_t)li * NE * 1024 * 256; S.gather = false; S.w_estride = (size_t)1024 * 256; S.w_pnrows = 256; S.ldb = 256;
    if (stage == 1) S.build(cnt, list, 4, 0, 4 * m.R1, bid - m.nB, G - m.nB, tid_());
    else S.build(cnt, list, 4, (m.nB < G) ? 4 * m.R1 : 0, 4 * m.NT, bid, G, tid_());
    EpiDown E; E.yb = (bf16_t*)(p.ws + WS_YBUF); E.list = list;
    gemm_phase<GCfg<256, 256, 256, 128, false>>(lds, S, E);
}
DI bool moe_has_stage2(int li) {
    LOAD_PARAMS();
    const MoePlan m = moe_plan((const unsigned*)(p.ws + WS_CTL) + CW_CNT + 32 * li);
    return m.NT > m.R1;
}

#define XB_TMO      128
#define XB_XCNT(j)  (256  + 64 * (j))
#define XB_XSUB(j)  (1280 + 64 * (j))
#define XB_XGEN(j)  (2304 + 64 * (j))
#define XB_TOP      3328
#define XB_TOPGEN   3392
#define XCD_BAR_WORDS 3456
#define XB_SPIN_CAP (1u << 18)

__device__ __forceinline__ unsigned xb_ld(unsigned* p)              { return __hip_atomic_load(p, __ATOMIC_RELAXED, __HIP_MEMORY_SCOPE_AGENT); }
__device__ __forceinline__ unsigned xb_add(unsigned* p, unsigned v) { return __hip_atomic_fetch_add(p, v, __ATOMIC_RELAXED, __HIP_MEMORY_SCOPE_AGENT); }
__device__ __forceinline__ unsigned xb_xcc_id() { return (unsigned)__builtin_amdgcn_s_getreg((3 << 11) | 20) & 0xFu; }
#define XB_SPIN(cond, bar) do { unsigned _sp = 0; while (cond) { __builtin_amdgcn_s_sleep(1); \
    if ((++_sp & 255u) == 0u) { if (xb_ld(&(bar)[XB_TMO])) break; if (_sp > XB_SPIN_CAP) { atomicAdd(&(bar)[XB_TMO], 1u); break; } } } } while (0)

struct XcdBarrier {
    unsigned* bar; unsigned x;
    volatile LAS unsigned* st;
};

__device__ __forceinline__ XcdBarrier xcd_barrier_post(unsigned* bar, volatile LAS unsigned* st) {
    XcdBarrier b; b.bar = bar; b.x = xb_xcc_id(); b.st = st;
    if (threadIdx.x == 0) (void)xb_add(&bar[XB_XCNT(b.x)], 1u);
    return b;
}
__device__ __forceinline__ void xcd_barrier_complete(unsigned* bar, unsigned x, unsigned& nloc, unsigned& nx) {
    const unsigned G = gridDim.x * gridDim.y * gridDim.z;
    unsigned sum, cnt, mine, sp = 0u;
    for (;;) {
        sum = 0u; cnt = 0u; mine = 0u;
#pragma unroll
        for (unsigned j = 0; j < 16; ++j) { const unsigned c = xb_ld(&bar[XB_XCNT(j)]); sum += c; cnt += (c > 0u) ? 1u : 0u; mine = (j == x) ? c : mine; }
        if (sum == G) break;
        __builtin_amdgcn_s_sleep(1);
        if ((++sp & 255u) == 0u) { if (xb_ld(&bar[XB_TMO])) break; if (sp > XB_SPIN_CAP) { atomicAdd(&bar[XB_TMO], 1u); break; } }
    }
    nloc = mine > 0u ? mine : 1u; nx = cnt > 0u ? cnt : 1u;
}

__device__ __forceinline__ void xcd_barrier(const XcdBarrier& b) {
    asm volatile("s_waitcnt vmcnt(0)" ::: "memory");
    __syncthreads();
    if (threadIdx.x == 0) {
        unsigned* bar = b.bar; unsigned bx = b.x;
        asm volatile("" : "+s"(bar), "+s"(bx));
        __builtin_amdgcn_s_waitcnt(0);
        unsigned nloc = b.st[0], nx = b.st[1];
        if (nloc == 0u) { xcd_barrier_complete(bar, bx, nloc, nx); b.st[0] = nloc; b.st[1] = nx; }
        const unsigned old = xb_add(&bar[XB_XSUB(bx)], 1u);
        const unsigned gen = old / nloc;
        if (old + 1u == (gen + 1u) * nloc) {
            __builtin_amdgcn_fence(__ATOMIC_RELEASE, "agent");
            asm volatile("s_waitcnt vmcnt(0)" ::: "memory");
            const unsigned og = xb_add(&bar[XB_TOP], 1u);
            const unsigned tg = og / nx;
            if (og + 1u == (tg + 1u) * nx) xb_add(&bar[XB_TOPGEN], 1u);
            else XB_SPIN(xb_ld(&bar[XB_TOPGEN]) == tg, bar);
            __builtin_amdgcn_fence(__ATOMIC_ACQUIRE, "agent");
            xb_add(&bar[XB_XGEN(bx)], 1u);
            asm volatile("s_waitcnt vmcnt(0)" ::: "memory");
        } else {
            XB_SPIN(xb_ld(&bar[XB_XGEN(bx)]) == gen, bar);
            __builtin_amdgcn_fence(__ATOMIC_ACQUIRE, "agent");
            asm volatile("s_waitcnt vmcnt(0)" ::: "memory");
        }
    }
    __syncthreads();
}
constexpr int CW_BAR = 4096;

extern __shared__ __attribute__((aligned(16))) unsigned char smem_raw[];
__global__ void __launch_bounds__(NTHR, 2) fwd(Params pk) {
    LAS unsigned char* smem = (LAS unsigned char*)smem_raw;
    if (threadIdx.x < 4) ((LAS unsigned*)(smem + LDS_XBW))[threadIdx.x] = 0u;
    __syncthreads();
    XcdBarrier bar;
    { LOAD_PARAMS(); bar = xcd_barrier_post((unsigned*)(p.ws + WS_CTL) + CW_BAR, (volatile LAS unsigned*)(smem + LDS_XBW)); }
    ph_prologue(smem);
    __syncthreads();
    for (int i = 0; i < DEPTH; ++i) {
        const int j = i >> 1;
        if ((i & 1) == 0) {
            ph_poolfuse(smem, j, i == 0);
            xcd_barrier(bar);
            ph_poolgemm(smem, j);
        } else {
            ph_combine<false>(0);
            xcd_barrier(bar);
            ph_qkv(smem, j);
            xcd_barrier(bar);
            ph_attn(smem);
            xcd_barrier(bar);
            ph_wo(smem, j);
        }
        xcd_barrier(bar);
        ph_router(smem, i);
        xcd_barrier(bar);
        for (int st = 0; st < 3; ++st) {
            if (st == 2 && !moe_has_stage2(i)) break;
            ph_gu(smem, i, st);
            ph_down(smem, i, st);
            xcd_barrier(bar);
        }
    }
    ph_combine<true>(1);
}

extern "C" void kernel_launch(void* const* d_in, const int* in_sizes, int n_in, void* d_out, int out_size, void* d_ws, size_t ws_size, hipStream_t stream) {
    if (ws_size < WS_NEED || n_in < 18) return;
    Params p{};
    p.x_in = (const float*)d_in[0]; p.pool_norm = (const float*)d_in[1]; p.pool_w = (const float*)d_in[2]; p.pool_b = (const float*)d_in[3]; p.pool_scale = (const float*)d_in[4];
    p.sb_norm = (const float*)d_in[5]; p.sb_wqkv = (const float*)d_in[6]; p.sb_qg = (const float*)d_in[7]; p.sb_kg = (const float*)d_in[8]; p.sb_wo = (const float*)d_in[9];
    p.moe_norm = (const float*)d_in[10]; p.moe_wg = (const float*)d_in[11]; p.moe_bg = (const float*)d_in[12]; p.moe_wr = (const float*)d_in[13]; p.moe_br = (const float*)d_in[14];
    p.moe_wgate = (const float*)d_in[15]; p.moe_wup = (const float*)d_in[16]; p.moe_wdown = (const float*)d_in[17];
    p.x = (float*)d_out; p.ws = (unsigned char*)d_ws;
    static int grid = 0;
    if (!grid) {
        int dev = 0, cus = 0, per_cu = 0;
        if (hipGetDevice(&dev) != hipSuccess || hipDeviceGetAttribute(&cus, hipDeviceAttributeMultiprocessorCount, dev) != hipSuccess) { grid = -1; return; }
        if (hipFuncSetAttribute((const void*)fwd, hipFuncAttributeMaxDynamicSharedMemorySize, LDS_BYTES) != hipSuccess) { grid = -1; return; }
        if (hipOccupancyMaxActiveBlocksPerMultiprocessor(&per_cu, (const void*)fwd, NTHR, LDS_BYTES) != hipSuccess || per_cu < 1) { (void)hipGetLastError(); }
        grid = cus;
    }
    if (grid <= 0) return;
    (void)hipMemsetAsync((char*)d_ws + WS_CTL, 0, CTL_BYTES, stream);
    hipLaunchKernelGGL(fwd, dim3(grid), dim3(NTHR), LDS_BYTES, stream, p);
}
```

```cpp
#include <hip/hip_runtime.h>
#include <stdint.h>

#define DI __device__ __forceinline__
#define LAS __attribute__((address_space(3)))
typedef unsigned short bf16_t;
typedef short bf16x8 __attribute__((ext_vector_type(8)));
typedef float f32x4 __attribute__((ext_vector_type(4)));
typedef float f32x16 __attribute__((ext_vector_type(16)));
typedef unsigned u32x4 __attribute__((ext_vector_type(4)));
typedef unsigned u32x2 __attribute__((ext_vector_type(2)));

constexpr int T = 16384, DM = 1024, SEQ = 8192, NH = 16, HD = 64, DEPTH = 4, NE = 32, DE = 256;
constexpr float EPS = 1e-6f;
constexpr int NTHR = 512, NWAVE = 8;
constexpr int LIST_CAP = 16384;
constexpr int DUMMY_ROW = 2 * T;

constexpr size_t MiB = 1u << 20;
constexpr size_t WS_CTL = 0, CTL_BYTES = 1 * MiB;
constexpr size_t WS_WQKV = 1 * MiB;
constexpr size_t WS_WO = 13 * MiB;
constexpr size_t WS_WPOOL = 17 * MiB;
constexpr size_t WS_RSTD = 18 * MiB;
constexpr size_t WS_WRH = 19 * MiB, WS_WRL = WS_WRH + 512 * 1024;
constexpr size_t WS_WGU = 20 * MiB;
constexpr size_t WS_WD = 148 * MiB;
constexpr size_t WS_XB = 212 * MiB;
constexpr size_t WS_XB1 = 384 * MiB;
constexpr size_t WS_NEED = 416 * MiB;
constexpr size_t WS_LIST = 244 * MiB;
constexpr size_t WS_Q = 256 * MiB;
constexpr size_t WS_DIFF = WS_Q;
constexpr size_t WS_K = 288 * MiB, WS_V = 320 * MiB, WS_O = 352 * MiB;
constexpr size_t WS_YBUF = 288 * MiB;
constexpr size_t WS_HID = 354 * MiB;
constexpr size_t WS_END = 384 * MiB;
static_assert(WS_V - WS_K == WS_K - WS_Q, "Q, K, V equally spaced");
static_assert(WS_YBUF + (size_t)(2 * T + 1) * DM * 2 <= WS_HID, "ybuf");
static_assert(WS_HID + (size_t)(2 * T + NE * 256) * DE * 2 <= WS_END, "hid");
constexpr int CW_CNT = 1024;

struct Entry { int dst; float rstd; float w; int tok; };

struct Params {
    const float* x_in; const float* pool_norm; const float* pool_w; const float* pool_b; const float* pool_scale;
    const float* sb_norm; const float* sb_wqkv; const float* sb_qg; const float* sb_kg; const float* sb_wo;
    const float* moe_norm; const float* moe_wg; const float* moe_bg; const float* moe_wr; const float* moe_br;
    const float* moe_wgate; const float* moe_wup; const float* moe_wdown;
    float* x;
    unsigned char* ws;
};

typedef const unsigned long long __attribute__((address_space(4)))* KArgPtr;
#define GP(T, i) ((T*)(T __attribute__((address_space(1)))*)q[i])
DI Params load_params() {
    KArgPtr q = (KArgPtr)__builtin_amdgcn_kernarg_segment_ptr(); asm volatile("" : "+s"(q));
    Params p;
    p.x_in = GP(const float, 0); p.pool_norm = GP(const float, 1); p.pool_w = GP(const float, 2); p.pool_b = GP(const float, 3); p.pool_scale = GP(const float, 4);
    p.sb_norm = GP(const float, 5); p.sb_wqkv = GP(const float, 6); p.sb_qg = GP(const float, 7); p.sb_kg = GP(const float, 8); p.sb_wo = GP(const float, 9);
    p.moe_norm = GP(const float, 10); p.moe_wg = GP(const float, 11); p.moe_bg = GP(const float, 12); p.moe_wr = GP(const float, 13); p.moe_br = GP(const float, 14);
    p.moe_wgate = GP(const float, 15); p.moe_wup = GP(const float, 16); p.moe_wdown = GP(const float, 17);
    p.x = GP(float, 18); p.ws = GP(unsigned char, 19);
    return p;
}
#define LOAD_PARAMS() const Params p = load_params()
DI int tid_() { int t = threadIdx.x; asm volatile("" : "+v"(t)); return t; }
DI int bid_() { int b = blockIdx.x; asm volatile("" : "+s"(b)); return b; }

DI unsigned cvt_pk_bf16(float lo, float hi) { unsigned r; asm volatile("v_cvt_pk_bf16_f32 %0, %1, %2" : "=v"(r) : "v"(lo), "v"(hi)); return r; }
DI float bf_lo(unsigned u) { return __uint_as_float(u << 16); }
DI float bf_hi(unsigned u) { return __uint_as_float(u & 0xffff0000u); }
DI float shflx(float v, int lane, int m) { return __int_as_float(__builtin_amdgcn_ds_bpermute((lane ^ m) << 2, __float_as_int(v))); }
DI float wave_sum(float v, int lane) {
#pragma unroll
    for (int o = 32; o >= 1; o >>= 1) v += shflx(v, lane, o);
    return v;
}
DI int perm32(int rho) { const int n = rho >> 4, i = rho & 15; return 8 * (i >> 2) + 4 * n + (i & 3); }

struct CvtTile { const float* src; bf16_t* dst; const float* scale; int K, N; };
DI CvtTile cvt_locate(const Params& p, int g) {
    int K, N, sdiv = 1; const float* sb; bf16_t* db; const float* scb = nullptr; size_t sms, dms;
    if (g < 384) { K = 1024; N = 3072; sb = p.sb_wqkv; db = (bf16_t*)(p.ws + WS_WQKV); scb = p.sb_norm; sms = (size_t)1024 * 3072; dms = sms; }
    else if ((g -= 384) < 128) { K = 1024; N = 1024; sb = p.sb_wo; db = (bf16_t*)(p.ws + WS_WO); sms = (size_t)1024 * 1024; dms = sms; }
    else if ((g -= 128) < 32) { K = 256; N = 256; sb = p.pool_w; db = (bf16_t*)(p.ws + WS_WPOOL); sms = 65536; dms = 65536; }
    else if ((g -= 32) < 2048) { K = 1024; N = 256; sb = p.moe_wgate; db = (bf16_t*)(p.ws + WS_WGU); scb = p.moe_norm; sdiv = 32; sms = (size_t)1024 * 256; dms = (size_t)512 * 1024; }
    else if ((g -= 2048) < 2048) { K = 1024; N = 256; sb = p.moe_wup; db = (bf16_t*)(p.ws + WS_WGU) + (size_t)256 * 1024; scb = p.moe_norm; sdiv = 32; sms = (size_t)1024 * 256; dms = (size_t)512 * 1024; }
    else { g -= 2048; K = 256; N = 1024; sb = p.moe_wdown; db = (bf16_t*)(p.ws + WS_WD); sms = (size_t)256 * 1024; dms = sms; }
    const int tn = N / 256, per = (K / 64) * tn, mat = g / per, rem = g % per, k0 = (rem / tn) * 64, n0 = (rem % tn) * 256;
    CvtTile t; t.K = K; t.N = N;
    t.src = sb + (size_t)mat * sms + (size_t)k0 * N + n0;
    t.dst = db + (size_t)mat * dms + (size_t)n0 * K + k0;
    t.scale = scb ? scb + (size_t)(mat / sdiv) * K + k0 : nullptr;
    return t;
}
constexpr int CVT_TILES = 384 + 128 + 32 + 2048 + 2048 + 2048;
DI void ph_prologue(LAS unsigned char* ldsb) {
    LOAD_PARAMS();
    const int tid = tid_(), bid = bid_();
    LAS float* lds = (LAS float*)ldsb;
    const int n4 = tid & 63, kq = tid >> 6;
    f32x4 regs[8]; float scl[8];
    int g = bid;
    CvtTile cur{};
    if (g < CVT_TILES) {
        cur = cvt_locate(p, g);
#pragma unroll
        for (int i = 0; i < 8; ++i) { regs[i] = *(const f32x4*)(cur.src + (size_t)(kq + 8 * i) * cur.N + 4 * n4); scl[i] = cur.scale ? cur.scale[kq + 8 * i] : 1.0f; }
    }
    for (; g < CVT_TILES; g += gridDim.x) {
        __syncthreads();
#pragma unroll
        for (int i = 0; i < 8; ++i) { const int k = kq + 8 * i; *(LAS f32x4*)(lds + k * 256 + ((4 * n4) ^ (4 * ((k >> 3) & 7)))) = regs[i] * scl[i]; }
        __syncthreads();
        const CvtTile now = cur;
        if (g + (int)gridDim.x < CVT_TILES) {
            cur = cvt_locate(p, g + gridDim.x);
#pragma unroll
            for (int i = 0; i < 8; ++i) { regs[i] = *(const f32x4*)(cur.src + (size_t)(kq + 8 * i) * cur.N + 4 * n4); scl[i] = cur.scale ? cur.scale[kq + 8 * i] : 1.0f; }
        }
#pragma unroll
        for (int it = 0; it < 4; ++it) {
            const int q = tid + 512 * it, ko = q & 7, n = q >> 3;
            float v[8];
#pragma unroll
            for (int j = 0; j < 8; ++j) v[j] = lds[(8 * ko + j) * 256 + (n ^ (4 * ko))];
            u32x4 w; w[0] = cvt_pk_bf16(v[0], v[1]); w[1] = cvt_pk_bf16(v[2], v[3]); w[2] = cvt_pk_bf16(v[4], v[5]); w[3] = cvt_pk_bf16(v[6], v[7]);
            *(u32x4*)(now.dst + (size_t)n * now.K + 8 * ko) = w;
        }
    }
    bf16_t* wh = (bf16_t*)(p.ws + WS_WRH); bf16_t* wl = (bf16_t*)(p.ws + WS_WRL);
    for (int idx = bid * NTHR + tid; idx < DEPTH * 48 * DM; idx += gridDim.x * NTHR) {
        const int l = idx / (48 * DM), n = (idx / DM) % 48, k = idx % DM;
        float v = 0.f;
        if (n < 4) v = p.moe_wg[((size_t)l * DM + k) * 4 + n]; else if (n < 36) v = p.moe_wr[((size_t)l * DM + k) * 32 + (n - 4)];
        v *= p.moe_norm[l * DM + k];
        const unsigned h = cvt_pk_bf16(v, 0.f), lo = cvt_pk_bf16(v - bf_lo(h), 0.f);
        wh[idx] = (bf16_t)(h & 0xffffu); wl[idx] = (bf16_t)(lo & 0xffffu);
    }
}

DI void unpack8(const u32x4 u, float (&f)[8]) {
#pragma unroll
    for (int i = 0; i < 4; ++i) { f[2 * i] = bf_lo(u[i]); f[2 * i + 1] = bf_hi(u[i]); }
}
template <bool FINAL>
DI void ph_combine(int src_buf) {
    LOAD_PARAMS();
    const int tid = tid_(), bid = bid_(), wid = tid >> 6, lane = tid & 63;
    const bf16_t* xs = (const bf16_t*)(p.ws + (src_buf ? WS_XB1 : WS_XB));
    bf16_t* xd = (bf16_t*)(p.ws + (src_buf ? WS_XB : WS_XB1));
    const bf16_t* yb = (const bf16_t*)(p.ws + WS_YBUF);
    float* rstd = (float*)(p.ws + WS_RSTD);
    for (int t = bid * NWAVE + wid; t < T; t += gridDim.x * NWAVE) {
        float ss = 0.f;
#pragma unroll
        for (int i = 0; i < 2; ++i) {
            const size_t o = (size_t)t * DM + lane * 8 + 512 * i;
            float a[8], b[8], c[8];
            unpack8(*(const u32x4*)(xs + o), a); unpack8(*(const u32x4*)(yb + o), b); unpack8(*(const u32x4*)(yb + (size_t)T * DM + o), c);
#pragma unroll
            for (int e = 0; e < 8; ++e) a[e] += b[e] + c[e];
            if (FINAL) {
                *(f32x4*)(p.x + o) = (f32x4){a[0], a[1], a[2], a[3]}; *(f32x4*)(p.x + o + 4) = (f32x4){a[4], a[5], a[6], a[7]};
            } else {
                u32x4 w; w[0] = cvt_pk_bf16(a[0], a[1]); w[1] = cvt_pk_bf16(a[2], a[3]); w[2] = cvt_pk_bf16(a[4], a[5]); w[3] = cvt_pk_bf16(a[6], a[7]);
                *(u32x4*)(xd + o) = w;
                float r[8]; unpack8(w, r);
#pragma unroll
                for (int e = 0; e < 8; ++e) ss += r[e] * r[e];
            }
        }
        if (!FINAL) { ss = wave_sum(ss, lane); if (lane == 0) rstd[t] = rsqrtf(ss * (1.0f / DM) + EPS); }
    }
}

constexpr int PF_ROWS = 47, PF_TOK = 32;
DI void ph_poolfuse(LAS unsigned char* ldsb, int j, bool first) {
    LOAD_PARAMS();
    const int tid = tid_(), bid = bid_(), wid = tid >> 6, lane = tid & 63;
    const bf16_t* xs = (const bf16_t*)(p.ws + WS_XB1);
    bf16_t* xd = (bf16_t*)(p.ws + WS_XB);
    const bf16_t* yb = (const bf16_t*)(p.ws + WS_YBUF);
    const float* gain = p.pool_norm + j * DM;
    bf16_t* diff = (bf16_t*)(p.ws + WS_DIFF);
    LAS unsigned char* ht = ldsb;
    for (int tile = bid; tile < T / PF_TOK; tile += gridDim.x) {
        const int t0 = tile * PF_TOK, s0 = t0 & (SEQ - 1);
        for (int rr = wid; rr < PF_ROWS; rr += NWAVE) {
            const int t = t0 - 15 + rr;
            if (s0 == 0 && rr < 15) {
#pragma unroll
                for (int i = 0; i < 2; ++i) *(LAS u32x4*)(ht + rr * 2048 + (lane * 8 + 512 * i) * 2) = (u32x4){0u, 0u, 0u, 0u};
                continue;
            }
            float v[2][8]; u32x4 w[2]; float ss = 0.f;
#pragma unroll
            for (int i = 0; i < 2; ++i) {
                const size_t o = (size_t)t * DM + lane * 8 + 512 * i;
                if (first) {
                    const f32x4 a = *(const f32x4*)(p.x_in + o), b = *(const f32x4*)(p.x_in + o + 4);
#pragma unroll
                    for (int e = 0; e < 4; ++e) { v[i][e] = a[e]; v[i][4 + e] = b[e]; }
                } else {
                    float b[8], c[8];
                    unpack8(*(const u32x4*)(xs + o), v[i]); unpack8(*(const u32x4*)(yb + o), b); unpack8(*(const u32x4*)(yb + (size_t)T * DM + o), c);
#pragma unroll
                    for (int e = 0; e < 8; ++e) v[i][e] += b[e] + c[e];
                }
                w[i][0] = cvt_pk_bf16(v[i][0], v[i][1]); w[i][1] = cvt_pk_bf16(v[i][2], v[i][3]); w[i][2] = cvt_pk_bf16(v[i][4], v[i][5]); w[i][3] = cvt_pk_bf16(v[i][6], v[i][7]);
                if (rr >= 15) *(u32x4*)(xd + o) = w[i];
                unpack8(w[i], v[i]);
#pragma unroll
                for (int e = 0; e < 8; ++e) ss += v[i][e] * v[i][e];
            }
            ss = wave_sum(ss, lane);
            const float rs = rsqrtf(ss * (1.0f / DM) + EPS);
#pragma unroll
            for (int i = 0; i < 2; ++i) {
                u32x4 hw; hw[0] = cvt_pk_bf16(v[i][0] * rs, v[i][1] * rs); hw[1] = cvt_pk_bf16(v[i][2] * rs, v[i][3] * rs); hw[2] = cvt_pk_bf16(v[i][4] * rs, v[i][5] * rs); hw[3] = cvt_pk_bf16(v[i][6] * rs, v[i][7] * rs);
                *(LAS u32x4*)(ht + rr * 2048 + (lane * 8 + 512 * i) * 2) = hw;
            }
        }
        __syncthreads();
        {
            const int c = 2 * tid, win = 2 << (c >> 8);
            const float g0 = gain[c], g1 = gain[c + 1];
            float S0 = 0.f, S1 = 0.f;
            const LAS unsigned char* col = ht + c * 2;
#pragma unroll 4
            for (int rr = 0; rr < PF_ROWS; ++rr) {
                const unsigned hv = *(const LAS unsigned*)(col + rr * 2048);
                const float h0 = bf_lo(hv), h1 = bf_hi(hv);
                S0 += h0; S1 += h1;
                if (rr >= win) { const unsigned ov = *(const LAS unsigned*)(col + (rr - win) * 2048); S0 -= bf_lo(ov); S1 -= bf_hi(ov); }
                if (rr >= 15) {
                    const int s = s0 + rr - 15;
                    const float inv = 1.0f / (float)((s + 1 < win) ? s + 1 : win);
                    *(unsigned*)(diff + (size_t)(t0 + rr - 15) * DM + c) = cvt_pk_bf16((S0 * inv - h0) * g0, (S1 * inv - h1) * g1);
                }
            }
        }
        __syncthreads();
    }
}

struct Unit { const bf16_t* A; const bf16_t* B; int pm, pn, e, nvalid, row0, lbase; };
template <int LDA_, int LDB_, int K_, int BH_, bool HEADMAP_> struct GCfg { static constexpr int LDA = LDA_, LDB = LDB_, K = K_, BH = BH_; static constexpr bool HEADMAP = HEADMAP_; };

constexpr int BK = 64, HTB = 128 * BK * 2  , STAGE_BYTES = 8 * HTB;
DI int lds_byte(int r, int c) { const int st = (r >> 4) * 2 + (c >> 5), rr = r & 15, cc = c & 31, ob = rr * 64 + cc * 2; return st * 1024 + (ob ^ (((ob >> 9) & 1) << 5)); }
DI void stage_rc(int b, int& R, int& C) { const int st = b / 1024, sb = b % 1024, swz = sb ^ (((sb >> 9) & 1) << 5); R = (st >> 1) * 16 + swz / 64; C = (st & 1) * 32 + (swz % 64) / 2; }

template <class Cfg, class Sched, class Epi>
DI void gemm_phase(LAS unsigned char* lds, const Sched& S, const Epi& E) {
    const int tid = tid_(), wid = __builtin_amdgcn_readfirstlane(tid >> 6), lane = tid & 63, wr = wid >> 2, wc = wid & 3, fr = lane & 15, fq = lane >> 4;
    constexpr int nt = Cfg::K / BK;
    static_assert(Cfg::K % 128 == 0 && Cfg::K >= 256, "K");
    unsigned voffA[2][2], voffB[2];
    int R0, C0, R1, C1; stage_rc(tid * 16, R0, C0); stage_rc(tid * 16 + 8192, R1, C1);
    voffB[0] = (unsigned)(((Cfg::HEADMAP ? 64 * (R0 >> 5) : (R0 & ~31)) + perm32(R0 & 31)) * Cfg::LDB + C0) * 2u;
    voffB[1] = (unsigned)(((Cfg::HEADMAP ? 64 * (R1 >> 5) : (R1 & ~31)) + perm32(R1 & 31)) * Cfg::LDB + C1) * 2u;
    constexpr size_t kstep = (size_t)(BK * 2);
    constexpr size_t bhstep = (size_t)Cfg::BH * Cfg::LDB * 2;
    const unsigned ldsw = (unsigned)wid * 1024u;
    const int aoff = lds_byte(wr * 64 + fr, fq * 8), boff = lds_byte(wc * 32 + fr, fq * 8);
#define PG8_SA(b, h) (((b) * 2 + (h)) * HTB)
#define PG8_SB(b, h) ((4 + (b) * 2 + (h)) * HTB)
#define PG8_STAGE(bufoff, gbase, voff) do { _Pragma("unroll") for (int _i = 0; _i < 2; ++_i) \
        __builtin_amdgcn_global_load_lds((const unsigned*)((const char*)(gbase) + (voff)[_i]), (LAS unsigned*)(lds + (bufoff) + ldsw + _i * 8192), 16, 0, 0); } while (0)
#define PG8_LDA(dst, b, h) do { _Pragma("unroll") for (int m = 0; m < 4; ++m) _Pragma("unroll") for (int k = 0; k < 2; ++k) dst[m][k] = *(const LAS bf16x8*)(lds + PG8_SA(b, h) + aoff + m * 2048 + k * 1024); } while (0)
#define PG8_LDB(dst, b, h) do { _Pragma("unroll") for (int n = 0; n < 2; ++n) _Pragma("unroll") for (int k = 0; k < 2; ++k) dst[n][k] = *(const LAS bf16x8*)(lds + PG8_SB(b, h) + boff + n * 2048 + k * 1024); } while (0)
#define PG8_MMA(ai, bj, At, Bt) do { __builtin_amdgcn_s_setprio(1); _Pragma("unroll") for (int m = 0; m < 4; ++m) _Pragma("unroll") for (int n = 0; n < 2; ++n) _Pragma("unroll") for (int k = 0; k < 2; ++k) \
        acc[ai][bj][m][n] = __builtin_amdgcn_mfma_f32_16x16x32_bf16(Bt[n][k], At[m][k], acc[ai][bj][m][n], 0, 0, 0); __builtin_amdgcn_s_setprio(0); } while (0)
#define PG8_WAIT_V(n) asm volatile("s_waitcnt vmcnt(" #n ")" ::: "memory")
#define PG8_WAIT_L(n) asm volatile("s_waitcnt lgkmcnt(" #n ")" ::: "memory")
#define PG8_BAR __builtin_amdgcn_s_barrier()
#define PG8_SCHED __builtin_amdgcn_sched_barrier(0)
#define PG8_AROWS(uidx, un) do { voffA[0][0] = (unsigned)S.arow(uidx, un, R0) * (unsigned)(Cfg::LDA * 2) + (unsigned)(C0 * 2); voffA[0][1] = (unsigned)S.arow(uidx, un, R1) * (unsigned)(Cfg::LDA * 2) + (unsigned)(C1 * 2); \
        voffA[1][0] = (unsigned)S.arow(uidx, un, 128 + R0) * (unsigned)(Cfg::LDA * 2) + (unsigned)(C0 * 2); voffA[1][1] = (unsigned)S.arow(uidx, un, 128 + R1) * (unsigned)(Cfg::LDA * 2) + (unsigned)(C1 * 2); } while (0)
    Unit cur, nxt; int ui = 0;
    if (!S.next(0, cur)) return;
    f32x4 acc[2][2][4][2];
#pragma unroll
    for (int a = 0; a < 2; ++a)
#pragma unroll
        for (int b = 0; b < 2; ++b)
#pragma unroll
            for (int m = 0; m < 4; ++m)
#pragma unroll
                for (int n = 0; n < 2; ++n) acc[a][b][m][n] = (f32x4){0.f, 0.f, 0.f, 0.f};
    bf16x8 At[4][2], B0[2][2], B1[2][2];
    PG8_AROWS(0, cur);
    const char* cA = (const char*)cur.A; const char* cB = (const char*)cur.B;
    PG8_STAGE(PG8_SB(0, 0), cB, voffB); PG8_STAGE(PG8_SB(0, 1), cB + bhstep, voffB); PG8_STAGE(PG8_SA(0, 0), cA, voffA[0]); PG8_STAGE(PG8_SA(0, 1), cA, voffA[1]);
    if (wr == 1) PG8_BAR;
    PG8_WAIT_V(2); PG8_BAR;
    PG8_STAGE(PG8_SB(1, 0), cB + kstep, voffB); PG8_STAGE(PG8_SA(1, 0), cA + kstep, voffA[0]); PG8_STAGE(PG8_SB(1, 1), cB + bhstep + kstep, voffB);
    PG8_WAIT_V(6); PG8_BAR;
    for (;;) {
        const bool has_next = S.next(ui + 1, nxt);
        const char* nA = has_next ? (const char*)nxt.A : cA; const char* nB = has_next ? (const char*)nxt.B : cB;
#pragma unroll 1
        for (int t = 0; t < nt; t += 2) {
            const bool last = (t == nt - 2);
            const char* a1 = cA + (size_t)(t + 1) * kstep;
            const char* a2 = last ? nA : cA + (size_t)(t + 2) * kstep; const char* b2 = last ? nB : cB + (size_t)(t + 2) * kstep;
            const char* a3 = a2 + kstep; const char* b3 = b2 + kstep;
            PG8_LDB(B0, 0, 0); PG8_LDB(B1, 0, 1); PG8_SCHED; PG8_LDA(At, 0, 0); PG8_STAGE(PG8_SA(1, 1), a1, voffA[1]);
            if (last && has_next) PG8_AROWS(ui + 1, nxt);
            PG8_WAIT_V(8); PG8_WAIT_L(0); PG8_BAR; PG8_MMA(0, 0, At, B0); PG8_MMA(0, 1, At, B1); PG8_BAR; PG8_SCHED;
            PG8_LDA(At, 0, 1); PG8_STAGE(PG8_SB(0, 0), b2, voffB); PG8_STAGE(PG8_SB(0, 1), b2 + bhstep, voffB); PG8_STAGE(PG8_SA(0, 0), a2, voffA[0]);
            PG8_WAIT_V(8); PG8_WAIT_L(0); PG8_BAR; PG8_MMA(1, 0, At, B0); PG8_MMA(1, 1, At, B1); PG8_BAR; PG8_SCHED;
            PG8_LDB(B0, 1, 0); PG8_LDB(B1, 1, 1); PG8_SCHED; PG8_LDA(At, 1, 0); PG8_STAGE(PG8_SA(0, 1), a2, voffA[1]);
            PG8_WAIT_V(8); PG8_WAIT_L(0); PG8_BAR; PG8_MMA(0, 0, At, B0); PG8_MMA(0, 1, At, B1); PG8_BAR; PG8_SCHED;
            PG8_LDA(At, 1, 1); PG8_STAGE(PG8_SB(1, 0), b3, voffB); PG8_STAGE(PG8_SB(1, 1), b3 + bhstep, voffB); PG8_STAGE(PG8_SA(1, 0), a3, voffA[0]);
            PG8_WAIT_V(8); PG8_WAIT_L(0); PG8_BAR; PG8_MMA(1, 0, At, B0); PG8_MMA(1, 1, At, B1); PG8_BAR; PG8_SCHED;
        }
        if (wr == 0) PG8_BAR;
        E(acc, cur, wr, wc, fr, fq);
        if (!has_next) break;
#pragma unroll
        for (int a = 0; a < 2; ++a)
#pragma unroll
            for (int b = 0; b < 2; ++b)
#pragma unroll
                for (int m = 0; m < 4; ++m)
#pragma unroll
                    for (int n = 0; n < 2; ++n) acc[a][b][m][n] = (f32x4){0.f, 0.f, 0.f, 0.f};
        cur = nxt; cA = nA; cB = nB; ++ui;
        if (wr == 1) PG8_BAR;
    }
    PG8_WAIT_V(0);
    PG8_BAR;
#undef PG8_SA
#undef PG8_SB
#undef PG8_STAGE
#undef PG8_LDA
#undef PG8_LDB
#undef PG8_MMA
#undef PG8_WAIT_V
#undef PG8_WAIT_L
#undef PG8_BAR
#undef PG8_SCHED
#undef PG8_AROWS
}

struct SchedPool {
    const bf16_t* diff; const bf16_t* w; int bid;
    DI bool next(int i, Unit& u) const { const int L = i * gridDim.x + bid; if (L >= 256) return false; u.pm = L >> 2; u.pn = L & 3; u.A = diff + 256 * u.pn; u.B = w + (size_t)u.pn * 65536; return true; }
    DI int arow(int, const Unit& u, int r) const { return u.pm * 256 + r; }
};
struct SchedDense {
    const bf16_t* A; const bf16_t* B; int npn, ldb, bid;
    DI bool next(int i, Unit& u) const { const int L = i * gridDim.x + bid; if (L >= 64 * npn) return false; u.pm = L / npn; u.pn = L % npn; u.A = A; u.B = B + (size_t)u.pn * 256 * ldb; return true; }
    DI int arow(int, const Unit& u, int r) const { return u.pm * 256 + r; }
};

struct EpiPool {
    bf16_t* x; const float* pb; const float* ps;
    DI void operator()(const f32x4 (&acc)[2][2][4][2], const Unit& u, int wr, int wc, int fr, int fq) const {
#pragma unroll
        for (int ai = 0; ai < 2; ++ai)
#pragma unroll
            for (int m = 0; m < 4; ++m) {
                const int t = u.pm * 256 + 128 * ai + 64 * wr + 16 * m + fr;
#pragma unroll
                for (int bj = 0; bj < 2; ++bj) {
                    const int c = 256 * u.pn + 128 * bj + 32 * wc + 8 * fq;
                    bf16_t* xp = x + (size_t)t * DM + c;
                    float xv[8]; unpack8(*(const u32x4*)xp, xv);
                    const f32x4 v0 = (acc[ai][bj][m][0] + *(const f32x4*)(pb + c)) * *(const f32x4*)(ps + c);
                    const f32x4 v1 = (acc[ai][bj][m][1] + *(const f32x4*)(pb + c + 4)) * *(const f32x4*)(ps + c + 4);
                    u32x4 w; w[0] = cvt_pk_bf16(xv[0] + v0[0], xv[1] + v0[1]); w[1] = cvt_pk_bf16(xv[2] + v0[2], xv[3] + v0[3]); w[2] = cvt_pk_bf16(xv[4] + v1[0], xv[5] + v1[1]); w[3] = cvt_pk_bf16(xv[6] + v1[2], xv[7] + v1[3]);
                    *(u32x4*)xp = w;
                }
            }
    }
};
struct EpiWo {
    bf16_t* x;
    DI void operator()(const f32x4 (&acc)[2][2][4][2], const Unit& u, int wr, int wc, int fr, int fq) const {
#pragma unroll
        for (int ai = 0; ai < 2; ++ai)
#pragma unroll
            for (int m = 0; m < 4; ++m) {
                const int t = u.pm * 256 + 128 * ai + 64 * wr + 16 * m + fr;
#pragma unroll
                for (int bj = 0; bj < 2; ++bj) {
                    const int c = 256 * u.pn + 128 * bj + 32 * wc + 8 * fq;
                    bf16_t* xp = x + (size_t)t * DM + c;
                    float xv[8]; unpack8(*(const u32x4*)xp, xv);
                    const f32x4 v0 = acc[ai][bj][m][0], v1 = acc[ai][bj][m][1];
                    u32x4 w; w[0] = cvt_pk_bf16(xv[0] + v0[0], xv[1] + v0[1]); w[1] = cvt_pk_bf16(xv[2] + v0[2], xv[3] + v0[3]); w[2] = cvt_pk_bf16(xv[4] + v1[0], xv[5] + v1[1]); w[3] = cvt_pk_bf16(xv[6] + v1[2], xv[7] + v1[3]);
                    *(u32x4*)xp = w;
                }
            }
    }
};
struct EpiQKV {
    bf16_t* q; const float* rstd; const float* qg; const float* kg;
    DI void operator()(const f32x4 (&acc)[2][2][4][2], const Unit& u, int wr, int wc, int fr, int fq) const {
        const int which = u.pn >> 2, head = (u.pn & 3) * 4 + wc;
        bf16_t* out = q + (size_t)which * ((WS_K - WS_Q) / 2);
        const float* gn = which == 0 ? qg : kg;
        const float post = which == 0 ? 0.125f * 1.4426950408889634f : 1.0f;
        f32x4 g[2][2];
#pragma unroll
        for (int bj = 0; bj < 2; ++bj)
#pragma unroll
            for (int n = 0; n < 2; ++n) g[bj][n] = (which < 2) ? *(const f32x4*)(gn + 32 * bj + 8 * fq + 4 * n) * post : (f32x4){1.f, 1.f, 1.f, 1.f};
        float rsv[2][4];
#pragma unroll
        for (int ai = 0; ai < 2; ++ai)
#pragma unroll
            for (int m = 0; m < 4; ++m) rsv[ai][m] = rstd[u.pm * 256 + 128 * ai + 64 * wr + 16 * m + fr];
#pragma unroll
        for (int ai = 0; ai < 2; ++ai)
#pragma unroll
            for (int m = 0; m < 4; ++m) {
                const int t = u.pm * 256 + 128 * ai + 64 * wr + 16 * m + fr;
                const float rs = rsv[ai][m];
                f32x4 v4[2][2]; float ss = 0.f;
#pragma unroll
                for (int bj = 0; bj < 2; ++bj)
#pragma unroll
                    for (int n = 0; n < 2; ++n) { v4[bj][n] = acc[ai][bj][m][n] * rs; const f32x4 s = v4[bj][n] * v4[bj][n]; ss += (s[0] + s[1]) + (s[2] + s[3]); }
                ss += shflx(ss, fr + 16 * fq, 16); ss += shflx(ss, fr + 16 * fq, 32);
                const float r2 = (which < 2) ? rsqrtf(ss * (1.0f / HD) + EPS) : 1.0f;
#pragma unroll
                for (int bj = 0; bj < 2; ++bj) {
                    const f32x4 a = v4[bj][0] * r2 * g[bj][0], b = v4[bj][1] * r2 * g[bj][1];
                    u32x4 w; w[0] = cvt_pk_bf16(a[0], a[1]); w[1] = cvt_pk_bf16(a[2], a[3]); w[2] = cvt_pk_bf16(b[0], b[1]); w[3] = cvt_pk_bf16(b[2], b[3]);
                    *(u32x4*)(out + (size_t)t * DM + head * HD + 32 * bj + 8 * fq) = w;
                }
            }
    }
};

typedef short v4i16_t __attribute__((ext_vector_type(4)));
constexpr int AT_VPITCH = 192;
constexpr int AT_VTILE = 32 * AT_VPITCH;
DI void ph_attn(LAS unsigned char* ldsb) {
    LOAD_PARAMS();
    const int tid = tid_(), bid = bid_(), wid = tid >> 6, lane = tid & 63, l31 = lane & 31, h2 = lane >> 5;
    const bf16_t* Q = (const bf16_t*)(p.ws + WS_Q); const bf16_t* K = (const bf16_t*)(p.ws + WS_K); const bf16_t* V = (const bf16_t*)(p.ws + WS_V);
    bf16_t* O = (bf16_t*)(p.ws + WS_O);
    LAS unsigned char* vl = ldsb + wid * AT_VTILE;
    LAS unsigned char* vw = vl + (lane >> 3) * AT_VPITCH + (lane & 7) * 16;
    const LAS unsigned char* vr = vl + (4 * h2 + ((lane & 15) >> 2)) * AT_VPITCH + (16 * ((lane >> 4) & 1) + 4 * (lane & 3)) * 2;
    for (int it = 0; it < 4 * ((2 * NH * 256 / 32 - bid + (int)gridDim.x - 1) / (int)gridDim.x); ++it) {
        const int tsk = (bid + (it >> 2) * gridDim.x) * 32 + (it & 3) * 8 + wid;
        const int bh = tsk >> 8, qb = tsk & 255, b = bh >> 4, h = bh & 15;
        const size_t tb = (size_t)b * SEQ;
        const int q0 = qb * 32;
        bf16x8 qf[4];
#pragma unroll
        for (int s = 0; s < 4; ++s) qf[s] = *(const bf16x8*)(Q + (tb + q0 + l31) * DM + h * HD + 16 * s + 8 * h2);
        f32x16 o0, o1;
#pragma unroll
        for (int r = 0; r < 16; ++r) { o0[r] = 0.f; o1[r] = 0.f; }
        float R = 1.f;
        const bf16_t* kp = K + (tb + q0 + l31) * DM + h * HD + 8 * h2;
        const bf16_t* vp = V + (tb + q0 + (lane >> 3)) * DM + h * HD + (lane & 7) * 8;
        bf16x8 kn[4], kq[4]; u32x4 vn[4], vq[4];
#pragma unroll
        for (int s = 0; s < 4; ++s) { kn[s] = *(const bf16x8*)(kp + 16 * s); vn[s] = *(const u32x4*)(vp + (size_t)8 * s * DM); }
        if (qb > 0) {
            kp -= (size_t)32 * DM; vp -= (size_t)32 * DM;
#pragma unroll
            for (int s = 0; s < 4; ++s) { kq[s] = *(const bf16x8*)(kp + 16 * s); vq[s] = *(const u32x4*)(vp + (size_t)8 * s * DM); }
        }
        for (int kt = qb; kt >= 0; --kt) {
            bf16x8 kf[4];
#pragma unroll
            for (int s = 0; s < 4; ++s) { kf[s] = kn[s]; *(LAS u32x4*)(vw + 8 * s * AT_VPITCH) = vn[s]; kn[s] = kq[s]; vn[s] = vq[s]; }
            if (kt > 1) {
                kp -= (size_t)32 * DM; vp -= (size_t)32 * DM;
#pragma unroll
                for (int s = 0; s < 4; ++s) { kq[s] = *(const bf16x8*)(kp + 16 * s); vq[s] = *(const u32x4*)(vp + (size_t)8 * s * DM); }
            }
            f32x16 z;
#pragma unroll
            for (int r = 0; r < 16; ++r) z[r] = 0.f;
#pragma unroll
            for (int s = 0; s < 4; ++s) z = __builtin_amdgcn_mfma_f32_32x32x16_bf16(kf[s], qf[s], z, 0, 0, 0);
            float e[16], kp_[16], gs[4], ot[4];
#pragma unroll
            for (int r = 0; r < 16; ++r) e[r] = __builtin_amdgcn_exp2f(__builtin_amdgcn_fmed3f(z[r], -1.0e30f, 126.f));
            if (kt == qb) {
#pragma unroll
                for (int r = 0; r < 16; ++r) { const int kl = (r & 3) + 8 * (r >> 2) + 4 * h2; e[r] = (kl < l31) ? e[r] : 0.f; }
            }
#pragma unroll
            for (int r = 0; r < 16; ++r) kp_[r] = __builtin_amdgcn_rcpf(1.0f + e[r]);
#pragma unroll
            for (int bb = 0; bb < 4; ++bb) { gs[bb] = (kp_[4 * bb] * kp_[4 * bb + 1]) * (kp_[4 * bb + 2] * kp_[4 * bb + 3]); ot[bb] = shflx(gs[bb], lane, 32); }
            const float tot_own = (gs[0] * gs[1]) * (gs[2] * gs[3]);
            const float tot_oth = (ot[0] * ot[1]) * (ot[2] * ot[3]);
            float later[4];
            {
                float own_tail = 1.f, oth_tail = 1.f;
#pragma unroll
                for (int bb = 3; bb >= 0; --bb) {
                    later[bb] = own_tail * oth_tail * (h2 == 0 ? ot[bb] : 1.f);
                    own_tail *= gs[bb]; oth_tail *= ot[bb];
                }
            }
            float a[16];
#pragma unroll
            for (int bb = 0; bb < 4; ++bb) {
                const float base = R * later[bb];
                const float s3 = base * kp_[4 * bb + 3], s2 = s3 * kp_[4 * bb + 2], s1 = s2 * kp_[4 * bb + 1], s0 = s1 * kp_[4 * bb];
                a[4 * bb] = e[4 * bb] * s0; a[4 * bb + 1] = e[4 * bb + 1] * s1; a[4 * bb + 2] = e[4 * bb + 2] * s2; a[4 * bb + 3] = e[4 * bb + 3] * s3;
            }
            R *= (h2 == 0) ? (tot_own * tot_oth) : (tot_oth * tot_own);
#pragma unroll
            for (int s = 0; s < 2; ++s) {
                u32x4 pw;
#pragma unroll
                for (int i = 0; i < 4; ++i) pw[i] = cvt_pk_bf16(a[8 * s + 2 * i], a[8 * s + 2 * i + 1]);
                const bf16x8 pa = __builtin_bit_cast(bf16x8, pw);
#pragma unroll
                for (int db = 0; db < 2; ++db) {
                    const v4i16_t lo4 = __builtin_amdgcn_ds_read_tr16_b64_v4i16((LAS v4i16_t*)(vr + (16 * s) * AT_VPITCH + 64 * db));
                    const v4i16_t hi4 = __builtin_amdgcn_ds_read_tr16_b64_v4i16((LAS v4i16_t*)(vr + (16 * s + 8) * AT_VPITCH + 64 * db));
                    bf16x8 vf; vf[0] = lo4[0]; vf[1] = lo4[1]; vf[2] = lo4[2]; vf[3] = lo4[3]; vf[4] = hi4[0]; vf[5] = hi4[1]; vf[6] = hi4[2]; vf[7] = hi4[3];
                    if (db == 0) o0 = __builtin_amdgcn_mfma_f32_32x32x16_bf16(vf, pa, o0, 0, 0, 0);
                    else o1 = __builtin_amdgcn_mfma_f32_32x32x16_bf16(vf, pa, o1, 0, 0, 0);
                }
            }
            if (__all(R < 1.0e-36f)) break;
        }
#pragma unroll
        for (int db = 0; db < 2; ++db)
#pragma unroll
            for (int rb = 0; rb < 4; ++rb) {
                const f32x16& o = db == 0 ? o0 : o1;
                u32x2 w; w[0] = cvt_pk_bf16(o[4 * rb], o[4 * rb + 1]); w[1] = cvt_pk_bf16(o[4 * rb + 2], o[4 * rb + 3]);
                *(u32x2*)(O + (tb + q0 + l31) * DM + h * HD + 32 * db + 8 * rb + 4 * h2) = w;
            }
    }
}

constexpr int RT_PART = 0;
constexpr int RT_SSQ = RT_PART + 2 * 4 * 16 * 52 * 4;
constexpr int RT_LCNT = RT_SSQ + 2 * 4 * 16 * 4;
constexpr int RT_GB = RT_LCNT + 128;
DI void ph_router(LAS unsigned char* lds, int li) {
    LOAD_PARAMS();
    const bf16_t* xcur = (const bf16_t*)(p.ws + ((li & 1) ? WS_XB1 : WS_XB));
    const int tid = tid_(), bid = bid_(), wid = tid >> 6, lane = tid & 63, fr = lane & 15, fq = lane >> 4;
    const bf16_t* wh = (const bf16_t*)(p.ws + WS_WRH) + (size_t)li * 48 * DM;
    const bf16_t* wl = (const bf16_t*)(p.ws + WS_WRL) + (size_t)li * 48 * DM;
    const float* bg = p.moe_bg + li * 4;
    const float* br = p.moe_br + li * 32;
    unsigned* cnt = (unsigned*)(p.ws + WS_CTL) + CW_CNT + 32 * li;
    Entry* list = (Entry*)(p.ws + WS_LIST);
    LAS float* part = (LAS float*)(lds + RT_PART); LAS float* ssq = (LAS float*)(lds + RT_SSQ);
    LAS int* lcnt = (LAS int*)(lds + RT_LCNT); LAS int* gb = (LAS int*)(lds + RT_GB);
    const int tb = wid & 3, kh = wid >> 2;
    for (int chunk = bid; chunk < T / 64; chunk += gridDim.x) {
        const int t = chunk * 64 + tb * 16 + fr;
        const bf16_t* xr = xcur + (size_t)t * DM + kh * 512 + fq * 8;
        const bf16_t* whr = wh + (size_t)fr * DM + kh * 512 + fq * 8;
        const bf16_t* wlr = wl + (size_t)fr * DM + kh * 512 + fq * 8;
        f32x4 acc[3]; float ss = 0.f;
#pragma unroll
        for (int nb = 0; nb < 3; ++nb) acc[nb] = (f32x4){0.f, 0.f, 0.f, 0.f};
#pragma unroll 4
        for (int ks = 0; ks < 16; ++ks) {
            const u32x4 xw = *(const u32x4*)(xr + ks * 32);
            float xf[8]; unpack8(xw, xf);
#pragma unroll
            for (int e = 0; e < 8; ++e) ss += xf[e] * xf[e];
            const bf16x8 xh = __builtin_bit_cast(bf16x8, xw);
#pragma unroll
            for (int nb = 0; nb < 3; ++nb) {
                const bf16x8 wH = *(const bf16x8*)(whr + (size_t)nb * 16 * DM + ks * 32), wL = *(const bf16x8*)(wlr + (size_t)nb * 16 * DM + ks * 32);
                acc[nb] = __builtin_amdgcn_mfma_f32_16x16x32_bf16(wH, xh, acc[nb], 0, 0, 0);
                acc[nb] = __builtin_amdgcn_mfma_f32_16x16x32_bf16(wL, xh, acc[nb], 0, 0, 0);
            }
        }
        ss += shflx(ss, lane, 16); ss += shflx(ss, lane, 32);
#pragma unroll
        for (int nb = 0; nb < 3; ++nb) *(LAS f32x4*)(part + ((kh * 4 + tb) * 16 + fr) * 52 + 16 * nb + 4 * fq) = acc[nb];
        if (fq == 0) ssq[(kh * 4 + tb) * 16 + fr] = ss;
        if (tid < 32) lcnt[tid] = 0;
        __syncthreads();
        int ea = 0, eb = 0, la = 0, lb = 0; float w1 = 0.f, w2 = 0.f, rs = 0.f;
        if (tid < 64) {
            const LAS float* p0 = part + tid * 52; const LAS float* p1 = part + (64 + tid) * 52;
            rs = rsqrtf((ssq[tid] + ssq[64 + tid]) * (1.0f / DM) + EPS);
            float lg[36];
#pragma unroll
            for (int q = 0; q < 9; ++q) { const f32x4 u = *(const LAS f32x4*)(p0 + 4 * q), v = *(const LAS f32x4*)(p1 + 4 * q);
#pragma unroll
                for (int e = 0; e < 4; ++e) lg[4 * q + e] = (u[e] + v[e]) * rs; }
            float gl[4];
#pragma unroll
            for (int n = 0; n < 4; ++n) gl[n] = lg[n] + bg[n];
            int g = 0; float gm = gl[0];
#pragma unroll
            for (int n = 1; n < 4; ++n) if (gl[n] > gm) { gm = gl[n]; g = n; }
            float den = 0.f;
#pragma unroll
            for (int n = 0; n < 4; ++n) den += __expf(gl[n] - gm);
            const float gprob = 1.0f / den;
            float el[8];
#pragma unroll
            for (int n = 0; n < 8; ++n) {
                float v = 0.f;
#pragma unroll
                for (int gg = 0; gg < 4; ++gg) v = (g == gg) ? lg[4 + 8 * gg + n] + br[8 * gg + n] : v;
                el[n] = v;
            }
            int e1 = 0; float m1 = el[0];
#pragma unroll
            for (int n = 1; n < 8; ++n) if (el[n] > m1) { m1 = el[n]; e1 = n; }
            int e2 = -1; float m2 = -3.0e38f;
#pragma unroll
            for (int n = 0; n < 8; ++n) if (n != e1 && (e2 < 0 || el[n] > m2)) { m2 = el[n]; e2 = n; }
            const float ex = __expf(m2 - m1);
            w1 = gprob / (1.0f + ex); w2 = gprob * ex / (1.0f + ex);
            ea = 8 * g + e1; eb = 8 * g + e2;
            la = __hip_atomic_fetch_add(lcnt + ea, 1, __ATOMIC_RELAXED, __HIP_MEMORY_SCOPE_WORKGROUP);
            lb = __hip_atomic_fetch_add(lcnt + eb, 1, __ATOMIC_RELAXED, __HIP_MEMORY_SCOPE_WORKGROUP);
        }
        __syncthreads();
        if (tid < 32) { const int c = lcnt[tid]; gb[tid] = c ? (int)atomicAdd(&cnt[tid], (unsigned)c) : 0; }
        __syncthreads();
        if (tid < 64) {
            const int tt = chunk * 64 + tid;
            Entry A; A.dst = tt; A.rstd = rs; A.w = w1; A.tok = tt;
            Entry B; B.dst = T + tt; B.rstd = rs; B.w = w2; B.tok = tt;
            list[(size_t)ea * LIST_CAP + gb[ea] + la] = A;
            list[(size_t)eb * LIST_CAP + gb[eb] + lb] = B;
        }
        __syncthreads();
    }
}

constexpr int MOE_MAXU = 4;
constexpr int LDS_ROWTAB = STAGE_BYTES;
constexpr int LDS_EPITAB = LDS_ROWTAB + MOE_MAXU * 1024;
constexpr int LDS_UTAB = LDS_EPITAB + MOE_MAXU * 2048;
constexpr int LDS_XBW = LDS_UTAB + MOE_MAXU * 32;
constexpr int LDS_BYTES = 147456;
static_assert(LDS_XBW + 16 <= LDS_BYTES, "LDS map");
struct SchedMoe {
    LAS unsigned char* lds; const bf16_t* A; const bf16_t* W; bool gather; size_t w_estride; int w_pnrows, ldb;
    DI void build(const unsigned* cnt, const Entry* list, int npn, int lo, int hi, int first, int stride, int tid) {
        LAS int* ut = (LAS int*)(lds + LDS_UTAB); LAS unsigned* rt = (LAS unsigned*)(lds + LDS_ROWTAB);
        for (int i = 0; i < MOE_MAXU; ++i) {
            const int L = lo + first + i * stride;
            int found = 0, e = 0, j = 0, nv = 0, rtile = 0, pn = 0;
            if (first >= 0 && L < hi) {
                rtile = L / npn; pn = L % npn;
                int acc = 0;
                for (int ee = 0; ee < NE; ++ee) {
                    const int c = (int)cnt[ee], ntl = (c + 255) >> 8;
                    if (!found && rtile < acc + ntl) { found = 1; e = ee; j = rtile - acc; nv = c - 256 * j; }
                    acc += ntl;
                }
            }
            nv = nv > 256 ? 256 : nv;
            if (tid == 0) { ut[i * 8 + 0] = found; ut[i * 8 + 1] = e; ut[i * 8 + 2] = nv; ut[i * 8 + 3] = 256 * rtile; ut[i * 8 + 4] = e * LIST_CAP + 256 * j; ut[i * 8 + 5] = pn; }
            if (found && tid < 256) {
                Entry en; en.dst = DUMMY_ROW; en.rstd = 0.f; en.w = 0.f; en.tok = 0;
                if (tid < nv) en = list[e * LIST_CAP + 256 * j + tid];
                LAS float* et = (LAS float*)(lds + LDS_EPITAB) + (i * 256 + tid) * 2;
                if (gather) { rt[i * 256 + tid] = (unsigned)en.tok; et[0] = en.rstd; et[1] = en.w; }
                else { et[0] = __int_as_float(en.dst); et[1] = 0.f; }
            }
            if (tid == 0) ut[i * 8 + 6] = i;
        }
        asm volatile("s_waitcnt vmcnt(0) lgkmcnt(0)" ::: "memory");
        __syncthreads();
    }
    DI bool next(int i, Unit& u) const {
        if (i >= MOE_MAXU) return false;
        const LAS int* ut = (const LAS int*)(lds + LDS_UTAB) + i * 8;
        const int found = __builtin_amdgcn_readfirstlane(ut[0]);
        if (!found) return false;
        u.e = __builtin_amdgcn_readfirstlane(ut[1]); u.nvalid = __builtin_amdgcn_readfirstlane(ut[2]); u.row0 = __builtin_amdgcn_readfirstlane(ut[3]);
        u.lbase = i * 256; u.pn = __builtin_amdgcn_readfirstlane(ut[5]); u.pm = u.row0 >> 8;
        u.A = gather ? A : A + (size_t)u.row0 * DE;
        u.B = W + (size_t)u.e * w_estride + (size_t)u.pn * w_pnrows * ldb;
        return true;
    }
    DI int arow(int ui, const Unit&, int r) const { if (!gather) return r; return (int)((const LAS unsigned*)(lds + LDS_ROWTAB))[ui * 256 + r]; }
};
struct EpiGU {
    bf16_t* hid; LAS unsigned char* lds;
    DI void operator()(const f32x4 (&acc)[2][2][4][2], const Unit& u, int wr, int wc, int fr, int fq) const {
        typedef float f32x2 __attribute__((ext_vector_type(2)));
#pragma unroll
        for (int ai = 0; ai < 2; ++ai)
#pragma unroll
            for (int m = 0; m < 4; ++m) {
                const int r = 128 * ai + 64 * wr + 16 * m + fr;
                const f32x2 rw = *(const LAS f32x2*)(lds + LDS_EPITAB + (u.lbase + r) * 8);
                const float rs = rw[0], w = rw[1];
                unsigned pk[4];
#pragma unroll
                for (int n = 0; n < 2; ++n) {
                    float hv[4];
#pragma unroll
                    for (int e = 0; e < 4; ++e) { const float g = acc[ai][0][m][n][e] * rs, up = acc[ai][1][m][n][e] * rs; hv[e] = g * __builtin_amdgcn_rcpf(1.0f + __builtin_amdgcn_exp2f(-1.4426950408889634f * g)) * up * w; }
                    pk[2 * n] = cvt_pk_bf16(hv[0], hv[1]); pk[2 * n + 1] = cvt_pk_bf16(hv[2], hv[3]);
                }
                u32x4 wv; wv[0] = pk[0]; wv[1] = pk[1]; wv[2] = pk[2]; wv[3] = pk[3];
                *(u32x4*)(hid + (size_t)(u.row0 + r) * DE + 128 * u.pn + 32 * wc + 8 * fq) = wv;
            }
    }
};
struct EpiDown {
    bf16_t* yb; LAS unsigned char* lds;
    DI void operator()(const f32x4 (&acc)[2][2][4][2], const Unit& u, int wr, int wc, int fr, int fq) const {
#pragma unroll
        for (int ai = 0; ai < 2; ++ai)
#pragma unroll
            for (int m = 0; m < 4; ++m) {
                const int r = 128 * ai + 64 * wr + 16 * m + fr;
                const int dst = *(const LAS int*)(lds + LDS_EPITAB + (u.lbase + r) * 8);
#pragma unroll
                for (int bj = 0; bj < 2; ++bj) {
                    const f32x4 a = acc[ai][bj][m][0], b = acc[ai][bj][m][1];
                    u32x4 w; w[0] = cvt_pk_bf16(a[0], a[1]); w[1] = cvt_pk_bf16(a[2], a[3]); w[2] = cvt_pk_bf16(b[0], b[1]); w[3] = cvt_pk_bf16(b[2], b[3]);
                    *(u32x4*)(yb + (size_t)dst * DM + 256 * u.pn + 128 * bj + 32 * wc + 8 * fq) = w;
                }
            }
    }
};

DI void ph_poolgemm(LAS unsigned char* lds, int j) {
    LOAD_PARAMS();
    SchedPool S; S.bid = bid_(); S.diff = (const bf16_t*)(p.ws + WS_DIFF); S.w = (const bf16_t*)(p.ws + WS_WPOOL) + (size_t)j * 4 * 65536;
    EpiPool E; E.x = (bf16_t*)(p.ws + WS_XB); E.pb = p.pool_b + j * DM; E.ps = p.pool_scale + j * DM;
    gemm_phase<GCfg<1024, 256, 256, 128, false>>(lds, S, E);
}
DI void ph_qkv(LAS unsigned char* lds, int j) {
    LOAD_PARAMS();
    SchedDense S; S.bid = bid_(); S.A = (const bf16_t*)(p.ws + WS_XB1); S.B = (const bf16_t*)(p.ws + WS_WQKV) + (size_t)j * 3072 * 1024; S.npn = 12; S.ldb = 1024;
    EpiQKV E; E.q = (bf16_t*)(p.ws + WS_Q); E.rstd = (const float*)(p.ws + WS_RSTD); E.qg = p.sb_qg + j * HD; E.kg = p.sb_kg + j * HD;
    gemm_phase<GCfg<1024, 1024, 1024, 32, true>>(lds, S, E);
}
DI void ph_wo(LAS unsigned char* lds, int j) {
    LOAD_PARAMS();
    SchedDense S; S.bid = bid_(); S.A = (const bf16_t*)(p.ws + WS_O); S.B = (const bf16_t*)(p.ws + WS_WO) + (size_t)j * 1024 * 1024; S.npn = 4; S.ldb = 1024;
    EpiWo E; E.x = (bf16_t*)(p.ws + WS_XB1);
    gemm_phase<GCfg<1024, 1024, 1024, 128, false>>(lds, S, E);
}
struct MoePlan { int NT, R1, nB, D1; };
DI MoePlan moe_plan(const unsigned* cnt) {
    int nt = 0;
    for (int e = 0; e < NE; ++e) nt += ((int)cnt[e] + 255) >> 8;
    MoePlan m; m.NT = nt; const int G = gridDim.x; m.R1 = nt < G / 2 ? nt : G / 2;
    const int late = 2 * (nt - m.R1); m.nB = late < G ? late : G;
    const int cap = 2 * (G - m.nB); m.D1 = 4 * m.R1 < cap ? 4 * m.R1 : cap;
    return m;
}
DI void ph_gu(LAS unsigned char* lds, int li, int stage) {
    LOAD_PARAMS();
    const Entry* list = (const Entry*)(p.ws + WS_LIST);
    const unsigned* cnt = (const unsigned*)(p.ws + WS_CTL) + CW_CNT + 32 * li;
    const MoePlan m = moe_plan(cnt);
    const int bid = bid_();
    if (stage == 2 || (stage == 1 && bid >= m.nB)) return;
    SchedMoe S; S.lds = lds; S.A = (const bf16_t*)(p.ws + ((li & 1) ? WS_XB1 : WS_XB));
    S.W = (const bf16_t*)(p.ws + WS_WGU) + (size_t)li * NE * 512 * 1024; S.gather = true; S.w_estride = (size_t)512 * 1024; S.w_pnrows = 128; S.ldb = 1024;
    if (stage == 0) S.build(cnt, list, 2, 0, 2 * m.R1, bid, gridDim.x, tid_());
    else S.build(cnt, list, 2, 2 * m.R1, 2 * m.NT, bid, gridDim.x, tid_());
    EpiGU E; E.hid = (bf16_t*)(p.ws + WS_HID); E.lds = lds;
    gemm_phase<GCfg<1024, 1024, 1024, 256, false>>(lds, S, E);
}
DI void ph_down(LAS unsigned char* lds, int li, int stage) {
    LOAD_PARAMS();
    const Entry* list = (const Entry*)(p.ws + WS_LIST);
    const unsigned* cnt = (const unsigned*)(p.ws + WS_CTL) + CW_CNT + 32 * li;
    const MoePlan m = moe_plan(cnt);
    const int bid = bid_(), G = gridDim.x;
    if (stage == 0 || (stage == 1 && bid < m.nB)) return;
    SchedMoe S; S.lds = lds; S.A = (const bf16_t*)(p.ws + WS_HID);
    S.W = (const bf16_t*)(p.ws + WS_WD) + (size_t)li * NE * 1024 * 256; S.gather = false; S.w_estride = (size_t)1024 * 256; S.w_pnrows = 256; S.ldb = 256;
    if (stage == 1) S.build(cnt, list, 4, 0, m.D1, bid - m.nB, G - m.nB, tid_());
    else S.build(cnt, list, 4, m.D1, 4 * m.NT, bid, G, tid_());
    EpiDown E; E.yb = (bf16_t*)(p.ws + WS_YBUF); E.lds = lds;
    gemm_phase<GCfg<256, 256, 256, 128, false>>(lds, S, E);
}
DI bool moe_has_stage2(int li) {
    LOAD_PARAMS();
    const MoePlan m = moe_plan((const unsigned*)(p.ws + WS_CTL) + CW_CNT + 32 * li);
    return 4 * m.NT > m.D1;
}

#define XB_TMO      128
#define XB_XCNT(j)  (256  + 64 * (j))
#define XB_XSUB(j)  (1280 + 64 * (j))
#define XB_XGEN(j)  (2304 + 64 * (j))
#define XB_TOP      3328
#define XB_TOPGEN   3392
#define XCD_BAR_WORDS 3456
#define XB_SPIN_CAP (1u << 18)

__device__ __forceinline__ unsigned xb_ld(unsigned* p)              { return __hip_atomic_load(p, __ATOMIC_RELAXED, __HIP_MEMORY_SCOPE_AGENT); }
__device__ __forceinline__ unsigned xb_add(unsigned* p, unsigned v) { return __hip_atomic_fetch_add(p, v, __ATOMIC_RELAXED, __HIP_MEMORY_SCOPE_AGENT); }
__device__ __forceinline__ unsigned xb_xcc_id() { return (unsigned)__builtin_amdgcn_s_getreg((3 << 11) | 20) & 0xFu; }
#define XB_SPIN(cond, bar) do { unsigned _sp = 0; while (cond) { __builtin_amdgcn_s_sleep(1); \
    if ((++_sp & 255u) == 0u) { if (xb_ld(&(bar)[XB_TMO])) break; if (_sp > XB_SPIN_CAP) { atomicAdd(&(bar)[XB_TMO], 1u); break; } } } } while (0)

struct XcdBarrier {
    unsigned* bar; unsigned x;
    volatile LAS unsigned* st;
};

__device__ __forceinline__ XcdBarrier xcd_barrier_post(unsigned* bar, volatile LAS unsigned* st) {
    XcdBarrier b; b.bar = bar; b.x = xb_xcc_id(); b.st = st;
    if (threadIdx.x == 0) (void)xb_add(&bar[XB_XCNT(b.x)], 1u);
    return b;
}
__device__ __forceinline__ void xcd_barrier_complete(unsigned* bar, unsigned x, unsigned& nloc, unsigned& nx) {
    const unsigned G = gridDim.x * gridDim.y * gridDim.z;
    unsigned sum, cnt, mine, sp = 0u;
    for (;;) {
        sum = 0u; cnt = 0u; mine = 0u;
#pragma unroll
        for (unsigned j = 0; j < 16; ++j) { const unsigned c = xb_ld(&bar[XB_XCNT(j)]); sum += c; cnt += (c > 0u) ? 1u : 0u; mine = (j == x) ? c : mine; }
        if (sum == G) break;
        __builtin_amdgcn_s_sleep(1);
        if ((++sp & 255u) == 0u) { if (xb_ld(&bar[XB_TMO])) break; if (sp > XB_SPIN_CAP) { atomicAdd(&bar[XB_TMO], 1u); break; } }
    }
    nloc = mine > 0u ? mine : 1u; nx = cnt > 0u ? cnt : 1u;
}

__device__ __forceinline__ void xcd_barrier(const XcdBarrier& b) {
    asm volatile("s_waitcnt vmcnt(0)" ::: "memory");
    __syncthreads();
    if (threadIdx.x == 0) {
        unsigned* bar = b.bar; unsigned bx = b.x;
        asm volatile("" : "+s"(bar), "+s"(bx));
        __builtin_amdgcn_s_waitcnt(0);
        unsigned nloc = b.st[0], nx = b.st[1];
        if (nloc == 0u) { xcd_barrier_complete(bar, bx, nloc, nx); b.st[0] = nloc; b.st[1] = nx; }
        const unsigned old = xb_add(&bar[XB_XSUB(bx)], 1u);
        const unsigned gen = old / nloc;
        if (old + 1u == (gen + 1u) * nloc) {
            __builtin_amdgcn_fence(__ATOMIC_RELEASE, "agent");
            asm volatile("s_waitcnt vmcnt(0)" ::: "memory");
            const unsigned og = xb_add(&bar[XB_TOP], 1u);
            const unsigned tg = og / nx;
            if (og + 1u == (tg + 1u) * nx) xb_add(&bar[XB_TOPGEN], 1u);
            else XB_SPIN(xb_ld(&bar[XB_TOPGEN]) == tg, bar);
            __builtin_amdgcn_fence(__ATOMIC_ACQUIRE, "agent");
            xb_add(&bar[XB_XGEN(bx)], 1u);
            asm volatile("s_waitcnt vmcnt(0)" ::: "memory");
        } else {
            XB_SPIN(xb_ld(&bar[XB_XGEN(bx)]) == gen, bar);
            __builtin_amdgcn_fence(__ATOMIC_ACQUIRE, "agent");
            asm volatile("s_waitcnt vmcnt(0)" ::: "memory");
        }
    }
    __syncthreads();
}
constexpr int CW_BAR = 4096;

extern __shared__ __attribute__((aligned(16))) unsigned char smem_raw[];
__global__ void __launch_bounds__(NTHR, 2) fwd(Params pk) {
    LAS unsigned char* smem = (LAS unsigned char*)smem_raw;
    if (threadIdx.x < 4) ((LAS unsigned*)(smem + LDS_XBW))[threadIdx.x] = 0u;
    __syncthreads();
    XcdBarrier bar;
    { LOAD_PARAMS(); bar = xcd_barrier_post((unsigned*)(p.ws + WS_CTL) + CW_BAR, (volatile LAS unsigned*)(smem + LDS_XBW)); }
    ph_prologue(smem);
    __syncthreads();
    for (int i = 0; i < DEPTH; ++i) {
        const int j = i >> 1;
        if ((i & 1) == 0) {
            ph_poolfuse(smem, j, i == 0);
            xcd_barrier(bar);
            ph_poolgemm(smem, j);
        } else {
            ph_combine<false>(0);
            xcd_barrier(bar);
            ph_qkv(smem, j);
            xcd_barrier(bar);
            ph_attn(smem);
            xcd_barrier(bar);
            ph_wo(smem, j);
        }
        xcd_barrier(bar);
        ph_router(smem, i);
        xcd_barrier(bar);
        for (int st = 0; st < 3; ++st) {
            if (st == 2 && !moe_has_stage2(i)) break;
            ph_gu(smem, i, st);
            ph_down(smem, i, st);
            xcd_barrier(bar);
        }
    }
    ph_combine<true>(1);
}

extern "C" void kernel_launch(void* const* d_in, const int* in_sizes, int n_in, void* d_out, int out_size, void* d_ws, size_t ws_size, hipStream_t stream) {
    if (ws_size < WS_NEED || n_in < 18) return;
    Params p{};
    p.x_in = (const float*)d_in[0]; p.pool_norm = (const float*)d_in[1]; p.pool_w = (const float*)d_in[2]; p.pool_b = (const float*)d_in[3]; p.pool_scale = (const float*)d_in[4];
    p.sb_norm = (const float*)d_in[5]; p.sb_wqkv = (const float*)d_in[6]; p.sb_qg = (const float*)d_in[7]; p.sb_kg = (const float*)d_in[8]; p.sb_wo = (const float*)d_in[9];
    p.moe_norm = (const float*)d_in[10]; p.moe_wg = (const float*)d_in[11]; p.moe_bg = (const float*)d_in[12]; p.moe_wr = (const float*)d_in[13]; p.moe_br = (const float*)d_in[14];
    p.moe_wgate = (const float*)d_in[15]; p.moe_wup = (const float*)d_in[16]; p.moe_wdown = (const float*)d_in[17];
    p.x = (float*)d_out; p.ws = (unsigned char*)d_ws;
    static int grid = 0;
    if (!grid) {
        int dev = 0, cus = 0, per_cu = 0;
        if (hipGetDevice(&dev) != hipSuccess || hipDeviceGetAttribute(&cus, hipDeviceAttributeMultiprocessorCount, dev) != hipSuccess) { grid = -1; return; }
        if (hipFuncSetAttribute((const void*)fwd, hipFuncAttributeMaxDynamicSharedMemorySize, LDS_BYTES) != hipSuccess) { grid = -1; return; }
        if (hipOccupancyMaxActiveBlocksPerMultiprocessor(&per_cu, (const void*)fwd, NTHR, LDS_BYTES) != hipSuccess || per_cu < 1) { (void)hipGetLastError(); }
        grid = cus;
    }
    if (grid <= 0) return;
    (void)hipMemsetAsync((char*)d_ws + WS_CTL, 0, CTL_BYTES, stream);
    hipLaunchKernelGGL(fwd, dim3(grid), dim3(NTHR), LDS_BYTES, stream, p);
}
```

```cpp
#include <hip/hip_runtime.h>
#include <stdint.h>

#define DI __device__ __forceinline__
#define LAS __attribute__((address_space(3)))
typedef unsigned short bf16_t;
typedef short bf16x8 __attribute__((ext_vector_type(8)));
typedef float f32x4 __attribute__((ext_vector_type(4)));
typedef float f32x16 __attribute__((ext_vector_type(16)));
typedef unsigned u32x4 __attribute__((ext_vector_type(4)));
typedef unsigned u32x2 __attribute__((ext_vector_type(2)));

constexpr int T = 16384, DM = 1024, SEQ = 8192, NH = 16, HD = 64, DEPTH = 4, NE = 32, DE = 256;
constexpr float EPS = 1e-6f;
constexpr int NTHR = 512, NWAVE = 8;
constexpr int LIST_CAP = 16384;
constexpr int DUMMY_ROW = 2 * T;

constexpr size_t MiB = 1u << 20;
constexpr size_t WS_CTL = 0, CTL_BYTES = 1 * MiB;
constexpr size_t WS_WQKV = 1 * MiB;
constexpr size_t WS_WO = 13 * MiB;
constexpr size_t WS_WPOOL = 17 * MiB;
constexpr size_t WS_RSTD = 18 * MiB;
constexpr size_t WS_WRH = 19 * MiB, WS_WRL = WS_WRH + 512 * 1024;
constexpr size_t WS_WGU = 20 * MiB;
constexpr size_t WS_WD = 148 * MiB;
constexpr size_t WS_XB = 212 * MiB;
constexpr size_t WS_XB1 = 384 * MiB;
constexpr size_t WS_NEED = 416 * MiB;
constexpr size_t WS_LIST = 244 * MiB;
constexpr size_t WS_Q = 256 * MiB;
constexpr size_t WS_DIFF = WS_Q;
constexpr size_t WS_K = 288 * MiB, WS_V = 320 * MiB, WS_O = 352 * MiB;
constexpr size_t WS_YBUF = 288 * MiB;
constexpr size_t WS_HID = 354 * MiB;
constexpr size_t WS_END = 384 * MiB;
static_assert(WS_V - WS_K == WS_K - WS_Q, "Q, K, V equally spaced");
static_assert(WS_YBUF + (size_t)(2 * T + 1) * DM * 2 <= WS_HID, "ybuf");
static_assert(WS_HID + (size_t)(2 * T + NE * 256) * DE * 2 <= WS_END, "hid");
constexpr int CW_CNT = 1024;

struct Entry { int dst; float rstd; float w; int tok; };

struct Params {
    const float* x_in; const float* pool_norm; const float* pool_w; const float* pool_b; const float* pool_scale;
    const float* sb_norm; const float* sb_wqkv; const float* sb_qg; const float* sb_kg; const float* sb_wo;
    const float* moe_norm; const float* moe_wg; const float* moe_bg; const float* moe_wr; const float* moe_br;
    const float* moe_wgate; const float* moe_wup; const float* moe_wdown;
    float* x;
    unsigned char* ws;
};

typedef const unsigned long long __attribute__((address_space(4)))* KArgPtr;
#define GP(T, i) ((T*)(T __attribute__((address_space(1)))*)q[i])
DI Params load_params() {
    KArgPtr q = (KArgPtr)__builtin_amdgcn_kernarg_segment_ptr(); asm volatile("" : "+s"(q));
    Params p;
    p.x_in = GP(const float, 0); p.pool_norm = GP(const float, 1); p.pool_w = GP(const float, 2); p.pool_b = GP(const float, 3); p.pool_scale = GP(const float, 4);
    p.sb_norm = GP(const float, 5); p.sb_wqkv = GP(const float, 6); p.sb_qg = GP(const float, 7); p.sb_kg = GP(const float, 8); p.sb_wo = GP(const float, 9);
    p.moe_norm = GP(const float, 10); p.moe_wg = GP(const float, 11); p.moe_bg = GP(const float, 12); p.moe_wr = GP(const float, 13); p.moe_br = GP(const float, 14);
    p.moe_wgate = GP(const float, 15); p.moe_wup = GP(const float, 16); p.moe_wdown = GP(const float, 17);
    p.x = GP(float, 18); p.ws = GP(unsigned char, 19);
    return p;
}
#define LOAD_PARAMS() const Params p = load_params()
DI int tid_() { int t = threadIdx.x; asm volatile("" : "+v"(t)); return t; }
DI int bid_() { int b = blockIdx.x; asm volatile("" : "+s"(b)); return b; }
DI int xbid_() { const int b = bid_(), G = gridDim.x; return (G % 8 == 0) ? (b % 8) * (G / 8) + b / 8 : b; }

DI unsigned cvt_pk_bf16(float lo, float hi) { unsigned r; asm volatile("v_cvt_pk_bf16_f32 %0, %1, %2" : "=v"(r) : "v"(lo), "v"(hi)); return r; }
DI float bf_lo(unsigned u) { return __uint_as_float(u << 16); }
DI float bf_hi(unsigned u) { return __uint_as_float(u & 0xffff0000u); }
DI float shflx(float v, int lane, int m) { return __int_as_float(__builtin_amdgcn_ds_bpermute((lane ^ m) << 2, __float_as_int(v))); }
DI float wave_sum(float v, int lane) {
#pragma unroll
    for (int o = 32; o >= 1; o >>= 1) v += shflx(v, lane, o);
    return v;
}
DI int perm32(int rho) { const int n = rho >> 4, i = rho & 15; return 8 * (i >> 2) + 4 * n + (i & 3); }

struct CvtTile { const float* src; bf16_t* dst; const float* scale; int K, N; };
DI CvtTile cvt_locate(const Params& p, int g) {
    int K, N, sdiv = 1; const float* sb; bf16_t* db; const float* scb = nullptr; size_t sms, dms;
    if (g < 384) { K = 1024; N = 3072; sb = p.sb_wqkv; db = (bf16_t*)(p.ws + WS_WQKV); scb = p.sb_norm; sms = (size_t)1024 * 3072; dms = sms; }
    else if ((g -= 384) < 128) { K = 1024; N = 1024; sb = p.sb_wo; db = (bf16_t*)(p.ws + WS_WO); sms = (size_t)1024 * 1024; dms = sms; }
    else if ((g -= 128) < 32) { K = 256; N = 256; sb = p.pool_w; db = (bf16_t*)(p.ws + WS_WPOOL); sms = 65536; dms = 65536; }
    else if ((g -= 32) < 2048) { K = 1024; N = 256; sb = p.moe_wgate; db = (bf16_t*)(p.ws + WS_WGU); scb = p.moe_norm; sdiv = 32; sms = (size_t)1024 * 256; dms = (size_t)512 * 1024; }
    else if ((g -= 2048) < 2048) { K = 1024; N = 256; sb = p.moe_wup; db = (bf16_t*)(p.ws + WS_WGU) + (size_t)256 * 1024; scb = p.moe_norm; sdiv = 32; sms = (size_t)1024 * 256; dms = (size_t)512 * 1024; }
    else { g -= 2048; K = 256; N = 1024; sb = p.moe_wdown; db = (bf16_t*)(p.ws + WS_WD); sms = (size_t)256 * 1024; dms = sms; }
    const int tn = N / 256, per = (K / 64) * tn, mat = g / per, rem = g % per, k0 = (rem / tn) * 64, n0 = (rem % tn) * 256;
    CvtTile t; t.K = K; t.N = N;
    t.src = sb + (size_t)mat * sms + (size_t)k0 * N + n0;
    t.dst = db + (size_t)mat * dms + (size_t)n0 * K + k0;
    t.scale = scb ? scb + (size_t)(mat / sdiv) * K + k0 : nullptr;
    return t;
}
constexpr int CVT_TILES = 384 + 128 + 32 + 2048 + 2048 + 2048;
DI void ph_prologue(LAS unsigned char* ldsb) {
    LOAD_PARAMS();
    const int tid = tid_(), bid = bid_();
    LAS float* lds = (LAS float*)ldsb;
    const int n4 = tid & 63, kq = tid >> 6;
    f32x4 regs[8]; float scl[8];
    int g = bid;
    CvtTile cur{};
    if (g < CVT_TILES) {
        cur = cvt_locate(p, g);
#pragma unroll
        for (int i = 0; i < 8; ++i) { regs[i] = *(const f32x4*)(cur.src + (size_t)(kq + 8 * i) * cur.N + 4 * n4); scl[i] = cur.scale ? cur.scale[kq + 8 * i] : 1.0f; }
    }
    for (; g < CVT_TILES; g += gridDim.x) {
        __syncthreads();
#pragma unroll
        for (int i = 0; i < 8; ++i) { const int k = kq + 8 * i; *(LAS f32x4*)(lds + k * 256 + ((4 * n4) ^ (4 * ((k >> 3) & 7)))) = regs[i] * scl[i]; }
        __syncthreads();
        const CvtTile now = cur;
        if (g + (int)gridDim.x < CVT_TILES) {
            cur = cvt_locate(p, g + gridDim.x);
#pragma unroll
            for (int i = 0; i < 8; ++i) { regs[i] = *(const f32x4*)(cur.src + (size_t)(kq + 8 * i) * cur.N + 4 * n4); scl[i] = cur.scale ? cur.scale[kq + 8 * i] : 1.0f; }
        }
#pragma unroll
        for (int it = 0; it < 4; ++it) {
            const int q = tid + 512 * it, ko = q & 7, n = q >> 3;
            float v[8];
#pragma unroll
            for (int j = 0; j < 8; ++j) v[j] = lds[(8 * ko + j) * 256 + (n ^ (4 * ko))];
            u32x4 w; w[0] = cvt_pk_bf16(v[0], v[1]); w[1] = cvt_pk_bf16(v[2], v[3]); w[2] = cvt_pk_bf16(v[4], v[5]); w[3] = cvt_pk_bf16(v[6], v[7]);
            *(u32x4*)(now.dst + (size_t)n * now.K + 8 * ko) = w;
        }
    }
    bf16_t* wh = (bf16_t*)(p.ws + WS_WRH); bf16_t* wl = (bf16_t*)(p.ws + WS_WRL);
    for (int idx = bid * NTHR + tid; idx < DEPTH * 48 * DM; idx += gridDim.x * NTHR) {
        const int l = idx / (48 * DM), n = (idx / DM) % 48, k = idx % DM;
        float v = 0.f;
        if (n < 4) v = p.moe_wg[((size_t)l * DM + k) * 4 + n]; else if (n < 36) v = p.moe_wr[((size_t)l * DM + k) * 32 + (n - 4)];
        v *= p.moe_norm[l * DM + k];
        const unsigned h = cvt_pk_bf16(v, 0.f), lo = cvt_pk_bf16(v - bf_lo(h), 0.f);
        wh[idx] = (bf16_t)(h & 0xffffu); wl[idx] = (bf16_t)(lo & 0xffffu);
    }
}

DI void unpack8(const u32x4 u, float (&f)[8]) {
#pragma unroll
    for (int i = 0; i < 4; ++i) { f[2 * i] = bf_lo(u[i]); f[2 * i + 1] = bf_hi(u[i]); }
}
template <bool FINAL>
DI void ph_combine(int src_buf) {
    LOAD_PARAMS();
    const int tid = tid_(), bid = bid_(), wid = tid >> 6, lane = tid & 63;
    const bf16_t* xs = (const bf16_t*)(p.ws + (src_buf ? WS_XB1 : WS_XB));
    bf16_t* xd = (bf16_t*)(p.ws + (src_buf ? WS_XB : WS_XB1));
    const bf16_t* yb = (const bf16_t*)(p.ws + WS_YBUF);
    float* rstd = (float*)(p.ws + WS_RSTD);
    for (int t = bid * NWAVE + wid; t < T; t += gridDim.x * NWAVE) {
        float ss = 0.f;
#pragma unroll
        for (int i = 0; i < 2; ++i) {
            const size_t o = (size_t)t * DM + lane * 8 + 512 * i;
            float a[8], b[8], c[8];
            unpack8(*(const u32x4*)(xs + o), a); unpack8(*(const u32x4*)(yb + o), b); unpack8(*(const u32x4*)(yb + (size_t)T * DM + o), c);
#pragma unroll
            for (int e = 0; e < 8; ++e) a[e] += b[e] + c[e];
            if (FINAL) {
                *(f32x4*)(p.x + o) = (f32x4){a[0], a[1], a[2], a[3]}; *(f32x4*)(p.x + o + 4) = (f32x4){a[4], a[5], a[6], a[7]};
            } else {
                u32x4 w; w[0] = cvt_pk_bf16(a[0], a[1]); w[1] = cvt_pk_bf16(a[2], a[3]); w[2] = cvt_pk_bf16(a[4], a[5]); w[3] = cvt_pk_bf16(a[6], a[7]);
                *(u32x4*)(xd + o) = w;
                float r[8]; unpack8(w, r);
#pragma unroll
                for (int e = 0; e < 8; ++e) ss += r[e] * r[e];
            }
        }
        if (!FINAL) { ss = wave_sum(ss, lane); if (lane == 0) rstd[t] = rsqrtf(ss * (1.0f / DM) + EPS); }
    }
}

constexpr int PF_ROWS = 47, PF_TOK = 32;
DI void ph_poolfuse(LAS unsigned char* ldsb, int j, bool first) {
    LOAD_PARAMS();
    const int tid = tid_(), bid = bid_(), wid = tid >> 6, lane = tid & 63;
    const bf16_t* xs = (const bf16_t*)(p.ws + WS_XB1);
    bf16_t* xd = (bf16_t*)(p.ws + WS_XB);
    const bf16_t* yb = (const bf16_t*)(p.ws + WS_YBUF);
    const float* gain = p.pool_norm + j * DM;
    bf16_t* diff = (bf16_t*)(p.ws + WS_DIFF);
    LAS unsigned char* ht = ldsb;
    for (int tile = bid; tile < T / PF_TOK; tile += gridDim.x) {
        const int t0 = tile * PF_TOK, s0 = t0 & (SEQ - 1);
        for (int rr = wid; rr < PF_ROWS; rr += NWAVE) {
            const int t = t0 - 15 + rr;
            if (s0 == 0 && rr < 15) {
#pragma unroll
                for (int i = 0; i < 2; ++i) *(LAS u32x4*)(ht + rr * 2048 + (lane * 8 + 512 * i) * 2) = (u32x4){0u, 0u, 0u, 0u};
                continue;
            }
            float v[2][8]; u32x4 w[2]; float ss = 0.f;
#pragma unroll
            for (int i = 0; i < 2; ++i) {
                const size_t o = (size_t)t * DM + lane * 8 + 512 * i;
                if (first) {
                    const f32x4 a = *(const f32x4*)(p.x_in + o), b = *(const f32x4*)(p.x_in + o + 4);
#pragma unroll
                    for (int e = 0; e < 4; ++e) { v[i][e] = a[e]; v[i][4 + e] = b[e]; }
                } else {
                    float b[8], c[8];
                    unpack8(*(const u32x4*)(xs + o), v[i]); unpack8(*(const u32x4*)(yb + o), b); unpack8(*(const u32x4*)(yb + (size_t)T * DM + o), c);
#pragma unroll
                    for (int e = 0; e < 8; ++e) v[i][e] += b[e] + c[e];
                }
                w[i][0] = cvt_pk_bf16(v[i][0], v[i][1]); w[i][1] = cvt_pk_bf16(v[i][2], v[i][3]); w[i][2] = cvt_pk_bf16(v[i][4], v[i][5]); w[i][3] = cvt_pk_bf16(v[i][6], v[i][7]);
                if (rr >= 15) *(u32x4*)(xd + o) = w[i];
                unpack8(w[i], v[i]);
#pragma unroll
                for (int e = 0; e < 8; ++e) ss += v[i][e] * v[i][e];
            }
            ss = wave_sum(ss, lane);
            const float rs = rsqrtf(ss * (1.0f / DM) + EPS);
#pragma unroll
            for (int i = 0; i < 2; ++i) {
                u32x4 hw; hw[0] = cvt_pk_bf16(v[i][0] * rs, v[i][1] * rs); hw[1] = cvt_pk_bf16(v[i][2] * rs, v[i][3] * rs); hw[2] = cvt_pk_bf16(v[i][4] * rs, v[i][5] * rs); hw[3] = cvt_pk_bf16(v[i][6] * rs, v[i][7] * rs);
                *(LAS u32x4*)(ht + rr * 2048 + (lane * 8 + 512 * i) * 2) = hw;
            }
        }
        __syncthreads();
        {
            const int c = 2 * tid, win = 2 << (c >> 8);
            const float g0 = gain[c], g1 = gain[c + 1];
            float S0 = 0.f, S1 = 0.f;
            const LAS unsigned char* col = ht + c * 2;
#pragma unroll 4
            for (int rr = 0; rr < PF_ROWS; ++rr) {
                const unsigned hv = *(const LAS unsigned*)(col + rr * 2048);
                const float h0 = bf_lo(hv), h1 = bf_hi(hv);
                S0 += h0; S1 += h1;
                if (rr >= win) { const unsigned ov = *(const LAS unsigned*)(col + (rr - win) * 2048); S0 -= bf_lo(ov); S1 -= bf_hi(ov); }
                if (rr >= 15) {
                    const int s = s0 + rr - 15;
                    const float inv = 1.0f / (float)((s + 1 < win) ? s + 1 : win);
                    *(unsigned*)(diff + (size_t)(t0 + rr - 15) * DM + c) = cvt_pk_bf16((S0 * inv - h0) * g0, (S1 * inv - h1) * g1);
                }
            }
        }
        __syncthreads();
    }
}

struct Unit { const bf16_t* A; const bf16_t* B; int pm, pn, e, nvalid, row0, lbase; };
template <int LDA_, int LDB_, int K_, int BH_, bool HEADMAP_> struct GCfg { static constexpr int LDA = LDA_, LDB = LDB_, K = K_, BH = BH_; static constexpr bool HEADMAP = HEADMAP_; };

constexpr int BK = 64, HTB = 128 * BK * 2  , STAGE_BYTES = 8 * HTB;
DI int lds_byte(int r, int c) { const int st = (r >> 4) * 2 + (c >> 5), rr = r & 15, cc = c & 31, ob = rr * 64 + cc * 2; return st * 1024 + (ob ^ (((ob >> 9) & 1) << 5)); }
DI void stage_rc(int b, int& R, int& C) { const int st = b / 1024, sb = b % 1024, swz = sb ^ (((sb >> 9) & 1) << 5); R = (st >> 1) * 16 + swz / 64; C = (st & 1) * 32 + (swz % 64) / 2; }

template <class Cfg, class Sched, class Epi>
DI void gemm_phase(LAS unsigned char* lds, const Sched& S, const Epi& E) {
    const int tid = tid_(), wid = __builtin_amdgcn_readfirstlane(tid >> 6), lane = tid & 63, wr = wid >> 2, wc = wid & 3, fr = lane & 15, fq = lane >> 4;
    constexpr int nt = Cfg::K / BK;
    static_assert(Cfg::K % 128 == 0 && Cfg::K >= 256, "K");
    unsigned voffA[2][2], voffB[2];
    int R0, C0, R1, C1; stage_rc(tid * 16, R0, C0); stage_rc(tid * 16 + 8192, R1, C1);
    voffB[0] = (unsigned)(((Cfg::HEADMAP ? 64 * (R0 >> 5) : (R0 & ~31)) + perm32(R0 & 31)) * Cfg::LDB + C0) * 2u;
    voffB[1] = (unsigned)(((Cfg::HEADMAP ? 64 * (R1 >> 5) : (R1 & ~31)) + perm32(R1 & 31)) * Cfg::LDB + C1) * 2u;
    constexpr size_t kstep = (size_t)(BK * 2);
    constexpr size_t bhstep = (size_t)Cfg::BH * Cfg::LDB * 2;
    const unsigned ldsw = (unsigned)wid * 1024u;
    const int aoff = lds_byte(wr * 64 + fr, fq * 8), boff = lds_byte(wc * 32 + fr, fq * 8);
#define PG8_SA(b, h) (((b) * 2 + (h)) * HTB)
#define PG8_SB(b, h) ((4 + (b) * 2 + (h)) * HTB)
#define PG8_STAGE(bufoff, gbase, voff) do { _Pragma("unroll") for (int _i = 0; _i < 2; ++_i) \
        __builtin_amdgcn_global_load_lds((const unsigned*)((const char*)(gbase) + (voff)[_i]), (LAS unsigned*)(lds + (bufoff) + ldsw + _i * 8192), 16, 0, 0); } while (0)
#define PG8_LDA(dst, b, h) do { _Pragma("unroll") for (int m = 0; m < 4; ++m) _Pragma("unroll") for (int k = 0; k < 2; ++k) dst[m][k] = *(const LAS bf16x8*)(lds + PG8_SA(b, h) + aoff + m * 2048 + k * 1024); } while (0)
#define PG8_LDB(dst, b, h) do { _Pragma("unroll") for (int n = 0; n < 2; ++n) _Pragma("unroll") for (int k = 0; k < 2; ++k) dst[n][k] = *(const LAS bf16x8*)(lds + PG8_SB(b, h) + boff + n * 2048 + k * 1024); } while (0)
#define PG8_MMA(ai, bj, At, Bt) do { __builtin_amdgcn_s_setprio(1); _Pragma("unroll") for (int m = 0; m < 4; ++m) _Pragma("unroll") for (int n = 0; n < 2; ++n) _Pragma("unroll") for (int k = 0; k < 2; ++k) \
        acc[ai][bj][m][n] = __builtin_amdgcn_mfma_f32_16x16x32_bf16(Bt[n][k], At[m][k], acc[ai][bj][m][n], 0, 0, 0); __builtin_amdgcn_s_setprio(0); } while (0)
#define PG8_WAIT_V(n) asm volatile("s_waitcnt vmcnt(" #n ")" ::: "memory")
#define PG8_WAIT_L(n) asm volatile("s_waitcnt lgkmcnt(" #n ")" ::: "memory")
#define PG8_BAR __builtin_amdgcn_s_barrier()
#define PG8_SCHED __builtin_amdgcn_sched_barrier(0)
#define PG8_AROWS(uidx, un) do { voffA[0][0] = (unsigned)S.arow(uidx, un, R0) * (unsigned)(Cfg::LDA * 2) + (unsigned)(C0 * 2); voffA[0][1] = (unsigned)S.arow(uidx, un, R1) * (unsigned)(Cfg::LDA * 2) + (unsigned)(C1 * 2); \
        voffA[1][0] = (unsigned)S.arow(uidx, un, 128 + R0) * (unsigned)(Cfg::LDA * 2) + (unsigned)(C0 * 2); voffA[1][1] = (unsigned)S.arow(uidx, un, 128 + R1) * (unsigned)(Cfg::LDA * 2) + (unsigned)(C1 * 2); } while (0)
    Unit cur, nxt; int ui = 0;
    if (!S.next(0, cur)) return;
    f32x4 acc[2][2][4][2];
#pragma unroll
    for (int a = 0; a < 2; ++a)
#pragma unroll
        for (int b = 0; b < 2; ++b)
#pragma unroll
            for (int m = 0; m < 4; ++m)
#pragma unroll
                for (int n = 0; n < 2; ++n) acc[a][b][m][n] = (f32x4){0.f, 0.f, 0.f, 0.f};
    bf16x8 At[4][2], B0[2][2], B1[2][2];
    PG8_AROWS(0, cur);
    const char* cA = (const char*)cur.A; const char* cB = (const char*)cur.B;
    PG8_STAGE(PG8_SB(0, 0), cB, voffB); PG8_STAGE(PG8_SB(0, 1), cB + bhstep, voffB); PG8_STAGE(PG8_SA(0, 0), cA, voffA[0]); PG8_STAGE(PG8_SA(0, 1), cA, voffA[1]);
    if (wr == 1) PG8_BAR;
    PG8_WAIT_V(2); PG8_BAR;
    PG8_STAGE(PG8_SB(1, 0), cB + kstep, voffB); PG8_STAGE(PG8_SA(1, 0), cA + kstep, voffA[0]); PG8_STAGE(PG8_SB(1, 1), cB + bhstep + kstep, voffB);
    PG8_WAIT_V(6); PG8_BAR;
    for (;;) {
        const bool has_next = S.next(ui + 1, nxt);
        const char* nA = has_next ? (const char*)nxt.A : cA; const char* nB = has_next ? (const char*)nxt.B : cB;
#pragma unroll 1
        for (int t = 0; t < nt; t += 2) {
            const bool last = (t == nt - 2);
            const char* a1 = cA + (size_t)(t + 1) * kstep;
            const char* a2 = last ? nA : cA + (size_t)(t + 2) * kstep; const char* b2 = last ? nB : cB + (size_t)(t + 2) * kstep;
            const char* a3 = a2 + kstep; const char* b3 = b2 + kstep;
            PG8_LDB(B0, 0, 0); PG8_LDB(B1, 0, 1); PG8_SCHED; PG8_LDA(At, 0, 0); PG8_STAGE(PG8_SA(1, 1), a1, voffA[1]);
            if (last && has_next) PG8_AROWS(ui + 1, nxt);
            PG8_WAIT_V(8); PG8_WAIT_L(0); PG8_BAR; PG8_MMA(0, 0, At, B0); PG8_MMA(0, 1, At, B1); PG8_BAR; PG8_SCHED;
            PG8_LDA(At, 0, 1); PG8_STAGE(PG8_SB(0, 0), b2, voffB); PG8_STAGE(PG8_SB(0, 1), b2 + bhstep, voffB); PG8_STAGE(PG8_SA(0, 0), a2, voffA[0]);
            PG8_WAIT_V(8); PG8_WAIT_L(0); PG8_BAR; PG8_MMA(1, 0, At, B0); PG8_MMA(1, 1, At, B1); PG8_BAR; PG8_SCHED;
            PG8_LDB(B0, 1, 0); PG8_LDB(B1, 1, 1); PG8_SCHED; PG8_LDA(At, 1, 0); PG8_STAGE(PG8_SA(0, 1), a2, voffA[1]);
            PG8_WAIT_V(8); PG8_WAIT_L(0); PG8_BAR; PG8_MMA(0, 0, At, B0); PG8_MMA(0, 1, At, B1); PG8_BAR; PG8_SCHED;
            PG8_LDA(At, 1, 1); PG8_STAGE(PG8_SB(1, 0), b3, voffB); PG8_STAGE(PG8_SB(1, 1), b3 + bhstep, voffB); PG8_STAGE(PG8_SA(1, 0), a3, voffA[0]);
            PG8_WAIT_V(8); PG8_WAIT_L(0); PG8_BAR; PG8_MMA(1, 0, At, B0); PG8_MMA(1, 1, At, B1); PG8_BAR; PG8_SCHED;
        }
        if (wr == 0) PG8_BAR;
        E(acc, cur, wr, wc, fr, fq);
        if (!has_next) break;
#pragma unroll
        for (int a = 0; a < 2; ++a)
#pragma unroll
            for (int b = 0; b < 2; ++b)
#pragma unroll
                for (int m = 0; m < 4; ++m)
#pragma unroll
                    for (int n = 0; n < 2; ++n) acc[a][b][m][n] = (f32x4){0.f, 0.f, 0.f, 0.f};
        cur = nxt; cA = nA; cB = nB; ++ui;
        if (wr == 1) PG8_BAR;
    }
    PG8_WAIT_V(0);
    PG8_BAR;
#undef PG8_SA
#undef PG8_SB
#undef PG8_STAGE
#undef PG8_LDA
#undef PG8_LDB
#undef PG8_MMA
#undef PG8_WAIT_V
#undef PG8_WAIT_L
#undef PG8_BAR
#undef PG8_SCHED
#undef PG8_AROWS
}

struct SchedPool {
    const bf16_t* diff; const bf16_t* w; int bid;
    DI bool next(int i, Unit& u) const { const int L = i * gridDim.x + bid; if (L >= 256) return false; u.pm = L >> 2; u.pn = L & 3; u.A = diff + 256 * u.pn; u.B = w + (size_t)u.pn * 65536; return true; }
    DI int arow(int, const Unit& u, int r) const { return u.pm * 256 + r; }
};
struct SchedDense {
    const bf16_t* A; const bf16_t* B; int npn, ldb, bid;
    DI bool next(int i, Unit& u) const { const int L = i * gridDim.x + bid; if (L >= 64 * npn) return false; u.pm = L / npn; u.pn = L % npn; u.A = A; u.B = B + (size_t)u.pn * 256 * ldb; return true; }
    DI int arow(int, const Unit& u, int r) const { return u.pm * 256 + r; }
};

struct EpiPool {
    bf16_t* x; const float* pb; const float* ps;
    DI void operator()(const f32x4 (&acc)[2][2][4][2], const Unit& u, int wr, int wc, int fr, int fq) const {
#pragma unroll
        for (int ai = 0; ai < 2; ++ai)
#pragma unroll
            for (int m = 0; m < 4; ++m) {
                const int t = u.pm * 256 + 128 * ai + 64 * wr + 16 * m + fr;
#pragma unroll
                for (int bj = 0; bj < 2; ++bj) {
                    const int c = 256 * u.pn + 128 * bj + 32 * wc + 8 * fq;
                    bf16_t* xp = x + (size_t)t * DM + c;
                    float xv[8]; unpack8(*(const u32x4*)xp, xv);
                    const f32x4 v0 = (acc[ai][bj][m][0] + *(const f32x4*)(pb + c)) * *(const f32x4*)(ps + c);
                    const f32x4 v1 = (acc[ai][bj][m][1] + *(const f32x4*)(pb + c + 4)) * *(const f32x4*)(ps + c + 4);
                    u32x4 w; w[0] = cvt_pk_bf16(xv[0] + v0[0], xv[1] + v0[1]); w[1] = cvt_pk_bf16(xv[2] + v0[2], xv[3] + v0[3]); w[2] = cvt_pk_bf16(xv[4] + v1[0], xv[5] + v1[1]); w[3] = cvt_pk_bf16(xv[6] + v1[2], xv[7] + v1[3]);
                    *(u32x4*)xp = w;
                }
            }
    }
};
struct EpiWo {
    bf16_t* x;
    DI void operator()(const f32x4 (&acc)[2][2][4][2], const Unit& u, int wr, int wc, int fr, int fq) const {
#pragma unroll
        for (int ai = 0; ai < 2; ++ai)
#pragma unroll
            for (int m = 0; m < 4; ++m) {
                const int t = u.pm * 256 + 128 * ai + 64 * wr + 16 * m + fr;
#pragma unroll
                for (int bj = 0; bj < 2; ++bj) {
                    const int c = 256 * u.pn + 128 * bj + 32 * wc + 8 * fq;
                    bf16_t* xp = x + (size_t)t * DM + c;
                    float xv[8]; unpack8(*(const u32x4*)xp, xv);
                    const f32x4 v0 = acc[ai][bj][m][0], v1 = acc[ai][bj][m][1];
                    u32x4 w; w[0] = cvt_pk_bf16(xv[0] + v0[0], xv[1] + v0[1]); w[1] = cvt_pk_bf16(xv[2] + v0[2], xv[3] + v0[3]); w[2] = cvt_pk_bf16(xv[4] + v1[0], xv[5] + v1[1]); w[3] = cvt_pk_bf16(xv[6] + v1[2], xv[7] + v1[3]);
                    *(u32x4*)xp = w;
                }
            }
    }
};
struct EpiQKV {
    bf16_t* q; const float* rstd; const float* qg; const float* kg;
    DI void operator()(const f32x4 (&acc)[2][2][4][2], const Unit& u, int wr, int wc, int fr, int fq) const {
        const int which = u.pn >> 2, head = (u.pn & 3) * 4 + wc;
        bf16_t* out = q + (size_t)which * ((WS_K - WS_Q) / 2);
        const float* gn = which == 0 ? qg : kg;
        const float post = which == 0 ? 0.125f * 1.4426950408889634f : 1.0f;
        f32x4 g[2][2];
#pragma unroll
        for (int bj = 0; bj < 2; ++bj)
#pragma unroll
            for (int n = 0; n < 2; ++n) g[bj][n] = (which < 2) ? *(const f32x4*)(gn + 32 * bj + 8 * fq + 4 * n) * post : (f32x4){1.f, 1.f, 1.f, 1.f};
        float rsv[2][4];
#pragma unroll
        for (int ai = 0; ai < 2; ++ai)
#pragma unroll
            for (int m = 0; m < 4; ++m) rsv[ai][m] = rstd[u.pm * 256 + 128 * ai + 64 * wr + 16 * m + fr];
#pragma unroll
        for (int ai = 0; ai < 2; ++ai)
#pragma unroll
            for (int m = 0; m < 4; ++m) {
                const int t = u.pm * 256 + 128 * ai + 64 * wr + 16 * m + fr;
                const float rs = rsv[ai][m];
                f32x4 v4[2][2]; float ss = 0.f;
#pragma unroll
                for (int bj = 0; bj < 2; ++bj)
#pragma unroll
                    for (int n = 0; n < 2; ++n) { v4[bj][n] = acc[ai][bj][m][n] * rs; const f32x4 s = v4[bj][n] * v4[bj][n]; ss += (s[0] + s[1]) + (s[2] + s[3]); }
                ss += shflx(ss, fr + 16 * fq, 16); ss += shflx(ss, fr + 16 * fq, 32);
                const float r2 = (which < 2) ? rsqrtf(ss * (1.0f / HD) + EPS) : 1.0f;
#pragma unroll
                for (int bj = 0; bj < 2; ++bj) {
                    const f32x4 a = v4[bj][0] * r2 * g[bj][0], b = v4[bj][1] * r2 * g[bj][1];
                    u32x4 w; w[0] = cvt_pk_bf16(a[0], a[1]); w[1] = cvt_pk_bf16(a[2], a[3]); w[2] = cvt_pk_bf16(b[0], b[1]); w[3] = cvt_pk_bf16(b[2], b[3]);
                    *(u32x4*)(out + (size_t)t * DM + head * HD + 32 * bj + 8 * fq) = w;
                }
            }
    }
};

typedef short v4i16_t __attribute__((ext_vector_type(4)));
constexpr int AT_VPITCH = 192;
constexpr int AT_VTILE = 32 * AT_VPITCH;
DI void ph_attn(LAS unsigned char* ldsb) {
    LOAD_PARAMS();
    const int tid = tid_(), bid = bid_(), wid = tid >> 6, lane = tid & 63, l31 = lane & 31, h2 = lane >> 5;
    const bf16_t* Q = (const bf16_t*)(p.ws + WS_Q); const bf16_t* K = (const bf16_t*)(p.ws + WS_K); const bf16_t* V = (const bf16_t*)(p.ws + WS_V);
    bf16_t* O = (bf16_t*)(p.ws + WS_O);
    LAS unsigned char* vl = ldsb + wid * AT_VTILE;
    LAS unsigned char* vw = vl + (lane >> 3) * AT_VPITCH + (lane & 7) * 16;
    const LAS unsigned char* vr = vl + (4 * h2 + ((lane & 15) >> 2)) * AT_VPITCH + (16 * ((lane >> 4) & 1) + 4 * (lane & 3)) * 2;
    for (int it = 0; it < 4 * ((2 * NH * 256 / 32 - bid + (int)gridDim.x - 1) / (int)gridDim.x); ++it) {
        const int tsk = (bid + (it >> 2) * gridDim.x) * 32 + (it & 3) * 8 + wid;
        const int bh = tsk >> 8, qb = tsk & 255, b = bh >> 4, h = bh & 15;
        const size_t tb = (size_t)b * SEQ;
        const int q0 = qb * 32;
        bf16x8 qf[4];
#pragma unroll
        for (int s = 0; s < 4; ++s) qf[s] = *(const bf16x8*)(Q + (tb + q0 + l31) * DM + h * HD + 16 * s + 8 * h2);
        f32x16 o0, o1;
#pragma unroll
        for (int r = 0; r < 16; ++r) { o0[r] = 0.f; o1[r] = 0.f; }
        float R = 1.f;
        const bf16_t* kp = K + (tb + q0 + l31) * DM + h * HD + 8 * h2;
        const bf16_t* vp = V + (tb + q0 + (lane >> 3)) * DM + h * HD + (lane & 7) * 8;
        bf16x8 kn[4], kq[4]; u32x4 vn[4], vq[4];
#pragma unroll
        for (int s = 0; s < 4; ++s) { kn[s] = *(const bf16x8*)(kp + 16 * s); vn[s] = *(const u32x4*)(vp + (size_t)8 * s * DM); }
        if (qb > 0) {
            kp -= (size_t)32 * DM; vp -= (size_t)32 * DM;
#pragma unroll
            for (int s = 0; s < 4; ++s) { kq[s] = *(const bf16x8*)(kp + 16 * s); vq[s] = *(const u32x4*)(vp + (size_t)8 * s * DM); }
        }
        for (int kt = qb; kt >= 0; --kt) {
            bf16x8 kf[4];
#pragma unroll
            for (int s = 0; s < 4; ++s) { kf[s] = kn[s]; *(LAS u32x4*)(vw + 8 * s * AT_VPITCH) = vn[s]; kn[s] = kq[s]; vn[s] = vq[s]; }
            if (kt > 1) {
                kp -= (size_t)32 * DM; vp -= (size_t)32 * DM;
#pragma unroll
                for (int s = 0; s < 4; ++s) { kq[s] = *(const bf16x8*)(kp + 16 * s); vq[s] = *(const u32x4*)(vp + (size_t)8 * s * DM); }
            }
            f32x16 z;
#pragma unroll
            for (int r = 0; r < 16; ++r) z[r] = 0.f;
#pragma unroll
            for (int s = 0; s < 4; ++s) z = __builtin_amdgcn_mfma_f32_32x32x16_bf16(kf[s], qf[s], z, 0, 0, 0);
            float e[16], kp_[16], gs[4], ot[4];
#pragma unroll
            for (int r = 0; r < 16; ++r) e[r] = __builtin_amdgcn_exp2f(__builtin_amdgcn_fmed3f(z[r], -1.0e30f, 126.f));
            if (kt == qb) {
#pragma unroll
                for (int r = 0; r < 16; ++r) { const int kl = (r & 3) + 8 * (r >> 2) + 4 * h2; e[r] = (kl < l31) ? e[r] : 0.f; }
            }
#pragma unroll
            for (int r = 0; r < 16; ++r) kp_[r] = __builtin_amdgcn_rcpf(1.0f + e[r]);
#pragma unroll
            for (int bb = 0; bb < 4; ++bb) { gs[bb] = (kp_[4 * bb] * kp_[4 * bb + 1]) * (kp_[4 * bb + 2] * kp_[4 * bb + 3]); ot[bb] = shflx(gs[bb], lane, 32); }
            const float tot_own = (gs[0] * gs[1]) * (gs[2] * gs[3]);
            const float tot_oth = (ot[0] * ot[1]) * (ot[2] * ot[3]);
            float later[4];
            {
                float own_tail = 1.f, oth_tail = 1.f;
#pragma unroll
                for (int bb = 3; bb >= 0; --bb) {
                    later[bb] = own_tail * oth_tail * (h2 == 0 ? ot[bb] : 1.f);
                    own_tail *= gs[bb]; oth_tail *= ot[bb];
                }
            }
            float a[16];
#pragma unroll
            for (int bb = 0; bb < 4; ++bb) {
                const float base = R * later[bb];
                const float s3 = base * kp_[4 * bb + 3], s2 = s3 * kp_[4 * bb + 2], s1 = s2 * kp_[4 * bb + 1], s0 = s1 * kp_[4 * bb];
                a[4 * bb] = e[4 * bb] * s0; a[4 * bb + 1] = e[4 * bb + 1] * s1; a[4 * bb + 2] = e[4 * bb + 2] * s2; a[4 * bb + 3] = e[4 * bb + 3] * s3;
            }
            R *= (h2 == 0) ? (tot_own * tot_oth) : (tot_oth * tot_own);
#pragma unroll
            for (int s = 0; s < 2; ++s) {
                u32x4 pw;
#pragma unroll
                for (int i = 0; i < 4; ++i) pw[i] = cvt_pk_bf16(a[8 * s + 2 * i], a[8 * s + 2 * i + 1]);
                const bf16x8 pa = __builtin_bit_cast(bf16x8, pw);
#pragma unroll
                for (int db = 0; db < 2; ++db) {
                    const v4i16_t lo4 = __builtin_amdgcn_ds_read_tr16_b64_v4i16((LAS v4i16_t*)(vr + (16 * s) * AT_VPITCH + 64 * db));
                    const v4i16_t hi4 = __builtin_amdgcn_ds_read_tr16_b64_v4i16((LAS v4i16_t*)(vr + (16 * s + 8) * AT_VPITCH + 64 * db));
                    bf16x8 vf; vf[0] = lo4[0]; vf[1] = lo4[1]; vf[2] = lo4[2]; vf[3] = lo4[3]; vf[4] = hi4[0]; vf[5] = hi4[1]; vf[6] = hi4[2]; vf[7] = hi4[3];
                    if (db == 0) o0 = __builtin_amdgcn_mfma_f32_32x32x16_bf16(vf, pa, o0, 0, 0, 0);
                    else o1 = __builtin_amdgcn_mfma_f32_32x32x16_bf16(vf, pa, o1, 0, 0, 0);
                }
            }
            if (__all(R < 1.0e-36f)) break;
        }
#pragma unroll
        for (int db = 0; db < 2; ++db)
#pragma unroll
            for (int rb = 0; rb < 4; ++rb) {
                const f32x16& o = db == 0 ? o0 : o1;
                u32x2 w; w[0] = cvt_pk_bf16(o[4 * rb], o[4 * rb + 1]); w[1] = cvt_pk_bf16(o[4 * rb + 2], o[4 * rb + 3]);
                *(u32x2*)(O + (tb + q0 + l31) * DM + h * HD + 32 * db + 8 * rb + 4 * h2) = w;
            }
    }
}

constexpr int RT_PART = 0;
constexpr int RT_SSQ = RT_PART + 4 * 64 * 52 * 4;
constexpr int RT_LCNT = RT_SSQ + 4 * 64 * 4;
constexpr int RT_GB = RT_LCNT + 128;
DI void ph_router(LAS unsigned char* lds, int li) {
    LOAD_PARAMS();
    const bf16_t* xcur = (const bf16_t*)(p.ws + ((li & 1) ? WS_XB1 : WS_XB));
    const int tid = tid_(), bid = bid_(), wid = tid >> 6, lane = tid & 63, fr = lane & 15, fq = lane >> 4;
    const bf16_t* wh = (const bf16_t*)(p.ws + WS_WRH) + (size_t)li * 48 * DM;
    const bf16_t* wl = (const bf16_t*)(p.ws + WS_WRL) + (size_t)li * 48 * DM;
    const float* bg = p.moe_bg + li * 4;
    const float* br = p.moe_br + li * 32;
    unsigned* cnt = (unsigned*)(p.ws + WS_CTL) + CW_CNT + 32 * li;
    Entry* list = (Entry*)(p.ws + WS_LIST);
    LAS float* part = (LAS float*)(lds + RT_PART); LAS float* ssq = (LAS float*)(lds + RT_SSQ);
    LAS int* lcnt = (LAS int*)(lds + RT_LCNT); LAS int* gb = (LAS int*)(lds + RT_GB);
    const int th = wid & 1, kq = wid >> 1;
    for (int chunk = bid; chunk < T / 64; chunk += gridDim.x) {
        const int t = chunk * 64 + th * 32 + fr;
        const bf16_t* xr = xcur + (size_t)t * DM + kq * 256 + fq * 8;
        const bf16_t* whr = wh + (size_t)fr * DM + kq * 256 + fq * 8;
        const bf16_t* wlr = wl + (size_t)fr * DM + kq * 256 + fq * 8;
        f32x4 acc[2][3]; float ss[2] = {0.f, 0.f};
#pragma unroll
        for (int b = 0; b < 2; ++b)
#pragma unroll
            for (int nb = 0; nb < 3; ++nb) acc[b][nb] = (f32x4){0.f, 0.f, 0.f, 0.f};
#pragma unroll 4
        for (int ks = 0; ks < 8; ++ks) {
            bf16x8 xh[2];
#pragma unroll
            for (int b = 0; b < 2; ++b) {
                const u32x4 xw = *(const u32x4*)(xr + (size_t)b * 16 * DM + ks * 32);
                float xf[8]; unpack8(xw, xf);
#pragma unroll
                for (int e = 0; e < 8; ++e) ss[b] += xf[e] * xf[e];
                xh[b] = __builtin_bit_cast(bf16x8, xw);
            }
#pragma unroll
            for (int nb = 0; nb < 3; ++nb) {
                const bf16x8 wH = *(const bf16x8*)(whr + (size_t)nb * 16 * DM + ks * 32), wL = *(const bf16x8*)(wlr + (size_t)nb * 16 * DM + ks * 32);
#pragma unroll
                for (int b = 0; b < 2; ++b) {
                    acc[b][nb] = __builtin_amdgcn_mfma_f32_16x16x32_bf16(wH, xh[b], acc[b][nb], 0, 0, 0);
                    acc[b][nb] = __builtin_amdgcn_mfma_f32_16x16x32_bf16(wL, xh[b], acc[b][nb], 0, 0, 0);
                }
            }
        }
#pragma unroll
        for (int b = 0; b < 2; ++b) {
            float sv = ss[b]; sv += shflx(sv, lane, 16); sv += shflx(sv, lane, 32);
            const int tl = th * 32 + 16 * b + fr;
#pragma unroll
            for (int nb = 0; nb < 3; ++nb) *(LAS f32x4*)(part + (kq * 64 + tl) * 52 + 16 * nb + 4 * fq) = acc[b][nb];
            if (fq == 0) ssq[kq * 64 + tl] = sv;
        }
        if (tid < 32) lcnt[tid] = 0;
        __syncthreads();
        int ea = 0, eb = 0, la = 0, lb = 0; float w1 = 0.f, w2 = 0.f, rs = 0.f;
        if (tid < 64) {
            rs = rsqrtf(((ssq[tid] + ssq[64 + tid]) + (ssq[128 + tid] + ssq[192 + tid])) * (1.0f / DM) + EPS);
            float lg[36];
#pragma unroll
            for (int q = 0; q < 9; ++q) {
                const f32x4 u0 = *(const LAS f32x4*)(part + tid * 52 + 4 * q), u1 = *(const LAS f32x4*)(part + (64 + tid) * 52 + 4 * q);
                const f32x4 u2 = *(const LAS f32x4*)(part + (128 + tid) * 52 + 4 * q), u3 = *(const LAS f32x4*)(part + (192 + tid) * 52 + 4 * q);
#pragma unroll
                for (int e = 0; e < 4; ++e) lg[4 * q + e] = ((u0[e] + u1[e]) + (u2[e] + u3[e])) * rs;
            }
            float gl[4];
#pragma unroll
            for (int n = 0; n < 4; ++n) gl[n] = lg[n] + bg[n];
            int g = 0; float gm = gl[0];
#pragma unroll
            for (int n = 1; n < 4; ++n) if (gl[n] > gm) { gm = gl[n]; g = n; }
            float den = 0.f;
#pragma unroll
            for (int n = 0; n < 4; ++n) den += __expf(gl[n] - gm);
            const float gprob = 1.0f / den;
            float el[8];
#pragma unroll
            for (int n = 0; n < 8; ++n) {
                float v = 0.f;
#pragma unroll
                for (int gg = 0; gg < 4; ++gg) v = (g == gg) ? lg[4 + 8 * gg + n] + br[8 * gg + n] : v;
                el[n] = v;
            }
            int e1 = 0; float m1 = el[0];
#pragma unroll
            for (int n = 1; n < 8; ++n) if (el[n] > m1) { m1 = el[n]; e1 = n; }
            int e2 = -1; float m2 = -3.0e38f;
#pragma unroll
            for (int n = 0; n < 8; ++n) if (n != e1 && (e2 < 0 || el[n] > m2)) { m2 = el[n]; e2 = n; }
            const float ex = __expf(m2 - m1);
            w1 = gprob / (1.0f + ex); w2 = gprob * ex / (1.0f + ex);
            ea = 8 * g + e1; eb = 8 * g + e2;
            la = __hip_atomic_fetch_add(lcnt + ea, 1, __ATOMIC_RELAXED, __HIP_MEMORY_SCOPE_WORKGROUP);
            lb = __hip_atomic_fetch_add(lcnt + eb, 1, __ATOMIC_RELAXED, __HIP_MEMORY_SCOPE_WORKGROUP);
        }
        __syncthreads();
        if (tid < 32) { const int c = lcnt[tid]; gb[tid] = c ? (int)atomicAdd(&cnt[tid], (unsigned)c) : 0; }
        __syncthreads();
        if (tid < 64) {
            const int tt = chunk * 64 + tid;
            Entry A; A.dst = tt; A.rstd = rs; A.w = w1; A.tok = tt;
            Entry B; B.dst = T + tt; B.rstd = rs; B.w = w2; B.tok = tt;
            list[(size_t)ea * LIST_CAP + gb[ea] + la] = A;
            list[(size_t)eb * LIST_CAP + gb[eb] + lb] = B;
        }
        __syncthreads();
    }
}

constexpr int MOE_MAXU = 4;
constexpr int LDS_ROWTAB = STAGE_BYTES;
constexpr int LDS_EPITAB = LDS_ROWTAB + MOE_MAXU * 1024;
constexpr int LDS_UTAB = LDS_EPITAB + MOE_MAXU * 2048;
constexpr int LDS_XBW = LDS_UTAB + MOE_MAXU * 32;
constexpr int LDS_BYTES = 147456;
static_assert(LDS_XBW + 16 <= LDS_BYTES, "LDS map");
struct SchedMoe {
    LAS unsigned char* lds; const bf16_t* A; const bf16_t* W; bool gather; size_t w_estride; int w_pnrows, ldb;
    DI void build(const unsigned* cnt, const Entry* list, int npn, int lo, int hi, int first, int stride, int tid) {
        LAS int* ut = (LAS int*)(lds + LDS_UTAB); LAS unsigned* rt = (LAS unsigned*)(lds + LDS_ROWTAB);
        for (int i = 0; i < MOE_MAXU; ++i) {
            const int L = lo + first + i * stride;
            int found = 0, e = 0, j = 0, nv = 0, rtile = 0, pn = 0;
            if (first >= 0 && L < hi) {
                rtile = L / npn; pn = L % npn;
                int acc = 0;
                for (int ee = 0; ee < NE; ++ee) {
                    const int c = (int)cnt[ee], ntl = (c + 255) >> 8;
                    if (!found && rtile < acc + ntl) { found = 1; e = ee; j = rtile - acc; nv = c - 256 * j; }
                    acc += ntl;
                }
            }
            nv = nv > 256 ? 256 : nv;
            if (tid == 0) { ut[i * 8 + 0] = found; ut[i * 8 + 1] = e; ut[i * 8 + 2] = nv; ut[i * 8 + 3] = 256 * rtile; ut[i * 8 + 4] = e * LIST_CAP + 256 * j; ut[i * 8 + 5] = pn; }
            if (found && tid < 256) {
                Entry en; en.dst = DUMMY_ROW; en.rstd = 0.f; en.w = 0.f; en.tok = 0;
                if (tid < nv) en = list[e * LIST_CAP + 256 * j + tid];
                LAS float* et = (LAS float*)(lds + LDS_EPITAB) + (i * 256 + tid) * 2;
                if (gather) { rt[i * 256 + tid] = (unsigned)en.tok; et[0] = en.rstd; et[1] = en.w; }
                else { et[0] = __int_as_float(en.dst); et[1] = 0.f; }
            }
            if (tid == 0) ut[i * 8 + 6] = i;
        }
        asm volatile("s_waitcnt vmcnt(0) lgkmcnt(0)" ::: "memory");
        __syncthreads();
    }
    DI bool next(int i, Unit& u) const {
        if (i >= MOE_MAXU) return false;
        const LAS int* ut = (const LAS int*)(lds + LDS_UTAB) + i * 8;
        const int found = __builtin_amdgcn_readfirstlane(ut[0]);
        if (!found) return false;
        u.e = __builtin_amdgcn_readfirstlane(ut[1]); u.nvalid = __builtin_amdgcn_readfirstlane(ut[2]); u.row0 = __builtin_amdgcn_readfirstlane(ut[3]);
        u.lbase = i * 256; u.pn = __builtin_amdgcn_readfirstlane(ut[5]); u.pm = u.row0 >> 8;
        u.A = gather ? A : A + (size_t)u.row0 * DE;
        u.B = W + (size_t)u.e * w_estride + (size_t)u.pn * w_pnrows * ldb;
        return true;
    }
    DI int arow(int ui, const Unit&, int r) const { if (!gather) return r; return (int)((const LAS unsigned*)(lds + LDS_ROWTAB))[ui * 256 + r]; }
};
struct EpiGU {
    bf16_t* hid; LAS unsigned char* lds;
    DI void operator()(const f32x4 (&acc)[2][2][4][2], const Unit& u, int wr, int wc, int fr, int fq) const {
        typedef float f32x2 __attribute__((ext_vector_type(2)));
#pragma unroll
        for (int ai = 0; ai < 2; ++ai)
#pragma unroll
            for (int m = 0; m < 4; ++m) {
                const int r = 128 * ai + 64 * wr + 16 * m + fr;
                const f32x2 rw = *(const LAS f32x2*)(lds + LDS_EPITAB + (u.lbase + r) * 8);
                const float rs = rw[0], w = rw[1];
                unsigned pk[4];
#pragma unroll
                for (int n = 0; n < 2; ++n) {
                    float hv[4];
#pragma unroll
                    for (int e = 0; e < 4; ++e) { const float g = acc[ai][0][m][n][e] * rs, up = acc[ai][1][m][n][e] * rs; hv[e] = g * __builtin_amdgcn_rcpf(1.0f + __builtin_amdgcn_exp2f(-1.4426950408889634f * g)) * up * w; }
                    pk[2 * n] = cvt_pk_bf16(hv[0], hv[1]); pk[2 * n + 1] = cvt_pk_bf16(hv[2], hv[3]);
                }
                u32x4 wv; wv[0] = pk[0]; wv[1] = pk[1]; wv[2] = pk[2]; wv[3] = pk[3];
                *(u32x4*)(hid + (size_t)(u.row0 + r) * DE + 128 * u.pn + 32 * wc + 8 * fq) = wv;
            }
    }
};
struct EpiDown {
    bf16_t* yb; LAS unsigned char* lds;
    DI void operator()(const f32x4 (&acc)[2][2][4][2], const Unit& u, int wr, int wc, int fr, int fq) const {
#pragma unroll
        for (int ai = 0; ai < 2; ++ai)
#pragma unroll
            for (int m = 0; m < 4; ++m) {
                const int r = 128 * ai + 64 * wr + 16 * m + fr;
                const int dst = *(const LAS int*)(lds + LDS_EPITAB + (u.lbase + r) * 8);
#pragma unroll
                for (int bj = 0; bj < 2; ++bj) {
                    const f32x4 a = acc[ai][bj][m][0], b = acc[ai][bj][m][1];
                    u32x4 w; w[0] = cvt_pk_bf16(a[0], a[1]); w[1] = cvt_pk_bf16(a[2], a[3]); w[2] = cvt_pk_bf16(b[0], b[1]); w[3] = cvt_pk_bf16(b[2], b[3]);
                    *(u32x4*)(yb + (size_t)dst * DM + 256 * u.pn + 128 * bj + 32 * wc + 8 * fq) = w;
                }
            }
    }
};

DI void ph_poolgemm(LAS unsigned char* lds, int j) {
    LOAD_PARAMS();
    SchedPool S; S.bid = xbid_(); S.diff = (const bf16_t*)(p.ws + WS_DIFF); S.w = (const bf16_t*)(p.ws + WS_WPOOL) + (size_t)j * 4 * 65536;
    EpiPool E; E.x = (bf16_t*)(p.ws + WS_XB); E.pb = p.pool_b + j * DM; E.ps = p.pool_scale + j * DM;
    gemm_phase<GCfg<1024, 256, 256, 128, false>>(lds, S, E);
}
DI void ph_qkv(LAS unsigned char* lds, int j) {
    LOAD_PARAMS();
    SchedDense S; S.bid = xbid_(); S.A = (const bf16_t*)(p.ws + WS_XB1); S.B = (const bf16_t*)(p.ws + WS_WQKV) + (size_t)j * 3072 * 1024; S.npn = 12; S.ldb = 1024;
    EpiQKV E; E.q = (bf16_t*)(p.ws + WS_Q); E.rstd = (const float*)(p.ws + WS_RSTD); E.qg = p.sb_qg + j * HD; E.kg = p.sb_kg + j * HD;
    gemm_phase<GCfg<1024, 1024, 1024, 32, true>>(lds, S, E);
}
DI void ph_wo(LAS unsigned char* lds, int j) {
    LOAD_PARAMS();
    SchedDense S; S.bid = xbid_(); S.A = (const bf16_t*)(p.ws + WS_O); S.B = (const bf16_t*)(p.ws + WS_WO) + (size_t)j * 1024 * 1024; S.npn = 4; S.ldb = 1024;
    EpiWo E; E.x = (bf16_t*)(p.ws + WS_XB1);
    gemm_phase<GCfg<1024, 1024, 1024, 128, false>>(lds, S, E);
}
struct MoePlan { int NT, R1, nB, D1; };
DI MoePlan moe_plan(const unsigned* cnt) {
    int nt = 0;
    for (int e = 0; e < NE; ++e) nt += ((int)cnt[e] + 255) >> 8;
    MoePlan m; m.NT = nt; const int G = gridDim.x; m.R1 = nt < G / 2 ? nt : G / 2;
    const int late = 2 * (nt - m.R1); m.nB = late < G ? late : G;
    const int cap = 2 * (G - m.nB); m.D1 = 4 * m.R1 < cap ? 4 * m.R1 : cap;
    return m;
}
DI void ph_gu(LAS unsigned char* lds, int li, int stage) {
    LOAD_PARAMS();
    const Entry* list = (const Entry*)(p.ws + WS_LIST);
    const unsigned* cnt = (const unsigned*)(p.ws + WS_CTL) + CW_CNT + 32 * li;
    const MoePlan m = moe_plan(cnt);
    const int bid = xbid_();
    if (stage == 2 || (stage == 1 && bid >= m.nB)) return;
    SchedMoe S; S.lds = lds; S.A = (const bf16_t*)(p.ws + ((li & 1) ? WS_XB1 : WS_XB));
    S.W = (const bf16_t*)(p.ws + WS_WGU) + (size_t)li * NE * 512 * 1024; S.gather = true; S.w_estride = (size_t)512 * 1024; S.w_pnrows = 128; S.ldb = 1024;
    if (stage == 0) S.build(cnt, list, 2, 0, 2 * m.R1, bid, gridDim.x, tid_());
    else S.build(cnt, list, 2, 2 * m.R1, 2 * m.NT, bid, gridDim.x, tid_());
    EpiGU E; E.hid = (bf16_t*)(p.ws + WS_HID); E.lds = lds;
    gemm_phase<GCfg<1024, 1024, 1024, 256, false>>(lds, S, E);
}
DI void ph_down(LAS unsigned char* lds, int li, int stage) {
    LOAD_PARAMS();
    const Entry* list = (const Entry*)(p.ws + WS_LIST);
    const unsigned* cnt = (const unsigned*)(p.ws + WS_CTL) + CW_CNT + 32 * li;
    const MoePlan m = moe_plan(cnt);
    const int bid = xbid_(), G = gridDim.x;
    if (stage == 0 || (stage == 1 && bid < m.nB)) return;
    SchedMoe S; S.lds = lds; S.A = (const bf16_t*)(p.ws + WS_HID);
    S.W = (const bf16_t*)(p.ws + WS_WD) + (size_t)li * NE * 1024 * 256; S.gather = false; S.w_estride = (size_t)1024 * 256; S.w_pnrows = 256; S.ldb = 256;
    if (stage == 1) S.build(cnt, list, 4, 0, m.D1, bid - m.nB, G - m.nB, tid_());
    else S.build(cnt, list, 4, m.D1, 4 * m.NT, bid, G, tid_());
    EpiDown E; E.yb = (bf16_t*)(p.ws + WS_YBUF); E.lds = lds;
    gemm_phase<GCfg<256, 256, 256, 128, false>>(lds, S, E);
}
DI bool moe_has_stage2(int li) {
    LOAD_PARAMS();
    const MoePlan m = moe_plan((const unsigned*)(p.ws + WS_CTL) + CW_CNT + 32 * li);
    return 4 * m.NT > m.D1;
}

#define XB_TMO      128
#define XB_XCNT(j)  (256  + 64 * (j))
#define XB_XSUB(j)  (1280 + 64 * (j))
#define XB_XGEN(j)  (2304 + 64 * (j))
#define XB_TOP      3328
#define XB_TOPGEN   3392
#define XCD_BAR_WORDS 3456
#define XB_SPIN_CAP (1u << 18)

__device__ __forceinline__ unsigned xb_ld(unsigned* p)              { return __hip_atomic_load(p, __ATOMIC_RELAXED, __HIP_MEMORY_SCOPE_AGENT); }
__device__ __forceinline__ unsigned xb_add(unsigned* p, unsigned v) { return __hip_atomic_fetch_add(p, v, __ATOMIC_RELAXED, __HIP_MEMORY_SCOPE_AGENT); }
__device__ __forceinline__ unsigned xb_xcc_id() { return (unsigned)__builtin_amdgcn_s_getreg((3 << 11) | 20) & 0xFu; }
#define XB_SPIN(cond, bar) do { unsigned _sp = 0; while (cond) { __builtin_amdgcn_s_sleep(1); \
    if ((++_sp & 255u) == 0u) { if (xb_ld(&(bar)[XB_TMO])) break; if (_sp > XB_SPIN_CAP) { atomicAdd(&(bar)[XB_TMO], 1u); break; } } } } while (0)

struct XcdBarrier {
    unsigned* bar; unsigned x;
    volatile LAS unsigned* st;
};

__device__ __forceinline__ XcdBarrier xcd_barrier_post(unsigned* bar, volatile LAS unsigned* st) {
    XcdBarrier b; b.bar = bar; b.x = xb_xcc_id(); b.st = st;
    if (threadIdx.x == 0) (void)xb_add(&bar[XB_XCNT(b.x)], 1u);
    return b;
}
__device__ __forceinline__ void xcd_barrier_complete(unsigned* bar, unsigned x, unsigned& nloc, unsigned& nx) {
    const unsigned G = gridDim.x * gridDim.y * gridDim.z;
    unsigned sum, cnt, mine, sp = 0u;
    for (;;) {
        sum = 0u; cnt = 0u; mine = 0u;
#pragma unroll
        for (unsigned j = 0; j < 16; ++j) { const unsigned c = xb_ld(&bar[XB_XCNT(j)]); sum += c; cnt += (c > 0u) ? 1u : 0u; mine = (j == x) ? c : mine; }
        if (sum == G) break;
        __builtin_amdgcn_s_sleep(1);
        if ((++sp & 255u) == 0u) { if (xb_ld(&bar[XB_TMO])) break; if (sp > XB_SPIN_CAP) { atomicAdd(&bar[XB_TMO], 1u); break; } }
    }
    nloc = mine > 0u ? mine : 1u; nx = cnt > 0u ? cnt : 1u;
}

__device__ __forceinline__ void xcd_barrier(const XcdBarrier& b) {
    asm volatile("s_waitcnt vmcnt(0)" ::: "memory");
    __syncthreads();
    if (threadIdx.x == 0) {
        unsigned* bar = b.bar; unsigned bx = b.x;
        asm volatile("" : "+s"(bar), "+s"(bx));
        __builtin_amdgcn_s_waitcnt(0);
        unsigned nloc = b.st[0], nx = b.st[1];
        if (nloc == 0u) { xcd_barrier_complete(bar, bx, nloc, nx); b.st[0] = nloc; b.st[1] = nx; }
        const unsigned old = xb_add(&bar[XB_XSUB(bx)], 1u);
        const unsigned gen = old / nloc;
        if (old + 1u == (gen + 1u) * nloc) {
            __builtin_amdgcn_fence(__ATOMIC_RELEASE, "agent");
            asm volatile("s_waitcnt vmcnt(0)" ::: "memory");
            const unsigned og = xb_add(&bar[XB_TOP], 1u);
            const unsigned tg = og / nx;
            if (og + 1u == (tg + 1u) * nx) xb_add(&bar[XB_TOPGEN], 1u);
            else XB_SPIN(xb_ld(&bar[XB_TOPGEN]) == tg, bar);
            __builtin_amdgcn_fence(__ATOMIC_ACQUIRE, "agent");
            xb_add(&bar[XB_XGEN(bx)], 1u);
            asm volatile("s_waitcnt vmcnt(0)" ::: "memory");
        } else {
            XB_SPIN(xb_ld(&bar[XB_XGEN(bx)]) == gen, bar);
            __builtin_amdgcn_fence(__ATOMIC_ACQUIRE, "agent");
            asm volatile("s_waitcnt vmcnt(0)" ::: "memory");
        }
    }
    __syncthreads();
}
constexpr int CW_BAR = 4096;

extern __shared__ __attribute__((aligned(16))) unsigned char smem_raw[];
__global__ void __launch_bounds__(NTHR, 2) fwd(Params pk) {
    LAS unsigned char* smem = (LAS unsigned char*)smem_raw;
    if (threadIdx.x < 4) ((LAS unsigned*)(smem + LDS_XBW))[threadIdx.x] = 0u;
    __syncthreads();
    XcdBarrier bar;
    { LOAD_PARAMS(); bar = xcd_barrier_post((unsigned*)(p.ws + WS_CTL) + CW_BAR, (volatile LAS unsigned*)(smem + LDS_XBW)); }
    ph_prologue(smem);
    __syncthreads();
    for (int i = 0; i < DEPTH; ++i) {
        const int j = i >> 1;
        if ((i & 1) == 0) {
            ph_poolfuse(smem, j, i == 0);
            xcd_barrier(bar);
            ph_poolgemm(smem, j);
        } else {
            ph_combine<false>(0);
            xcd_barrier(bar);
            ph_qkv(smem, j);
            xcd_barrier(bar);
            ph_attn(smem);
            xcd_barrier(bar);
            ph_wo(smem, j);
        }
        xcd_barrier(bar);
        ph_router(smem, i);
        xcd_barrier(bar);
        for (int st = 0; st < 3; ++st) {
            if (st == 2 && !moe_has_stage2(i)) break;
            ph_gu(smem, i, st);
            ph_down(smem, i, st);
            xcd_barrier(bar);
        }
    }
    ph_combine<true>(1);
}

extern "C" void kernel_launch(void* const* d_in, const int* in_sizes, int n_in, void* d_out, int out_size, void* d_ws, size_t ws_size, hipStream_t stream) {
    if (ws_size < WS_NEED || n_in < 18) return;
    Params p{};
    p.x_in = (const float*)d_in[0]; p.pool_norm = (const float*)d_in[1]; p.pool_w = (const float*)d_in[2]; p.pool_b = (const float*)d_in[3]; p.pool_scale = (const float*)d_in[4];
    p.sb_norm = (const float*)d_in[5]; p.sb_wqkv = (const float*)d_in[6]; p.sb_qg = (const float*)d_in[7]; p.sb_kg = (const float*)d_in[8]; p.sb_wo = (const float*)d_in[9];
    p.moe_norm = (const float*)d_in[10]; p.moe_wg = (const float*)d_in[11]; p.moe_bg = (const float*)d_in[12]; p.moe_wr = (const float*)d_in[13]; p.moe_br = (const float*)d_in[14];
    p.moe_wgate = (const float*)d_in[15]; p.moe_wup = (const float*)d_in[16]; p.moe_wdown = (const float*)d_in[17];
    p.x = (float*)d_out; p.ws = (unsigned char*)d_ws;
    static int grid = 0;
    if (!grid) {
        int dev = 0, cus = 0, per_cu = 0;
        if (hipGetDevice(&dev) != hipSuccess || hipDeviceGetAttribute(&cus, hipDeviceAttributeMultiprocessorCount, dev) != hipSuccess) { grid = -1; return; }
        if (hipFuncSetAttribute((const void*)fwd, hipFuncAttributeMaxDynamicSharedMemorySize, LDS_BYTES) != hipSuccess) { grid = -1; return; }
        if (hipOccupancyMaxActiveBlocksPerMultiprocessor(&per_cu, (const void*)fwd, NTHR, LDS_BYTES) != hipSuccess || per_cu < 1) { (void)hipGetLastError(); }
        grid = cus;
    }
    if (grid <= 0) return;
    (void)hipMemsetAsync((char*)d_ws + WS_CTL, 0, CTL_BYTES, stream);
    hipLaunchKernelGGL(fwd, dim3(grid), dim3(NTHR), LDS_BYTES, stream, p);
}
```

```cpp
#include <hip/hip_runtime.h>
#include <stdint.h>

#define DI __device__ __forceinline__
#define LAS __attribute__((address_space(3)))
typedef unsigned short bf16_t;
typedef short bf16x8 __attribute__((ext_vector_type(8)));
typedef float f32x4 __attribute__((ext_vector_type(4)));
typedef float f32x16 __attribute__((ext_vector_type(16)));
typedef unsigned u32x4 __attribute__((ext_vector_type(4)));
typedef unsigned u32x2 __attribute__((ext_vector_type(2)));

constexpr int T = 16384, DM = 1024, SEQ = 8192, NH = 16, HD = 64, DEPTH = 4, NE = 32, DE = 256;
constexpr float EPS = 1e-6f;
constexpr int NTHR = 512, NWAVE = 8;
constexpr int LIST_CAP = 16384;
constexpr int DUMMY_ROW = 2 * T;

constexpr size_t MiB = 1u << 20;
constexpr size_t WS_CTL = 0, CTL_BYTES = 1 * MiB;
constexpr size_t WS_WQKV = 1 * MiB;
constexpr size_t WS_WO = 13 * MiB;
constexpr size_t WS_WPOOL = 17 * MiB;
constexpr size_t WS_RSTD = 18 * MiB;
constexpr size_t WS_WRH = 19 * MiB, WS_WRL = WS_WRH + 512 * 1024;
constexpr size_t WS_WGU = 20 * MiB;
constexpr size_t WS_WD = 148 * MiB;
constexpr size_t WS_XB = 212 * MiB;
constexpr size_t WS_XB1 = 384 * MiB;
constexpr size_t WS_NEED = 416 * MiB;
constexpr size_t WS_LIST = 244 * MiB;
constexpr size_t WS_Q = 256 * MiB;
constexpr size_t WS_DIFF = WS_Q;
constexpr size_t WS_K = 288 * MiB, WS_V = 320 * MiB, WS_O = 352 * MiB;
constexpr size_t WS_YBUF = 288 * MiB;
constexpr size_t WS_HID = 354 * MiB;
constexpr size_t WS_END = 384 * MiB;
static_assert(WS_V - WS_K == WS_K - WS_Q, "Q, K, V equally spaced");
static_assert(WS_YBUF + (size_t)(2 * T + 1) * DM * 2 <= WS_HID, "ybuf");
static_assert(WS_HID + (size_t)(2 * T + NE * 256) * DE * 2 <= WS_END, "hid");
constexpr int CW_CNT = 1024;

struct Entry { int dst; float rstd; float w; int tok; };

struct Params {
    const float* x_in; const float* pool_norm; const float* pool_w; const float* pool_b; const float* pool_scale;
    const float* sb_norm; const float* sb_wqkv; const float* sb_qg; const float* sb_kg; const float* sb_wo;
    const float* moe_norm; const float* moe_wg; const float* moe_bg; const float* moe_wr; const float* moe_br;
    const float* moe_wgate; const float* moe_wup; const float* moe_wdown;
    float* x;
    unsigned char* ws;
};

typedef const unsigned long long __attribute__((address_space(4)))* KArgPtr;
#define GP(T, i) ((T*)(T __attribute__((address_space(1)))*)q[i])
DI Params load_params() {
    KArgPtr q = (KArgPtr)__builtin_amdgcn_kernarg_segment_ptr(); asm volatile("" : "+s"(q));
    Params p;
    p.x_in = GP(const float, 0); p.pool_norm = GP(const float, 1); p.pool_w = GP(const float, 2); p.pool_b = GP(const float, 3); p.pool_scale = GP(const float, 4);
    p.sb_norm = GP(const float, 5); p.sb_wqkv = GP(const float, 6); p.sb_qg = GP(const float, 7); p.sb_kg = GP(const float, 8); p.sb_wo = GP(const float, 9);
    p.moe_norm = GP(const float, 10); p.moe_wg = GP(const float, 11); p.moe_bg = GP(const float, 12); p.moe_wr = GP(const float, 13); p.moe_br = GP(const float, 14);
    p.moe_wgate = GP(const float, 15); p.moe_wup = GP(const float, 16); p.moe_wdown = GP(const float, 17);
    p.x = GP(float, 18); p.ws = GP(unsigned char, 19);
    return p;
}
#define LOAD_PARAMS() const Params p = load_params()
DI int tid_() { int t = threadIdx.x; asm volatile("" : "+v"(t)); return t; }
DI int bid_() { int b = blockIdx.x; asm volatile("" : "+s"(b)); return b; }
DI int xbid_() { const int b = bid_(), G = gridDim.x; return (G % 8 == 0) ? (b % 8) * (G / 8) + b / 8 : b; }

DI unsigned cvt_pk_bf16(float lo, float hi) { unsigned r; asm volatile("v_cvt_pk_bf16_f32 %0, %1, %2" : "=v"(r) : "v"(lo), "v"(hi)); return r; }
DI float bf_lo(unsigned u) { return __uint_as_float(u << 16); }
DI float bf_hi(unsigned u) { return __uint_as_float(u & 0xffff0000u); }
DI float shflx(float v, int lane, int m) { return __int_as_float(__builtin_amdgcn_ds_bpermute((lane ^ m) << 2, __float_as_int(v))); }
DI float wave_sum(float v, int lane) {
#pragma unroll
    for (int o = 32; o >= 1; o >>= 1) v += shflx(v, lane, o);
    return v;
}
DI int perm32(int rho) { const int n = rho >> 4, i = rho & 15; return 8 * (i >> 2) + 4 * n + (i & 3); }

struct CvtTile { const float* src; bf16_t* dst; const float* scale; int K, N; };
DI CvtTile cvt_locate(const Params& p, int g) {
    int K, N, sdiv = 1; const float* sb; bf16_t* db; const float* scb = nullptr; size_t sms, dms;
    if (g < 384) { K = 1024; N = 3072; sb = p.sb_wqkv; db = (bf16_t*)(p.ws + WS_WQKV); scb = p.sb_norm; sms = (size_t)1024 * 3072; dms = sms; }
    else if ((g -= 384) < 128) { K = 1024; N = 1024; sb = p.sb_wo; db = (bf16_t*)(p.ws + WS_WO); sms = (size_t)1024 * 1024; dms = sms; }
    else if ((g -= 128) < 32) { K = 256; N = 256; sb = p.pool_w; db = (bf16_t*)(p.ws + WS_WPOOL); sms = 65536; dms = 65536; }
    else if ((g -= 32) < 2048) { K = 1024; N = 256; sb = p.moe_wgate; db = (bf16_t*)(p.ws + WS_WGU); scb = p.moe_norm; sdiv = 32; sms = (size_t)1024 * 256; dms = (size_t)512 * 1024; }
    else if ((g -= 2048) < 2048) { K = 1024; N = 256; sb = p.moe_wup; db = (bf16_t*)(p.ws + WS_WGU) + (size_t)256 * 1024; scb = p.moe_norm; sdiv = 32; sms = (size_t)1024 * 256; dms = (size_t)512 * 1024; }
    else { g -= 2048; K = 256; N = 1024; sb = p.moe_wdown; db = (bf16_t*)(p.ws + WS_WD); sms = (size_t)256 * 1024; dms = sms; }
    const int tn = N / 256, per = (K / 64) * tn, mat = g / per, rem = g % per, k0 = (rem / tn) * 64, n0 = (rem % tn) * 256;
    CvtTile t; t.K = K; t.N = N;
    t.src = sb + (size_t)mat * sms + (size_t)k0 * N + n0;
    t.dst = db + (size_t)mat * dms + (size_t)n0 * K + k0;
    t.scale = scb ? scb + (size_t)(mat / sdiv) * K + k0 : nullptr;
    return t;
}
constexpr int CVT_TILES = 384 + 128 + 32 + 2048 + 2048 + 2048;
DI void ph_prologue(LAS unsigned char* ldsb) {
    LOAD_PARAMS();
    const int tid = tid_(), bid = bid_();
    LAS float* lds = (LAS float*)ldsb;
    const int n4 = tid & 63, kq = tid >> 6;
    f32x4 regs[8]; float scl[8];
    int g = bid;
    CvtTile cur{};
    if (g < CVT_TILES) {
        cur = cvt_locate(p, g);
#pragma unroll
        for (int i = 0; i < 8; ++i) { regs[i] = __builtin_nontemporal_load((const f32x4*)(cur.src + (size_t)(kq + 8 * i) * cur.N + 4 * n4)); scl[i] = cur.scale ? cur.scale[kq + 8 * i] : 1.0f; }
    }
    for (; g < CVT_TILES; g += gridDim.x) {
        __syncthreads();
#pragma unroll
        for (int i = 0; i < 8; ++i) { const int k = kq + 8 * i; *(LAS f32x4*)(lds + k * 256 + ((4 * n4) ^ (4 * ((k >> 3) & 7)))) = regs[i] * scl[i]; }
        __syncthreads();
        const CvtTile now = cur;
        if (g + (int)gridDim.x < CVT_TILES) {
            cur = cvt_locate(p, g + gridDim.x);
#pragma unroll
            for (int i = 0; i < 8; ++i) { regs[i] = __builtin_nontemporal_load((const f32x4*)(cur.src + (size_t)(kq + 8 * i) * cur.N + 4 * n4)); scl[i] = cur.scale ? cur.scale[kq + 8 * i] : 1.0f; }
        }
#pragma unroll
        for (int it = 0; it < 4; ++it) {
            const int q = tid + 512 * it, ko = q & 7, n = q >> 3;
            float v[8];
#pragma unroll
            for (int j = 0; j < 8; ++j) v[j] = lds[(8 * ko + j) * 256 + (n ^ (4 * ko))];
            u32x4 w; w[0] = cvt_pk_bf16(v[0], v[1]); w[1] = cvt_pk_bf16(v[2], v[3]); w[2] = cvt_pk_bf16(v[4], v[5]); w[3] = cvt_pk_bf16(v[6], v[7]);
            __builtin_nontemporal_store(w, (u32x4*)(now.dst + (size_t)n * now.K + 8 * ko));
        }
    }
    bf16_t* wh = (bf16_t*)(p.ws + WS_WRH); bf16_t* wl = (bf16_t*)(p.ws + WS_WRL);
    for (int idx = bid * NTHR + tid; idx < DEPTH * 48 * DM; idx += gridDim.x * NTHR) {
        const int l = idx / (48 * DM), n = (idx / DM) % 48, k = idx % DM;
        float v = 0.f;
        if (n < 4) v = p.moe_wg[((size_t)l * DM + k) * 4 + n]; else if (n < 36) v = p.moe_wr[((size_t)l * DM + k) * 32 + (n - 4)];
        v *= p.moe_norm[l * DM + k];
        const unsigned h = cvt_pk_bf16(v, 0.f), lo = cvt_pk_bf16(v - bf_lo(h), 0.f);
        wh[idx] = (bf16_t)(h & 0xffffu); wl[idx] = (bf16_t)(lo & 0xffffu);
    }
}

DI void unpack8(const u32x4 u, float (&f)[8]) {
#pragma unroll
    for (int i = 0; i < 4; ++i) { f[2 * i] = bf_lo(u[i]); f[2 * i + 1] = bf_hi(u[i]); }
}
template <bool FINAL>
DI void ph_combine(int src_buf) {
    LOAD_PARAMS();
    const int tid = tid_(), bid = bid_(), wid = tid >> 6, lane = tid & 63;
    const bf16_t* xs = (const bf16_t*)(p.ws + (src_buf ? WS_XB1 : WS_XB));
    bf16_t* xd = (bf16_t*)(p.ws + (src_buf ? WS_XB : WS_XB1));
    const bf16_t* yb = (const bf16_t*)(p.ws + WS_YBUF);
    float* rstd = (float*)(p.ws + WS_RSTD);
    for (int t = bid * NWAVE + wid; t < T; t += gridDim.x * NWAVE) {
        float ss = 0.f;
#pragma unroll
        for (int i = 0; i < 2; ++i) {
            const size_t o = (size_t)t * DM + lane * 8 + 512 * i;
            float a[8], b[8], c[8];
            unpack8(*(const u32x4*)(xs + o), a); unpack8(*(const u32x4*)(yb + o), b); unpack8(*(const u32x4*)(yb + (size_t)T * DM + o), c);
#pragma unroll
            for (int e = 0; e < 8; ++e) a[e] += b[e] + c[e];
            if (FINAL) {
                __builtin_nontemporal_store((f32x4){a[0], a[1], a[2], a[3]}, (f32x4*)(p.x + o)); __builtin_nontemporal_store((f32x4){a[4], a[5], a[6], a[7]}, (f32x4*)(p.x + o + 4));
            } else {
                u32x4 w; w[0] = cvt_pk_bf16(a[0], a[1]); w[1] = cvt_pk_bf16(a[2], a[3]); w[2] = cvt_pk_bf16(a[4], a[5]); w[3] = cvt_pk_bf16(a[6], a[7]);
                *(u32x4*)(xd + o) = w;
                float r[8]; unpack8(w, r);
#pragma unroll
                for (int e = 0; e < 8; ++e) ss += r[e] * r[e];
            }
        }
        if (!FINAL) { ss = wave_sum(ss, lane); if (lane == 0) rstd[t] = rsqrtf(ss * (1.0f / DM) + EPS); }
    }
}

constexpr int PF_ROWS = 47, PF_TOK = 32;
DI void ph_poolfuse(LAS unsigned char* ldsb, int j, bool first) {
    LOAD_PARAMS();
    const int tid = tid_(), bid = bid_(), wid = tid >> 6, lane = tid & 63;
    const bf16_t* xs = (const bf16_t*)(p.ws + WS_XB1);
    bf16_t* xd = (bf16_t*)(p.ws + WS_XB);
    const bf16_t* yb = (const bf16_t*)(p.ws + WS_YBUF);
    const float* gain = p.pool_norm + j * DM;
    bf16_t* diff = (bf16_t*)(p.ws + WS_DIFF);
    LAS unsigned char* ht = ldsb;
    for (int tile = bid; tile < T / PF_TOK; tile += gridDim.x) {
        const int t0 = tile * PF_TOK, s0 = t0 & (SEQ - 1);
        for (int rr = wid; rr < PF_ROWS; rr += NWAVE) {
            const int t = t0 - 15 + rr;
            if (s0 == 0 && rr < 15) {
#pragma unroll
                for (int i = 0; i < 2; ++i) *(LAS u32x4*)(ht + rr * 2048 + (lane * 8 + 512 * i) * 2) = (u32x4){0u, 0u, 0u, 0u};
                continue;
            }
            float v[2][8]; u32x4 w[2]; float ss = 0.f;
#pragma unroll
            for (int i = 0; i < 2; ++i) {
                const size_t o = (size_t)t * DM + lane * 8 + 512 * i;
                if (first) {
                    const f32x4 a = *(const f32x4*)(p.x_in + o), b = *(const f32x4*)(p.x_in + o + 4);
#pragma unroll
                    for (int e = 0; e < 4; ++e) { v[i][e] = a[e]; v[i][4 + e] = b[e]; }
                } else {
                    float b[8], c[8];
                    unpack8(*(const u32x4*)(xs + o), v[i]); unpack8(*(const u32x4*)(yb + o), b); unpack8(*(const u32x4*)(yb + (size_t)T * DM + o), c);
#pragma unroll
                    for (int e = 0; e < 8; ++e) v[i][e] += b[e] + c[e];
                }
                w[i][0] = cvt_pk_bf16(v[i][0], v[i][1]); w[i][1] = cvt_pk_bf16(v[i][2], v[i][3]); w[i][2] = cvt_pk_bf16(v[i][4], v[i][5]); w[i][3] = cvt_pk_bf16(v[i][6], v[i][7]);
                if (rr >= 15) *(u32x4*)(xd + o) = w[i];
                unpack8(w[i], v[i]);
#pragma unroll
                for (int e = 0; e < 8; ++e) ss += v[i][e] * v[i][e];
            }
            ss = wave_sum(ss, lane);
            const float rs = rsqrtf(ss * (1.0f / DM) + EPS);
#pragma unroll
            for (int i = 0; i < 2; ++i) {
                u32x4 hw; hw[0] = cvt_pk_bf16(v[i][0] * rs, v[i][1] * rs); hw[1] = cvt_pk_bf16(v[i][2] * rs, v[i][3] * rs); hw[2] = cvt_pk_bf16(v[i][4] * rs, v[i][5] * rs); hw[3] = cvt_pk_bf16(v[i][6] * rs, v[i][7] * rs);
                *(LAS u32x4*)(ht + rr * 2048 + (lane * 8 + 512 * i) * 2) = hw;
            }
        }
        __syncthreads();
        {
            const int c = 2 * tid, win = 2 << (c >> 8);
            const float g0 = gain[c], g1 = gain[c + 1];
            float S0 = 0.f, S1 = 0.f;
            const LAS unsigned char* col = ht + c * 2;
#pragma unroll 4
            for (int rr = 0; rr < PF_ROWS; ++rr) {
                const unsigned hv = *(const LAS unsigned*)(col + rr * 2048);
                const float h0 = bf_lo(hv), h1 = bf_hi(hv);
                S0 += h0; S1 += h1;
                if (rr >= win) { const unsigned ov = *(const LAS unsigned*)(col + (rr - win) * 2048); S0 -= bf_lo(ov); S1 -= bf_hi(ov); }
                if (rr >= 15) {
                    const int s = s0 + rr - 15;
                    const float inv = 1.0f / (float)((s + 1 < win) ? s + 1 : win);
                    *(unsigned*)(diff + (size_t)(t0 + rr - 15) * DM + c) = cvt_pk_bf16((S0 * inv - h0) * g0, (S1 * inv - h1) * g1);
                }
            }
        }
        __syncthreads();
    }
}

struct Unit { const bf16_t* A; const bf16_t* B; int pm, pn, e, nvalid, row0, lbase; };
template <int LDA_, int LDB_, int K_, int BH_, bool HEADMAP_> struct GCfg { static constexpr int LDA = LDA_, LDB = LDB_, K = K_, BH = BH_; static constexpr bool HEADMAP = HEADMAP_; };

constexpr int BK = 64, HTB = 128 * BK * 2  , STAGE_BYTES = 8 * HTB;
DI int lds_byte(int r, int c) { const int st = (r >> 4) * 2 + (c >> 5), rr = r & 15, cc = c & 31, ob = rr * 64 + cc * 2; return st * 1024 + (ob ^ (((ob >> 9) & 1) << 5)); }
DI void stage_rc(int b, int& R, int& C) { const int st = b / 1024, sb = b % 1024, swz = sb ^ (((sb >> 9) & 1) << 5); R = (st >> 1) * 16 + swz / 64; C = (st & 1) * 32 + (swz % 64) / 2; }

template <class Cfg, class Sched, class Epi>
DI void gemm_phase(LAS unsigned char* lds, const Sched& S, const Epi& E) {
    const int tid = tid_(), wid = __builtin_amdgcn_readfirstlane(tid >> 6), lane = tid & 63, wr = wid >> 2, wc = wid & 3, fr = lane & 15, fq = lane >> 4;
    constexpr int nt = Cfg::K / BK;
    static_assert(Cfg::K % 128 == 0 && Cfg::K >= 256, "K");
    unsigned voffA[2][2], voffB[2];
    int R0, C0, R1, C1; stage_rc(tid * 16, R0, C0); stage_rc(tid * 16 + 8192, R1, C1);
    voffB[0] = (unsigned)(((Cfg::HEADMAP ? 64 * (R0 >> 5) : (R0 & ~31)) + perm32(R0 & 31)) * Cfg::LDB + C0) * 2u;
    voffB[1] = (unsigned)(((Cfg::HEADMAP ? 64 * (R1 >> 5) : (R1 & ~31)) + perm32(R1 & 31)) * Cfg::LDB + C1) * 2u;
    constexpr size_t kstep = (size_t)(BK * 2);
    constexpr size_t bhstep = (size_t)Cfg::BH * Cfg::LDB * 2;
    const unsigned ldsw = (unsigned)wid * 1024u;
    const int aoff = lds_byte(wr * 64 + fr, fq * 8), boff = lds_byte(wc * 32 + fr, fq * 8);
#define PG8_SA(b, h) (((b) * 2 + (h)) * HTB)
#define PG8_SB(b, h) ((4 + (b) * 2 + (h)) * HTB)
#define PG8_STAGE(bufoff, gbase, voff) do { _Pragma("unroll") for (int _i = 0; _i < 2; ++_i) \
        __builtin_amdgcn_global_load_lds((const unsigned*)((const char*)(gbase) + (voff)[_i]), (LAS unsigned*)(lds + (bufoff) + ldsw + _i * 8192), 16, 0, 0); } while (0)
#define PG8_LDA(dst, b, h) do { _Pragma("unroll") for (int m = 0; m < 4; ++m) _Pragma("unroll") for (int k = 0; k < 2; ++k) dst[m][k] = *(const LAS bf16x8*)(lds + PG8_SA(b, h) + aoff + m * 2048 + k * 1024); } while (0)
#define PG8_LDB(dst, b, h) do { _Pragma("unroll") for (int n = 0; n < 2; ++n) _Pragma("unroll") for (int k = 0; k < 2; ++k) dst[n][k] = *(const LAS bf16x8*)(lds + PG8_SB(b, h) + boff + n * 2048 + k * 1024); } while (0)
#define PG8_MMA(ai, bj, At, Bt) do { __builtin_amdgcn_s_setprio(1); _Pragma("unroll") for (int m = 0; m < 4; ++m) _Pragma("unroll") for (int n = 0; n < 2; ++n) _Pragma("unroll") for (int k = 0; k < 2; ++k) \
        acc[ai][bj][m][n] = __builtin_amdgcn_mfma_f32_16x16x32_bf16(Bt[n][k], At[m][k], acc[ai][bj][m][n], 0, 0, 0); __builtin_amdgcn_s_setprio(0); } while (0)
#define PG8_WAIT_V(n) asm volatile("s_waitcnt vmcnt(" #n ")" ::: "memory")
#define PG8_WAIT_L(n) asm volatile("s_waitcnt lgkmcnt(" #n ")" ::: "memory")
#define PG8_BAR __builtin_amdgcn_s_barrier()
#define PG8_SCHED __builtin_amdgcn_sched_barrier(0)
#define PG8_AROWS(uidx, un) do { voffA[0][0] = (unsigned)S.arow(uidx, un, R0) * (unsigned)(Cfg::LDA * 2) + (unsigned)(C0 * 2); voffA[0][1] = (unsigned)S.arow(uidx, un, R1) * (unsigned)(Cfg::LDA * 2) + (unsigned)(C1 * 2); \
        voffA[1][0] = (unsigned)S.arow(uidx, un, 128 + R0) * (unsigned)(Cfg::LDA * 2) + (unsigned)(C0 * 2); voffA[1][1] = (unsigned)S.arow(uidx, un, 128 + R1) * (unsigned)(Cfg::LDA * 2) + (unsigned)(C1 * 2); } while (0)
    Unit cur, nxt; int ui = 0;
    if (!S.next(0, cur)) return;
    f32x4 acc[2][2][4][2];
#pragma unroll
    for (int a = 0; a < 2; ++a)
#pragma unroll
        for (int b = 0; b < 2; ++b)
#pragma unroll
            for (int m = 0; m < 4; ++m)
#pragma unroll
                for (int n = 0; n < 2; ++n) acc[a][b][m][n] = (f32x4){0.f, 0.f, 0.f, 0.f};
    bf16x8 At[4][2], B0[2][2], B1[2][2];
    PG8_AROWS(0, cur);
    const char* cA = (const char*)cur.A; const char* cB = (const char*)cur.B;
    PG8_STAGE(PG8_SB(0, 0), cB, voffB); PG8_STAGE(PG8_SB(0, 1), cB + bhstep, voffB); PG8_STAGE(PG8_SA(0, 0), cA, voffA[0]); PG8_STAGE(PG8_SA(0, 1), cA, voffA[1]);
    if (wr == 1) PG8_BAR;
    PG8_WAIT_V(2); PG8_BAR;
    PG8_STAGE(PG8_SB(1, 0), cB + kstep, voffB); PG8_STAGE(PG8_SA(1, 0), cA + kstep, voffA[0]); PG8_STAGE(PG8_SB(1, 1), cB + bhstep + kstep, voffB);
    PG8_WAIT_V(6); PG8_BAR;
    for (;;) {
        const bool has_next = S.next(ui + 1, nxt);
        const char* nA = has_next ? (const char*)nxt.A : cA; const char* nB = has_next ? (const char*)nxt.B : cB;
#pragma unroll 1
        for (int t = 0; t < nt; t += 2) {
            const bool last = (t == nt - 2);
            const char* a1 = cA + (size_t)(t + 1) * kstep;
            const char* a2 = last ? nA : cA + (size_t)(t + 2) * kstep; const char* b2 = last ? nB : cB + (size_t)(t + 2) * kstep;
            const char* a3 = a2 + kstep; const char* b3 = b2 + kstep;
            PG8_LDB(B0, 0, 0); PG8_LDB(B1, 0, 1); PG8_SCHED; PG8_LDA(At, 0, 0); PG8_STAGE(PG8_SA(1, 1), a1, voffA[1]);
            if (last && has_next) PG8_AROWS(ui + 1, nxt);
            PG8_WAIT_V(8); PG8_WAIT_L(0); PG8_BAR; PG8_MMA(0, 0, At, B0); PG8_MMA(0, 1, At, B1); PG8_BAR; PG8_SCHED;
            PG8_LDA(At, 0, 1); PG8_STAGE(PG8_SB(0, 0), b2, voffB); PG8_STAGE(PG8_SB(0, 1), b2 + bhstep, voffB); PG8_STAGE(PG8_SA(0, 0), a2, voffA[0]);
            PG8_WAIT_V(8); PG8_WAIT_L(0); PG8_BAR; PG8_MMA(1, 0, At, B0); PG8_MMA(1, 1, At, B1); PG8_BAR; PG8_SCHED;
            PG8_LDB(B0, 1, 0); PG8_LDB(B1, 1, 1); PG8_SCHED; PG8_LDA(At, 1, 0); PG8_STAGE(PG8_SA(0, 1), a2, voffA[1]);
            PG8_WAIT_V(8); PG8_WAIT_L(0); PG8_BAR; PG8_MMA(0, 0, At, B0); PG8_MMA(0, 1, At, B1); PG8_BAR; PG8_SCHED;
            PG8_LDA(At, 1, 1); PG8_STAGE(PG8_SB(1, 0), b3, voffB); PG8_STAGE(PG8_SB(1, 1), b3 + bhstep, voffB); PG8_STAGE(PG8_SA(1, 0), a3, voffA[0]);
            PG8_WAIT_V(8); PG8_WAIT_L(0); PG8_BAR; PG8_MMA(1, 0, At, B0); PG8_MMA(1, 1, At, B1); PG8_BAR; PG8_SCHED;
        }
        if (wr == 0) PG8_BAR;
        E(acc, cur, wr, wc, fr, fq);
        if (!has_next) break;
#pragma unroll
        for (int a = 0; a < 2; ++a)
#pragma unroll
            for (int b = 0; b < 2; ++b)
#pragma unroll
                for (int m = 0; m < 4; ++m)
#pragma unroll
                    for (int n = 0; n < 2; ++n) acc[a][b][m][n] = (f32x4){0.f, 0.f, 0.f, 0.f};
        cur = nxt; cA = nA; cB = nB; ++ui;
        if (wr == 1) PG8_BAR;
    }
    PG8_WAIT_V(0);
    PG8_BAR;
#undef PG8_SA
#undef PG8_SB
#undef PG8_STAGE
#undef PG8_LDA
#undef PG8_LDB
#undef PG8_MMA
#undef PG8_WAIT_V
#undef PG8_WAIT_L
#undef PG8_BAR
#undef PG8_SCHED
#undef PG8_AROWS
}

struct SchedPool {
    const bf16_t* diff; const bf16_t* w; int bid;
    DI bool next(int i, Unit& u) const { const int L = i * gridDim.x + bid; if (L >= 256) return false; u.pm = L >> 2; u.pn = L & 3; u.A = diff + 256 * u.pn; u.B = w + (size_t)u.pn * 65536; return true; }
    DI int arow(int, const Unit& u, int r) const { return u.pm * 256 + r; }
};
struct SchedDense {
    const bf16_t* A; const bf16_t* B; int npn, ldb, bid;
    DI bool next(int i, Unit& u) const { const int L = i * gridDim.x + bid; if (L >= 64 * npn) return false; u.pm = L / npn; u.pn = L % npn; u.A = A; u.B = B + (size_t)u.pn * 256 * ldb; return true; }
    DI int arow(int, const Unit& u, int r) const { return u.pm * 256 + r; }
};

struct EpiPool {
    bf16_t* x; const float* pb; const float* ps;
    DI void operator()(const f32x4 (&acc)[2][2][4][2], const Unit& u, int wr, int wc, int fr, int fq) const {
#pragma unroll
        for (int ai = 0; ai < 2; ++ai)
#pragma unroll
            for (int m = 0; m < 4; ++m) {
                const int t = u.pm * 256 + 128 * ai + 64 * wr + 16 * m + fr;
#pragma unroll
                for (int bj = 0; bj < 2; ++bj) {
                    const int c = 256 * u.pn + 128 * bj + 32 * wc + 8 * fq;
                    bf16_t* xp = x + (size_t)t * DM + c;
                    float xv[8]; unpack8(*(const u32x4*)xp, xv);
                    const f32x4 v0 = (acc[ai][bj][m][0] + *(const f32x4*)(pb + c)) * *(const f32x4*)(ps + c);
                    const f32x4 v1 = (acc[ai][bj][m][1] + *(const f32x4*)(pb + c + 4)) * *(const f32x4*)(ps + c + 4);
                    u32x4 w; w[0] = cvt_pk_bf16(xv[0] + v0[0], xv[1] + v0[1]); w[1] = cvt_pk_bf16(xv[2] + v0[2], xv[3] + v0[3]); w[2] = cvt_pk_bf16(xv[4] + v1[0], xv[5] + v1[1]); w[3] = cvt_pk_bf16(xv[6] + v1[2], xv[7] + v1[3]);
                    *(u32x4*)xp = w;
                }
            }
    }
};
struct EpiWo {
    bf16_t* x;
    DI void operator()(const f32x4 (&acc)[2][2][4][2], const Unit& u, int wr, int wc, int fr, int fq) const {
#pragma unroll
        for (int ai = 0; ai < 2; ++ai)
#pragma unroll
            for (int m = 0; m < 4; ++m) {
                const int t = u.pm * 256 + 128 * ai + 64 * wr + 16 * m + fr;
#pragma unroll
                for (int bj = 0; bj < 2; ++bj) {
                    const int c = 256 * u.pn + 128 * bj + 32 * wc + 8 * fq;
                    bf16_t* xp = x + (size_t)t * DM + c;
                    float xv[8]; unpack8(*(const u32x4*)xp, xv);
                    const f32x4 v0 = acc[ai][bj][m][0], v1 = acc[ai][bj][m][1];
                    u32x4 w; w[0] = cvt_pk_bf16(xv[0] + v0[0], xv[1] + v0[1]); w[1] = cvt_pk_bf16(xv[2] + v0[2], xv[3] + v0[3]); w[2] = cvt_pk_bf16(xv[4] + v1[0], xv[5] + v1[1]); w[3] = cvt_pk_bf16(xv[6] + v1[2], xv[7] + v1[3]);
                    *(u32x4*)xp = w;
                }
            }
    }
};
struct EpiQKV {
    bf16_t* q; const float* rstd; const float* qg; const float* kg;
    DI void operator()(const f32x4 (&acc)[2][2][4][2], const Unit& u, int wr, int wc, int fr, int fq) const {
        const int which = u.pn >> 2, head = (u.pn & 3) * 4 + wc;
        bf16_t* out = q + (size_t)which * ((WS_K - WS_Q) / 2);
        const float* gn = which == 0 ? qg : kg;
        const float post = which == 0 ? 0.125f * 1.4426950408889634f : 1.0f;
        f32x4 g[2][2];
#pragma unroll
        for (int bj = 0; bj < 2; ++bj)
#pragma unroll
            for (int n = 0; n < 2; ++n) g[bj][n] = (which < 2) ? *(const f32x4*)(gn + 32 * bj + 8 * fq + 4 * n) * post : (f32x4){1.f, 1.f, 1.f, 1.f};
        float rsv[2][4];
#pragma unroll
        for (int ai = 0; ai < 2; ++ai)
#pragma unroll
            for (int m = 0; m < 4; ++m) rsv[ai][m] = rstd[u.pm * 256 + 128 * ai + 64 * wr + 16 * m + fr];
#pragma unroll
        for (int ai = 0; ai < 2; ++ai)
#pragma unroll
            for (int m = 0; m < 4; ++m) {
                const int t = u.pm * 256 + 128 * ai + 64 * wr + 16 * m + fr;
                const float rs = rsv[ai][m];
                f32x4 v4[2][2]; float ss = 0.f;
#pragma unroll
                for (int bj = 0; bj < 2; ++bj)
#pragma unroll
                    for (int n = 0; n < 2; ++n) { v4[bj][n] = acc[ai][bj][m][n] * rs; const f32x4 s = v4[bj][n] * v4[bj][n]; ss += (s[0] + s[1]) + (s[2] + s[3]); }
                ss += shflx(ss, fr + 16 * fq, 16); ss += shflx(ss, fr + 16 * fq, 32);
                const float r2 = (which < 2) ? rsqrtf(ss * (1.0f / HD) + EPS) : 1.0f;
#pragma unroll
                for (int bj = 0; bj < 2; ++bj) {
                    const f32x4 a = v4[bj][0] * r2 * g[bj][0], b = v4[bj][1] * r2 * g[bj][1];
                    u32x4 w; w[0] = cvt_pk_bf16(a[0], a[1]); w[1] = cvt_pk_bf16(a[2], a[3]); w[2] = cvt_pk_bf16(b[0], b[1]); w[3] = cvt_pk_bf16(b[2], b[3]);
                    *(u32x4*)(out + (size_t)t * DM + head * HD + 32 * bj + 8 * fq) = w;
                }
            }
    }
};

typedef short v4i16_t __attribute__((ext_vector_type(4)));
constexpr int AT_VPITCH = 192;
constexpr int AT_VTILE = 32 * AT_VPITCH;
DI void ph_attn(LAS unsigned char* ldsb) {
    LOAD_PARAMS();
    const int tid = tid_(), bid = bid_(), wid = tid >> 6, lane = tid & 63, l31 = lane & 31, h2 = lane >> 5;
    const bf16_t* Q = (const bf16_t*)(p.ws + WS_Q); const bf16_t* K = (const bf16_t*)(p.ws + WS_K); const bf16_t* V = (const bf16_t*)(p.ws + WS_V);
    bf16_t* O = (bf16_t*)(p.ws + WS_O);
    LAS unsigned char* vl = ldsb + wid * AT_VTILE;
    LAS unsigned char* vw = vl + (lane >> 3) * AT_VPITCH + (lane & 7) * 16;
    const LAS unsigned char* vr = vl + (4 * h2 + ((lane & 15) >> 2)) * AT_VPITCH + (16 * ((lane >> 4) & 1) + 4 * (lane & 3)) * 2;
    for (int it = 0; it < 4 * ((2 * NH * 256 / 32 - bid + (int)gridDim.x - 1) / (int)gridDim.x); ++it) {
        const int tsk = (bid + (it >> 2) * gridDim.x) * 32 + (it & 3) * 8 + wid;
        const int bh = tsk >> 8, qb = tsk & 255, b = bh >> 4, h = bh & 15;
        const size_t tb = (size_t)b * SEQ;
        const int q0 = qb * 32;
        bf16x8 qf[4];
#pragma unroll
        for (int s = 0; s < 4; ++s) qf[s] = *(const bf16x8*)(Q + (tb + q0 + l31) * DM + h * HD + 16 * s + 8 * h2);
        f32x16 o0, o1;
#pragma unroll
        for (int r = 0; r < 16; ++r) { o0[r] = 0.f; o1[r] = 0.f; }
        float R = 1.f;
        const bf16_t* kp = K + (tb + q0 + l31) * DM + h * HD + 8 * h2;
        const bf16_t* vp = V + (tb + q0 + (lane >> 3)) * DM + h * HD + (lane & 7) * 8;
        bf16x8 kn[4], kq[4]; u32x4 vn[4], vq[4];
#pragma unroll
        for (int s = 0; s < 4; ++s) { kn[s] = *(const bf16x8*)(kp + 16 * s); vn[s] = *(const u32x4*)(vp + (size_t)8 * s * DM); }
        if (qb > 0) {
            kp -= (size_t)32 * DM; vp -= (size_t)32 * DM;
#pragma unroll
            for (int s = 0; s < 4; ++s) { kq[s] = *(const bf16x8*)(kp + 16 * s); vq[s] = *(const u32x4*)(vp + (size_t)8 * s * DM); }
        }
        for (int kt = qb; kt >= 0; --kt) {
            bf16x8 kf[4];
#pragma unroll
            for (int s = 0; s < 4; ++s) { kf[s] = kn[s]; *(LAS u32x4*)(vw + 8 * s * AT_VPITCH) = vn[s]; kn[s] = kq[s]; vn[s] = vq[s]; }
            if (kt > 1) {
                kp -= (size_t)32 * DM; vp -= (size_t)32 * DM;
#pragma unroll
                for (int s = 0; s < 4; ++s) { kq[s] = *(const bf16x8*)(kp + 16 * s); vq[s] = *(const u32x4*)(vp + (size_t)8 * s * DM); }
            }
            f32x16 z;
#pragma unroll
            for (int r = 0; r < 16; ++r) z[r] = 0.f;
#pragma unroll
            for (int s = 0; s < 4; ++s) z = __builtin_amdgcn_mfma_f32_32x32x16_bf16(kf[s], qf[s], z, 0, 0, 0);
            float kp_[16], gs[4], ot[4];
#pragma unroll
            for (int r = 0; r < 16; ++r) kp_[r] = __builtin_amdgcn_rcpf(1.0f + __builtin_amdgcn_exp2f(z[r]));
            if (kt == qb) {
#pragma unroll
                for (int r = 0; r < 16; ++r) { const int kl = (r & 3) + 8 * (r >> 2) + 4 * h2; kp_[r] = (kl < l31) ? kp_[r] : 1.0f; }
            }
#pragma unroll
            for (int bb = 0; bb < 4; ++bb) { gs[bb] = (kp_[4 * bb] * kp_[4 * bb + 1]) * (kp_[4 * bb + 2] * kp_[4 * bb + 3]); ot[bb] = shflx(gs[bb], lane, 32); }
            const float tot_own = (gs[0] * gs[1]) * (gs[2] * gs[3]);
            const float tot_oth = (ot[0] * ot[1]) * (ot[2] * ot[3]);
            float later[4];
            {
                float own_tail = 1.f, oth_tail = 1.f;
#pragma unroll
                for (int bb = 3; bb >= 0; --bb) {
                    later[bb] = own_tail * oth_tail * (h2 == 0 ? ot[bb] : 1.f);
                    own_tail *= gs[bb]; oth_tail *= ot[bb];
                }
            }
            float a[16];
#pragma unroll
            for (int bb = 0; bb < 4; ++bb) {
                const float x3 = R * later[bb];
                const float x2 = x3 * kp_[4 * bb + 3], x1 = x2 * kp_[4 * bb + 2], x0 = x1 * kp_[4 * bb + 1];
                a[4 * bb] = x0 - x0 * kp_[4 * bb]; a[4 * bb + 1] = x1 - x1 * kp_[4 * bb + 1]; a[4 * bb + 2] = x2 - x2 * kp_[4 * bb + 2]; a[4 * bb + 3] = x3 - x3 * kp_[4 * bb + 3];
            }
            R *= (h2 == 0) ? (tot_own * tot_oth) : (tot_oth * tot_own);
#pragma unroll
            for (int s = 0; s < 2; ++s) {
                u32x4 pw;
#pragma unroll
                for (int i = 0; i < 4; ++i) pw[i] = cvt_pk_bf16(a[8 * s + 2 * i], a[8 * s + 2 * i + 1]);
                const bf16x8 pa = __builtin_bit_cast(bf16x8, pw);
#pragma unroll
                for (int db = 0; db < 2; ++db) {
                    const v4i16_t lo4 = __builtin_amdgcn_ds_read_tr16_b64_v4i16((LAS v4i16_t*)(vr + (16 * s) * AT_VPITCH + 64 * db));
                    const v4i16_t hi4 = __builtin_amdgcn_ds_read_tr16_b64_v4i16((LAS v4i16_t*)(vr + (16 * s + 8) * AT_VPITCH + 64 * db));
                    bf16x8 vf; vf[0] = lo4[0]; vf[1] = lo4[1]; vf[2] = lo4[2]; vf[3] = lo4[3]; vf[4] = hi4[0]; vf[5] = hi4[1]; vf[6] = hi4[2]; vf[7] = hi4[3];
                    if (db == 0) o0 = __builtin_amdgcn_mfma_f32_32x32x16_bf16(vf, pa, o0, 0, 0, 0);
                    else o1 = __builtin_amdgcn_mfma_f32_32x32x16_bf16(vf, pa, o1, 0, 0, 0);
                }
            }
            if (__all(R < 1.0e-36f)) break;
        }
#pragma unroll
        for (int db = 0; db < 2; ++db)
#pragma unroll
            for (int rb = 0; rb < 4; ++rb) {
                const f32x16& o = db == 0 ? o0 : o1;
                u32x2 w; w[0] = cvt_pk_bf16(o[4 * rb], o[4 * rb + 1]); w[1] = cvt_pk_bf16(o[4 * rb + 2], o[4 * rb + 3]);
                *(u32x2*)(O + (tb + q0 + l31) * DM + h * HD + 32 * db + 8 * rb + 4 * h2) = w;
            }
    }
}

constexpr int RT_PART = 0;
constexpr int RT_SSQ = RT_PART + 4 * 64 * 52 * 4;
constexpr int RT_LCNT = RT_SSQ + 4 * 64 * 4;
constexpr int RT_GB = RT_LCNT + 128;
DI void ph_router(LAS unsigned char* lds, int li) {
    LOAD_PARAMS();
    const bf16_t* xcur = (const bf16_t*)(p.ws + ((li & 1) ? WS_XB1 : WS_XB));
    const int tid = tid_(), bid = bid_(), wid = tid >> 6, lane = tid & 63, fr = lane & 15, fq = lane >> 4;
    const bf16_t* wh = (const bf16_t*)(p.ws + WS_WRH) + (size_t)li * 48 * DM;
    const bf16_t* wl = (const bf16_t*)(p.ws + WS_WRL) + (size_t)li * 48 * DM;
    const float* bg = p.moe_bg + li * 4;
    const float* br = p.moe_br + li * 32;
    unsigned* cnt = (unsigned*)(p.ws + WS_CTL) + CW_CNT + 32 * li;
    Entry* list = (Entry*)(p.ws + WS_LIST);
    LAS float* part = (LAS float*)(lds + RT_PART); LAS float* ssq = (LAS float*)(lds + RT_SSQ);
    LAS int* lcnt = (LAS int*)(lds + RT_LCNT); LAS int* gb = (LAS int*)(lds + RT_GB);
    const int th = wid & 1, kq = wid >> 1;
    for (int chunk = bid; chunk < T / 64; chunk += gridDim.x) {
        const int t = chunk * 64 + th * 32 + fr;
        const bf16_t* xr = xcur + (size_t)t * DM + kq * 256 + fq * 8;
        const bf16_t* whr = wh + (size_t)fr * DM + kq * 256 + fq * 8;
        const bf16_t* wlr = wl + (size_t)fr * DM + kq * 256 + fq * 8;
        f32x4 acc[2][3]; float ss[2] = {0.f, 0.f};
#pragma unroll
        for (int b = 0; b < 2; ++b)
#pragma unroll
            for (int nb = 0; nb < 3; ++nb) acc[b][nb] = (f32x4){0.f, 0.f, 0.f, 0.f};
#pragma unroll 4
        for (int ks = 0; ks < 8; ++ks) {
            bf16x8 xh[2];
#pragma unroll
            for (int b = 0; b < 2; ++b) {
                const u32x4 xw = *(const u32x4*)(xr + (size_t)b * 16 * DM + ks * 32);
                float xf[8]; unpack8(xw, xf);
#pragma unroll
                for (int e = 0; e < 8; ++e) ss[b] += xf[e] * xf[e];
                xh[b] = __builtin_bit_cast(bf16x8, xw);
            }
#pragma unroll
            for (int nb = 0; nb < 3; ++nb) {
                const bf16x8 wH = *(const bf16x8*)(whr + (size_t)nb * 16 * DM + ks * 32), wL = *(const bf16x8*)(wlr + (size_t)nb * 16 * DM + ks * 32);
#pragma unroll
                for (int b = 0; b < 2; ++b) {
                    acc[b][nb] = __builtin_amdgcn_mfma_f32_16x16x32_bf16(wH, xh[b], acc[b][nb], 0, 0, 0);
                    acc[b][nb] = __builtin_amdgcn_mfma_f32_16x16x32_bf16(wL, xh[b], acc[b][nb], 0, 0, 0);
                }
            }
        }
#pragma unroll
        for (int b = 0; b < 2; ++b) {
            float sv = ss[b]; sv += shflx(sv, lane, 16); sv += shflx(sv, lane, 32);
            const int tl = th * 32 + 16 * b + fr;
#pragma unroll
            for (int nb = 0; nb < 3; ++nb) *(LAS f32x4*)(part + (kq * 64 + tl) * 52 + 16 * nb + 4 * fq) = acc[b][nb];
            if (fq == 0) ssq[kq * 64 + tl] = sv;
        }
        if (tid < 32) lcnt[tid] = 0;
        __syncthreads();
        int ea = 0, eb = 0, la = 0, lb = 0; float w1 = 0.f, w2 = 0.f, rs = 0.f;
        if (tid < 64) {
            rs = rsqrtf(((ssq[tid] + ssq[64 + tid]) + (ssq[128 + tid] + ssq[192 + tid])) * (1.0f / DM) + EPS);
            float lg[36];
#pragma unroll
            for (int q = 0; q < 9; ++q) {
                const f32x4 u0 = *(const LAS f32x4*)(part + tid * 52 + 4 * q), u1 = *(const LAS f32x4*)(part + (64 + tid) * 52 + 4 * q);
                const f32x4 u2 = *(const LAS f32x4*)(part + (128 + tid) * 52 + 4 * q), u3 = *(const LAS f32x4*)(part + (192 + tid) * 52 + 4 * q);
#pragma unroll
                for (int e = 0; e < 4; ++e) lg[4 * q + e] = ((u0[e] + u1[e]) + (u2[e] + u3[e])) * rs;
            }
            float gl[4];
#pragma unroll
            for (int n = 0; n < 4; ++n) gl[n] = lg[n] + bg[n];
            int g = 0; float gm = gl[0];
#pragma unroll
            for (int n = 1; n < 4; ++n) if (gl[n] > gm) { gm = gl[n]; g = n; }
            float den = 0.f;
#pragma unroll
            for (int n = 0; n < 4; ++n) den += __expf(gl[n] - gm);
            const float gprob = 1.0f / den;
            float el[8];
#pragma unroll
            for (int n = 0; n < 8; ++n) {
                float v = 0.f;
#pragma unroll
                for (int gg = 0; gg < 4; ++gg) v = (g == gg) ? lg[4 + 8 * gg + n] + br[8 * gg + n] : v;
                el[n] = v;
            }
            int e1 = 0; float m1 = el[0];
#pragma unroll
            for (int n = 1; n < 8; ++n) if (el[n] > m1) { m1 = el[n]; e1 = n; }
            int e2 = -1; float m2 = -3.0e38f;
#pragma unroll
            for (int n = 0; n < 8; ++n) if (n != e1 && (e2 < 0 || el[n] > m2)) { m2 = el[n]; e2 = n; }
            const float ex = __expf(m2 - m1);
            w1 = gprob / (1.0f + ex); w2 = gprob * ex / (1.0f + ex);
            ea = 8 * g + e1; eb = 8 * g + e2;
            la = __hip_atomic_fetch_add(lcnt + ea, 1, __ATOMIC_RELAXED, __HIP_MEMORY_SCOPE_WORKGROUP);
            lb = __hip_atomic_fetch_add(lcnt + eb, 1, __ATOMIC_RELAXED, __HIP_MEMORY_SCOPE_WORKGROUP);
        }
        __syncthreads();
        if (tid < 32) { const int c = lcnt[tid]; gb[tid] = c ? (int)atomicAdd(&cnt[tid], (unsigned)c) : 0; }
        __syncthreads();
        if (tid < 64) {
            const int tt = chunk * 64 + tid;
            Entry A; A.dst = tt; A.rstd = rs; A.w = w1; A.tok = tt;
            Entry B; B.dst = T + tt; B.rstd = rs; B.w = w2; B.tok = tt;
            list[(size_t)ea * LIST_CAP + gb[ea] + la] = A;
            list[(size_t)eb * LIST_CAP + gb[eb] + lb] = B;
        }
        __syncthreads();
    }
}

constexpr int MOE_MAXU = 4;
constexpr int LDS_ROWTAB = STAGE_BYTES;
constexpr int LDS_EPITAB = LDS_ROWTAB + MOE_MAXU * 1024;
constexpr int LDS_UTAB = LDS_EPITAB + MOE_MAXU * 2048;
constexpr int LDS_XBW = LDS_UTAB + MOE_MAXU * 32;
constexpr int LDS_BYTES = 147456;
static_assert(LDS_XBW + 16 <= LDS_BYTES, "LDS map");
struct SchedMoe {
    LAS unsigned char* lds; const bf16_t* A; const bf16_t* W; bool gather; size_t w_estride; int w_pnrows, ldb;
    DI void build(const unsigned* cnt, const Entry* list, int npn, int lo, int hi, int first, int stride, int tid) {
        LAS int* ut = (LAS int*)(lds + LDS_UTAB); LAS unsigned* rt = (LAS unsigned*)(lds + LDS_ROWTAB);
        for (int i = 0; i < MOE_MAXU; ++i) {
            const int L = lo + first + i * stride;
            int found = 0, e = 0, j = 0, nv = 0, rtile = 0, pn = 0;
            if (first >= 0 && L < hi) {
                rtile = L / npn; pn = L % npn;
                int acc = 0;
                for (int ee = 0; ee < NE; ++ee) {
                    const int c = (int)cnt[ee], ntl = (c + 255) >> 8;
                    if (!found && rtile < acc + ntl) { found = 1; e = ee; j = rtile - acc; nv = c - 256 * j; }
                    acc += ntl;
                }
            }
            nv = nv > 256 ? 256 : nv;
            if (tid == 0) { ut[i * 8 + 0] = found; ut[i * 8 + 1] = e; ut[i * 8 + 2] = nv; ut[i * 8 + 3] = 256 * rtile; ut[i * 8 + 4] = e * LIST_CAP + 256 * j; ut[i * 8 + 5] = pn; }
            if (found && tid < 256) {
                Entry en; en.dst = DUMMY_ROW; en.rstd = 0.f; en.w = 0.f; en.tok = 0;
                if (tid < nv) en = list[e * LIST_CAP + 256 * j + tid];
                LAS float* et = (LAS float*)(lds + LDS_EPITAB) + (i * 256 + tid) * 2;
                if (gather) { rt[i * 256 + tid] = (unsigned)en.tok; et[0] = en.rstd; et[1] = en.w; }
                else { et[0] = __int_as_float(en.dst); et[1] = 0.f; }
            }
            if (tid == 0) ut[i * 8 + 6] = i;
        }
        asm volatile("s_waitcnt vmcnt(0) lgkmcnt(0)" ::: "memory");
        __syncthreads();
    }
    DI bool next(int i, Unit& u) const {
        if (i >= MOE_MAXU) return false;
        const LAS int* ut = (const LAS int*)(lds + LDS_UTAB) + i * 8;
        const int found = __builtin_amdgcn_readfirstlane(ut[0]);
        if (!found) return false;
        u.e = __builtin_amdgcn_readfirstlane(ut[1]); u.nvalid = __builtin_amdgcn_readfirstlane(ut[2]); u.row0 = __builtin_amdgcn_readfirstlane(ut[3]);
        u.lbase = i * 256; u.pn = __builtin_amdgcn_readfirstlane(ut[5]); u.pm = u.row0 >> 8;
        u.A = gather ? A : A + (size_t)u.row0 * DE;
        u.B = W + (size_t)u.e * w_estride + (size_t)u.pn * w_pnrows * ldb;
        return true;
    }
    DI int arow(int ui, const Unit&, int r) const { if (!gather) return r; return (int)((const LAS unsigned*)(lds + LDS_ROWTAB))[ui * 256 + r]; }
};
struct EpiGU {
    bf16_t* hid; LAS unsigned char* lds;
    DI void operator()(const f32x4 (&acc)[2][2][4][2], const Unit& u, int wr, int wc, int fr, int fq) const {
        typedef float f32x2 __attribute__((ext_vector_type(2)));
#pragma unroll
        for (int ai = 0; ai < 2; ++ai)
#pragma unroll
            for (int m = 0; m < 4; ++m) {
                const int r = 128 * ai + 64 * wr + 16 * m + fr;
                const f32x2 rw = *(const LAS f32x2*)(lds + LDS_EPITAB + (u.lbase + r) * 8);
                const float rs = rw[0], w = rw[1];
                unsigned pk[4];
#pragma unroll
                for (int n = 0; n < 2; ++n) {
                    float hv[4];
#pragma unroll
                    for (int e = 0; e < 4; ++e) { const float g = acc[ai][0][m][n][e] * rs, up = acc[ai][1][m][n][e] * rs; hv[e] = g * __builtin_amdgcn_rcpf(1.0f + __builtin_amdgcn_exp2f(-1.4426950408889634f * g)) * up * w; }
                    pk[2 * n] = cvt_pk_bf16(hv[0], hv[1]); pk[2 * n + 1] = cvt_pk_bf16(hv[2], hv[3]);
                }
                u32x4 wv; wv[0] = pk[0]; wv[1] = pk[1]; wv[2] = pk[2]; wv[3] = pk[3];
                *(u32x4*)(hid + (size_t)(u.row0 + r) * DE + 128 * u.pn + 32 * wc + 8 * fq) = wv;
            }
    }
};
struct EpiDown {
    bf16_t* yb; LAS unsigned char* lds;
    DI void operator()(const f32x4 (&acc)[2][2][4][2], const Unit& u, int wr, int wc, int fr, int fq) const {
#pragma unroll
        for (int ai = 0; ai < 2; ++ai)
#pragma unroll
            for (int m = 0; m < 4; ++m) {
                const int r = 128 * ai + 64 * wr + 16 * m + fr;
                const int dst = *(const LAS int*)(lds + LDS_EPITAB + (u.lbase + r) * 8);
                if (dst == DUMMY_ROW) continue;
#pragma unroll
                for (int bj = 0; bj < 2; ++bj) {
                    const f32x4 a = acc[ai][bj][m][0], b = acc[ai][bj][m][1];
                    u32x4 w; w[0] = cvt_pk_bf16(a[0], a[1]); w[1] = cvt_pk_bf16(a[2], a[3]); w[2] = cvt_pk_bf16(b[0], b[1]); w[3] = cvt_pk_bf16(b[2], b[3]);
                    *(u32x4*)(yb + (size_t)dst * DM + 256 * u.pn + 128 * bj + 32 * wc + 8 * fq) = w;
                }
            }
    }
};

DI void ph_poolgemm(LAS unsigned char* lds, int j) {
    LOAD_PARAMS();
    SchedPool S; S.bid = xbid_(); S.diff = (const bf16_t*)(p.ws + WS_DIFF); S.w = (const bf16_t*)(p.ws + WS_WPOOL) + (size_t)j * 4 * 65536;
    EpiPool E; E.x = (bf16_t*)(p.ws + WS_XB); E.pb = p.pool_b + j * DM; E.ps = p.pool_scale + j * DM;
    gemm_phase<GCfg<1024, 256, 256, 128, false>>(lds, S, E);
}
DI void ph_qkv(LAS unsigned char* lds, int j) {
    LOAD_PARAMS();
    SchedDense S; S.bid = xbid_(); S.A = (const bf16_t*)(p.ws + WS_XB1); S.B = (const bf16_t*)(p.ws + WS_WQKV) + (size_t)j * 3072 * 1024; S.npn = 12; S.ldb = 1024;
    EpiQKV E; E.q = (bf16_t*)(p.ws + WS_Q); E.rstd = (const float*)(p.ws + WS_RSTD); E.qg = p.sb_qg + j * HD; E.kg = p.sb_kg + j * HD;
    gemm_phase<GCfg<1024, 1024, 1024, 32, true>>(lds, S, E);
}
DI void ph_wo(LAS unsigned char* lds, int j) {
    LOAD_PARAMS();
    SchedDense S; S.bid = xbid_(); S.A = (const bf16_t*)(p.ws + WS_O); S.B = (const bf16_t*)(p.ws + WS_WO) + (size_t)j * 1024 * 1024; S.npn = 4; S.ldb = 1024;
    EpiWo E; E.x = (bf16_t*)(p.ws + WS_XB1);
    gemm_phase<GCfg<1024, 1024, 1024, 128, false>>(lds, S, E);
}
struct MoePlan { int NT, R1, nB, D1; };
DI MoePlan moe_plan(const unsigned* cnt) {
    int nt = 0;
    for (int e = 0; e < NE; ++e) nt += ((int)cnt[e] + 255) >> 8;
    MoePlan m; m.NT = nt; const int G = gridDim.x; m.R1 = nt < G / 2 ? nt : G / 2;
    const int late = 2 * (nt - m.R1); m.nB = late < G ? late : G;
    const int cap = 2 * (G - m.nB); m.D1 = 4 * m.R1 < cap ? 4 * m.R1 : cap;
    return m;
}
DI void ph_gu(LAS unsigned char* lds, int li, int stage) {
    LOAD_PARAMS();
    const Entry* list = (const Entry*)(p.ws + WS_LIST);
    const unsigned* cnt = (const unsigned*)(p.ws + WS_CTL) + CW_CNT + 32 * li;
    const MoePlan m = moe_plan(cnt);
    const int bid = xbid_();
    if (stage == 2 || (stage == 1 && bid >= m.nB)) return;
    SchedMoe S; S.lds = lds; S.A = (const bf16_t*)(p.ws + ((li & 1) ? WS_XB1 : WS_XB));
    S.W = (const bf16_t*)(p.ws + WS_WGU) + (size_t)li * NE * 512 * 1024; S.gather = true; S.w_estride = (size_t)512 * 1024; S.w_pnrows = 128; S.ldb = 1024;
    const int lo = stage == 0 ? 0 : 2 * m.R1, hi = stage == 0 ? 2 * m.R1 : 2 * m.NT, G = gridDim.x;
    EpiGU E; E.hid = (bf16_t*)(p.ws + WS_HID); E.lds = lds;
    for (int first = bid; lo + first < hi; first += MOE_MAXU * G) {
        S.build(cnt, list, 2, lo, hi, first, G, tid_());
        gemm_phase<GCfg<1024, 1024, 1024, 256, false>>(lds, S, E);
        __syncthreads();
    }
}
DI void ph_down(LAS unsigned char* lds, int li, int stage) {
    LOAD_PARAMS();
    const Entry* list = (const Entry*)(p.ws + WS_LIST);
    const unsigned* cnt = (const unsigned*)(p.ws + WS_CTL) + CW_CNT + 32 * li;
    const MoePlan m = moe_plan(cnt);
    const int bid = xbid_(), G = gridDim.x;
    if (stage == 0 || (stage == 1 && bid < m.nB)) return;
    SchedMoe S; S.lds = lds; S.A = (const bf16_t*)(p.ws + WS_HID);
    S.W = (const bf16_t*)(p.ws + WS_WD) + (size_t)li * NE * 1024 * 256; S.gather = false; S.w_estride = (size_t)1024 * 256; S.w_pnrows = 256; S.ldb = 256;
    const int lo = stage == 1 ? 0 : m.D1, hi = stage == 1 ? m.D1 : 4 * m.NT, stride = stage == 1 ? G - m.nB : G;
    EpiDown E; E.yb = (bf16_t*)(p.ws + WS_YBUF); E.lds = lds;
    for (int first = stage == 1 ? bid - m.nB : bid; lo + first < hi; first += MOE_MAXU * stride) {
        S.build(cnt, list, 4, lo, hi, first, stride, tid_());
        gemm_phase<GCfg<256, 256, 256, 128, false>>(lds, S, E);
        __syncthreads();
    }
}
DI bool moe_has_stage2(int li) {
    LOAD_PARAMS();
    const MoePlan m = moe_plan((const unsigned*)(p.ws + WS_CTL) + CW_CNT + 32 * li);
    return 4 * m.NT > m.D1;
}

#define XB_TMO      128
#define XB_XCNT(j)  (256  + 64 * (j))
#define XB_XSUB(j)  (1280 + 64 * (j))
#define XB_XGEN(j)  (2304 + 64 * (j))
#define XB_TOP      3328
#define XB_TOPGEN   3392
#define XCD_BAR_WORDS 3456
#define XB_SPIN_CAP (1u << 18)

__device__ __forceinline__ unsigned xb_ld(unsigned* p)              { return __hip_atomic_load(p, __ATOMIC_RELAXED, __HIP_MEMORY_SCOPE_AGENT); }
__device__ __forceinline__ unsigned xb_add(unsigned* p, unsigned v) { return __hip_atomic_fetch_add(p, v, __ATOMIC_RELAXED, __HIP_MEMORY_SCOPE_AGENT); }
__device__ __forceinline__ unsigned xb_xcc_id() { return (unsigned)__builtin_amdgcn_s_getreg((3 << 11) | 20) & 0xFu; }
#define XB_SPIN(cond, bar) do { unsigned _sp = 0; while (cond) { __builtin_amdgcn_s_sleep(1); \
    if ((++_sp & 255u) == 0u) { if (xb_ld(&(bar)[XB_TMO])) break; if (_sp > XB_SPIN_CAP) { atomicAdd(&(bar)[XB_TMO], 1u); break; } } } } while (0)

struct XcdBarrier {
    unsigned* bar; unsigned x;
    volatile LAS unsigned* st;
};

__device__ __forceinline__ XcdBarrier xcd_barrier_post(unsigned* bar, volatile LAS unsigned* st) {
    XcdBarrier b; b.bar = bar; b.x = xb_xcc_id(); b.st = st;
    if (threadIdx.x == 0) (void)xb_add(&bar[XB_XCNT(b.x)], 1u);
    return b;
}
__device__ __forceinline__ void xcd_barrier_complete(unsigned* bar, unsigned x, unsigned& nloc, unsigned& nx) {
    const unsigned G = gridDim.x * gridDim.y * gridDim.z;
    unsigned sum, cnt, mine, sp = 0u;
    for (;;) {
        sum = 0u; cnt = 0u; mine = 0u;
#pragma unroll
        for (unsigned j = 0; j < 16; ++j) { const unsigned c = xb_ld(&bar[XB_XCNT(j)]); sum += c; cnt += (c > 0u) ? 1u : 0u; mine = (j == x) ? c : mine; }
        if (sum == G) break;
        __builtin_amdgcn_s_sleep(1);
        if ((++sp & 255u) == 0u) { if (xb_ld(&bar[XB_TMO])) break; if (sp > XB_SPIN_CAP) { atomicAdd(&bar[XB_TMO], 1u); break; } }
    }
    nloc = mine > 0u ? mine : 1u; nx = cnt > 0u ? cnt : 1u;
}

__device__ __forceinline__ void xcd_barrier(const XcdBarrier& b) {
    asm volatile("s_waitcnt vmcnt(0)" ::: "memory");
    __syncthreads();
    if (threadIdx.x == 0) {
        unsigned* bar = b.bar; unsigned bx = b.x;
        asm volatile("" : "+s"(bar), "+s"(bx));
        __builtin_amdgcn_s_waitcnt(0);
        unsigned nloc = b.st[0], nx = b.st[1];
        if (nloc == 0u) { xcd_barrier_complete(bar, bx, nloc, nx); b.st[0] = nloc; b.st[1] = nx; }
        const unsigned old = xb_add(&bar[XB_XSUB(bx)], 1u);
        const unsigned gen = old / nloc;
        if (old + 1u == (gen + 1u) * nloc) {
            __builtin_amdgcn_fence(__ATOMIC_RELEASE, "agent");
            asm volatile("s_waitcnt vmcnt(0)" ::: "memory");
            const unsigned og = xb_add(&bar[XB_TOP], 1u);
            const unsigned tg = og / nx;
            if (og + 1u == (tg + 1u) * nx) xb_add(&bar[XB_TOPGEN], 1u);
            else XB_SPIN(xb_ld(&bar[XB_TOPGEN]) == tg, bar);
            __builtin_amdgcn_fence(__ATOMIC_ACQUIRE, "agent");
            xb_add(&bar[XB_XGEN(bx)], 1u);
            asm volatile("s_waitcnt vmcnt(0)" ::: "memory");
        } else {
            XB_SPIN(xb_ld(&bar[XB_XGEN(bx)]) == gen, bar);
            __builtin_amdgcn_fence(__ATOMIC_ACQUIRE, "agent");
            asm volatile("s_waitcnt vmcnt(0)" ::: "memory");
        }
    }
    __syncthreads();
}
constexpr int CW_BAR = 4096;

extern __shared__ __attribute__((aligned(16))) unsigned char smem_raw[];
__global__ void __launch_bounds__(NTHR, 2) fwd(Params pk) {
    LAS unsigned char* smem = (LAS unsigned char*)smem_raw;
    if (threadIdx.x < 4) ((LAS unsigned*)(smem + LDS_XBW))[threadIdx.x] = 0u;
    __syncthreads();
    XcdBarrier bar;
    { LOAD_PARAMS(); bar = xcd_barrier_post((unsigned*)(p.ws + WS_CTL) + CW_BAR, (volatile LAS unsigned*)(smem + LDS_XBW)); }
    ph_prologue(smem);
    __syncthreads();
    for (int i = 0; i < DEPTH; ++i) {
        const int j = i >> 1;
        if ((i & 1) == 0) {
            ph_poolfuse(smem, j, i == 0);
            xcd_barrier(bar);
            ph_poolgemm(smem, j);
        } else {
            ph_combine<false>(0);
            xcd_barrier(bar);
            ph_qkv(smem, j);
            xcd_barrier(bar);
            ph_attn(smem);
            xcd_barrier(bar);
            ph_wo(smem, j);
        }
        xcd_barrier(bar);
        ph_router(smem, i);
        xcd_barrier(bar);
        for (int st = 0; st < 3; ++st) {
            if (st == 2 && !moe_has_stage2(i)) break;
            ph_gu(smem, i, st);
            ph_down(smem, i, st);
            xcd_barrier(bar);
        }
    }
    ph_combine<true>(1);
}

extern "C" void kernel_launch(void* const* d_in, const int* in_sizes, int n_in, void* d_out, int out_size, void* d_ws, size_t ws_size, hipStream_t stream) {
    if (ws_size < WS_NEED || n_in < 18) return;
    Params p{};
    p.x_in = (const float*)d_in[0]; p.pool_norm = (const float*)d_in[1]; p.pool_w = (const float*)d_in[2]; p.pool_b = (const float*)d_in[3]; p.pool_scale = (const float*)d_in[4];
    p.sb_norm = (const float*)d_in[5]; p.sb_wqkv = (const float*)d_in[6]; p.sb_qg = (const float*)d_in[7]; p.sb_kg = (const float*)d_in[8]; p.sb_wo = (const float*)d_in[9];
    p.moe_norm = (const float*)d_in[10]; p.moe_wg = (const float*)d_in[11]; p.moe_bg = (const float*)d_in[12]; p.moe_wr = (const float*)d_in[13]; p.moe_br = (const float*)d_in[14];
    p.moe_wgate = (const float*)d_in[15]; p.moe_wup = (const float*)d_in[16]; p.moe_wdown = (const float*)d_in[17];
    p.x = (float*)d_out; p.ws = (unsigned char*)d_ws;
    static int grid = 0;
    if (!grid) {
        int dev = 0, cus = 0, per_cu = 0;
        if (hipGetDevice(&dev) != hipSuccess || hipDeviceGetAttribute(&cus, hipDeviceAttributeMultiprocessorCount, dev) != hipSuccess) { grid = -1; return; }
        if (hipFuncSetAttribute((const void*)fwd, hipFuncAttributeMaxDynamicSharedMemorySize, LDS_BYTES) != hipSuccess) { grid = -1; return; }
        if (hipOccupancyMaxActiveBlocksPerMultiprocessor(&per_cu, (const void*)fwd, NTHR, LDS_BYTES) != hipSuccess || per_cu < 1) { (void)hipGetLastError(); }
        grid = cus;
    }
    if (grid <= 0) return;
    (void)hipMemsetAsync((char*)d_ws + WS_CTL, 0, CTL_BYTES, stream);
    hipLaunchKernelGGL(fwd, dim3(grid), dim3(NTHR), LDS_BYTES, stream, p);
}
```

```cpp
#include <hip/hip_runtime.h>
#include <stdint.h>

#define DI __device__ __forceinline__
#define LAS __attribute__((address_space(3)))
typedef unsigned short bf16_t;
typedef short bf16x8 __attribute__((ext_vector_type(8)));
typedef float f32x4 __attribute__((ext_vector_type(4)));
typedef float f32x16 __attribute__((ext_vector_type(16)));
typedef unsigned u32x4 __attribute__((ext_vector_type(4)));
typedef unsigned u32x2 __attribute__((ext_vector_type(2)));

constexpr int T = 16384, DM = 1024, SEQ = 8192, NH = 16, HD = 64, DEPTH = 4, NE = 32, DE = 256;
constexpr float EPS = 1e-6f;
constexpr int NTHR = 512, NWAVE = 8;
constexpr int LIST_CAP = 16384;
constexpr int DUMMY_ROW = 2 * T;

constexpr size_t MiB = 1u << 20;
constexpr size_t WS_CTL = 0, CTL_BYTES = 1 * MiB;
constexpr size_t WS_WQKV = 1 * MiB;
constexpr size_t WS_WO = 13 * MiB;
constexpr size_t WS_WPOOL = 17 * MiB;
constexpr size_t WS_RSTD = 18 * MiB;
constexpr size_t WS_WRH = 19 * MiB, WS_WRL = WS_WRH + 512 * 1024;
constexpr size_t WS_WGU = 20 * MiB;
constexpr size_t WS_WD = 148 * MiB;
constexpr size_t WS_XB = 212 * MiB;
constexpr size_t WS_XB1 = 384 * MiB;
constexpr size_t WS_NEED = 416 * MiB;
constexpr size_t WS_LIST = 244 * MiB;
constexpr size_t WS_Q = 256 * MiB;
constexpr size_t WS_DIFF = WS_Q;
constexpr size_t WS_K = 288 * MiB, WS_V = 320 * MiB, WS_O = 352 * MiB;
constexpr size_t WS_YBUF = 288 * MiB;
constexpr size_t WS_HID = 354 * MiB;
constexpr size_t WS_END = 384 * MiB;
static_assert(WS_V - WS_K == WS_K - WS_Q, "Q, K, V equally spaced");
static_assert(WS_YBUF + (size_t)(2 * T + 1) * DM * 2 <= WS_HID, "ybuf");
static_assert(WS_HID + (size_t)(2 * T + NE * 256) * DE * 2 <= WS_END, "hid");
constexpr int CW_CNT = 1024;

struct Entry { int dst; float rstd; float w; int tok; };

struct Params {
    const float* x_in; const float* pool_norm; const float* pool_w; const float* pool_b; const float* pool_scale;
    const float* sb_norm; const float* sb_wqkv; const float* sb_qg; const float* sb_kg; const float* sb_wo;
    const float* moe_norm; const float* moe_wg; const float* moe_bg; const float* moe_wr; const float* moe_br;
    const float* moe_wgate; const float* moe_wup; const float* moe_wdown;
    float* x;
    unsigned char* ws;
};

typedef const unsigned long long __attribute__((address_space(4)))* KArgPtr;
#define GP(T, i) ((T*)(T __attribute__((address_space(1)))*)q[i])
DI Params load_params() {
    KArgPtr q = (KArgPtr)__builtin_amdgcn_kernarg_segment_ptr(); asm volatile("" : "+s"(q));
    Params p;
    p.x_in = GP(const float, 0); p.pool_norm = GP(const float, 1); p.pool_w = GP(const float, 2); p.pool_b = GP(const float, 3); p.pool_scale = GP(const float, 4);
    p.sb_norm = GP(const float, 5); p.sb_wqkv = GP(const float, 6); p.sb_qg = GP(const float, 7); p.sb_kg = GP(const float, 8); p.sb_wo = GP(const float, 9);
    p.moe_norm = GP(const float, 10); p.moe_wg = GP(const float, 11); p.moe_bg = GP(const float, 12); p.moe_wr = GP(const float, 13); p.moe_br = GP(const float, 14);
    p.moe_wgate = GP(const float, 15); p.moe_wup = GP(const float, 16); p.moe_wdown = GP(const float, 17);
    p.x = GP(float, 18); p.ws = GP(unsigned char, 19);
    return p;
}
#define LOAD_PARAMS() const Params p = load_params()
DI int tid_() { int t = threadIdx.x; asm volatile("" : "+v"(t)); return t; }
DI int bid_() { int b = blockIdx.x; asm volatile("" : "+s"(b)); return b; }
DI int xbid_() { const int b = bid_(), G = gridDim.x; return (G % 8 == 0) ? (b % 8) * (G / 8) + b / 8 : b; }

DI unsigned cvt_pk_bf16(float lo, float hi) { unsigned r; asm volatile("v_cvt_pk_bf16_f32 %0, %1, %2" : "=v"(r) : "v"(lo), "v"(hi)); return r; }
DI float bf_lo(unsigned u) { return __uint_as_float(u << 16); }
DI float bf_hi(unsigned u) { return __uint_as_float(u & 0xffff0000u); }
DI float shflx(float v, int lane, int m) { return __int_as_float(__builtin_amdgcn_ds_bpermute((lane ^ m) << 2, __float_as_int(v))); }
DI float wave_sum(float v, int lane) {
#pragma unroll
    for (int o = 32; o >= 1; o >>= 1) v += shflx(v, lane, o);
    return v;
}
DI int perm32(int rho) { const int n = rho >> 4, i = rho & 15; return 8 * (i >> 2) + 4 * n + (i & 3); }

struct CvtTile { const float* src; bf16_t* dst; const float* scale; int K, N; };
DI CvtTile cvt_locate(const Params& p, int g) {
    int K, N, sdiv = 1; const float* sb; bf16_t* db; const float* scb = nullptr; size_t sms, dms;
    if (g < 384) { K = 1024; N = 3072; sb = p.sb_wqkv; db = (bf16_t*)(p.ws + WS_WQKV); scb = p.sb_norm; sms = (size_t)1024 * 3072; dms = sms; }
    else if ((g -= 384) < 128) { K = 1024; N = 1024; sb = p.sb_wo; db = (bf16_t*)(p.ws + WS_WO); sms = (size_t)1024 * 1024; dms = sms; }
    else if ((g -= 128) < 32) { K = 256; N = 256; sb = p.pool_w; db = (bf16_t*)(p.ws + WS_WPOOL); sms = 65536; dms = 65536; }
    else if ((g -= 32) < 2048) { K = 1024; N = 256; sb = p.moe_wgate; db = (bf16_t*)(p.ws + WS_WGU); scb = p.moe_norm; sdiv = 32; sms = (size_t)1024 * 256; dms = (size_t)512 * 1024; }
    else if ((g -= 2048) < 2048) { K = 1024; N = 256; sb = p.moe_wup; db = (bf16_t*)(p.ws + WS_WGU) + (size_t)256 * 1024; scb = p.moe_norm; sdiv = 32; sms = (size_t)1024 * 256; dms = (size_t)512 * 1024; }
    else { g -= 2048; K = 256; N = 1024; sb = p.moe_wdown; db = (bf16_t*)(p.ws + WS_WD); sms = (size_t)256 * 1024; dms = sms; }
    const int tn = N / 256, per = (K / 64) * tn, mat = g / per, rem = g % per, k0 = (rem / tn) * 64, n0 = (rem % tn) * 256;
    CvtTile t; t.K = K; t.N = N;
    t.src = sb + (size_t)mat * sms + (size_t)k0 * N + n0;
    t.dst = db + (size_t)mat * dms + (size_t)n0 * K + k0;
    t.scale = scb ? scb + (size_t)(mat / sdiv) * K + k0 : nullptr;
    return t;
}
constexpr int CVT_TILES = 384 + 128 + 32 + 2048 + 2048 + 2048;
DI void ph_prologue(LAS unsigned char* ldsb) {
    LOAD_PARAMS();
    const int tid = tid_(), bid = bid_();
    LAS float* lds = (LAS float*)ldsb;
    const int n4 = tid & 63, kq = tid >> 6;
    f32x4 regs[8]; float scl[8];
    int g = bid;
    CvtTile cur{};
    if (g < CVT_TILES) {
        cur = cvt_locate(p, g);
#pragma unroll
        for (int i = 0; i < 8; ++i) { regs[i] = __builtin_nontemporal_load((const f32x4*)(cur.src + (size_t)(kq + 8 * i) * cur.N + 4 * n4)); scl[i] = cur.scale ? cur.scale[kq + 8 * i] : 1.0f; }
    }
    for (; g < CVT_TILES; g += gridDim.x) {
        __syncthreads();
#pragma unroll
        for (int i = 0; i < 8; ++i) { const int k = kq + 8 * i; *(LAS f32x4*)(lds + k * 256 + ((4 * n4) ^ (4 * ((k >> 3) & 7)))) = regs[i] * scl[i]; }
        __syncthreads();
        const CvtTile now = cur;
        if (g + (int)gridDim.x < CVT_TILES) {
            cur = cvt_locate(p, g + gridDim.x);
#pragma unroll
            for (int i = 0; i < 8; ++i) { regs[i] = __builtin_nontemporal_load((const f32x4*)(cur.src + (size_t)(kq + 8 * i) * cur.N + 4 * n4)); scl[i] = cur.scale ? cur.scale[kq + 8 * i] : 1.0f; }
        }
#pragma unroll
        for (int it = 0; it < 4; ++it) {
            const int q = tid + 512 * it, ko = q & 7, n = q >> 3;
            float v[8];
#pragma unroll
            for (int j = 0; j < 8; ++j) v[j] = lds[(8 * ko + j) * 256 + (n ^ (4 * ko))];
            u32x4 w; w[0] = cvt_pk_bf16(v[0], v[1]); w[1] = cvt_pk_bf16(v[2], v[3]); w[2] = cvt_pk_bf16(v[4], v[5]); w[3] = cvt_pk_bf16(v[6], v[7]);
            __builtin_nontemporal_store(w, (u32x4*)(now.dst + (size_t)n * now.K + 8 * ko));
        }
    }
    bf16_t* wh = (bf16_t*)(p.ws + WS_WRH); bf16_t* wl = (bf16_t*)(p.ws + WS_WRL);
    for (int idx = bid * NTHR + tid; idx < DEPTH * 48 * DM; idx += gridDim.x * NTHR) {
        const int l = idx / (48 * DM), n = (idx / DM) % 48, k = idx % DM;
        float v = 0.f;
        if (n < 4) v = p.moe_wg[((size_t)l * DM + k) * 4 + n]; else if (n < 36) v = p.moe_wr[((size_t)l * DM + k) * 32 + (n - 4)];
        v *= p.moe_norm[l * DM + k];
        const unsigned h = cvt_pk_bf16(v, 0.f), lo = cvt_pk_bf16(v - bf_lo(h), 0.f);
        wh[idx] = (bf16_t)(h & 0xffffu); wl[idx] = (bf16_t)(lo & 0xffffu);
    }
}

DI void unpack8(const u32x4 u, float (&f)[8]) {
#pragma unroll
    for (int i = 0; i < 4; ++i) { f[2 * i] = bf_lo(u[i]); f[2 * i + 1] = bf_hi(u[i]); }
}
template <bool FINAL>
DI void ph_combine(int src_buf) {
    LOAD_PARAMS();
    const int tid = tid_(), bid = bid_(), wid = tid >> 6, lane = tid & 63;
    const bf16_t* xs = (const bf16_t*)(p.ws + (src_buf ? WS_XB1 : WS_XB));
    bf16_t* xd = (bf16_t*)(p.ws + (src_buf ? WS_XB : WS_XB1));
    const bf16_t* yb = (const bf16_t*)(p.ws + WS_YBUF);
    float* rstd = (float*)(p.ws + WS_RSTD);
    for (int t = bid * NWAVE + wid; t < T; t += gridDim.x * NWAVE) {
        float ss = 0.f;
#pragma unroll
        for (int i = 0; i < 2; ++i) {
            const size_t o = (size_t)t * DM + lane * 8 + 512 * i;
            float a[8], b[8], c[8];
            unpack8(*(const u32x4*)(xs + o), a); unpack8(*(const u32x4*)(yb + o), b); unpack8(*(const u32x4*)(yb + (size_t)T * DM + o), c);
#pragma unroll
            for (int e = 0; e < 8; ++e) a[e] += b[e] + c[e];
            if (FINAL) {
                __builtin_nontemporal_store((f32x4){a[0], a[1], a[2], a[3]}, (f32x4*)(p.x + o)); __builtin_nontemporal_store((f32x4){a[4], a[5], a[6], a[7]}, (f32x4*)(p.x + o + 4));
            } else {
                u32x4 w; w[0] = cvt_pk_bf16(a[0], a[1]); w[1] = cvt_pk_bf16(a[2], a[3]); w[2] = cvt_pk_bf16(a[4], a[5]); w[3] = cvt_pk_bf16(a[6], a[7]);
                *(u32x4*)(xd + o) = w;
                float r[8]; unpack8(w, r);
#pragma unroll
                for (int e = 0; e < 8; ++e) ss += r[e] * r[e];
            }
        }
        if (!FINAL) { ss = wave_sum(ss, lane); if (lane == 0) rstd[t] = rsqrtf(ss * (1.0f / DM) + EPS); }
    }
}

constexpr int PF_ROWS = 47, PF_TOK = 32;
DI void ph_poolfuse(LAS unsigned char* ldsb, int j, bool first) {
    LOAD_PARAMS();
    const int tid = tid_(), bid = bid_(), wid = tid >> 6, lane = tid & 63;
    const bf16_t* xs = (const bf16_t*)(p.ws + WS_XB1);
    bf16_t* xd = (bf16_t*)(p.ws + WS_XB);
    const bf16_t* yb = (const bf16_t*)(p.ws + WS_YBUF);
    const float* gain = p.pool_norm + j * DM;
    bf16_t* diff = (bf16_t*)(p.ws + WS_DIFF);
    LAS unsigned char* ht = ldsb;
    for (int tile = bid; tile < T / PF_TOK; tile += gridDim.x) {
        const int t0 = tile * PF_TOK, s0 = t0 & (SEQ - 1);
        for (int rr = wid; rr < PF_ROWS; rr += NWAVE) {
            const int t = t0 - 15 + rr;
            if (s0 == 0 && rr < 15) {
#pragma unroll
                for (int i = 0; i < 2; ++i) *(LAS u32x4*)(ht + rr * 2048 + (lane * 8 + 512 * i) * 2) = (u32x4){0u, 0u, 0u, 0u};
                continue;
            }
            float v[2][8]; u32x4 w[2]; float ss = 0.f;
#pragma unroll
            for (int i = 0; i < 2; ++i) {
                const size_t o = (size_t)t * DM + lane * 8 + 512 * i;
                if (first) {
                    const f32x4 a = *(const f32x4*)(p.x_in + o), b = *(const f32x4*)(p.x_in + o + 4);
#pragma unroll
                    for (int e = 0; e < 4; ++e) { v[i][e] = a[e]; v[i][4 + e] = b[e]; }
                } else {
                    float b[8], c[8];
                    unpack8(*(const u32x4*)(xs + o), v[i]); unpack8(*(const u32x4*)(yb + o), b); unpack8(*(const u32x4*)(yb + (size_t)T * DM + o), c);
#pragma unroll
                    for (int e = 0; e < 8; ++e) v[i][e] += b[e] + c[e];
                }
                w[i][0] = cvt_pk_bf16(v[i][0], v[i][1]); w[i][1] = cvt_pk_bf16(v[i][2], v[i][3]); w[i][2] = cvt_pk_bf16(v[i][4], v[i][5]); w[i][3] = cvt_pk_bf16(v[i][6], v[i][7]);
                if (rr >= 15) *(u32x4*)(xd + o) = w[i];
                unpack8(w[i], v[i]);
#pragma unroll
                for (int e = 0; e < 8; ++e) ss += v[i][e] * v[i][e];
            }
            ss = wave_sum(ss, lane);
            const float rs = rsqrtf(ss * (1.0f / DM) + EPS);
#pragma unroll
            for (int i = 0; i < 2; ++i) {
                u32x4 hw; hw[0] = cvt_pk_bf16(v[i][0] * rs, v[i][1] * rs); hw[1] = cvt_pk_bf16(v[i][2] * rs, v[i][3] * rs); hw[2] = cvt_pk_bf16(v[i][4] * rs, v[i][5] * rs); hw[3] = cvt_pk_bf16(v[i][6] * rs, v[i][7] * rs);
                *(LAS u32x4*)(ht + rr * 2048 + (lane * 8 + 512 * i) * 2) = hw;
            }
        }
        __syncthreads();
        {
            const int c = 2 * tid, win = 2 << (c >> 8);
            const float g0 = gain[c], g1 = gain[c + 1];
            float S0 = 0.f, S1 = 0.f;
            const LAS unsigned char* col = ht + c * 2;
#pragma unroll 4
            for (int rr = 0; rr < PF_ROWS; ++rr) {
                const unsigned hv = *(const LAS unsigned*)(col + rr * 2048);
                const float h0 = bf_lo(hv), h1 = bf_hi(hv);
                S0 += h0; S1 += h1;
                if (rr >= win) { const unsigned ov = *(const LAS unsigned*)(col + (rr - win) * 2048); S0 -= bf_lo(ov); S1 -= bf_hi(ov); }
                if (rr >= 15) {
                    const int s = s0 + rr - 15;
                    const float inv = 1.0f / (float)((s + 1 < win) ? s + 1 : win);
                    *(unsigned*)(diff + (size_t)(t0 + rr - 15) * DM + c) = cvt_pk_bf16((S0 * inv - h0) * g0, (S1 * inv - h1) * g1);
                }
            }
        }
        __syncthreads();
    }
}

struct Unit { const bf16_t* A; const bf16_t* B; int pm, pn, e, nvalid, row0, lbase; };
template <int LDA_, int LDB_, int K_, int BH_, bool HEADMAP_> struct GCfg { static constexpr int LDA = LDA_, LDB = LDB_, K = K_, BH = BH_; static constexpr bool HEADMAP = HEADMAP_; };

constexpr int BK = 64, HTB = 128 * BK * 2  , STAGE_BYTES = 8 * HTB;
DI int lds_byte(int r, int c) { const int st = (r >> 4) * 2 + (c >> 5), rr = r & 15, cc = c & 31, ob = rr * 64 + cc * 2; return st * 1024 + (ob ^ (((ob >> 9) & 1) << 5)); }
DI void stage_rc(int b, int& R, int& C) { const int st = b / 1024, sb = b % 1024, swz = sb ^ (((sb >> 9) & 1) << 5); R = (st >> 1) * 16 + swz / 64; C = (st & 1) * 32 + (swz % 64) / 2; }

template <class Cfg, class Sched, class Epi>
DI void gemm_phase(LAS unsigned char* lds, const Sched& S, const Epi& E) {
    const int tid = tid_(), wid = __builtin_amdgcn_readfirstlane(tid >> 6), lane = tid & 63, wr = wid >> 2, wc = wid & 3, fr = lane & 15, fq = lane >> 4;
    constexpr int nt = Cfg::K / BK;
    static_assert(Cfg::K % 128 == 0 && Cfg::K >= 256, "K");
    unsigned voffA[2][2], voffB[2];
    int R0, C0, R1, C1; stage_rc(tid * 16, R0, C0); stage_rc(tid * 16 + 8192, R1, C1);
    voffB[0] = (unsigned)(((Cfg::HEADMAP ? 64 * (R0 >> 5) : (R0 & ~31)) + perm32(R0 & 31)) * Cfg::LDB + C0) * 2u;
    voffB[1] = (unsigned)(((Cfg::HEADMAP ? 64 * (R1 >> 5) : (R1 & ~31)) + perm32(R1 & 31)) * Cfg::LDB + C1) * 2u;
    constexpr size_t kstep = (size_t)(BK * 2);
    constexpr size_t bhstep = (size_t)Cfg::BH * Cfg::LDB * 2;
    const unsigned ldsw = (unsigned)wid * 1024u;
    const int aoff = lds_byte(wr * 64 + fr, fq * 8), boff = lds_byte(wc * 32 + fr, fq * 8);
#define PG8_SA(b, h) (((b) * 2 + (h)) * HTB)
#define PG8_SB(b, h) ((4 + (b) * 2 + (h)) * HTB)
#define PG8_STAGE(bufoff, gbase, voff) do { _Pragma("unroll") for (int _i = 0; _i < 2; ++_i) \
        __builtin_amdgcn_global_load_lds((const unsigned*)((const char*)(gbase) + (voff)[_i]), (LAS unsigned*)(lds + (bufoff) + ldsw + _i * 8192), 16, 0, 0); } while (0)
#define PG8_LDA(dst, b, h) do { _Pragma("unroll") for (int m = 0; m < 4; ++m) _Pragma("unroll") for (int k = 0; k < 2; ++k) dst[m][k] = *(const LAS bf16x8*)(lds + PG8_SA(b, h) + aoff + m * 2048 + k * 1024); } while (0)
#define PG8_LDB(dst, b, h) do { _Pragma("unroll") for (int n = 0; n < 2; ++n) _Pragma("unroll") for (int k = 0; k < 2; ++k) dst[n][k] = *(const LAS bf16x8*)(lds + PG8_SB(b, h) + boff + n * 2048 + k * 1024); } while (0)
#define PG8_MMA(ai, bj, At, Bt) do { __builtin_amdgcn_s_setprio(1); _Pragma("unroll") for (int m = 0; m < 4; ++m) _Pragma("unroll") for (int n = 0; n < 2; ++n) _Pragma("unroll") for (int k = 0; k < 2; ++k) \
        acc[ai][bj][m][n] = __builtin_amdgcn_mfma_f32_16x16x32_bf16(Bt[n][k], At[m][k], acc[ai][bj][m][n], 0, 0, 0); __builtin_amdgcn_s_setprio(0); } while (0)
#define PG8_WAIT_V(n) asm volatile("s_waitcnt vmcnt(" #n ")" ::: "memory")
#define PG8_WAIT_L(n) asm volatile("s_waitcnt lgkmcnt(" #n ")" ::: "memory")
#define PG8_BAR __builtin_amdgcn_s_barrier()
#define PG8_SCHED __builtin_amdgcn_sched_barrier(0)
#define PG8_AROWS(uidx, un) do { voffA[0][0] = (unsigned)S.arow(uidx, un, R0) * (unsigned)(Cfg::LDA * 2) + (unsigned)(C0 * 2); voffA[0][1] = (unsigned)S.arow(uidx, un, R1) * (unsigned)(Cfg::LDA * 2) + (unsigned)(C1 * 2); \
        voffA[1][0] = (unsigned)S.arow(uidx, un, 128 + R0) * (unsigned)(Cfg::LDA * 2) + (unsigned)(C0 * 2); voffA[1][1] = (unsigned)S.arow(uidx, un, 128 + R1) * (unsigned)(Cfg::LDA * 2) + (unsigned)(C1 * 2); } while (0)
    Unit cur, nxt; int ui = 0;
    if (!S.next(0, cur)) return;
    f32x4 acc[2][2][4][2];
#pragma unroll
    for (int a = 0; a < 2; ++a)
#pragma unroll
        for (int b = 0; b < 2; ++b)
#pragma unroll
            for (int m = 0; m < 4; ++m)
#pragma unroll
                for (int n = 0; n < 2; ++n) acc[a][b][m][n] = (f32x4){0.f, 0.f, 0.f, 0.f};
    bf16x8 At[4][2], B0[2][2], B1[2][2];
    PG8_AROWS(0, cur);
    const char* cA = (const char*)cur.A; const char* cB = (const char*)cur.B;
    PG8_STAGE(PG8_SB(0, 0), cB, voffB); PG8_STAGE(PG8_SB(0, 1), cB + bhstep, voffB); PG8_STAGE(PG8_SA(0, 0), cA, voffA[0]); PG8_STAGE(PG8_SA(0, 1), cA, voffA[1]);
    if (wr == 1) PG8_BAR;
    PG8_WAIT_V(2); PG8_BAR;
    PG8_STAGE(PG8_SB(1, 0), cB + kstep, voffB); PG8_STAGE(PG8_SA(1, 0), cA + kstep, voffA[0]); PG8_STAGE(PG8_SB(1, 1), cB + bhstep + kstep, voffB);
    PG8_WAIT_V(6); PG8_BAR;
    for (;;) {
        const bool has_next = S.next(ui + 1, nxt);
        const char* nA = has_next ? (const char*)nxt.A : cA; const char* nB = has_next ? (const char*)nxt.B : cB;
#pragma unroll 1
        for (int t = 0; t < nt; t += 2) {
            const bool last = (t == nt - 2);
            const char* a1 = cA + (size_t)(t + 1) * kstep;
            const char* a2 = last ? nA : cA + (size_t)(t + 2) * kstep; const char* b2 = last ? nB : cB + (size_t)(t + 2) * kstep;
            const char* a3 = a2 + kstep; const char* b3 = b2 + kstep;
            PG8_LDB(B0, 0, 0); PG8_LDB(B1, 0, 1); PG8_SCHED; PG8_LDA(At, 0, 0); PG8_STAGE(PG8_SA(1, 1), a1, voffA[1]);
            if (last && has_next) PG8_AROWS(ui + 1, nxt);
            PG8_WAIT_V(8); PG8_WAIT_L(0); PG8_BAR; PG8_MMA(0, 0, At, B0); PG8_MMA(0, 1, At, B1); PG8_BAR; PG8_SCHED;
            PG8_LDA(At, 0, 1); PG8_STAGE(PG8_SB(0, 0), b2, voffB); PG8_STAGE(PG8_SB(0, 1), b2 + bhstep, voffB); PG8_STAGE(PG8_SA(0, 0), a2, voffA[0]);
            PG8_WAIT_V(8); PG8_WAIT_L(0); PG8_BAR; PG8_MMA(1, 0, At, B0); PG8_MMA(1, 1, At, B1); PG8_BAR; PG8_SCHED;
            PG8_LDB(B0, 1, 0); PG8_LDB(B1, 1, 1); PG8_SCHED; PG8_LDA(At, 1, 0); PG8_STAGE(PG8_SA(0, 1), a2, voffA[1]);
            PG8_WAIT_V(8); PG8_WAIT_L(0); PG8_BAR; PG8_MMA(0, 0, At, B0); PG8_MMA(0, 1, At, B1); PG8_BAR; PG8_SCHED;
            PG8_LDA(At, 1, 1); PG8_STAGE(PG8_SB(1, 0), b3, voffB); PG8_STAGE(PG8_SB(1, 1), b3 + bhstep, voffB); PG8_STAGE(PG8_SA(1, 0), a3, voffA[0]);
            PG8_WAIT_V(8); PG8_WAIT_L(0); PG8_BAR; PG8_MMA(1, 0, At, B0); PG8_MMA(1, 1, At, B1); PG8_BAR; PG8_SCHED;
        }
        if (wr == 0) PG8_BAR;
        E(acc, cur, wr, wc, fr, fq);
        if (!has_next) break;
#pragma unroll
        for (int a = 0; a < 2; ++a)
#pragma unroll
            for (int b = 0; b < 2; ++b)
#pragma unroll
                for (int m = 0; m < 4; ++m)
#pragma unroll
                    for (int n = 0; n < 2; ++n) acc[a][b][m][n] = (f32x4){0.f, 0.f, 0.f, 0.f};
        cur = nxt; cA = nA; cB = nB; ++ui;
        if (wr == 1) PG8_BAR;
    }
    PG8_WAIT_V(0);
    PG8_BAR;
#undef PG8_SA
#undef PG8_SB
#undef PG8_STAGE
#undef PG8_LDA
#undef PG8_LDB
#undef PG8_MMA
#undef PG8_WAIT_V
#undef PG8_WAIT_L
#undef PG8_BAR
#undef PG8_SCHED
#undef PG8_AROWS
}

struct SchedPool {
    const bf16_t* diff; const bf16_t* w; int bid;
    DI bool next(int i, Unit& u) const { const int L = i * gridDim.x + bid; if (L >= 256) return false; u.pm = L >> 2; u.pn = L & 3; u.A = diff + 256 * u.pn; u.B = w + (size_t)u.pn * 65536; return true; }
    DI int arow(int, const Unit& u, int r) const { return u.pm * 256 + r; }
};
struct SchedDense {
    const bf16_t* A; const bf16_t* B; int npn, ldb, bid;
    DI bool next(int i, Unit& u) const { const int L = i * gridDim.x + bid; if (L >= 64 * npn) return false; u.pm = L / npn; u.pn = L % npn; u.A = A; u.B = B + (size_t)u.pn * 256 * ldb; return true; }
    DI int arow(int, const Unit& u, int r) const { return u.pm * 256 + r; }
};

struct EpiPool {
    bf16_t* x; const float* pb; const float* ps;
    DI void operator()(const f32x4 (&acc)[2][2][4][2], const Unit& u, int wr, int wc, int fr, int fq) const {
#pragma unroll
        for (int ai = 0; ai < 2; ++ai)
#pragma unroll
            for (int m = 0; m < 4; ++m) {
                const int t = u.pm * 256 + 128 * ai + 64 * wr + 16 * m + fr;
#pragma unroll
                for (int bj = 0; bj < 2; ++bj) {
                    const int c = 256 * u.pn + 128 * bj + 32 * wc + 8 * fq;
                    bf16_t* xp = x + (size_t)t * DM + c;
                    float xv[8]; unpack8(*(const u32x4*)xp, xv);
                    const f32x4 v0 = (acc[ai][bj][m][0] + *(const f32x4*)(pb + c)) * *(const f32x4*)(ps + c);
                    const f32x4 v1 = (acc[ai][bj][m][1] + *(const f32x4*)(pb + c + 4)) * *(const f32x4*)(ps + c + 4);
                    u32x4 w; w[0] = cvt_pk_bf16(xv[0] + v0[0], xv[1] + v0[1]); w[1] = cvt_pk_bf16(xv[2] + v0[2], xv[3] + v0[3]); w[2] = cvt_pk_bf16(xv[4] + v1[0], xv[5] + v1[1]); w[3] = cvt_pk_bf16(xv[6] + v1[2], xv[7] + v1[3]);
                    *(u32x4*)xp = w;
                }
            }
    }
};
struct EpiWo {
    bf16_t* x;
    DI void operator()(const f32x4 (&acc)[2][2][4][2], const Unit& u, int wr, int wc, int fr, int fq) const {
#pragma unroll
        for (int ai = 0; ai < 2; ++ai)
#pragma unroll
            for (int m = 0; m < 4; ++m) {
                const int t = u.pm * 256 + 128 * ai + 64 * wr + 16 * m + fr;
#pragma unroll
                for (int bj = 0; bj < 2; ++bj) {
                    const int c = 256 * u.pn + 128 * bj + 32 * wc + 8 * fq;
                    bf16_t* xp = x + (size_t)t * DM + c;
                    float xv[8]; unpack8(*(const u32x4*)xp, xv);
                    const f32x4 v0 = acc[ai][bj][m][0], v1 = acc[ai][bj][m][1];
                    u32x4 w; w[0] = cvt_pk_bf16(xv[0] + v0[0], xv[1] + v0[1]); w[1] = cvt_pk_bf16(xv[2] + v0[2], xv[3] + v0[3]); w[2] = cvt_pk_bf16(xv[4] + v1[0], xv[5] + v1[1]); w[3] = cvt_pk_bf16(xv[6] + v1[2], xv[7] + v1[3]);
                    *(u32x4*)xp = w;
                }
            }
    }
};
struct EpiQKV {
    bf16_t* q; const float* rstd; const float* qg; const float* kg;
    DI void operator()(const f32x4 (&acc)[2][2][4][2], const Unit& u, int wr, int wc, int fr, int fq) const {
        const int which = u.pn >> 2, head = (u.pn & 3) * 4 + wc;
        bf16_t* out = q + (size_t)which * ((WS_K - WS_Q) / 2);
        const float* gn = which == 0 ? qg : kg;
        const float post = which == 0 ? 0.125f * 1.4426950408889634f : 1.0f;
        f32x4 g[2][2];
#pragma unroll
        for (int bj = 0; bj < 2; ++bj)
#pragma unroll
            for (int n = 0; n < 2; ++n) g[bj][n] = (which < 2) ? *(const f32x4*)(gn + 32 * bj + 8 * fq + 4 * n) * post : (f32x4){1.f, 1.f, 1.f, 1.f};
        float rsv[2][4];
#pragma unroll
        for (int ai = 0; ai < 2; ++ai)
#pragma unroll
            for (int m = 0; m < 4; ++m) rsv[ai][m] = rstd[u.pm * 256 + 128 * ai + 64 * wr + 16 * m + fr];
#pragma unroll
        for (int ai = 0; ai < 2; ++ai)
#pragma unroll
            for (int m = 0; m < 4; ++m) {
                const int t = u.pm * 256 + 128 * ai + 64 * wr + 16 * m + fr;
                const float rs = rsv[ai][m];
                f32x4 v4[2][2]; float ss = 0.f;
#pragma unroll
                for (int bj = 0; bj < 2; ++bj)
#pragma unroll
                    for (int n = 0; n < 2; ++n) { v4[bj][n] = acc[ai][bj][m][n] * rs; const f32x4 s = v4[bj][n] * v4[bj][n]; ss += (s[0] + s[1]) + (s[2] + s[3]); }
                ss += shflx(ss, fr + 16 * fq, 16); ss += shflx(ss, fr + 16 * fq, 32);
                const float r2 = (which < 2) ? rsqrtf(ss * (1.0f / HD) + EPS) : 1.0f;
#pragma unroll
                for (int bj = 0; bj < 2; ++bj) {
                    const f32x4 a = v4[bj][0] * r2 * g[bj][0], b = v4[bj][1] * r2 * g[bj][1];
                    u32x4 w; w[0] = cvt_pk_bf16(a[0], a[1]); w[1] = cvt_pk_bf16(a[2], a[3]); w[2] = cvt_pk_bf16(b[0], b[1]); w[3] = cvt_pk_bf16(b[2], b[3]);
                    *(u32x4*)(out + (size_t)t * DM + head * HD + 32 * bj + 8 * fq) = w;
                }
            }
    }
};

typedef short v4i16_t __attribute__((ext_vector_type(4)));
constexpr int AT_VPITCH = 192;
constexpr int AT_VTILE = 32 * AT_VPITCH;
DI void ph_attn(LAS unsigned char* ldsb) {
    LOAD_PARAMS();
    const int tid = tid_(), bid = bid_(), wid = tid >> 6, lane = tid & 63, l31 = lane & 31, h2 = lane >> 5;
    const bf16_t* Q = (const bf16_t*)(p.ws + WS_Q); const bf16_t* K = (const bf16_t*)(p.ws + WS_K); const bf16_t* V = (const bf16_t*)(p.ws + WS_V);
    bf16_t* O = (bf16_t*)(p.ws + WS_O);
    LAS unsigned char* vl = ldsb + wid * AT_VTILE;
    LAS unsigned char* vw = vl + (lane >> 3) * AT_VPITCH + (lane & 7) * 16;
    const LAS unsigned char* vr = vl + (4 * h2 + ((lane & 15) >> 2)) * AT_VPITCH + (16 * ((lane >> 4) & 1) + 4 * (lane & 3)) * 2;
    for (int it = 0; it < 4 * ((2 * NH * 256 / 32 - bid + (int)gridDim.x - 1) / (int)gridDim.x); ++it) {
        const int tsk = (bid + (it >> 2) * gridDim.x) * 32 + (it & 3) * 8 + wid;
        const int bh = tsk >> 8, qb = tsk & 255, b = bh >> 4, h = bh & 15;
        const size_t tb = (size_t)b * SEQ;
        const int q0 = qb * 32;
        bf16x8 qf[4];
#pragma unroll
        for (int s = 0; s < 4; ++s) qf[s] = *(const bf16x8*)(Q + (tb + q0 + l31) * DM + h * HD + 16 * s + 8 * h2);
        f32x16 o0, o1;
#pragma unroll
        for (int r = 0; r < 16; ++r) { o0[r] = 0.f; o1[r] = 0.f; }
        float R = 1.f;
        const bf16_t* kp = K + (tb + q0 + l31) * DM + h * HD + 8 * h2;
        const bf16_t* vp = V + (tb + q0 + (lane >> 3)) * DM + h * HD + (lane & 7) * 8;
        bf16x8 kn[4], kq[4]; u32x4 vn[4], vq[4];
#pragma unroll
        for (int s = 0; s < 4; ++s) { kn[s] = *(const bf16x8*)(kp + 16 * s); vn[s] = *(const u32x4*)(vp + (size_t)8 * s * DM); }
        if (qb > 0) {
            kp -= (size_t)32 * DM; vp -= (size_t)32 * DM;
#pragma unroll
            for (int s = 0; s < 4; ++s) { kq[s] = *(const bf16x8*)(kp + 16 * s); vq[s] = *(const u32x4*)(vp + (size_t)8 * s * DM); }
        }
        for (int kt = qb; kt >= 0; --kt) {
            bf16x8 kf[4];
#pragma unroll
            for (int s = 0; s < 4; ++s) { kf[s] = kn[s]; *(LAS u32x4*)(vw + 8 * s * AT_VPITCH) = vn[s]; kn[s] = kq[s]; vn[s] = vq[s]; }
            if (kt > 1) {
                kp -= (size_t)32 * DM; vp -= (size_t)32 * DM;
#pragma unroll
                for (int s = 0; s < 4; ++s) { kq[s] = *(const bf16x8*)(kp + 16 * s); vq[s] = *(const u32x4*)(vp + (size_t)8 * s * DM); }
            }
            f32x16 z;
#pragma unroll
            for (int r = 0; r < 16; ++r) z[r] = 0.f;
#pragma unroll
            for (int s = 0; s < 4; ++s) z = __builtin_amdgcn_mfma_f32_32x32x16_bf16(kf[s], qf[s], z, 0, 0, 0);
            float kp_[16], gs[4], ot[4];
#pragma unroll
            for (int r = 0; r < 16; ++r) kp_[r] = __builtin_amdgcn_rcpf(1.0f + __builtin_amdgcn_exp2f(z[r]));
            if (kt == qb) {
#pragma unroll
                for (int r = 0; r < 16; ++r) { const int kl = (r & 3) + 8 * (r >> 2) + 4 * h2; kp_[r] = (kl < l31) ? kp_[r] : 1.0f; }
            }
#pragma unroll
            for (int bb = 0; bb < 4; ++bb) { gs[bb] = (kp_[4 * bb] * kp_[4 * bb + 1]) * (kp_[4 * bb + 2] * kp_[4 * bb + 3]); ot[bb] = shflx(gs[bb], lane, 32); }
            const float tot_own = (gs[0] * gs[1]) * (gs[2] * gs[3]);
            const float tot_oth = (ot[0] * ot[1]) * (ot[2] * ot[3]);
            float later[4];
            {
                float own_tail = 1.f, oth_tail = 1.f;
#pragma unroll
                for (int bb = 3; bb >= 0; --bb) {
                    later[bb] = own_tail * oth_tail * (h2 == 0 ? ot[bb] : 1.f);
                    own_tail *= gs[bb]; oth_tail *= ot[bb];
                }
            }
            float a[16];
#pragma unroll
            for (int bb = 0; bb < 4; ++bb) {
                const float x3 = R * later[bb];
                const float x2 = x3 * kp_[4 * bb + 3], x1 = x2 * kp_[4 * bb + 2], x0 = x1 * kp_[4 * bb + 1];
                a[4 * bb] = x0 - x0 * kp_[4 * bb]; a[4 * bb + 1] = x1 - x1 * kp_[4 * bb + 1]; a[4 * bb + 2] = x2 - x2 * kp_[4 * bb + 2]; a[4 * bb + 3] = x3 - x3 * kp_[4 * bb + 3];
            }
            R *= (h2 == 0) ? (tot_own * tot_oth) : (tot_oth * tot_own);
#pragma unroll
            for (int s = 0; s < 2; ++s) {
                u32x4 pw;
#pragma unroll
                for (int i = 0; i < 4; ++i) pw[i] = cvt_pk_bf16(a[8 * s + 2 * i], a[8 * s + 2 * i + 1]);
                const bf16x8 pa = __builtin_bit_cast(bf16x8, pw);
#pragma unroll
                for (int db = 0; db < 2; ++db) {
                    const v4i16_t lo4 = __builtin_amdgcn_ds_read_tr16_b64_v4i16((LAS v4i16_t*)(vr + (16 * s) * AT_VPITCH + 64 * db));
                    const v4i16_t hi4 = __builtin_amdgcn_ds_read_tr16_b64_v4i16((LAS v4i16_t*)(vr + (16 * s + 8) * AT_VPITCH + 64 * db));
                    bf16x8 vf; vf[0] = lo4[0]; vf[1] = lo4[1]; vf[2] = lo4[2]; vf[3] = lo4[3]; vf[4] = hi4[0]; vf[5] = hi4[1]; vf[6] = hi4[2]; vf[7] = hi4[3];
                    if (db == 0) o0 = __builtin_amdgcn_mfma_f32_32x32x16_bf16(vf, pa, o0, 0, 0, 0);
                    else o1 = __builtin_amdgcn_mfma_f32_32x32x16_bf16(vf, pa, o1, 0, 0, 0);
                }
            }
            if (__all(R < 1.0e-36f)) break;
        }
#pragma unroll
        for (int db = 0; db < 2; ++db)
#pragma unroll
            for (int rb = 0; rb < 4; ++rb) {
                const f32x16& o = db == 0 ? o0 : o1;
                u32x2 w; w[0] = cvt_pk_bf16(o[4 * rb], o[4 * rb + 1]); w[1] = cvt_pk_bf16(o[4 * rb + 2], o[4 * rb + 3]);
                *(u32x2*)(O + (tb + q0 + l31) * DM + h * HD + 32 * db + 8 * rb + 4 * h2) = w;
            }
    }
}

constexpr int RT_PART = 0;
constexpr int RT_SSQ = RT_PART + 4 * 64 * 52 * 4;
constexpr int RT_LCNT = RT_SSQ + 4 * 64 * 4;
constexpr int RT_GB = RT_LCNT + 128;
DI void ph_router(LAS unsigned char* lds, int li) {
    LOAD_PARAMS();
    const bf16_t* xcur = (const bf16_t*)(p.ws + ((li & 1) ? WS_XB1 : WS_XB));
    const int tid = tid_(), bid = bid_(), wid = tid >> 6, lane = tid & 63, fr = lane & 15, fq = lane >> 4;
    const bf16_t* wh = (const bf16_t*)(p.ws + WS_WRH) + (size_t)li * 48 * DM;
    const bf16_t* wl = (const bf16_t*)(p.ws + WS_WRL) + (size_t)li * 48 * DM;
    const float* bg = p.moe_bg + li * 4;
    const float* br = p.moe_br + li * 32;
    unsigned* cnt = (unsigned*)(p.ws + WS_CTL) + CW_CNT + 32 * li;
    Entry* list = (Entry*)(p.ws + WS_LIST);
    LAS float* part = (LAS float*)(lds + RT_PART); LAS float* ssq = (LAS float*)(lds + RT_SSQ);
    LAS int* lcnt = (LAS int*)(lds + RT_LCNT); LAS int* gb = (LAS int*)(lds + RT_GB);
    const int th = wid & 1, kq = wid >> 1;
    for (int chunk = bid; chunk < T / 64; chunk += gridDim.x) {
        const int t = chunk * 64 + th * 32 + fr;
        const bf16_t* xr = xcur + (size_t)t * DM + kq * 256 + fq * 8;
        const bf16_t* whr = wh + (size_t)fr * DM + kq * 256 + fq * 8;
        const bf16_t* wlr = wl + (size_t)fr * DM + kq * 256 + fq * 8;
        f32x4 acc[2][3]; float ss[2] = {0.f, 0.f};
#pragma unroll
        for (int b = 0; b < 2; ++b)
#pragma unroll
            for (int nb = 0; nb < 3; ++nb) acc[b][nb] = (f32x4){0.f, 0.f, 0.f, 0.f};
#pragma unroll 4
        for (int ks = 0; ks < 8; ++ks) {
            bf16x8 xh[2];
#pragma unroll
            for (int b = 0; b < 2; ++b) {
                const u32x4 xw = *(const u32x4*)(xr + (size_t)b * 16 * DM + ks * 32);
                float xf[8]; unpack8(xw, xf);
#pragma unroll
                for (int e = 0; e < 8; ++e) ss[b] += xf[e] * xf[e];
                xh[b] = __builtin_bit_cast(bf16x8, xw);
            }
#pragma unroll
            for (int nb = 0; nb < 3; ++nb) {
                const bf16x8 wH = *(const bf16x8*)(whr + (size_t)nb * 16 * DM + ks * 32), wL = *(const bf16x8*)(wlr + (size_t)nb * 16 * DM + ks * 32);
#pragma unroll
                for (int b = 0; b < 2; ++b) {
                    acc[b][nb] = __builtin_amdgcn_mfma_f32_16x16x32_bf16(wH, xh[b], acc[b][nb], 0, 0, 0);
                    acc[b][nb] = __builtin_amdgcn_mfma_f32_16x16x32_bf16(wL, xh[b], acc[b][nb], 0, 0, 0);
                }
            }
        }
#pragma unroll
        for (int b = 0; b < 2; ++b) {
            float sv = ss[b]; sv += shflx(sv, lane, 16); sv += shflx(sv, lane, 32);
            const int tl = th * 32 + 16 * b + fr;
#pragma unroll
            for (int nb = 0; nb < 3; ++nb) *(LAS f32x4*)(part + (kq * 64 + tl) * 52 + 16 * nb + 4 * fq) = acc[b][nb];
            if (fq == 0) ssq[kq * 64 + tl] = sv;
        }
        if (tid < 32) lcnt[tid] = 0;
        __syncthreads();
        int ea = 0, eb = 0, la = 0, lb = 0; float w1 = 0.f, w2 = 0.f, rs = 0.f;
        if (tid < 64) {
            rs = rsqrtf(((ssq[tid] + ssq[64 + tid]) + (ssq[128 + tid] + ssq[192 + tid])) * (1.0f / DM) + EPS);
            float lg[36];
#pragma unroll
            for (int q = 0; q < 9; ++q) {
                const f32x4 u0 = *(const LAS f32x4*)(part + tid * 52 + 4 * q), u1 = *(const LAS f32x4*)(part + (64 + tid) * 52 + 4 * q);
                const f32x4 u2 = *(const LAS f32x4*)(part + (128 + tid) * 52 + 4 * q), u3 = *(const LAS f32x4*)(part + (192 + tid) * 52 + 4 * q);
#pragma unroll
                for (int e = 0; e < 4; ++e) lg[4 * q + e] = ((u0[e] + u1[e]) + (u2[e] + u3[e])) * rs;
            }
            float gl[4];
#pragma unroll
            for (int n = 0; n < 4; ++n) gl[n] = lg[n] + bg[n];
            int g = 0; float gm = gl[0];
#pragma unroll
            for (int n = 1; n < 4; ++n) if (gl[n] > gm) { gm = gl[n]; g = n; }
            float den = 0.f;
#pragma unroll
            for (int n = 0; n < 4; ++n) den += __expf(gl[n] - gm);
            const float gprob = 1.0f / den;
            float el[8];
#pragma unroll
            for (int n = 0; n < 8; ++n) {
                float v = 0.f;
#pragma unroll
                for (int gg = 0; gg < 4; ++gg) v = (g == gg) ? lg[4 + 8 * gg + n] + br[8 * gg + n] : v;
                el[n] = v;
            }
            int e1 = 0; float m1 = el[0];
#pragma unroll
            for (int n = 1; n < 8; ++n) if (el[n] > m1) { m1 = el[n]; e1 = n; }
            int e2 = -1; float m2 = -3.0e38f;
#pragma unroll
            for (int n = 0; n < 8; ++n) if (n != e1 && (e2 < 0 || el[n] > m2)) { m2 = el[n]; e2 = n; }
            const float ex = __expf(m2 - m1);
            w1 = gprob / (1.0f + ex); w2 = gprob * ex / (1.0f + ex);
            ea = 8 * g + e1; eb = 8 * g + e2;
            la = __hip_atomic_fetch_add(lcnt + ea, 1, __ATOMIC_RELAXED, __HIP_MEMORY_SCOPE_WORKGROUP);
            lb = __hip_atomic_fetch_add(lcnt + eb, 1, __ATOMIC_RELAXED, __HIP_MEMORY_SCOPE_WORKGROUP);
        }
        __syncthreads();
        if (tid < 32) { const int c = lcnt[tid]; gb[tid] = c ? (int)atomicAdd(&cnt[tid], (unsigned)c) : 0; }
        __syncthreads();
        if (tid < 64) {
            const int tt = chunk * 64 + tid;
            Entry A; A.dst = tt; A.rstd = rs; A.w = w1; A.tok = tt;
            Entry B; B.dst = T + tt; B.rstd = rs; B.w = w2; B.tok = tt;
            list[(size_t)ea * LIST_CAP + gb[ea] + la] = A;
            list[(size_t)eb * LIST_CAP + gb[eb] + lb] = B;
        }
        __syncthreads();
    }
}

constexpr int MOE_MAXU = 4;
constexpr int LDS_ROWTAB = STAGE_BYTES;
constexpr int LDS_EPITAB = LDS_ROWTAB + MOE_MAXU * 1024;
constexpr int LDS_UTAB = LDS_EPITAB + MOE_MAXU * 2048;
constexpr int LDS_XBW = LDS_UTAB + MOE_MAXU * 32;
constexpr int LDS_BYTES = 147456;
static_assert(LDS_XBW + 16 <= LDS_BYTES, "LDS map");
struct SchedMoe {
    LAS unsigned char* lds; const bf16_t* A; const bf16_t* W; bool gather; size_t w_estride; int w_pnrows, ldb;
    DI void build(const unsigned* cnt, const Entry* list, int npn, int lo, int hi, int first, int stride, int tid) {
        LAS int* ut = (LAS int*)(lds + LDS_UTAB); LAS unsigned* rt = (LAS unsigned*)(lds + LDS_ROWTAB);
        const int lane = tid & 63;
        if (tid < 64) {
            const int c = (int)cnt[lane & 31], ntl = (c + 255) >> 8;
            int inc = ntl;
#pragma unroll
            for (int d = 1; d < 32; d <<= 1) { const int v = __builtin_amdgcn_ds_bpermute(((lane - d) & 63) << 2, inc); if ((lane & 31) >= d) inc += v; }
            const int exc = inc - ntl;
#pragma unroll
            for (int i = 0; i < MOE_MAXU; ++i) {
                const int L = lo + first + i * stride, rtile = L / npn, pn = L % npn;
                const bool hit = (first >= 0) && (L < hi) && (lane < 32) && (rtile >= exc) && (rtile < inc);
                const unsigned long long mask = __ballot(hit);
                int found = 0, e = 0, j = 0, nv = 0;
                if (mask) {
                    found = 1; e = __builtin_ctzll(mask);
                    j = rtile - __builtin_amdgcn_readlane(exc, e); nv = __builtin_amdgcn_readlane(c, e) - 256 * j; nv = nv > 256 ? 256 : nv;
                }
                if (lane == 0) { ut[i * 8 + 0] = found; ut[i * 8 + 1] = e; ut[i * 8 + 2] = nv; ut[i * 8 + 3] = 256 * rtile; ut[i * 8 + 4] = e * LIST_CAP + 256 * j; ut[i * 8 + 5] = pn; }
            }
        }
        __syncthreads();
        if (tid < 256) {
#pragma unroll
            for (int i = 0; i < MOE_MAXU; ++i) {
                if (!ut[i * 8]) continue;
                const int nv = ut[i * 8 + 2], lb = ut[i * 8 + 4];
                Entry en; en.dst = DUMMY_ROW; en.rstd = 0.f; en.w = 0.f; en.tok = 0;
                if (tid < nv) en = list[lb + tid];
                LAS float* et = (LAS float*)(lds + LDS_EPITAB) + (i * 256 + tid) * 2;
                if (gather) { rt[i * 256 + tid] = (unsigned)en.tok; et[0] = en.rstd; et[1] = en.w; }
                else { et[0] = __int_as_float(en.dst); et[1] = 0.f; }
            }
        }
        asm volatile("s_waitcnt vmcnt(0) lgkmcnt(0)" ::: "memory");
        __syncthreads();
    }
    DI bool next(int i, Unit& u) const {
        if (i >= MOE_MAXU) return false;
        const LAS int* ut = (const LAS int*)(lds + LDS_UTAB) + i * 8;
        const int found = __builtin_amdgcn_readfirstlane(ut[0]);
        if (!found) return false;
        u.e = __builtin_amdgcn_readfirstlane(ut[1]); u.nvalid = __builtin_amdgcn_readfirstlane(ut[2]); u.row0 = __builtin_amdgcn_readfirstlane(ut[3]);
        u.lbase = i * 256; u.pn = __builtin_amdgcn_readfirstlane(ut[5]); u.pm = u.row0 >> 8;
        u.A = gather ? A : A + (size_t)u.row0 * DE;
        u.B = W + (size_t)u.e * w_estride + (size_t)u.pn * w_pnrows * ldb;
        return true;
    }
    DI int arow(int ui, const Unit&, int r) const { if (!gather) return r; return (int)((const LAS unsigned*)(lds + LDS_ROWTAB))[ui * 256 + r]; }
};
struct EpiGU {
    bf16_t* hid; LAS unsigned char* lds;
    DI void operator()(const f32x4 (&acc)[2][2][4][2], const Unit& u, int wr, int wc, int fr, int fq) const {
        typedef float f32x2 __attribute__((ext_vector_type(2)));
#pragma unroll
        for (int ai = 0; ai < 2; ++ai)
#pragma unroll
            for (int m = 0; m < 4; ++m) {
                const int r = 128 * ai + 64 * wr + 16 * m + fr;
                const f32x2 rw = *(const LAS f32x2*)(lds + LDS_EPITAB + (u.lbase + r) * 8);
                const float rs = rw[0], w = rw[1];
                unsigned pk[4];
#pragma unroll
                for (int n = 0; n < 2; ++n) {
                    float hv[4];
#pragma unroll
                    for (int e = 0; e < 4; ++e) { const float g = acc[ai][0][m][n][e] * rs, up = acc[ai][1][m][n][e] * rs; hv[e] = g * __builtin_amdgcn_rcpf(1.0f + __builtin_amdgcn_exp2f(-1.4426950408889634f * g)) * up * w; }
                    pk[2 * n] = cvt_pk_bf16(hv[0], hv[1]); pk[2 * n + 1] = cvt_pk_bf16(hv[2], hv[3]);
                }
                u32x4 wv; wv[0] = pk[0]; wv[1] = pk[1]; wv[2] = pk[2]; wv[3] = pk[3];
                *(u32x4*)(hid + (size_t)(u.row0 + r) * DE + 128 * u.pn + 32 * wc + 8 * fq) = wv;
            }
    }
};
struct EpiDown {
    bf16_t* yb; LAS unsigned char* lds;
    DI void operator()(const f32x4 (&acc)[2][2][4][2], const Unit& u, int wr, int wc, int fr, int fq) const {
#pragma unroll
        for (int ai = 0; ai < 2; ++ai)
#pragma unroll
            for (int m = 0; m < 4; ++m) {
                const int r = 128 * ai + 64 * wr + 16 * m + fr;
                const int dst = *(const LAS int*)(lds + LDS_EPITAB + (u.lbase + r) * 8);
                if (dst == DUMMY_ROW) continue;
#pragma unroll
                for (int bj = 0; bj < 2; ++bj) {
                    const f32x4 a = acc[ai][bj][m][0], b = acc[ai][bj][m][1];
                    u32x4 w; w[0] = cvt_pk_bf16(a[0], a[1]); w[1] = cvt_pk_bf16(a[2], a[3]); w[2] = cvt_pk_bf16(b[0], b[1]); w[3] = cvt_pk_bf16(b[2], b[3]);
                    *(u32x4*)(yb + (size_t)dst * DM + 256 * u.pn + 128 * bj + 32 * wc + 8 * fq) = w;
                }
            }
    }
};

DI void ph_poolgemm(LAS unsigned char* lds, int j) {
    LOAD_PARAMS();
    SchedPool S; S.bid = xbid_(); S.diff = (const bf16_t*)(p.ws + WS_DIFF); S.w = (const bf16_t*)(p.ws + WS_WPOOL) + (size_t)j * 4 * 65536;
    EpiPool E; E.x = (bf16_t*)(p.ws + WS_XB); E.pb = p.pool_b + j * DM; E.ps = p.pool_scale + j * DM;
    gemm_phase<GCfg<1024, 256, 256, 128, false>>(lds, S, E);
}
DI void ph_qkv(LAS unsigned char* lds, int j) {
    LOAD_PARAMS();
    SchedDense S; S.bid = xbid_(); S.A = (const bf16_t*)(p.ws + WS_XB1); S.B = (const bf16_t*)(p.ws + WS_WQKV) + (size_t)j * 3072 * 1024; S.npn = 12; S.ldb = 1024;
    EpiQKV E; E.q = (bf16_t*)(p.ws + WS_Q); E.rstd = (const float*)(p.ws + WS_RSTD); E.qg = p.sb_qg + j * HD; E.kg = p.sb_kg + j * HD;
    gemm_phase<GCfg<1024, 1024, 1024, 32, true>>(lds, S, E);
}
DI void ph_wo(LAS unsigned char* lds, int j) {
    LOAD_PARAMS();
    SchedDense S; S.bid = xbid_(); S.A = (const bf16_t*)(p.ws + WS_O); S.B = (const bf16_t*)(p.ws + WS_WO) + (size_t)j * 1024 * 1024; S.npn = 4; S.ldb = 1024;
    EpiWo E; E.x = (bf16_t*)(p.ws + WS_XB1);
    gemm_phase<GCfg<1024, 1024, 1024, 128, false>>(lds, S, E);
}
struct MoePlan { int NT, R1, nB, D1; };
DI MoePlan moe_plan(const unsigned* cnt) {
    const int lane = tid_() & 63;
    int nt = ((int)cnt[lane & 31] + 255) >> 8;
#pragma unroll
    for (int o = 1; o < 32; o <<= 1) nt += __builtin_amdgcn_ds_bpermute((lane ^ o) << 2, nt);
    nt = __builtin_amdgcn_readfirstlane(nt);
    MoePlan m; m.NT = nt; const int G = gridDim.x; m.R1 = nt < G / 2 ? nt : G / 2;
    const int late = 2 * (nt - m.R1); m.nB = late < G ? late : G;
    const int cap = 2 * (G - m.nB); m.D1 = 4 * m.R1 < cap ? 4 * m.R1 : cap;
    return m;
}
DI void ph_gu(LAS unsigned char* lds, int li, int stage, const MoePlan m) {
    LOAD_PARAMS();
    const Entry* list = (const Entry*)(p.ws + WS_LIST);
    const unsigned* cnt = (const unsigned*)(p.ws + WS_CTL) + CW_CNT + 32 * li;
    const int bid = xbid_();
    if (stage == 2 || (stage == 1 && bid >= m.nB)) return;
    SchedMoe S; S.lds = lds; S.A = (const bf16_t*)(p.ws + ((li & 1) ? WS_XB1 : WS_XB));
    S.W = (const bf16_t*)(p.ws + WS_WGU) + (size_t)li * NE * 512 * 1024; S.gather = true; S.w_estride = (size_t)512 * 1024; S.w_pnrows = 128; S.ldb = 1024;
    const int lo = stage == 0 ? 0 : 2 * m.R1, hi = stage == 0 ? 2 * m.R1 : 2 * m.NT, G = gridDim.x;
    EpiGU E; E.hid = (bf16_t*)(p.ws + WS_HID); E.lds = lds;
    for (int first = bid; lo + first < hi; first += MOE_MAXU * G) {
        S.build(cnt, list, 2, lo, hi, first, G, tid_());
        gemm_phase<GCfg<1024, 1024, 1024, 256, false>>(lds, S, E);
        __syncthreads();
    }
}
DI void ph_down(LAS unsigned char* lds, int li, int stage, const MoePlan m) {
    LOAD_PARAMS();
    const Entry* list = (const Entry*)(p.ws + WS_LIST);
    const unsigned* cnt = (const unsigned*)(p.ws + WS_CTL) + CW_CNT + 32 * li;
    const int bid = xbid_(), G = gridDim.x;
    if (stage == 0 || (stage == 1 && bid < m.nB)) return;
    SchedMoe S; S.lds = lds; S.A = (const bf16_t*)(p.ws + WS_HID);
    S.W = (const bf16_t*)(p.ws + WS_WD) + (size_t)li * NE * 1024 * 256; S.gather = false; S.w_estride = (size_t)1024 * 256; S.w_pnrows = 256; S.ldb = 256;
    const int lo = stage == 1 ? 0 : m.D1, hi = stage == 1 ? m.D1 : 4 * m.NT, stride = stage == 1 ? G - m.nB : G;
    EpiDown E; E.yb = (bf16_t*)(p.ws + WS_YBUF); E.lds = lds;
    for (int first = stage == 1 ? bid - m.nB : bid; lo + first < hi; first += MOE_MAXU * stride) {
        S.build(cnt, list, 4, lo, hi, first, stride, tid_());
        gemm_phase<GCfg<256, 256, 256, 128, false>>(lds, S, E);
        __syncthreads();
    }
}
DI MoePlan moe_layer_plan(int li) {
    LOAD_PARAMS();
    return moe_plan((const unsigned*)(p.ws + WS_CTL) + CW_CNT + 32 * li);
}

#define XB_TMO      128
#define XB_XCNT(j)  (256  + 64 * (j))
#define XB_XSUB(j)  (1280 + 64 * (j))
#define XB_XGEN(j)  (2304 + 64 * (j))
#define XB_TOP      3328
#define XB_TOPGEN   3392
#define XCD_BAR_WORDS 3456
#define XB_SPIN_CAP (1u << 18)

__device__ __forceinline__ unsigned xb_ld(unsigned* p)              { return __hip_atomic_load(p, __ATOMIC_RELAXED, __HIP_MEMORY_SCOPE_AGENT); }
__device__ __forceinline__ unsigned xb_add(unsigned* p, unsigned v) { return __hip_atomic_fetch_add(p, v, __ATOMIC_RELAXED, __HIP_MEMORY_SCOPE_AGENT); }
__device__ __forceinline__ unsigned xb_xcc_id() { return (unsigned)__builtin_amdgcn_s_getreg((3 << 11) | 20) & 0xFu; }
#define XB_SPIN(cond, bar) do { unsigned _sp = 0; while (cond) { __builtin_amdgcn_s_sleep(1); \
    if ((++_sp & 255u) == 0u) { if (xb_ld(&(bar)[XB_TMO])) break; if (_sp > XB_SPIN_CAP) { atomicAdd(&(bar)[XB_TMO], 1u); break; } } } } while (0)

struct XcdBarrier {
    unsigned* bar; unsigned x;
    volatile LAS unsigned* st;
};

__device__ __forceinline__ XcdBarrier xcd_barrier_post(unsigned* bar, volatile LAS unsigned* st) {
    XcdBarrier b; b.bar = bar; b.x = xb_xcc_id(); b.st = st;
    if (threadIdx.x == 0) (void)xb_add(&bar[XB_XCNT(b.x)], 1u);
    return b;
}
__device__ __forceinline__ void xcd_barrier_complete(unsigned* bar, unsigned x, unsigned& nloc, unsigned& nx) {
    const unsigned G = gridDim.x * gridDim.y * gridDim.z;
    unsigned sum, cnt, mine, sp = 0u;
    for (;;) {
        sum = 0u; cnt = 0u; mine = 0u;
#pragma unroll
        for (unsigned j = 0; j < 16; ++j) { const unsigned c = xb_ld(&bar[XB_XCNT(j)]); sum += c; cnt += (c > 0u) ? 1u : 0u; mine = (j == x) ? c : mine; }
        if (sum == G) break;
        __builtin_amdgcn_s_sleep(1);
        if ((++sp & 255u) == 0u) { if (xb_ld(&bar[XB_TMO])) break; if (sp > XB_SPIN_CAP) { atomicAdd(&bar[XB_TMO], 1u); break; } }
    }
    nloc = mine > 0u ? mine : 1u; nx = cnt > 0u ? cnt : 1u;
}

__device__ __forceinline__ void xcd_barrier(const XcdBarrier& b) {
    asm volatile("s_waitcnt vmcnt(0)" ::: "memory");
    __syncthreads();
    if (threadIdx.x == 0) {
        unsigned* bar = b.bar; unsigned bx = b.x;
        asm volatile("" : "+s"(bar), "+s"(bx));
        __builtin_amdgcn_s_waitcnt(0);
        unsigned nloc = b.st[0], nx = b.st[1];
        if (nloc == 0u) { xcd_barrier_complete(bar, bx, nloc, nx); b.st[0] = nloc; b.st[1] = nx; }
        const unsigned old = xb_add(&bar[XB_XSUB(bx)], 1u);
        const unsigned gen = old / nloc;
        if (old + 1u == (gen + 1u) * nloc) {
            __builtin_amdgcn_fence(__ATOMIC_RELEASE, "agent");
            asm volatile("s_waitcnt vmcnt(0)" ::: "memory");
            const unsigned og = xb_add(&bar[XB_TOP], 1u);
            const unsigned tg = og / nx;
            if (og + 1u == (tg + 1u) * nx) xb_add(&bar[XB_TOPGEN], 1u);
            else XB_SPIN(xb_ld(&bar[XB_TOPGEN]) == tg, bar);
            __builtin_amdgcn_fence(__ATOMIC_ACQUIRE, "agent");
            xb_add(&bar[XB_XGEN(bx)], 1u);
            asm volatile("s_waitcnt vmcnt(0)" ::: "memory");
        } else {
            XB_SPIN(xb_ld(&bar[XB_XGEN(bx)]) == gen, bar);
            __builtin_amdgcn_fence(__ATOMIC_ACQUIRE, "agent");
            asm volatile("s_waitcnt vmcnt(0)" ::: "memory");
        }
    }
    __syncthreads();
}
constexpr int CW_BAR = 4096;

extern __shared__ __attribute__((aligned(16))) unsigned char smem_raw[];
__global__ void __launch_bounds__(NTHR, 2) fwd(Params pk) {
    LAS unsigned char* smem = (LAS unsigned char*)smem_raw;
    if (threadIdx.x < 4) ((LAS unsigned*)(smem + LDS_XBW))[threadIdx.x] = 0u;
    __syncthreads();
    XcdBarrier bar;
    { LOAD_PARAMS(); bar = xcd_barrier_post((unsigned*)(p.ws + WS_CTL) + CW_BAR, (volatile LAS unsigned*)(smem + LDS_XBW)); }
    ph_prologue(smem);
    __syncthreads();
    for (int i = 0; i < DEPTH; ++i) {
        const int j = i >> 1;
        if ((i & 1) == 0) {
            ph_poolfuse(smem, j, i == 0);
            xcd_barrier(bar);
            ph_poolgemm(smem, j);
        } else {
            ph_combine<false>(0);
            xcd_barrier(bar);
            ph_qkv(smem, j);
            xcd_barrier(bar);
            ph_attn(smem);
            xcd_barrier(bar);
            ph_wo(smem, j);
        }
        xcd_barrier(bar);
        ph_router(smem, i);
        xcd_barrier(bar);
        const MoePlan mp = moe_layer_plan(i);
        for (int st = 0; st < 3; ++st) {
            if (st == 2 && 4 * mp.NT <= mp.D1) break;
            ph_gu(smem, i, st, mp);
            ph_down(smem, i, st, mp);
            xcd_barrier(bar);
        }
    }
    ph_combine<true>(1);
}

extern "C" void kernel_launch(void* const* d_in, const int* in_sizes, int n_in, void* d_out, int out_size, void* d_ws, size_t ws_size, hipStream_t stream) {
    if (ws_size < WS_NEED || n_in < 18) return;
    Params p{};
    p.x_in = (const float*)d_in[0]; p.pool_norm = (const float*)d_in[1]; p.pool_w = (const float*)d_in[2]; p.pool_b = (const float*)d_in[3]; p.pool_scale = (const float*)d_in[4];
    p.sb_norm = (const float*)d_in[5]; p.sb_wqkv = (const float*)d_in[6]; p.sb_qg = (const float*)d_in[7]; p.sb_kg = (const float*)d_in[8]; p.sb_wo = (const float*)d_in[9];
    p.moe_norm = (const float*)d_in[10]; p.moe_wg = (const float*)d_in[11]; p.moe_bg = (const float*)d_in[12]; p.moe_wr = (const float*)d_in[13]; p.moe_br = (const float*)d_in[14];
    p.moe_wgate = (const float*)d_in[15]; p.moe_wup = (const float*)d_in[16]; p.moe_wdown = (const float*)d_in[17];
    p.x = (float*)d_out; p.ws = (unsigned char*)d_ws;
    static int grid = 0;
    if (!grid) {
        int dev = 0, cus = 0, per_cu = 0;
        if (hipGetDevice(&dev) != hipSuccess || hipDeviceGetAttribute(&cus, hipDeviceAttributeMultiprocessorCount, dev) != hipSuccess) { grid = -1; return; }
        if (hipFuncSetAttribute((const void*)fwd, hipFuncAttributeMaxDynamicSharedMemorySize, LDS_BYTES) != hipSuccess) { grid = -1; return; }
        if (hipOccupancyMaxActiveBlocksPerMultiprocessor(&per_cu, (const void*)fwd, NTHR, LDS_BYTES) != hipSuccess || per_cu < 1) { (void)hipGetLastError(); }
        grid = cus;
    }
    if (grid <= 0) return;
    (void)hipMemsetAsync((char*)d_ws + WS_CTL, 0, CTL_BYTES, stream);
    hipLaunchKernelGGL(fwd, dim3(grid), dim3(NTHR), LDS_BYTES, stream, p);
}
```

```cpp
#include <hip/hip_runtime.h>
#include <stdint.h>

#define DI __device__ __forceinline__
#define LAS __attribute__((address_space(3)))
typedef unsigned short bf16_t;
typedef short bf16x8 __attribute__((ext_vector_type(8)));
typedef float f32x4 __attribute__((ext_vector_type(4)));
typedef float f32x16 __attribute__((ext_vector_type(16)));
typedef unsigned u32x4 __attribute__((ext_vector_type(4)));
typedef unsigned u32x2 __attribute__((ext_vector_type(2)));

constexpr int T = 16384, DM = 1024, SEQ = 8192, NH = 16, HD = 64, DEPTH = 4, NE = 32, DE = 256;
constexpr float EPS = 1e-6f;
constexpr int NTHR = 512, NWAVE = 8;
constexpr int LIST_CAP = 16384;
constexpr int DUMMY_ROW = 2 * T;

constexpr size_t MiB = 1u << 20;
constexpr size_t WS_CTL = 0, CTL_BYTES = 1 * MiB;
constexpr size_t WS_WQKV = 1 * MiB;
constexpr size_t WS_WO = 13 * MiB;
constexpr size_t WS_WPOOL = 17 * MiB;
constexpr size_t WS_RSTD = 18 * MiB;
constexpr size_t WS_WRH = 19 * MiB, WS_WRL = WS_WRH + 512 * 1024;
constexpr size_t WS_WGU = 20 * MiB;
constexpr size_t WS_WD = 148 * MiB;
constexpr size_t WS_XB = 212 * MiB;
constexpr size_t WS_XB1 = 384 * MiB;
constexpr size_t WS_NEED = 416 * MiB;
constexpr size_t WS_LIST = 244 * MiB;
constexpr size_t WS_Q = 256 * MiB;
constexpr size_t WS_DIFF = WS_Q;
constexpr size_t WS_K = 288 * MiB, WS_V = 320 * MiB, WS_O = 352 * MiB;
constexpr size_t WS_YBUF = 288 * MiB;
constexpr size_t WS_HID = 354 * MiB;
constexpr size_t WS_END = 384 * MiB;
static_assert(WS_V - WS_K == WS_K - WS_Q, "Q, K, V equally spaced");
static_assert(WS_YBUF + (size_t)(2 * T + 1) * DM * 2 <= WS_HID, "ybuf");
static_assert(WS_HID + (size_t)(2 * T + NE * 256) * DE * 2 <= WS_END, "hid");
constexpr int CW_CNT = 1024;

struct Entry { int dst; float rstd; float w; int tok; };

struct Params {
    const float* x_in; const float* pool_norm; const float* pool_w; const float* pool_b; const float* pool_scale;
    const float* sb_norm; const float* sb_wqkv; const float* sb_qg; const float* sb_kg; const float* sb_wo;
    const float* moe_norm; const float* moe_wg; const float* moe_bg; const float* moe_wr; const float* moe_br;
    const float* moe_wgate; const float* moe_wup; const float* moe_wdown;
    float* x;
    unsigned char* ws;
};

typedef const unsigned long long __attribute__((address_space(4)))* KArgPtr;
#define GP(T, i) ((T*)(T __attribute__((address_space(1)))*)q[i])
DI Params load_params() {
    KArgPtr q = (KArgPtr)__builtin_amdgcn_kernarg_segment_ptr(); asm volatile("" : "+s"(q));
    Params p;
    p.x_in = GP(const float, 0); p.pool_norm = GP(const float, 1); p.pool_w = GP(const float, 2); p.pool_b = GP(const float, 3); p.pool_scale = GP(const float, 4);
    p.sb_norm = GP(const float, 5); p.sb_wqkv = GP(const float, 6); p.sb_qg = GP(const float, 7); p.sb_kg = GP(const float, 8); p.sb_wo = GP(const float, 9);
    p.moe_norm = GP(const float, 10); p.moe_wg = GP(const float, 11); p.moe_bg = GP(const float, 12); p.moe_wr = GP(const float, 13); p.moe_br = GP(const float, 14);
    p.moe_wgate = GP(const float, 15); p.moe_wup = GP(const float, 16); p.moe_wdown = GP(const float, 17);
    p.x = GP(float, 18); p.ws = GP(unsigned char, 19);
    return p;
}
#define LOAD_PARAMS() const Params p = load_params()
DI int tid_() { int t = threadIdx.x; asm volatile("" : "+v"(t)); return t; }
DI int bid_() { int b = blockIdx.x; asm volatile("" : "+s"(b)); return b; }
DI int xbid_() { const int b = bid_(), G = gridDim.x; return (G % 8 == 0) ? (b % 8) * (G / 8) + b / 8 : b; }

DI unsigned cvt_pk_bf16(float lo, float hi) { unsigned r; asm volatile("v_cvt_pk_bf16_f32 %0, %1, %2" : "=v"(r) : "v"(lo), "v"(hi)); return r; }
DI float bf_lo(unsigned u) { return __uint_as_float(u << 16); }
DI float bf_hi(unsigned u) { return __uint_as_float(u & 0xffff0000u); }
DI float shflx(float v, int lane, int m) { return __int_as_float(__builtin_amdgcn_ds_bpermute((lane ^ m) << 2, __float_as_int(v))); }
DI float wave_sum(float v, int lane) {
#pragma unroll
    for (int o = 32; o >= 1; o >>= 1) v += shflx(v, lane, o);
    return v;
}
DI int perm32(int rho) { const int n = rho >> 4, i = rho & 15; return 8 * (i >> 2) + 4 * n + (i & 3); }

struct CvtTile { const float* src; bf16_t* dst; const float* scale; int K, N; };
DI CvtTile cvt_locate(const Params& p, int g) {
    int K, N, sdiv = 1; const float* sb; bf16_t* db; const float* scb = nullptr; size_t sms, dms;
    if (g < 384) { K = 1024; N = 3072; sb = p.sb_wqkv; db = (bf16_t*)(p.ws + WS_WQKV); scb = p.sb_norm; sms = (size_t)1024 * 3072; dms = sms; }
    else if ((g -= 384) < 128) { K = 1024; N = 1024; sb = p.sb_wo; db = (bf16_t*)(p.ws + WS_WO); sms = (size_t)1024 * 1024; dms = sms; }
    else if ((g -= 128) < 32) { K = 256; N = 256; sb = p.pool_w; db = (bf16_t*)(p.ws + WS_WPOOL); sms = 65536; dms = 65536; }
    else if ((g -= 32) < 2048) { K = 1024; N = 256; sb = p.moe_wgate; db = (bf16_t*)(p.ws + WS_WGU); scb = p.moe_norm; sdiv = 32; sms = (size_t)1024 * 256; dms = (size_t)512 * 1024; }
    else if ((g -= 2048) < 2048) { K = 1024; N = 256; sb = p.moe_wup; db = (bf16_t*)(p.ws + WS_WGU) + (size_t)256 * 1024; scb = p.moe_norm; sdiv = 32; sms = (size_t)1024 * 256; dms = (size_t)512 * 1024; }
    else { g -= 2048; K = 256; N = 1024; sb = p.moe_wdown; db = (bf16_t*)(p.ws + WS_WD); sms = (size_t)256 * 1024; dms = sms; }
    const int tn = N / 256, per = (K / 64) * tn, mat = g / per, rem = g % per, k0 = (rem / tn) * 64, n0 = (rem % tn) * 256;
    CvtTile t; t.K = K; t.N = N;
    t.src = sb + (size_t)mat * sms + (size_t)k0 * N + n0;
    t.dst = db + (size_t)mat * dms + (size_t)n0 * K + k0;
    t.scale = scb ? scb + (size_t)(mat / sdiv) * K + k0 : nullptr;
    return t;
}
constexpr int CVT_TILES = 384 + 128 + 32 + 2048 + 2048 + 2048;
DI void ph_prologue(LAS unsigned char* ldsb) {
    LOAD_PARAMS();
    const int tid = tid_(), bid = bid_();
    LAS float* lds = (LAS float*)ldsb;
    const int n4 = tid & 63, kq = tid >> 6;
    f32x4 regs[8]; float scl[8];
    int g = bid;
    CvtTile cur{};
    if (g < CVT_TILES) {
        cur = cvt_locate(p, g);
#pragma unroll
        for (int i = 0; i < 8; ++i) { regs[i] = __builtin_nontemporal_load((const f32x4*)(cur.src + (size_t)(kq + 8 * i) * cur.N + 4 * n4)); scl[i] = cur.scale ? cur.scale[kq + 8 * i] : 1.0f; }
    }
    for (; g < CVT_TILES; g += gridDim.x) {
        __syncthreads();
#pragma unroll
        for (int i = 0; i < 8; ++i) { const int k = kq + 8 * i; *(LAS f32x4*)(lds + k * 256 + ((4 * n4) ^ (4 * ((k >> 3) & 7)))) = regs[i] * scl[i]; }
        __syncthreads();
        const CvtTile now = cur;
        if (g + (int)gridDim.x < CVT_TILES) {
            cur = cvt_locate(p, g + gridDim.x);
#pragma unroll
            for (int i = 0; i < 8; ++i) { regs[i] = __builtin_nontemporal_load((const f32x4*)(cur.src + (size_t)(kq + 8 * i) * cur.N + 4 * n4)); scl[i] = cur.scale ? cur.scale[kq + 8 * i] : 1.0f; }
        }
#pragma unroll
        for (int it = 0; it < 4; ++it) {
            const int q = tid + 512 * it, ko = q & 7, n = q >> 3;
            float v[8];
#pragma unroll
            for (int j = 0; j < 8; ++j) v[j] = lds[(8 * ko + j) * 256 + (n ^ (4 * ko))];
            u32x4 w; w[0] = cvt_pk_bf16(v[0], v[1]); w[1] = cvt_pk_bf16(v[2], v[3]); w[2] = cvt_pk_bf16(v[4], v[5]); w[3] = cvt_pk_bf16(v[6], v[7]);
            __builtin_nontemporal_store(w, (u32x4*)(now.dst + (size_t)n * now.K + 8 * ko));
        }
    }
    bf16_t* wh = (bf16_t*)(p.ws + WS_WRH); bf16_t* wl = (bf16_t*)(p.ws + WS_WRL);
    for (int idx = bid * NTHR + tid; idx < DEPTH * 48 * DM; idx += gridDim.x * NTHR) {
        const int l = idx / (48 * DM), n = (idx / DM) % 48, k = idx % DM;
        float v = 0.f;
        if (n < 4) v = p.moe_wg[((size_t)l * DM + k) * 4 + n]; else if (n < 36) v = p.moe_wr[((size_t)l * DM + k) * 32 + (n - 4)];
        v *= p.moe_norm[l * DM + k];
        const unsigned h = cvt_pk_bf16(v, 0.f), lo = cvt_pk_bf16(v - bf_lo(h), 0.f);
        wh[idx] = (bf16_t)(h & 0xffffu); wl[idx] = (bf16_t)(lo & 0xffffu);
    }
}

DI void unpack8(const u32x4 u, float (&f)[8]) {
#pragma unroll
    for (int i = 0; i < 4; ++i) { f[2 * i] = bf_lo(u[i]); f[2 * i + 1] = bf_hi(u[i]); }
}
template <bool FINAL>
DI void ph_combine(int src_buf) {
    LOAD_PARAMS();
    const int tid = tid_(), bid = bid_(), wid = tid >> 6, lane = tid & 63;
    const bf16_t* xs = (const bf16_t*)(p.ws + (src_buf ? WS_XB1 : WS_XB));
    bf16_t* xd = (bf16_t*)(p.ws + (src_buf ? WS_XB : WS_XB1));
    const bf16_t* yb = (const bf16_t*)(p.ws + WS_YBUF);
    float* rstd = (float*)(p.ws + WS_RSTD);
    for (int t = bid * NWAVE + wid; t < T; t += gridDim.x * NWAVE) {
        float ss = 0.f;
#pragma unroll
        for (int i = 0; i < 2; ++i) {
            const size_t o = (size_t)t * DM + lane * 8 + 512 * i;
            float a[8], b[8], c[8];
            unpack8(*(const u32x4*)(xs + o), a); unpack8(*(const u32x4*)(yb + o), b); unpack8(*(const u32x4*)(yb + (size_t)T * DM + o), c);
#pragma unroll
            for (int e = 0; e < 8; ++e) a[e] += b[e] + c[e];
            if (FINAL) {
                __builtin_nontemporal_store((f32x4){a[0], a[1], a[2], a[3]}, (f32x4*)(p.x + o)); __builtin_nontemporal_store((f32x4){a[4], a[5], a[6], a[7]}, (f32x4*)(p.x + o + 4));
            } else {
                u32x4 w; w[0] = cvt_pk_bf16(a[0], a[1]); w[1] = cvt_pk_bf16(a[2], a[3]); w[2] = cvt_pk_bf16(a[4], a[5]); w[3] = cvt_pk_bf16(a[6], a[7]);
                *(u32x4*)(xd + o) = w;
                float r[8]; unpack8(w, r);
#pragma unroll
                for (int e = 0; e < 8; ++e) ss += r[e] * r[e];
            }
        }
        if (!FINAL) { ss = wave_sum(ss, lane); if (lane == 0) rstd[t] = rsqrtf(ss * (1.0f / DM) + EPS); }
    }
}

constexpr int PF_ROWS = 47, PF_TOK = 32;
DI void ph_poolfuse(LAS unsigned char* ldsb, int j, bool first) {
    LOAD_PARAMS();
    const int tid = tid_(), bid = bid_(), wid = tid >> 6, lane = tid & 63;
    const bf16_t* xs = (const bf16_t*)(p.ws + WS_XB1);
    bf16_t* xd = (bf16_t*)(p.ws + WS_XB);
    const bf16_t* yb = (const bf16_t*)(p.ws + WS_YBUF);
    const float* gain = p.pool_norm + j * DM;
    bf16_t* diff = (bf16_t*)(p.ws + WS_DIFF);
    LAS unsigned char* ht = ldsb;
    for (int tile = bid; tile < T / PF_TOK; tile += gridDim.x) {
        const int t0 = tile * PF_TOK, s0 = t0 & (SEQ - 1);
        for (int rr = wid; rr < PF_ROWS; rr += NWAVE) {
            const int t = t0 - 15 + rr;
            if (s0 == 0 && rr < 15) {
#pragma unroll
                for (int i = 0; i < 2; ++i) *(LAS u32x4*)(ht + rr * 2048 + (lane * 8 + 512 * i) * 2) = (u32x4){0u, 0u, 0u, 0u};
                continue;
            }
            float v[2][8]; u32x4 w[2]; float ss = 0.f;
#pragma unroll
            for (int i = 0; i < 2; ++i) {
                const size_t o = (size_t)t * DM + lane * 8 + 512 * i;
                if (first) {
                    const f32x4 a = *(const f32x4*)(p.x_in + o), b = *(const f32x4*)(p.x_in + o + 4);
#pragma unroll
                    for (int e = 0; e < 4; ++e) { v[i][e] = a[e]; v[i][4 + e] = b[e]; }
                } else {
                    float b[8], c[8];
                    unpack8(*(const u32x4*)(xs + o), v[i]); unpack8(*(const u32x4*)(yb + o), b); unpack8(*(const u32x4*)(yb + (size_t)T * DM + o), c);
#pragma unroll
                    for (int e = 0; e < 8; ++e) v[i][e] += b[e] + c[e];
                }
                w[i][0] = cvt_pk_bf16(v[i][0], v[i][1]); w[i][1] = cvt_pk_bf16(v[i][2], v[i][3]); w[i][2] = cvt_pk_bf16(v[i][4], v[i][5]); w[i][3] = cvt_pk_bf16(v[i][6], v[i][7]);
                if (rr >= 15) *(u32x4*)(xd + o) = w[i];
                unpack8(w[i], v[i]);
#pragma unroll
                for (int e = 0; e < 8; ++e) ss += v[i][e] * v[i][e];
            }
            ss = wave_sum(ss, lane);
            const float rs = rsqrtf(ss * (1.0f / DM) + EPS);
#pragma unroll
            for (int i = 0; i < 2; ++i) {
                u32x4 hw; hw[0] = cvt_pk_bf16(v[i][0] * rs, v[i][1] * rs); hw[1] = cvt_pk_bf16(v[i][2] * rs, v[i][3] * rs); hw[2] = cvt_pk_bf16(v[i][4] * rs, v[i][5] * rs); hw[3] = cvt_pk_bf16(v[i][6] * rs, v[i][7] * rs);
                *(LAS u32x4*)(ht + rr * 2048 + (lane * 8 + 512 * i) * 2) = hw;
            }
        }
        __syncthreads();
        {
            const int c = 2 * tid, win = 2 << (c >> 8);
            const float g0 = gain[c], g1 = gain[c + 1];
            float S0 = 0.f, S1 = 0.f;
            const LAS unsigned char* col = ht + c * 2;
#pragma unroll 4
            for (int rr = 0; rr < PF_ROWS; ++rr) {
                const unsigned hv = *(const LAS unsigned*)(col + rr * 2048);
                const float h0 = bf_lo(hv), h1 = bf_hi(hv);
                S0 += h0; S1 += h1;
                if (rr >= win) { const unsigned ov = *(const LAS unsigned*)(col + (rr - win) * 2048); S0 -= bf_lo(ov); S1 -= bf_hi(ov); }
                if (rr >= 15) {
                    const int s = s0 + rr - 15;
                    const float inv = 1.0f / (float)((s + 1 < win) ? s + 1 : win);
                    *(unsigned*)(diff + (size_t)(t0 + rr - 15) * DM + c) = cvt_pk_bf16((S0 * inv - h0) * g0, (S1 * inv - h1) * g1);
                }
            }
        }
        __syncthreads();
    }
}

struct Unit { const bf16_t* A; const bf16_t* B; int pm, pn, e, nvalid, row0, lbase; };
template <int LDA_, int LDB_, int K_, int BH_, bool HEADMAP_> struct GCfg { static constexpr int LDA = LDA_, LDB = LDB_, K = K_, BH = BH_; static constexpr bool HEADMAP = HEADMAP_; };

constexpr int BK = 64, HTB = 128 * BK * 2  , STAGE_BYTES = 8 * HTB;
DI int lds_byte(int r, int c) { const int st = (r >> 4) * 2 + (c >> 5), rr = r & 15, cc = c & 31, ob = rr * 64 + cc * 2; return st * 1024 + (ob ^ (((ob >> 9) & 1) << 5)); }
DI void stage_rc(int b, int& R, int& C) { const int st = b / 1024, sb = b % 1024, swz = sb ^ (((sb >> 9) & 1) << 5); R = (st >> 1) * 16 + swz / 64; C = (st & 1) * 32 + (swz % 64) / 2; }

template <class Cfg, class Sched, class Epi>
DI void gemm_phase(LAS unsigned char* lds, const Sched& S, const Epi& E) {
    const int tid = tid_(), wid = __builtin_amdgcn_readfirstlane(tid >> 6), lane = tid & 63, wr = wid >> 2, wc = wid & 3, fr = lane & 15, fq = lane >> 4;
    constexpr int nt = Cfg::K / BK;
    static_assert(Cfg::K % 128 == 0 && Cfg::K >= 256, "K");
    unsigned voffA[2][2], voffB[2];
    int R0, C0, R1, C1; stage_rc(tid * 16, R0, C0); stage_rc(tid * 16 + 8192, R1, C1);
    voffB[0] = (unsigned)(((Cfg::HEADMAP ? 64 * (R0 >> 5) : (R0 & ~31)) + perm32(R0 & 31)) * Cfg::LDB + C0) * 2u;
    voffB[1] = (unsigned)(((Cfg::HEADMAP ? 64 * (R1 >> 5) : (R1 & ~31)) + perm32(R1 & 31)) * Cfg::LDB + C1) * 2u;
    constexpr size_t kstep = (size_t)(BK * 2);
    constexpr size_t bhstep = (size_t)Cfg::BH * Cfg::LDB * 2;
    const unsigned ldsw = (unsigned)wid * 1024u;
    const int aoff = lds_byte(wr * 64 + fr, fq * 8), boff = lds_byte(wc * 32 + fr, fq * 8);
#define PG8_SA(b, h) (((b) * 2 + (h)) * HTB)
#define PG8_SB(b, h) ((4 + (b) * 2 + (h)) * HTB)
#define PG8_STAGE(bufoff, gbase, voff) do { _Pragma("unroll") for (int _i = 0; _i < 2; ++_i) \
        __builtin_amdgcn_global_load_lds((const unsigned*)((const char*)(gbase) + (voff)[_i]), (LAS unsigned*)(lds + (bufoff) + ldsw + _i * 8192), 16, 0, 0); } while (0)
#define PG8_LDA(dst, b, h) do { _Pragma("unroll") for (int m = 0; m < 4; ++m) _Pragma("unroll") for (int k = 0; k < 2; ++k) dst[m][k] = *(const LAS bf16x8*)(lds + PG8_SA(b, h) + aoff + m * 2048 + k * 1024); } while (0)
#define PG8_LDB(dst, b, h) do { _Pragma("unroll") for (int n = 0; n < 2; ++n) _Pragma("unroll") for (int k = 0; k < 2; ++k) dst[n][k] = *(const LAS bf16x8*)(lds + PG8_SB(b, h) + boff + n * 2048 + k * 1024); } while (0)
#define PG8_MMA(ai, bj, At, Bt) do { __builtin_amdgcn_s_setprio(1); _Pragma("unroll") for (int m = 0; m < 4; ++m) _Pragma("unroll") for (int n = 0; n < 2; ++n) _Pragma("unroll") for (int k = 0; k < 2; ++k) \
        acc[ai][bj][m][n] = __builtin_amdgcn_mfma_f32_16x16x32_bf16(Bt[n][k], At[m][k], acc[ai][bj][m][n], 0, 0, 0); __builtin_amdgcn_s_setprio(0); } while (0)
#define PG8_WAIT_V(n) asm volatile("s_waitcnt vmcnt(" #n ")" ::: "memory")
#define PG8_WAIT_L(n) asm volatile("s_waitcnt lgkmcnt(" #n ")" ::: "memory")
#define PG8_BAR __builtin_amdgcn_s_barrier()
#define PG8_SCHED __builtin_amdgcn_sched_barrier(0)
#define PG8_AROWS(uidx, un) do { voffA[0][0] = (unsigned)S.arow(uidx, un, R0) * (unsigned)(Cfg::LDA * 2) + (unsigned)(C0 * 2); voffA[0][1] = (unsigned)S.arow(uidx, un, R1) * (unsigned)(Cfg::LDA * 2) + (unsigned)(C1 * 2); \
        voffA[1][0] = (unsigned)S.arow(uidx, un, 128 + R0) * (unsigned)(Cfg::LDA * 2) + (unsigned)(C0 * 2); voffA[1][1] = (unsigned)S.arow(uidx, un, 128 + R1) * (unsigned)(Cfg::LDA * 2) + (unsigned)(C1 * 2); } while (0)
    Unit cur, nxt; int ui = 0;
    if (!S.next(0, cur)) return;
    f32x4 acc[2][2][4][2];
#pragma unroll
    for (int a = 0; a < 2; ++a)
#pragma unroll
        for (int b = 0; b < 2; ++b)
#pragma unroll
            for (int m = 0; m < 4; ++m)
#pragma unroll
                for (int n = 0; n < 2; ++n) acc[a][b][m][n] = (f32x4){0.f, 0.f, 0.f, 0.f};
    bf16x8 At[4][2], B0[2][2], B1[2][2];
    PG8_AROWS(0, cur);
    const char* cA = (const char*)cur.A; const char* cB = (const char*)cur.B;
    PG8_STAGE(PG8_SB(0, 0), cB, voffB); PG8_STAGE(PG8_SB(0, 1), cB + bhstep, voffB); PG8_STAGE(PG8_SA(0, 0), cA, voffA[0]); PG8_STAGE(PG8_SA(0, 1), cA, voffA[1]);
    if (wr == 1) PG8_BAR;
    PG8_WAIT_V(2); PG8_BAR;
    PG8_STAGE(PG8_SB(1, 0), cB + kstep, voffB); PG8_STAGE(PG8_SA(1, 0), cA + kstep, voffA[0]); PG8_STAGE(PG8_SB(1, 1), cB + bhstep + kstep, voffB);
    PG8_WAIT_V(6); PG8_BAR;
    for (;;) {
        const bool has_next = S.next(ui + 1, nxt);
        const char* nA = has_next ? (const char*)nxt.A : cA; const char* nB = has_next ? (const char*)nxt.B : cB;
#pragma unroll 1
        for (int t = 0; t < nt; t += 2) {
            const bool last = (t == nt - 2);
            const char* a1 = cA + (size_t)(t + 1) * kstep;
            const char* a2 = last ? nA : cA + (size_t)(t + 2) * kstep; const char* b2 = last ? nB : cB + (size_t)(t + 2) * kstep;
            const char* a3 = a2 + kstep; const char* b3 = b2 + kstep;
            PG8_LDB(B0, 0, 0); PG8_LDB(B1, 0, 1); PG8_SCHED; PG8_LDA(At, 0, 0); PG8_STAGE(PG8_SA(1, 1), a1, voffA[1]);
            if (last && has_next) PG8_AROWS(ui + 1, nxt);
            PG8_WAIT_V(8); PG8_WAIT_L(0); PG8_BAR; PG8_MMA(0, 0, At, B0); PG8_MMA(0, 1, At, B1); PG8_BAR; PG8_SCHED;
            PG8_LDA(At, 0, 1); PG8_STAGE(PG8_SB(0, 0), b2, voffB); PG8_STAGE(PG8_SB(0, 1), b2 + bhstep, voffB); PG8_STAGE(PG8_SA(0, 0), a2, voffA[0]);
            PG8_WAIT_V(8); PG8_WAIT_L(0); PG8_BAR; PG8_MMA(1, 0, At, B0); PG8_MMA(1, 1, At, B1); PG8_BAR; PG8_SCHED;
            PG8_LDB(B0, 1, 0); PG8_LDB(B1, 1, 1); PG8_SCHED; PG8_LDA(At, 1, 0); PG8_STAGE(PG8_SA(0, 1), a2, voffA[1]);
            PG8_WAIT_V(8); PG8_WAIT_L(0); PG8_BAR; PG8_MMA(0, 0, At, B0); PG8_MMA(0, 1, At, B1); PG8_BAR; PG8_SCHED;
            PG8_LDA(At, 1, 1); PG8_STAGE(PG8_SB(1, 0), b3, voffB); PG8_STAGE(PG8_SB(1, 1), b3 + bhstep, voffB); PG8_STAGE(PG8_SA(1, 0), a3, voffA[0]);
            PG8_WAIT_V(8); PG8_WAIT_L(0); PG8_BAR; PG8_MMA(1, 0, At, B0); PG8_MMA(1, 1, At, B1); PG8_BAR; PG8_SCHED;
        }
        if (wr == 0) PG8_BAR;
        E(acc, cur, wr, wc, fr, fq);
        if (!has_next) break;
#pragma unroll
        for (int a = 0; a < 2; ++a)
#pragma unroll
            for (int b = 0; b < 2; ++b)
#pragma unroll
                for (int m = 0; m < 4; ++m)
#pragma unroll
                    for (int n = 0; n < 2; ++n) acc[a][b][m][n] = (f32x4){0.f, 0.f, 0.f, 0.f};
        cur = nxt; cA = nA; cB = nB; ++ui;
        if (wr == 1) PG8_BAR;
    }
    PG8_WAIT_V(0);
    PG8_BAR;
#undef PG8_SA
#undef PG8_SB
#undef PG8_STAGE
#undef PG8_LDA
#undef PG8_LDB
#undef PG8_MMA
#undef PG8_WAIT_V
#undef PG8_WAIT_L
#undef PG8_BAR
#undef PG8_SCHED
#undef PG8_AROWS
}

struct SchedPool {
    const bf16_t* diff; const bf16_t* w; int bid;
    DI bool next(int i, Unit& u) const { const int L = i * gridDim.x + bid; if (L >= 256) return false; u.pm = L >> 2; u.pn = L & 3; u.A = diff + 256 * u.pn; u.B = w + (size_t)u.pn * 65536; return true; }
    DI int arow(int, const Unit& u, int r) const { return u.pm * 256 + r; }
};
struct SchedDense {
    const bf16_t* A; const bf16_t* B; int npn, ldb, bid;
    DI bool next(int i, Unit& u) const { const int L = i * gridDim.x + bid; if (L >= 64 * npn) return false; u.pm = L / npn; u.pn = L % npn; u.A = A; u.B = B + (size_t)u.pn * 256 * ldb; return true; }
    DI int arow(int, const Unit& u, int r) const { return u.pm * 256 + r; }
};

struct EpiPool {
    bf16_t* x; const float* pb; const float* ps;
    DI void operator()(const f32x4 (&acc)[2][2][4][2], const Unit& u, int wr, int wc, int fr, int fq) const {
        f32x4 bb[2][2], sc[2][2];
#pragma unroll
        for (int bj = 0; bj < 2; ++bj) {
            const int c = 256 * u.pn + 128 * bj + 32 * wc + 8 * fq;
            bb[bj][0] = *(const f32x4*)(pb + c); bb[bj][1] = *(const f32x4*)(pb + c + 4); sc[bj][0] = *(const f32x4*)(ps + c); sc[bj][1] = *(const f32x4*)(ps + c + 4);
        }
#pragma unroll
        for (int ai = 0; ai < 2; ++ai) {
            u32x4 xin[4][2];
#pragma unroll
            for (int m = 0; m < 4; ++m)
#pragma unroll
                for (int bj = 0; bj < 2; ++bj)
                    xin[m][bj] = *(const u32x4*)(x + (size_t)(u.pm * 256 + 128 * ai + 64 * wr + 16 * m + fr) * DM + 256 * u.pn + 128 * bj + 32 * wc + 8 * fq);
            asm volatile("" ::: "memory");
#pragma unroll
            for (int m = 0; m < 4; ++m) {
                const int t = u.pm * 256 + 128 * ai + 64 * wr + 16 * m + fr;
#pragma unroll
                for (int bj = 0; bj < 2; ++bj) {
                    const int c = 256 * u.pn + 128 * bj + 32 * wc + 8 * fq;
                    float xv[8]; unpack8(xin[m][bj], xv);
                    const f32x4 v0 = (acc[ai][bj][m][0] + bb[bj][0]) * sc[bj][0];
                    const f32x4 v1 = (acc[ai][bj][m][1] + bb[bj][1]) * sc[bj][1];
                    u32x4 w; w[0] = cvt_pk_bf16(xv[0] + v0[0], xv[1] + v0[1]); w[1] = cvt_pk_bf16(xv[2] + v0[2], xv[3] + v0[3]); w[2] = cvt_pk_bf16(xv[4] + v1[0], xv[5] + v1[1]); w[3] = cvt_pk_bf16(xv[6] + v1[2], xv[7] + v1[3]);
                    *(u32x4*)(x + (size_t)t * DM + c) = w;
                }
            }
        }
    }
};
struct EpiWo {
    bf16_t* x;
    DI void operator()(const f32x4 (&acc)[2][2][4][2], const Unit& u, int wr, int wc, int fr, int fq) const {
#pragma unroll
        for (int ai = 0; ai < 2; ++ai) {
            u32x4 xin[4][2];
#pragma unroll
            for (int m = 0; m < 4; ++m)
#pragma unroll
                for (int bj = 0; bj < 2; ++bj)
                    xin[m][bj] = *(const u32x4*)(x + (size_t)(u.pm * 256 + 128 * ai + 64 * wr + 16 * m + fr) * DM + 256 * u.pn + 128 * bj + 32 * wc + 8 * fq);
            asm volatile("" ::: "memory");
#pragma unroll
            for (int m = 0; m < 4; ++m) {
                const int t = u.pm * 256 + 128 * ai + 64 * wr + 16 * m + fr;
#pragma unroll
                for (int bj = 0; bj < 2; ++bj) {
                    const int c = 256 * u.pn + 128 * bj + 32 * wc + 8 * fq;
                    float xv[8]; unpack8(xin[m][bj], xv);
                    const f32x4 v0 = acc[ai][bj][m][0], v1 = acc[ai][bj][m][1];
                    u32x4 w; w[0] = cvt_pk_bf16(xv[0] + v0[0], xv[1] + v0[1]); w[1] = cvt_pk_bf16(xv[2] + v0[2], xv[3] + v0[3]); w[2] = cvt_pk_bf16(xv[4] + v1[0], xv[5] + v1[1]); w[3] = cvt_pk_bf16(xv[6] + v1[2], xv[7] + v1[3]);
                    *(u32x4*)(x + (size_t)t * DM + c) = w;
                }
            }
        }
    }
};
struct EpiQKV {
    bf16_t* q; const float* rstd; const float* qg; const float* kg;
    DI void operator()(const f32x4 (&acc)[2][2][4][2], const Unit& u, int wr, int wc, int fr, int fq) const {
        const int which = u.pn >> 2, head = (u.pn & 3) * 4 + wc;
        bf16_t* out = q + (size_t)which * ((WS_K - WS_Q) / 2);
        const float* gn = which == 0 ? qg : kg;
        const float post = which == 0 ? 0.125f * 1.4426950408889634f : 1.0f;
        f32x4 g[2][2];
#pragma unroll
        for (int bj = 0; bj < 2; ++bj)
#pragma unroll
            for (int n = 0; n < 2; ++n) g[bj][n] = (which < 2) ? *(const f32x4*)(gn + 32 * bj + 8 * fq + 4 * n) * post : (f32x4){1.f, 1.f, 1.f, 1.f};
        float rsv[2][4];
#pragma unroll
        for (int ai = 0; ai < 2; ++ai)
#pragma unroll
            for (int m = 0; m < 4; ++m) rsv[ai][m] = rstd[u.pm * 256 + 128 * ai + 64 * wr + 16 * m + fr];
#pragma unroll
        for (int ai = 0; ai < 2; ++ai)
#pragma unroll
            for (int m = 0; m < 4; ++m) {
                const int t = u.pm * 256 + 128 * ai + 64 * wr + 16 * m + fr;
                const float rs = rsv[ai][m];
                f32x4 v4[2][2]; float ss = 0.f;
#pragma unroll
                for (int bj = 0; bj < 2; ++bj)
#pragma unroll
                    for (int n = 0; n < 2; ++n) { v4[bj][n] = acc[ai][bj][m][n] * rs; const f32x4 s = v4[bj][n] * v4[bj][n]; ss += (s[0] + s[1]) + (s[2] + s[3]); }
                ss += shflx(ss, fr + 16 * fq, 16); ss += shflx(ss, fr + 16 * fq, 32);
                const float r2 = (which < 2) ? rsqrtf(ss * (1.0f / HD) + EPS) : 1.0f;
#pragma unroll
                for (int bj = 0; bj < 2; ++bj) {
                    const f32x4 a = v4[bj][0] * r2 * g[bj][0], b = v4[bj][1] * r2 * g[bj][1];
                    u32x4 w; w[0] = cvt_pk_bf16(a[0], a[1]); w[1] = cvt_pk_bf16(a[2], a[3]); w[2] = cvt_pk_bf16(b[0], b[1]); w[3] = cvt_pk_bf16(b[2], b[3]);
                    *(u32x4*)(out + (size_t)t * DM + head * HD + 32 * bj + 8 * fq) = w;
                }
            }
    }
};

typedef short v4i16_t __attribute__((ext_vector_type(4)));
constexpr int AT_VPITCH = 192;
constexpr int AT_VTILE = 32 * AT_VPITCH;
DI void ph_attn(LAS unsigned char* ldsb) {
    LOAD_PARAMS();
    const int tid = tid_(), bid = bid_(), wid = tid >> 6, lane = tid & 63, l31 = lane & 31, h2 = lane >> 5;
    const bf16_t* Q = (const bf16_t*)(p.ws + WS_Q); const bf16_t* K = (const bf16_t*)(p.ws + WS_K); const bf16_t* V = (const bf16_t*)(p.ws + WS_V);
    bf16_t* O = (bf16_t*)(p.ws + WS_O);
    LAS unsigned char* vl = ldsb + wid * AT_VTILE;
    LAS unsigned char* vw = vl + (lane >> 3) * AT_VPITCH + (lane & 7) * 16;
    const LAS unsigned char* vr = vl + (4 * h2 + ((lane & 15) >> 2)) * AT_VPITCH + (16 * ((lane >> 4) & 1) + 4 * (lane & 3)) * 2;
    for (int it = 0; it < 4 * ((2 * NH * 256 / 32 - bid + (int)gridDim.x - 1) / (int)gridDim.x); ++it) {
        const int tsk = (bid + (it >> 2) * gridDim.x) * 32 + (it & 3) * 8 + wid;
        const int bh = tsk >> 8, qb = tsk & 255, b = bh >> 4, h = bh & 15;
        const size_t tb = (size_t)b * SEQ;
        const int q0 = qb * 32;
        bf16x8 qf[4];
#pragma unroll
        for (int s = 0; s < 4; ++s) qf[s] = *(const bf16x8*)(Q + (tb + q0 + l31) * DM + h * HD + 16 * s + 8 * h2);
        f32x16 o0, o1;
#pragma unroll
        for (int r = 0; r < 16; ++r) { o0[r] = 0.f; o1[r] = 0.f; }
        float R = 1.f;
        const bf16_t* kp = K + (tb + q0 + l31) * DM + h * HD + 8 * h2;
        const bf16_t* vp = V + (tb + q0 + (lane >> 3)) * DM + h * HD + (lane & 7) * 8;
        bf16x8 kn[4], kq[4]; u32x4 vn[4], vq[4];
#pragma unroll
        for (int s = 0; s < 4; ++s) { kn[s] = *(const bf16x8*)(kp + 16 * s); vn[s] = *(const u32x4*)(vp + (size_t)8 * s * DM); }
        if (qb > 0) {
            kp -= (size_t)32 * DM; vp -= (size_t)32 * DM;
#pragma unroll
            for (int s = 0; s < 4; ++s) { kq[s] = *(const bf16x8*)(kp + 16 * s); vq[s] = *(const u32x4*)(vp + (size_t)8 * s * DM); }
        }
        for (int kt = qb; kt >= 0; --kt) {
            bf16x8 kf[4];
#pragma unroll
            for (int s = 0; s < 4; ++s) { kf[s] = kn[s]; *(LAS u32x4*)(vw + 8 * s * AT_VPITCH) = vn[s]; kn[s] = kq[s]; vn[s] = vq[s]; }
            if (kt > 1) {
                kp -= (size_t)32 * DM; vp -= (size_t)32 * DM;
#pragma unroll
                for (int s = 0; s < 4; ++s) { kq[s] = *(const bf16x8*)(kp + 16 * s); vq[s] = *(const u32x4*)(vp + (size_t)8 * s * DM); }
            }
            f32x16 z;
#pragma unroll
            for (int r = 0; r < 16; ++r) z[r] = 0.f;
#pragma unroll
            for (int s = 0; s < 4; ++s) z = __builtin_amdgcn_mfma_f32_32x32x16_bf16(kf[s], qf[s], z, 0, 0, 0);
            float kp_[16], gs[4], ot[4];
#pragma unroll
            for (int r = 0; r < 16; ++r) kp_[r] = __builtin_amdgcn_rcpf(1.0f + __builtin_amdgcn_exp2f(z[r]));
            if (kt == qb) {
#pragma unroll
                for (int r = 0; r < 16; ++r) { const int kl = (r & 3) + 8 * (r >> 2) + 4 * h2; kp_[r] = (kl < l31) ? kp_[r] : 1.0f; }
            }
#pragma unroll
            for (int bb = 0; bb < 4; ++bb) { gs[bb] = (kp_[4 * bb] * kp_[4 * bb + 1]) * (kp_[4 * bb + 2] * kp_[4 * bb + 3]); ot[bb] = shflx(gs[bb], lane, 32); }
            const float tot_own = (gs[0] * gs[1]) * (gs[2] * gs[3]);
            const float tot_oth = (ot[0] * ot[1]) * (ot[2] * ot[3]);
            float later[4];
            {
                float own_tail = 1.f, oth_tail = 1.f;
#pragma unroll
                for (int bb = 3; bb >= 0; --bb) {
                    later[bb] = own_tail * oth_tail * (h2 == 0 ? ot[bb] : 1.f);
                    own_tail *= gs[bb]; oth_tail *= ot[bb];
                }
            }
            float a[16];
#pragma unroll
            for (int bb = 0; bb < 4; ++bb) {
                const float x3 = R * later[bb];
                const float x2 = x3 * kp_[4 * bb + 3], x1 = x2 * kp_[4 * bb + 2], x0 = x1 * kp_[4 * bb + 1];
                a[4 * bb] = x0 - x0 * kp_[4 * bb]; a[4 * bb + 1] = x1 - x1 * kp_[4 * bb + 1]; a[4 * bb + 2] = x2 - x2 * kp_[4 * bb + 2]; a[4 * bb + 3] = x3 - x3 * kp_[4 * bb + 3];
            }
            R *= (h2 == 0) ? (tot_own * tot_oth) : (tot_oth * tot_own);
#pragma unroll
            for (int s = 0; s < 2; ++s) {
                u32x4 pw;
#pragma unroll
                for (int i = 0; i < 4; ++i) pw[i] = cvt_pk_bf16(a[8 * s + 2 * i], a[8 * s + 2 * i + 1]);
                const bf16x8 pa = __builtin_bit_cast(bf16x8, pw);
#pragma unroll
                for (int db = 0; db < 2; ++db) {
                    const v4i16_t lo4 = __builtin_amdgcn_ds_read_tr16_b64_v4i16((LAS v4i16_t*)(vr + (16 * s) * AT_VPITCH + 64 * db));
                    const v4i16_t hi4 = __builtin_amdgcn_ds_read_tr16_b64_v4i16((LAS v4i16_t*)(vr + (16 * s + 8) * AT_VPITCH + 64 * db));
                    bf16x8 vf; vf[0] = lo4[0]; vf[1] = lo4[1]; vf[2] = lo4[2]; vf[3] = lo4[3]; vf[4] = hi4[0]; vf[5] = hi4[1]; vf[6] = hi4[2]; vf[7] = hi4[3];
                    if (db == 0) o0 = __builtin_amdgcn_mfma_f32_32x32x16_bf16(vf, pa, o0, 0, 0, 0);
                    else o1 = __builtin_amdgcn_mfma_f32_32x32x16_bf16(vf, pa, o1, 0, 0, 0);
                }
            }
            if (__all(R < 1.0e-36f)) break;
        }
#pragma unroll
        for (int db = 0; db < 2; ++db)
#pragma unroll
            for (int rb = 0; rb < 4; ++rb) {
                const f32x16& o = db == 0 ? o0 : o1;
                u32x2 w; w[0] = cvt_pk_bf16(o[4 * rb], o[4 * rb + 1]); w[1] = cvt_pk_bf16(o[4 * rb + 2], o[4 * rb + 3]);
                *(u32x2*)(O + (tb + q0 + l31) * DM + h * HD + 32 * db + 8 * rb + 4 * h2) = w;
            }
    }
}

constexpr int RT_PART = 0;
constexpr int RT_SSQ = RT_PART + 4 * 64 * 52 * 4;
constexpr int RT_LCNT = RT_SSQ + 4 * 64 * 4;
constexpr int RT_GB = RT_LCNT + 128;
DI void ph_router(LAS unsigned char* lds, int li) {
    LOAD_PARAMS();
    const bf16_t* xcur = (const bf16_t*)(p.ws + ((li & 1) ? WS_XB1 : WS_XB));
    const int tid = tid_(), bid = bid_(), wid = tid >> 6, lane = tid & 63, fr = lane & 15, fq = lane >> 4;
    const bf16_t* wh = (const bf16_t*)(p.ws + WS_WRH) + (size_t)li * 48 * DM;
    const bf16_t* wl = (const bf16_t*)(p.ws + WS_WRL) + (size_t)li * 48 * DM;
    const float* bg = p.moe_bg + li * 4;
    const float* br = p.moe_br + li * 32;
    unsigned* cnt = (unsigned*)(p.ws + WS_CTL) + CW_CNT + 32 * li;
    Entry* list = (Entry*)(p.ws + WS_LIST);
    LAS float* part = (LAS float*)(lds + RT_PART); LAS float* ssq = (LAS float*)(lds + RT_SSQ);
    LAS int* lcnt = (LAS int*)(lds + RT_LCNT); LAS int* gb = (LAS int*)(lds + RT_GB);
    const int th = wid & 1, kq = wid >> 1;
    for (int chunk = bid; chunk < T / 64; chunk += gridDim.x) {
        const int t = chunk * 64 + th * 32 + fr;
        const bf16_t* xr = xcur + (size_t)t * DM + kq * 256 + fq * 8;
        const bf16_t* whr = wh + (size_t)fr * DM + kq * 256 + fq * 8;
        const bf16_t* wlr = wl + (size_t)fr * DM + kq * 256 + fq * 8;
        f32x4 acc[2][3]; float ss[2] = {0.f, 0.f};
#pragma unroll
        for (int b = 0; b < 2; ++b)
#pragma unroll
            for (int nb = 0; nb < 3; ++nb) acc[b][nb] = (f32x4){0.f, 0.f, 0.f, 0.f};
#pragma unroll 4
        for (int ks = 0; ks < 8; ++ks) {
            bf16x8 xh[2];
#pragma unroll
            for (int b = 0; b < 2; ++b) {
                const u32x4 xw = *(const u32x4*)(xr + (size_t)b * 16 * DM + ks * 32);
                float xf[8]; unpack8(xw, xf);
#pragma unroll
                for (int e = 0; e < 8; ++e) ss[b] += xf[e] * xf[e];
                xh[b] = __builtin_bit_cast(bf16x8, xw);
            }
#pragma unroll
            for (int nb = 0; nb < 3; ++nb) {
                const bf16x8 wH = *(const bf16x8*)(whr + (size_t)nb * 16 * DM + ks * 32), wL = *(const bf16x8*)(wlr + (size_t)nb * 16 * DM + ks * 32);
#pragma unroll
                for (int b = 0; b < 2; ++b) {
                    acc[b][nb] = __builtin_amdgcn_mfma_f32_16x16x32_bf16(wH, xh[b], acc[b][nb], 0, 0, 0);
                    acc[b][nb] = __builtin_amdgcn_mfma_f32_16x16x32_bf16(wL, xh[b], acc[b][nb], 0, 0, 0);
                }
            }
        }
#pragma unroll
        for (int b = 0; b < 2; ++b) {
            float sv = ss[b]; sv += shflx(sv, lane, 16); sv += shflx(sv, lane, 32);
            const int tl = th * 32 + 16 * b + fr;
#pragma unroll
            for (int nb = 0; nb < 3; ++nb) *(LAS f32x4*)(part + (kq * 64 + tl) * 52 + 16 * nb + 4 * fq) = acc[b][nb];
            if (fq == 0) ssq[kq * 64 + tl] = sv;
        }
        if (tid < 32) lcnt[tid] = 0;
        __syncthreads();
        int ea = 0, eb = 0, la = 0, lb = 0; float w1 = 0.f, w2 = 0.f, rs = 0.f;
        if (tid < 64) {
            rs = rsqrtf(((ssq[tid] + ssq[64 + tid]) + (ssq[128 + tid] + ssq[192 + tid])) * (1.0f / DM) + EPS);
            float lg[36];
#pragma unroll
            for (int q = 0; q < 9; ++q) {
                const f32x4 u0 = *(const LAS f32x4*)(part + tid * 52 + 4 * q), u1 = *(const LAS f32x4*)(part + (64 + tid) * 52 + 4 * q);
                const f32x4 u2 = *(const LAS f32x4*)(part + (128 + tid) * 52 + 4 * q), u3 = *(const LAS f32x4*)(part + (192 + tid) * 52 + 4 * q);
#pragma unroll
                for (int e = 0; e < 4; ++e) lg[4 * q + e] = ((u0[e] + u1[e]) + (u2[e] + u3[e])) * rs;
            }
            float gl[4];
#pragma unroll
            for (int n = 0; n < 4; ++n) gl[n] = lg[n] + bg[n];
            int g = 0; float gm = gl[0];
#pragma unroll
            for (int n = 1; n < 4; ++n) if (gl[n] > gm) { gm = gl[n]; g = n; }
            float den = 0.f;
#pragma unroll
            for (int n = 0; n < 4; ++n) den += __expf(gl[n] - gm);
            const float gprob = 1.0f / den;
            float el[8];
#pragma unroll
            for (int n = 0; n < 8; ++n) {
                float v = 0.f;
#pragma unroll
                for (int gg = 0; gg < 4; ++gg) v = (g == gg) ? lg[4 + 8 * gg + n] + br[8 * gg + n] : v;
                el[n] = v;
            }
            int e1 = 0; float m1 = el[0];
#pragma unroll
            for (int n = 1; n < 8; ++n) if (el[n] > m1) { m1 = el[n]; e1 = n; }
            int e2 = -1; float m2 = -3.0e38f;
#pragma unroll
            for (int n = 0; n < 8; ++n) if (n != e1 && (e2 < 0 || el[n] > m2)) { m2 = el[n]; e2 = n; }
            const float ex = __expf(m2 - m1);
            w1 = gprob / (1.0f + ex); w2 = gprob * ex / (1.0f + ex);
            ea = 8 * g + e1; eb = 8 * g + e2;
            la = __hip_atomic_fetch_add(lcnt + ea, 1, __ATOMIC_RELAXED, __HIP_MEMORY_SCOPE_WORKGROUP);
            lb = __hip_atomic_fetch_add(lcnt + eb, 1, __ATOMIC_RELAXED, __HIP_MEMORY_SCOPE_WORKGROUP);
        }
        __syncthreads();
        if (tid < 32) { const int c = lcnt[tid]; gb[tid] = c ? (int)atomicAdd(&cnt[tid], (unsigned)c) : 0; }
        __syncthreads();
        if (tid < 64) {
            const int tt = chunk * 64 + tid;
            Entry A; A.dst = tt; A.rstd = rs; A.w = w1; A.tok = tt;
            Entry B; B.dst = T + tt; B.rstd = rs; B.w = w2; B.tok = tt;
            list[(size_t)ea * LIST_CAP + gb[ea] + la] = A;
            list[(size_t)eb * LIST_CAP + gb[eb] + lb] = B;
        }
        __syncthreads();
    }
}

constexpr int MOE_MAXU = 4;
constexpr int LDS_ROWTAB = STAGE_BYTES;
constexpr int LDS_EPITAB = LDS_ROWTAB + MOE_MAXU * 1024;
constexpr int LDS_UTAB = LDS_EPITAB + MOE_MAXU * 2048;
constexpr int LDS_XBW = LDS_UTAB + MOE_MAXU * 32;
constexpr int LDS_BYTES = 147456;
static_assert(LDS_XBW + 16 <= LDS_BYTES, "LDS map");
struct SchedMoe {
    LAS unsigned char* lds; const bf16_t* A; const bf16_t* W; bool gather; size_t w_estride; int w_pnrows, ldb;
    DI void build(const unsigned* cnt, const Entry* list, int npn, int lo, int hi, int first, int stride, int tid) {
        LAS int* ut = (LAS int*)(lds + LDS_UTAB); LAS unsigned* rt = (LAS unsigned*)(lds + LDS_ROWTAB);
        const int lane = tid & 63;
        if (tid < 64) {
            const int c = (int)cnt[lane & 31], ntl = (c + 255) >> 8;
            int inc = ntl;
#pragma unroll
            for (int d = 1; d < 32; d <<= 1) { const int v = __builtin_amdgcn_ds_bpermute(((lane - d) & 63) << 2, inc); if ((lane & 31) >= d) inc += v; }
            const int exc = inc - ntl;
#pragma unroll
            for (int i = 0; i < MOE_MAXU; ++i) {
                const int L = lo + first + i * stride, rtile = L / npn, pn = L % npn;
                const bool hit = (first >= 0) && (L < hi) && (lane < 32) && (rtile >= exc) && (rtile < inc);
                const unsigned long long mask = __ballot(hit);
                int found = 0, e = 0, j = 0, nv = 0;
                if (mask) {
                    found = 1; e = __builtin_ctzll(mask);
                    j = rtile - __builtin_amdgcn_readlane(exc, e); nv = __builtin_amdgcn_readlane(c, e) - 256 * j; nv = nv > 256 ? 256 : nv;
                }
                if (lane == 0) { ut[i * 8 + 0] = found; ut[i * 8 + 1] = e; ut[i * 8 + 2] = nv; ut[i * 8 + 3] = 256 * rtile; ut[i * 8 + 4] = e * LIST_CAP + 256 * j; ut[i * 8 + 5] = pn; }
            }
        }
        __syncthreads();
        if (tid < 256) {
#pragma unroll
            for (int i = 0; i < MOE_MAXU; ++i) {
                if (!ut[i * 8]) continue;
                const int nv = ut[i * 8 + 2], lb = ut[i * 8 + 4];
                Entry en; en.dst = DUMMY_ROW; en.rstd = 0.f; en.w = 0.f; en.tok = 0;
                if (tid < nv) en = list[lb + tid];
                LAS float* et = (LAS float*)(lds + LDS_EPITAB) + (i * 256 + tid) * 2;
                if (gather) { rt[i * 256 + tid] = (unsigned)en.tok; et[0] = en.rstd; et[1] = en.w; }
                else { et[0] = __int_as_float(en.dst); et[1] = 0.f; }
            }
        }
        asm volatile("s_waitcnt vmcnt(0) lgkmcnt(0)" ::: "memory");
        __syncthreads();
    }
    DI bool next(int i, Unit& u) const {
        if (i >= MOE_MAXU) return false;
        const LAS int* ut = (const LAS int*)(lds + LDS_UTAB) + i * 8;
        const int found = __builtin_amdgcn_readfirstlane(ut[0]);
        if (!found) return false;
        u.e = __builtin_amdgcn_readfirstlane(ut[1]); u.nvalid = __builtin_amdgcn_readfirstlane(ut[2]); u.row0 = __builtin_amdgcn_readfirstlane(ut[3]);
        u.lbase = i * 256; u.pn = __builtin_amdgcn_readfirstlane(ut[5]); u.pm = u.row0 >> 8;
        u.A = gather ? A : A + (size_t)u.row0 * DE;
        u.B = W + (size_t)u.e * w_estride + (size_t)u.pn * w_pnrows * ldb;
        return true;
    }
    DI int arow(int ui, const Unit&, int r) const { if (!gather) return r; return (int)((const LAS unsigned*)(lds + LDS_ROWTAB))[ui * 256 + r]; }
};
struct EpiGU {
    bf16_t* hid; LAS unsigned char* lds;
    DI void operator()(const f32x4 (&acc)[2][2][4][2], const Unit& u, int wr, int wc, int fr, int fq) const {
        typedef float f32x2 __attribute__((ext_vector_type(2)));
#pragma unroll
        for (int ai = 0; ai < 2; ++ai)
#pragma unroll
            for (int m = 0; m < 4; ++m) {
                const int r = 128 * ai + 64 * wr + 16 * m + fr;
                const f32x2 rw = *(const LAS f32x2*)(lds + LDS_EPITAB + (u.lbase + r) * 8);
                const float rs = rw[0], w = rw[1];
                unsigned pk[4];
#pragma unroll
                for (int n = 0; n < 2; ++n) {
                    float hv[4];
#pragma unroll
                    for (int e = 0; e < 4; ++e) { const float g = acc[ai][0][m][n][e] * rs, up = acc[ai][1][m][n][e] * rs; hv[e] = g * __builtin_amdgcn_rcpf(1.0f + __builtin_amdgcn_exp2f(-1.4426950408889634f * g)) * up * w; }
                    pk[2 * n] = cvt_pk_bf16(hv[0], hv[1]); pk[2 * n + 1] = cvt_pk_bf16(hv[2], hv[3]);
                }
                u32x4 wv; wv[0] = pk[0]; wv[1] = pk[1]; wv[2] = pk[2]; wv[3] = pk[3];
                *(u32x4*)(hid + (size_t)(u.row0 + r) * DE + 128 * u.pn + 32 * wc + 8 * fq) = wv;
            }
    }
};
struct EpiDown {
    bf16_t* yb; LAS unsigned char* lds;
    DI void operator()(const f32x4 (&acc)[2][2][4][2], const Unit& u, int wr, int wc, int fr, int fq) const {
#pragma unroll
        for (int ai = 0; ai < 2; ++ai)
#pragma unroll
            for (int m = 0; m < 4; ++m) {
                const int r = 128 * ai + 64 * wr + 16 * m + fr;
                const int dst = *(const LAS int*)(lds + LDS_EPITAB + (u.lbase + r) * 8);
                if (dst == DUMMY_ROW) continue;
#pragma unroll
                for (int bj = 0; bj < 2; ++bj) {
                    const f32x4 a = acc[ai][bj][m][0], b = acc[ai][bj][m][1];
                    u32x4 w; w[0] = cvt_pk_bf16(a[0], a[1]); w[1] = cvt_pk_bf16(a[2], a[3]); w[2] = cvt_pk_bf16(b[0], b[1]); w[3] = cvt_pk_bf16(b[2], b[3]);
                    *(u32x4*)(yb + (size_t)dst * DM + 256 * u.pn + 128 * bj + 32 * wc + 8 * fq) = w;
                }
            }
    }
};

DI void ph_poolgemm(LAS unsigned char* lds, int j) {
    LOAD_PARAMS();
    SchedPool S; S.bid = xbid_(); S.diff = (const bf16_t*)(p.ws + WS_DIFF); S.w = (const bf16_t*)(p.ws + WS_WPOOL) + (size_t)j * 4 * 65536;
    EpiPool E; E.x = (bf16_t*)(p.ws + WS_XB); E.pb = p.pool_b + j * DM; E.ps = p.pool_scale + j * DM;
    gemm_phase<GCfg<1024, 256, 256, 128, false>>(lds, S, E);
}
DI void ph_qkv(LAS unsigned char* lds, int j) {
    LOAD_PARAMS();
    SchedDense S; S.bid = xbid_(); S.A = (const bf16_t*)(p.ws + WS_XB1); S.B = (const bf16_t*)(p.ws + WS_WQKV) + (size_t)j * 3072 * 1024; S.npn = 12; S.ldb = 1024;
    EpiQKV E; E.q = (bf16_t*)(p.ws + WS_Q); E.rstd = (const float*)(p.ws + WS_RSTD); E.qg = p.sb_qg + j * HD; E.kg = p.sb_kg + j * HD;
    gemm_phase<GCfg<1024, 1024, 1024, 32, true>>(lds, S, E);
}
DI void ph_wo(LAS unsigned char* lds, int j) {
    LOAD_PARAMS();
    SchedDense S; S.bid = xbid_(); S.A = (const bf16_t*)(p.ws + WS_O); S.B = (const bf16_t*)(p.ws + WS_WO) + (size_t)j * 1024 * 1024; S.npn = 4; S.ldb = 1024;
    EpiWo E; E.x = (bf16_t*)(p.ws + WS_XB1);
    gemm_phase<GCfg<1024, 1024, 1024, 128, false>>(lds, S, E);
}
struct MoePlan { int NT, R1, nB, D1; };
DI MoePlan moe_plan(const unsigned* cnt) {
    const int lane = tid_() & 63;
    int nt = ((int)cnt[lane & 31] + 255) >> 8;
#pragma unroll
    for (int o = 1; o < 32; o <<= 1) nt += __builtin_amdgcn_ds_bpermute((lane ^ o) << 2, nt);
    nt = __builtin_amdgcn_readfirstlane(nt);
    MoePlan m; m.NT = nt; const int G = gridDim.x; m.R1 = nt < G / 2 ? nt : G / 2;
    const int late = 2 * (nt - m.R1); m.nB = late < G ? late : G;
    const int cap = 2 * (G - m.nB); m.D1 = 4 * m.R1 < cap ? 4 * m.R1 : cap;
    return m;
}
DI void ph_gu(LAS unsigned char* lds, int li, int stage, const MoePlan m) {
    LOAD_PARAMS();
    const Entry* list = (const Entry*)(p.ws + WS_LIST);
    const unsigned* cnt = (const unsigned*)(p.ws + WS_CTL) + CW_CNT + 32 * li;
    const int bid = xbid_();
    if (stage == 2 || (stage == 1 && bid >= m.nB)) return;
    SchedMoe S; S.lds = lds; S.A = (const bf16_t*)(p.ws + ((li & 1) ? WS_XB1 : WS_XB));
    S.W = (const bf16_t*)(p.ws + WS_WGU) + (size_t)li * NE * 512 * 1024; S.gather = true; S.w_estride = (size_t)512 * 1024; S.w_pnrows = 128; S.ldb = 1024;
    const int lo = stage == 0 ? 0 : 2 * m.R1, hi = stage == 0 ? 2 * m.R1 : 2 * m.NT, G = gridDim.x;
    EpiGU E; E.hid = (bf16_t*)(p.ws + WS_HID); E.lds = lds;
    for (int first = bid; lo + first < hi; first += MOE_MAXU * G) {
        S.build(cnt, list, 2, lo, hi, first, G, tid_());
        gemm_phase<GCfg<1024, 1024, 1024, 256, false>>(lds, S, E);
        __syncthreads();
    }
}
DI void ph_down(LAS unsigned char* lds, int li, int stage, const MoePlan m) {
    LOAD_PARAMS();
    const Entry* list = (const Entry*)(p.ws + WS_LIST);
    const unsigned* cnt = (const unsigned*)(p.ws + WS_CTL) + CW_CNT + 32 * li;
    const int bid = xbid_(), G = gridDim.x;
    if (stage == 0 || (stage == 1 && bid < m.nB)) return;
    SchedMoe S; S.lds = lds; S.A = (const bf16_t*)(p.ws + WS_HID);
    S.W = (const bf16_t*)(p.ws + WS_WD) + (size_t)li * NE * 1024 * 256; S.gather = false; S.w_estride = (size_t)1024 * 256; S.w_pnrows = 256; S.ldb = 256;
    const int lo = stage == 1 ? 0 : m.D1, hi = stage == 1 ? m.D1 : 4 * m.NT, stride = stage == 1 ? G - m.nB : G;
    EpiDown E; E.yb = (bf16_t*)(p.ws + WS_YBUF); E.lds = lds;
    for (int first = stage == 1 ? bid - m.nB : bid; lo + first < hi; first += MOE_MAXU * stride) {
        S.build(cnt, list, 4, lo, hi, first, stride, tid_());
        gemm_phase<GCfg<256, 256, 256, 128, false>>(lds, S, E);
        __syncthreads();
    }
}
DI MoePlan moe_layer_plan(int li) {
    LOAD_PARAMS();
    return moe_plan((const unsigned*)(p.ws + WS_CTL) + CW_CNT + 32 * li);
}

#define XB_TMO      128
#define XB_XCNT(j)  (256  + 64 * (j))
#define XB_XSUB(j)  (1280 + 64 * (j))
#define XB_XGEN(j)  (2304 + 64 * (j))
#define XB_TOP      3328
#define XB_TOPGEN   3392
#define XCD_BAR_WORDS 3456
#define XB_SPIN_CAP (1u << 18)

__device__ __forceinline__ unsigned xb_ld(unsigned* p)              { return __hip_atomic_load(p, __ATOMIC_RELAXED, __HIP_MEMORY_SCOPE_AGENT); }
__device__ __forceinline__ unsigned xb_add(unsigned* p, unsigned v) { return __hip_atomic_fetch_add(p, v, __ATOMIC_RELAXED, __HIP_MEMORY_SCOPE_AGENT); }
__device__ __forceinline__ unsigned xb_xcc_id() { return (unsigned)__builtin_amdgcn_s_getreg((3 << 11) | 20) & 0xFu; }
#define XB_SPIN(cond, bar) do { unsigned _sp = 0; while (cond) { __builtin_amdgcn_s_sleep(1); \
    if ((++_sp & 255u) == 0u) { if (xb_ld(&(bar)[XB_TMO])) break; if (_sp > XB_SPIN_CAP) { atomicAdd(&(bar)[XB_TMO], 1u); break; } } } } while (0)

struct XcdBarrier {
    unsigned* bar; unsigned x;
    volatile LAS unsigned* st;
};

__device__ __forceinline__ XcdBarrier xcd_barrier_post(unsigned* bar, volatile LAS unsigned* st) {
    XcdBarrier b; b.bar = bar; b.x = xb_xcc_id(); b.st = st;
    if (threadIdx.x == 0) (void)xb_add(&bar[XB_XCNT(b.x)], 1u);
    return b;
}
__device__ __forceinline__ void xcd_barrier_complete(unsigned* bar, unsigned x, unsigned& nloc, unsigned& nx) {
    const unsigned G = gridDim.x * gridDim.y * gridDim.z;
    unsigned sum, cnt, mine, sp = 0u;
    for (;;) {
        sum = 0u; cnt = 0u; mine = 0u;
#pragma unroll
        for (unsigned j = 0; j < 16; ++j) { const unsigned c = xb_ld(&bar[XB_XCNT(j)]); sum += c; cnt += (c > 0u) ? 1u : 0u; mine = (j == x) ? c : mine; }
        if (sum == G) break;
        __builtin_amdgcn_s_sleep(1);
        if ((++sp & 255u) == 0u) { if (xb_ld(&bar[XB_TMO])) break; if (sp > XB_SPIN_CAP) { atomicAdd(&bar[XB_TMO], 1u); break; } }
    }
    nloc = mine > 0u ? mine : 1u; nx = cnt > 0u ? cnt : 1u;
}

__device__ __forceinline__ void xcd_barrier(const XcdBarrier& b) {
    asm volatile("s_waitcnt vmcnt(0)" ::: "memory");
    __syncthreads();
    if (threadIdx.x == 0) {
        unsigned* bar = b.bar; unsigned bx = b.x;
        asm volatile("" : "+s"(bar), "+s"(bx));
        __builtin_amdgcn_s_waitcnt(0);
        unsigned nloc = b.st[0], nx = b.st[1];
        if (nloc == 0u) { xcd_barrier_complete(bar, bx, nloc, nx); b.st[0] = nloc; b.st[1] = nx; }
        const unsigned old = xb_add(&bar[XB_XSUB(bx)], 1u);
        const unsigned gen = old / nloc;
        if (old + 1u == (gen + 1u) * nloc) {
            __builtin_amdgcn_fence(__ATOMIC_RELEASE, "agent");
            asm volatile("s_waitcnt vmcnt(0)" ::: "memory");
            const unsigned og = xb_add(&bar[XB_TOP], 1u);
            const unsigned tg = og / nx;
            if (og + 1u == (tg + 1u) * nx) xb_add(&bar[XB_TOPGEN], 1u);
            else XB_SPIN(xb_ld(&bar[XB_TOPGEN]) == tg, bar);
            __builtin_amdgcn_fence(__ATOMIC_ACQUIRE, "agent");
            xb_add(&bar[XB_XGEN(bx)], 1u);
            asm volatile("s_waitcnt vmcnt(0)" ::: "memory");
        } else {
            XB_SPIN(xb_ld(&bar[XB_XGEN(bx)]) == gen, bar);
            __builtin_amdgcn_fence(__ATOMIC_ACQUIRE, "agent");
            asm volatile("s_waitcnt vmcnt(0)" ::: "memory");
        }
    }
    __syncthreads();
}
constexpr int CW_BAR = 4096;

extern __shared__ __attribute__((aligned(16))) unsigned char smem_raw[];
__global__ void __launch_bounds__(NTHR, 2) fwd(Params pk) {
    LAS unsigned char* smem = (LAS unsigned char*)smem_raw;
    if (threadIdx.x < 4) ((LAS unsigned*)(smem + LDS_XBW))[threadIdx.x] = 0u;
    __syncthreads();
    XcdBarrier bar;
    { LOAD_PARAMS(); bar = xcd_barrier_post((unsigned*)(p.ws + WS_CTL) + CW_BAR, (volatile LAS unsigned*)(smem + LDS_XBW)); }
    ph_prologue(smem);
    __syncthreads();
    for (int i = 0; i < DEPTH; ++i) {
        const int j = i >> 1;
        if ((i & 1) == 0) {
            ph_poolfuse(smem, j, i == 0);
            xcd_barrier(bar);
            ph_poolgemm(smem, j);
        } else {
            ph_combine<false>(0);
            xcd_barrier(bar);
            ph_qkv(smem, j);
            xcd_barrier(bar);
            ph_attn(smem);
            xcd_barrier(bar);
            ph_wo(smem, j);
        }
        xcd_barrier(bar);
        ph_router(smem, i);
        xcd_barrier(bar);
        const MoePlan mp = moe_layer_plan(i);
        for (int st = 0; st < 3; ++st) {
            if (st == 2 && 4 * mp.NT <= mp.D1) break;
            ph_gu(smem, i, st, mp);
            ph_down(smem, i, st, mp);
            xcd_barrier(bar);
        }
    }
    ph_combine<true>(1);
}

extern "C" void kernel_launch(void* const* d_in, const int* in_sizes, int n_in, void* d_out, int out_size, void* d_ws, size_t ws_size, hipStream_t stream) {
    if (ws_size < WS_NEED || n_in < 18) return;
    Params p{};
    p.x_in = (const float*)d_in[0]; p.pool_norm = (const float*)d_in[1]; p.pool_w = (const float*)d_in[2]; p.pool_b = (const float*)d_in[3]; p.pool_scale = (const float*)d_in[4];
    p.sb_norm = (const float*)d_in[5]; p.sb_wqkv = (const float*)d_in[6]; p.sb_qg = (const float*)d_in[7]; p.sb_kg = (const float*)d_in[8]; p.sb_wo = (const float*)d_in[9];
    p.moe_norm = (const float*)d_in[10]; p.moe_wg = (const float*)d_in[11]; p.moe_bg = (const float*)d_in[12]; p.moe_wr = (const float*)d_in[13]; p.moe_br = (const float*)d_in[14];
    p.moe_wgate = (const float*)d_in[15]; p.moe_wup = (const float*)d_in[16]; p.moe_wdown = (const float*)d_in[17];
    p.x = (float*)d_out; p.ws = (unsigned char*)d_ws;
    static int grid = 0;
    if (!grid) {
        int dev = 0, cus = 0, per_cu = 0;
        if (hipGetDevice(&dev) != hipSuccess || hipDeviceGetAttribute(&cus, hipDeviceAttributeMultiprocessorCount, dev) != hipSuccess) { grid = -1; return; }
        if (hipFuncSetAttribute((const void*)fwd, hipFuncAttributeMaxDynamicSharedMemorySize, LDS_BYTES) != hipSuccess) { grid = -1; return; }
        if (hipOccupancyMaxActiveBlocksPerMultiprocessor(&per_cu, (const void*)fwd, NTHR, LDS_BYTES) != hipSuccess || per_cu < 1) { (void)hipGetLastError(); }
        grid = cus;
    }
    if (grid <= 0) return;
    (void)hipMemsetAsync((char*)d_ws + WS_CTL, 0, CTL_BYTES, stream);
    hipLaunchKernelGGL(fwd, dim3(grid), dim3(NTHR), LDS_BYTES, stream, p);
}
```

```cpp
#include <hip/hip_runtime.h>
#include <stdint.h>

#define DI __device__ __forceinline__
#define LAS __attribute__((address_space(3)))
typedef unsigned short bf16_t;
typedef short bf16x8 __attribute__((ext_vector_type(8)));
typedef float f32x4 __attribute__((ext_vector_type(4)));
typedef float f32x16 __attribute__((ext_vector_type(16)));
typedef unsigned u32x4 __attribute__((ext_vector_type(4)));
typedef unsigned u32x2 __attribute__((ext_vector_type(2)));

constexpr int T = 16384, DM = 1024, SEQ = 8192, NH = 16, HD = 64, DEPTH = 4, NE = 32, DE = 256;
constexpr float EPS = 1e-6f;
constexpr int NTHR = 512, NWAVE = 8;
constexpr int LIST_CAP = 16384;
constexpr int DUMMY_ROW = 2 * T;

constexpr size_t MiB = 1u << 20;
constexpr size_t WS_CTL = 0, CTL_BYTES = 1 * MiB;
constexpr size_t WS_WQKV = 1 * MiB;
constexpr size_t WS_WO = 13 * MiB;
constexpr size_t WS_WPOOL = 17 * MiB;
constexpr size_t WS_RSTD = 18 * MiB;
constexpr size_t WS_WRH = 19 * MiB, WS_WRL = WS_WRH + 512 * 1024;
constexpr size_t WS_WGU = 20 * MiB;
constexpr size_t WS_WD = 148 * MiB;
constexpr size_t WS_XB = 212 * MiB;
constexpr size_t WS_XB1 = 384 * MiB;
constexpr size_t WS_NEED = 416 * MiB;
constexpr size_t WS_LIST = 244 * MiB;
constexpr size_t WS_Q = 256 * MiB;
constexpr size_t WS_DIFF = WS_Q;
constexpr size_t WS_K = 288 * MiB, WS_V = 320 * MiB, WS_O = 352 * MiB;
constexpr size_t WS_YBUF = 288 * MiB;
constexpr size_t WS_HID = 354 * MiB;
constexpr size_t WS_END = 384 * MiB;
static_assert(WS_V - WS_K == WS_K - WS_Q, "Q, K, V equally spaced");
static_assert(WS_YBUF + (size_t)(2 * T + 1) * DM * 2 <= WS_HID, "ybuf");
static_assert(WS_HID + (size_t)(2 * T + NE * 256) * DE * 2 <= WS_END, "hid");
constexpr int CW_CNT = 1024;

struct Entry { int dst; float rstd; float w; int tok; };

struct Params {
    const float* x_in; const float* pool_norm; const float* pool_w; const float* pool_b; const float* pool_scale;
    const float* sb_norm; const float* sb_wqkv; const float* sb_qg; const float* sb_kg; const float* sb_wo;
    const float* moe_norm; const float* moe_wg; const float* moe_bg; const float* moe_wr; const float* moe_br;
    const float* moe_wgate; const float* moe_wup; const float* moe_wdown;
    float* x;
    unsigned char* ws;
};

typedef const unsigned long long __attribute__((address_space(4)))* KArgPtr;
#define GP(T, i) ((T*)(T __attribute__((address_space(1)))*)q[i])
DI Params load_params() {
    KArgPtr q = (KArgPtr)__builtin_amdgcn_kernarg_segment_ptr(); asm volatile("" : "+s"(q));
    Params p;
    p.x_in = GP(const float, 0); p.pool_norm = GP(const float, 1); p.pool_w = GP(const float, 2); p.pool_b = GP(const float, 3); p.pool_scale = GP(const float, 4);
    p.sb_norm = GP(const float, 5); p.sb_wqkv = GP(const float, 6); p.sb_qg = GP(const float, 7); p.sb_kg = GP(const float, 8); p.sb_wo = GP(const float, 9);
    p.moe_norm = GP(const float, 10); p.moe_wg = GP(const float, 11); p.moe_bg = GP(const float, 12); p.moe_wr = GP(const float, 13); p.moe_br = GP(const float, 14);
    p.moe_wgate = GP(const float, 15); p.moe_wup = GP(const float, 16); p.moe_wdown = GP(const float, 17);
    p.x = GP(float, 18); p.ws = GP(unsigned char, 19);
    return p;
}
#define LOAD_PARAMS() const Params p = load_params()
DI int tid_() { int t = threadIdx.x; asm volatile("" : "+v"(t)); return t; }
DI int bid_() { int b = blockIdx.x; asm volatile("" : "+s"(b)); return b; }
DI int xbid_() { const int b = bid_(), G = gridDim.x; return (G % 8 == 0) ? (b % 8) * (G / 8) + b / 8 : b; }

DI unsigned cvt_pk_bf16(float lo, float hi) { unsigned r; asm volatile("v_cvt_pk_bf16_f32 %0, %1, %2" : "=v"(r) : "v"(lo), "v"(hi)); return r; }
DI float bf_lo(unsigned u) { return __uint_as_float(u << 16); }
DI float bf_hi(unsigned u) { return __uint_as_float(u & 0xffff0000u); }
DI float shflx(float v, int lane, int m) { return __int_as_float(__builtin_amdgcn_ds_bpermute((lane ^ m) << 2, __float_as_int(v))); }
DI float wave_sum(float v, int lane) {
#pragma unroll
    for (int o = 32; o >= 1; o >>= 1) v += shflx(v, lane, o);
    return v;
}
DI int perm32(int rho) { const int n = rho >> 4, i = rho & 15; return 8 * (i >> 2) + 4 * n + (i & 3); }

struct CvtTile { const float* src; bf16_t* dst; const float* scale; int K, N; };
DI CvtTile cvt_locate(const Params& p, int g) {
    int K, N, sdiv = 1; const float* sb; bf16_t* db; const float* scb = nullptr; size_t sms, dms;
    if (g < 384) { K = 1024; N = 3072; sb = p.sb_wqkv; db = (bf16_t*)(p.ws + WS_WQKV); scb = p.sb_norm; sms = (size_t)1024 * 3072; dms = sms; }
    else if ((g -= 384) < 128) { K = 1024; N = 1024; sb = p.sb_wo; db = (bf16_t*)(p.ws + WS_WO); sms = (size_t)1024 * 1024; dms = sms; }
    else if ((g -= 128) < 32) { K = 256; N = 256; sb = p.pool_w; db = (bf16_t*)(p.ws + WS_WPOOL); sms = 65536; dms = 65536; }
    else if ((g -= 32) < 2048) { K = 1024; N = 256; sb = p.moe_wgate; db = (bf16_t*)(p.ws + WS_WGU); scb = p.moe_norm; sdiv = 32; sms = (size_t)1024 * 256; dms = (size_t)512 * 1024; }
    else if ((g -= 2048) < 2048) { K = 1024; N = 256; sb = p.moe_wup; db = (bf16_t*)(p.ws + WS_WGU) + (size_t)256 * 1024; scb = p.moe_norm; sdiv = 32; sms = (size_t)1024 * 256; dms = (size_t)512 * 1024; }
    else { g -= 2048; K = 256; N = 1024; sb = p.moe_wdown; db = (bf16_t*)(p.ws + WS_WD); sms = (size_t)256 * 1024; dms = sms; }
    const int tn = N / 256, per = (K / 64) * tn, mat = g / per, rem = g % per, k0 = (rem / tn) * 64, n0 = (rem % tn) * 256;
    CvtTile t; t.K = K; t.N = N;
    t.src = sb + (size_t)mat * sms + (size_t)k0 * N + n0;
    t.dst = db + (size_t)mat * dms + (size_t)n0 * K + k0;
    t.scale = scb ? scb + (size_t)(mat / sdiv) * K + k0 : nullptr;
    return t;
}
constexpr int CVT_TILES = 384 + 128 + 32 + 2048 + 2048 + 2048;
constexpr int CVT_NONMOE = 384 + 128 + 32, CVT_LAYER = 3 * 512, CVT_U0 = 1152, CVT_PRO = CVT_NONMOE + CVT_LAYER + 3 * CVT_U0;
DI int cvt_moe_tile(int L, int u) { return CVT_NONMOE + (u / 512) * 2048 + 512 * L + (u % 512); }
DI int cvt_map(int mode, int L, int q) {
    if (mode == 1) return cvt_moe_tile(L, CVT_U0 + q);
    if (q < CVT_NONMOE) return q;
    q -= CVT_NONMOE;
    if (q < CVT_LAYER) return cvt_moe_tile(0, q);
    q -= CVT_LAYER;
    return cvt_moe_tile(1 + q / CVT_U0, q % CVT_U0);
}
DI void cvt_run(LAS unsigned char* ldsb, const Params& p, int mode, int L, int count, int rank, int nranks, int tid) {
    LAS float* lds = (LAS float*)ldsb;
    const int n4 = tid & 63, kq = tid >> 6;
    f32x4 regs[8]; float scl[8];
    int q = rank;
    CvtTile cur{};
    if (q < count) {
        cur = cvt_locate(p, cvt_map(mode, L, q));
#pragma unroll
        for (int i = 0; i < 8; ++i) { regs[i] = __builtin_nontemporal_load((const f32x4*)(cur.src + (size_t)(kq + 8 * i) * cur.N + 4 * n4)); scl[i] = cur.scale ? cur.scale[kq + 8 * i] : 1.0f; }
    }
    for (; q < count; q += nranks) {
        __syncthreads();
#pragma unroll
        for (int i = 0; i < 8; ++i) { const int k = kq + 8 * i; *(LAS f32x4*)(lds + k * 256 + ((4 * n4) ^ (4 * ((k >> 3) & 7)))) = regs[i] * scl[i]; }
        __syncthreads();
        const CvtTile now = cur;
        if (q + nranks < count) {
            cur = cvt_locate(p, cvt_map(mode, L, q + nranks));
#pragma unroll
            for (int i = 0; i < 8; ++i) { regs[i] = __builtin_nontemporal_load((const f32x4*)(cur.src + (size_t)(kq + 8 * i) * cur.N + 4 * n4)); scl[i] = cur.scale ? cur.scale[kq + 8 * i] : 1.0f; }
        }
#pragma unroll
        for (int it = 0; it < 4; ++it) {
            const int qq = tid + 512 * it, ko = qq & 7, n = qq >> 3;
            float v[8];
#pragma unroll
            for (int j = 0; j < 8; ++j) v[j] = lds[(8 * ko + j) * 256 + (n ^ (4 * ko))];
            u32x4 w; w[0] = cvt_pk_bf16(v[0], v[1]); w[1] = cvt_pk_bf16(v[2], v[3]); w[2] = cvt_pk_bf16(v[4], v[5]); w[3] = cvt_pk_bf16(v[6], v[7]);
            __builtin_nontemporal_store(w, (u32x4*)(now.dst + (size_t)n * now.K + 8 * ko));
        }
    }
    __syncthreads();
}
DI void ph_cvt_deferred(LAS unsigned char* ldsb, int L, int ns2) {
    LOAD_PARAMS();
    const int G = gridDim.x, bid = xbid_(), nidle = G - ns2;
    if (nidle >= 32) { if (bid >= ns2) cvt_run(ldsb, p, 1, L, CVT_LAYER - CVT_U0, bid - ns2, nidle, tid_()); }
    else cvt_run(ldsb, p, 1, L, CVT_LAYER - CVT_U0, bid, G, tid_());
}
DI void ph_prologue(LAS unsigned char* ldsb) {
    LOAD_PARAMS();
    const int tid = tid_(), bid = bid_();
    cvt_run(ldsb, p, 0, 0, CVT_PRO, bid, gridDim.x, tid);
    bf16_t* wh = (bf16_t*)(p.ws + WS_WRH); bf16_t* wl = (bf16_t*)(p.ws + WS_WRL);
    for (int idx = bid * NTHR + tid; idx < DEPTH * 48 * DM; idx += gridDim.x * NTHR) {
        const int l = idx / (48 * DM), n = (idx / DM) % 48, k = idx % DM;
        float v = 0.f;
        if (n < 4) v = p.moe_wg[((size_t)l * DM + k) * 4 + n]; else if (n < 36) v = p.moe_wr[((size_t)l * DM + k) * 32 + (n - 4)];
        v *= p.moe_norm[l * DM + k];
        const unsigned h = cvt_pk_bf16(v, 0.f), lo = cvt_pk_bf16(v - bf_lo(h), 0.f);
        wh[idx] = (bf16_t)(h & 0xffffu); wl[idx] = (bf16_t)(lo & 0xffffu);
    }
}

DI void unpack8(const u32x4 u, float (&f)[8]) {
#pragma unroll
    for (int i = 0; i < 4; ++i) { f[2 * i] = bf_lo(u[i]); f[2 * i + 1] = bf_hi(u[i]); }
}
template <bool FINAL>
DI void ph_combine(int src_buf) {
    LOAD_PARAMS();
    const int tid = tid_(), bid = bid_(), wid = tid >> 6, lane = tid & 63;
    const bf16_t* xs = (const bf16_t*)(p.ws + (src_buf ? WS_XB1 : WS_XB));
    bf16_t* xd = (bf16_t*)(p.ws + (src_buf ? WS_XB : WS_XB1));
    const bf16_t* yb = (const bf16_t*)(p.ws + WS_YBUF);
    float* rstd = (float*)(p.ws + WS_RSTD);
    for (int t = bid * NWAVE + wid; t < T; t += gridDim.x * NWAVE) {
        float ss = 0.f;
#pragma unroll
        for (int i = 0; i < 2; ++i) {
            const size_t o = (size_t)t * DM + lane * 8 + 512 * i;
            float a[8], b[8], c[8];
            unpack8(*(const u32x4*)(xs + o), a); unpack8(*(const u32x4*)(yb + o), b); unpack8(*(const u32x4*)(yb + (size_t)T * DM + o), c);
#pragma unroll
            for (int e = 0; e < 8; ++e) a[e] += b[e] + c[e];
            if (FINAL) {
                __builtin_nontemporal_store((f32x4){a[0], a[1], a[2], a[3]}, (f32x4*)(p.x + o)); __builtin_nontemporal_store((f32x4){a[4], a[5], a[6], a[7]}, (f32x4*)(p.x + o + 4));
            } else {
                u32x4 w; w[0] = cvt_pk_bf16(a[0], a[1]); w[1] = cvt_pk_bf16(a[2], a[3]); w[2] = cvt_pk_bf16(a[4], a[5]); w[3] = cvt_pk_bf16(a[6], a[7]);
                *(u32x4*)(xd + o) = w;
                float r[8]; unpack8(w, r);
#pragma unroll
                for (int e = 0; e < 8; ++e) ss += r[e] * r[e];
            }
        }
        if (!FINAL) { ss = wave_sum(ss, lane); if (lane == 0) rstd[t] = rsqrtf(ss * (1.0f / DM) + EPS); }
    }
}

constexpr int PF_ROWS = 47, PF_TOK = 32;
DI void ph_poolfuse(LAS unsigned char* ldsb, int j, bool first) {
    LOAD_PARAMS();
    const int tid = tid_(), bid = bid_(), wid = tid >> 6, lane = tid & 63;
    const bf16_t* xs = (const bf16_t*)(p.ws + WS_XB1);
    bf16_t* xd = (bf16_t*)(p.ws + WS_XB);
    const bf16_t* yb = (const bf16_t*)(p.ws + WS_YBUF);
    const float* gain = p.pool_norm + j * DM;
    bf16_t* diff = (bf16_t*)(p.ws + WS_DIFF);
    LAS unsigned char* ht = ldsb;
    for (int tile = bid; tile < T / PF_TOK; tile += gridDim.x) {
        const int t0 = tile * PF_TOK, s0 = t0 & (SEQ - 1);
        for (int rr = wid; rr < PF_ROWS; rr += NWAVE) {
            const int t = t0 - 15 + rr;
            if (s0 == 0 && rr < 15) {
#pragma unroll
                for (int i = 0; i < 2; ++i) *(LAS u32x4*)(ht + rr * 2048 + (lane * 8 + 512 * i) * 2) = (u32x4){0u, 0u, 0u, 0u};
                continue;
            }
            float v[2][8]; u32x4 w[2]; float ss = 0.f;
#pragma unroll
            for (int i = 0; i < 2; ++i) {
                const size_t o = (size_t)t * DM + lane * 8 + 512 * i;
                if (first) {
                    const f32x4 a = *(const f32x4*)(p.x_in + o), b = *(const f32x4*)(p.x_in + o + 4);
#pragma unroll
                    for (int e = 0; e < 4; ++e) { v[i][e] = a[e]; v[i][4 + e] = b[e]; }
                } else {
                    float b[8], c[8];
                    unpack8(*(const u32x4*)(xs + o), v[i]); unpack8(*(const u32x4*)(yb + o), b); unpack8(*(const u32x4*)(yb + (size_t)T * DM + o), c);
#pragma unroll
                    for (int e = 0; e < 8; ++e) v[i][e] += b[e] + c[e];
                }
                w[i][0] = cvt_pk_bf16(v[i][0], v[i][1]); w[i][1] = cvt_pk_bf16(v[i][2], v[i][3]); w[i][2] = cvt_pk_bf16(v[i][4], v[i][5]); w[i][3] = cvt_pk_bf16(v[i][6], v[i][7]);
                if (rr >= 15) *(u32x4*)(xd + o) = w[i];
                unpack8(w[i], v[i]);
#pragma unroll
                for (int e = 0; e < 8; ++e) ss += v[i][e] * v[i][e];
            }
            ss = wave_sum(ss, lane);
            const float rs = rsqrtf(ss * (1.0f / DM) + EPS);
#pragma unroll
            for (int i = 0; i < 2; ++i) {
                u32x4 hw; hw[0] = cvt_pk_bf16(v[i][0] * rs, v[i][1] * rs); hw[1] = cvt_pk_bf16(v[i][2] * rs, v[i][3] * rs); hw[2] = cvt_pk_bf16(v[i][4] * rs, v[i][5] * rs); hw[3] = cvt_pk_bf16(v[i][6] * rs, v[i][7] * rs);
                *(LAS u32x4*)(ht + rr * 2048 + (lane * 8 + 512 * i) * 2) = hw;
            }
        }
        __syncthreads();
        {
            const int c = 2 * tid, win = 2 << (c >> 8);
            const float g0 = gain[c], g1 = gain[c + 1];
            float S0 = 0.f, S1 = 0.f;
            const LAS unsigned char* col = ht + c * 2;
#pragma unroll 4
            for (int rr = 0; rr < PF_ROWS; ++rr) {
                const unsigned hv = *(const LAS unsigned*)(col + rr * 2048);
                const float h0 = bf_lo(hv), h1 = bf_hi(hv);
                S0 += h0; S1 += h1;
                if (rr >= win) { const unsigned ov = *(const LAS unsigned*)(col + (rr - win) * 2048); S0 -= bf_lo(ov); S1 -= bf_hi(ov); }
                if (rr >= 15) {
                    const int s = s0 + rr - 15;
                    const float inv = 1.0f / (float)((s + 1 < win) ? s + 1 : win);
                    *(unsigned*)(diff + (size_t)(t0 + rr - 15) * DM + c) = cvt_pk_bf16((S0 * inv - h0) * g0, (S1 * inv - h1) * g1);
                }
            }
        }
        __syncthreads();
    }
}

struct Unit { const bf16_t* A; const bf16_t* B; int pm, pn, e, nvalid, row0, lbase; };
template <int LDA_, int LDB_, int K_, int BH_, bool HEADMAP_> struct GCfg { static constexpr int LDA = LDA_, LDB = LDB_, K = K_, BH = BH_; static constexpr bool HEADMAP = HEADMAP_; };

constexpr int BK = 64, HTB = 128 * BK * 2  , STAGE_BYTES = 8 * HTB;
DI int lds_byte(int r, int c) { const int st = (r >> 4) * 2 + (c >> 5), rr = r & 15, cc = c & 31, ob = rr * 64 + cc * 2; return st * 1024 + (ob ^ (((ob >> 9) & 1) << 5)); }
DI void stage_rc(int b, int& R, int& C) { const int st = b / 1024, sb = b % 1024, swz = sb ^ (((sb >> 9) & 1) << 5); R = (st >> 1) * 16 + swz / 64; C = (st & 1) * 32 + (swz % 64) / 2; }

template <class Cfg, class Sched, class Epi>
DI void gemm_phase(LAS unsigned char* lds, const Sched& S, const Epi& E) {
    const int tid = tid_(), wid = __builtin_amdgcn_readfirstlane(tid >> 6), lane = tid & 63, wr = wid >> 2, wc = wid & 3, fr = lane & 15, fq = lane >> 4;
    constexpr int nt = Cfg::K / BK;
    static_assert(Cfg::K % 128 == 0 && Cfg::K >= 256, "K");
    unsigned voffA[2][2], voffB[2];
    int R0, C0, R1, C1; stage_rc(tid * 16, R0, C0); stage_rc(tid * 16 + 8192, R1, C1);
    voffB[0] = (unsigned)(((Cfg::HEADMAP ? 64 * (R0 >> 5) : (R0 & ~31)) + perm32(R0 & 31)) * Cfg::LDB + C0) * 2u;
    voffB[1] = (unsigned)(((Cfg::HEADMAP ? 64 * (R1 >> 5) : (R1 & ~31)) + perm32(R1 & 31)) * Cfg::LDB + C1) * 2u;
    constexpr size_t kstep = (size_t)(BK * 2);
    constexpr size_t bhstep = (size_t)Cfg::BH * Cfg::LDB * 2;
    const unsigned ldsw = (unsigned)wid * 1024u;
    const int aoff = lds_byte(wr * 64 + fr, fq * 8), boff = lds_byte(wc * 32 + fr, fq * 8);
#define PG8_SA(b, h) (((b) * 2 + (h)) * HTB)
#define PG8_SB(b, h) ((4 + (b) * 2 + (h)) * HTB)
#define PG8_STAGE(bufoff, gbase, voff) do { _Pragma("unroll") for (int _i = 0; _i < 2; ++_i) \
        __builtin_amdgcn_global_load_lds((const unsigned*)((const char*)(gbase) + (voff)[_i]), (LAS unsigned*)(lds + (bufoff) + ldsw + _i * 8192), 16, 0, 0); } while (0)
#define PG8_LDA(dst, b, h) do { _Pragma("unroll") for (int m = 0; m < 4; ++m) _Pragma("unroll") for (int k = 0; k < 2; ++k) dst[m][k] = *(const LAS bf16x8*)(lds + PG8_SA(b, h) + aoff + m * 2048 + k * 1024); } while (0)
#define PG8_LDB(dst, b, h) do { _Pragma("unroll") for (int n = 0; n < 2; ++n) _Pragma("unroll") for (int k = 0; k < 2; ++k) dst[n][k] = *(const LAS bf16x8*)(lds + PG8_SB(b, h) + boff + n * 2048 + k * 1024); } while (0)
#define PG8_MMA(ai, bj, At, Bt) do { __builtin_amdgcn_s_setprio(1); _Pragma("unroll") for (int m = 0; m < 4; ++m) _Pragma("unroll") for (int n = 0; n < 2; ++n) _Pragma("unroll") for (int k = 0; k < 2; ++k) \
        acc[ai][bj][m][n] = __builtin_amdgcn_mfma_f32_16x16x32_bf16(Bt[n][k], At[m][k], acc[ai][bj][m][n], 0, 0, 0); __builtin_amdgcn_s_setprio(0); } while (0)
#define PG8_WAIT_V(n) asm volatile("s_waitcnt vmcnt(" #n ")" ::: "memory")
#define PG8_WAIT_L(n) asm volatile("s_waitcnt lgkmcnt(" #n ")" ::: "memory")
#define PG8_BAR __builtin_amdgcn_s_barrier()
#define PG8_SCHED __builtin_amdgcn_sched_barrier(0)
#define PG8_AROWS(uidx, un) do { voffA[0][0] = (unsigned)S.arow(uidx, un, R0) * (unsigned)(Cfg::LDA * 2) + (unsigned)(C0 * 2); voffA[0][1] = (unsigned)S.arow(uidx, un, R1) * (unsigned)(Cfg::LDA * 2) + (unsigned)(C1 * 2); \
        voffA[1][0] = (unsigned)S.arow(uidx, un, 128 + R0) * (unsigned)(Cfg::LDA * 2) + (unsigned)(C0 * 2); voffA[1][1] = (unsigned)S.arow(uidx, un, 128 + R1) * (unsigned)(Cfg::LDA * 2) + (unsigned)(C1 * 2); } while (0)
    Unit cur, nxt; int ui = 0;
    if (!S.next(0, cur)) return;
    f32x4 acc[2][2][4][2];
#pragma unroll
    for (int a = 0; a < 2; ++a)
#pragma unroll
        for (int b = 0; b < 2; ++b)
#pragma unroll
            for (int m = 0; m < 4; ++m)
#pragma unroll
                for (int n = 0; n < 2; ++n) acc[a][b][m][n] = (f32x4){0.f, 0.f, 0.f, 0.f};
    bf16x8 At[4][2], B0[2][2], B1[2][2];
    PG8_AROWS(0, cur);
    const char* cA = (const char*)cur.A; const char* cB = (const char*)cur.B;
    PG8_STAGE(PG8_SB(0, 0), cB, voffB); PG8_STAGE(PG8_SB(0, 1), cB + bhstep, voffB); PG8_STAGE(PG8_SA(0, 0), cA, voffA[0]); PG8_STAGE(PG8_SA(0, 1), cA, voffA[1]);
    if (wr == 1) PG8_BAR;
    PG8_WAIT_V(2); PG8_BAR;
    PG8_STAGE(PG8_SB(1, 0), cB + kstep, voffB); PG8_STAGE(PG8_SA(1, 0), cA + kstep, voffA[0]); PG8_STAGE(PG8_SB(1, 1), cB + bhstep + kstep, voffB);
    PG8_WAIT_V(6); PG8_BAR;
    for (;;) {
        const bool has_next = S.next(ui + 1, nxt);
        const char* nA = has_next ? (const char*)nxt.A : cA; const char* nB = has_next ? (const char*)nxt.B : cB;
#pragma unroll 1
        for (int t = 0; t < nt; t += 2) {
            const bool last = (t == nt - 2);
            const char* a1 = cA + (size_t)(t + 1) * kstep;
            const char* a2 = last ? nA : cA + (size_t)(t + 2) * kstep; const char* b2 = last ? nB : cB + (size_t)(t + 2) * kstep;
            const char* a3 = a2 + kstep; const char* b3 = b2 + kstep;
            PG8_LDB(B0, 0, 0); PG8_LDB(B1, 0, 1); PG8_SCHED; PG8_LDA(At, 0, 0); PG8_STAGE(PG8_SA(1, 1), a1, voffA[1]);
            if (last && has_next) PG8_AROWS(ui + 1, nxt);
            PG8_WAIT_V(8); PG8_WAIT_L(0); PG8_BAR; PG8_MMA(0, 0, At, B0); PG8_MMA(0, 1, At, B1); PG8_BAR; PG8_SCHED;
            PG8_LDA(At, 0, 1); PG8_STAGE(PG8_SB(0, 0), b2, voffB); PG8_STAGE(PG8_SB(0, 1), b2 + bhstep, voffB); PG8_STAGE(PG8_SA(0, 0), a2, voffA[0]);
            PG8_WAIT_V(8); PG8_WAIT_L(0); PG8_BAR; PG8_MMA(1, 0, At, B0); PG8_MMA(1, 1, At, B1); PG8_BAR; PG8_SCHED;
            PG8_LDB(B0, 1, 0); PG8_LDB(B1, 1, 1); PG8_SCHED; PG8_LDA(At, 1, 0); PG8_STAGE(PG8_SA(0, 1), a2, voffA[1]);
            PG8_WAIT_V(8); PG8_WAIT_L(0); PG8_BAR; PG8_MMA(0, 0, At, B0); PG8_MMA(0, 1, At, B1); PG8_BAR; PG8_SCHED;
            PG8_LDA(At, 1, 1); PG8_STAGE(PG8_SB(1, 0), b3, voffB); PG8_STAGE(PG8_SB(1, 1), b3 + bhstep, voffB); PG8_STAGE(PG8_SA(1, 0), a3, voffA[0]);
            PG8_WAIT_V(8); PG8_WAIT_L(0); PG8_BAR; PG8_MMA(1, 0, At, B0); PG8_MMA(1, 1, At, B1); PG8_BAR; PG8_SCHED;
        }
        if (wr == 0) PG8_BAR;
        E(acc, cur, wr, wc, fr, fq);
        if (!has_next) break;
#pragma unroll
        for (int a = 0; a < 2; ++a)
#pragma unroll
            for (int b = 0; b < 2; ++b)
#pragma unroll
                for (int m = 0; m < 4; ++m)
#pragma unroll
                    for (int n = 0; n < 2; ++n) acc[a][b][m][n] = (f32x4){0.f, 0.f, 0.f, 0.f};
        cur = nxt; cA = nA; cB = nB; ++ui;
        if (wr == 1) PG8_BAR;
    }
    PG8_WAIT_V(0);
    PG8_BAR;
#undef PG8_SA
#undef PG8_SB
#undef PG8_STAGE
#undef PG8_LDA
#undef PG8_LDB
#undef PG8_MMA
#undef PG8_WAIT_V
#undef PG8_WAIT_L
#undef PG8_BAR
#undef PG8_SCHED
#undef PG8_AROWS
}

struct SchedPool {
    const bf16_t* diff; const bf16_t* w; int bid;
    DI bool next(int i, Unit& u) const { const int L = i * gridDim.x + bid; if (L >= 256) return false; u.pm = L >> 2; u.pn = L & 3; u.A = diff + 256 * u.pn; u.B = w + (size_t)u.pn * 65536; return true; }
    DI int arow(int, const Unit& u, int r) const { return u.pm * 256 + r; }
};
struct SchedDense {
    const bf16_t* A; const bf16_t* B; int npn, ldb, bid;
    DI bool next(int i, Unit& u) const { const int L = i * gridDim.x + bid; if (L >= 64 * npn) return false; u.pm = L / npn; u.pn = L % npn; u.A = A; u.B = B + (size_t)u.pn * 256 * ldb; return true; }
    DI int arow(int, const Unit& u, int r) const { return u.pm * 256 + r; }
};

struct EpiPool {
    bf16_t* x; const float* pb; const float* ps;
    DI void operator()(const f32x4 (&acc)[2][2][4][2], const Unit& u, int wr, int wc, int fr, int fq) const {
        f32x4 bb[2][2], sc[2][2];
#pragma unroll
        for (int bj = 0; bj < 2; ++bj) {
            const int c = 256 * u.pn + 128 * bj + 32 * wc + 8 * fq;
            bb[bj][0] = *(const f32x4*)(pb + c); bb[bj][1] = *(const f32x4*)(pb + c + 4); sc[bj][0] = *(const f32x4*)(ps + c); sc[bj][1] = *(const f32x4*)(ps + c + 4);
        }
#pragma unroll
        for (int ai = 0; ai < 2; ++ai) {
            u32x4 xin[4][2];
#pragma unroll
            for (int m = 0; m < 4; ++m)
#pragma unroll
                for (int bj = 0; bj < 2; ++bj)
                    xin[m][bj] = *(const u32x4*)(x + (size_t)(u.pm * 256 + 128 * ai + 64 * wr + 16 * m + fr) * DM + 256 * u.pn + 128 * bj + 32 * wc + 8 * fq);
            asm volatile("" ::: "memory");
#pragma unroll
            for (int m = 0; m < 4; ++m) {
                const int t = u.pm * 256 + 128 * ai + 64 * wr + 16 * m + fr;
#pragma unroll
                for (int bj = 0; bj < 2; ++bj) {
                    const int c = 256 * u.pn + 128 * bj + 32 * wc + 8 * fq;
                    float xv[8]; unpack8(xin[m][bj], xv);
                    const f32x4 v0 = (acc[ai][bj][m][0] + bb[bj][0]) * sc[bj][0];
                    const f32x4 v1 = (acc[ai][bj][m][1] + bb[bj][1]) * sc[bj][1];
                    u32x4 w; w[0] = cvt_pk_bf16(xv[0] + v0[0], xv[1] + v0[1]); w[1] = cvt_pk_bf16(xv[2] + v0[2], xv[3] + v0[3]); w[2] = cvt_pk_bf16(xv[4] + v1[0], xv[5] + v1[1]); w[3] = cvt_pk_bf16(xv[6] + v1[2], xv[7] + v1[3]);
                    *(u32x4*)(x + (size_t)t * DM + c) = w;
                }
            }
        }
    }
};
struct EpiWo {
    bf16_t* x;
    DI void operator()(const f32x4 (&acc)[2][2][4][2], const Unit& u, int wr, int wc, int fr, int fq) const {
#pragma unroll
        for (int ai = 0; ai < 2; ++ai) {
            u32x4 xin[4][2];
#pragma unroll
            for (int m = 0; m < 4; ++m)
#pragma unroll
                for (int bj = 0; bj < 2; ++bj)
                    xin[m][bj] = *(const u32x4*)(x + (size_t)(u.pm * 256 + 128 * ai + 64 * wr + 16 * m + fr) * DM + 256 * u.pn + 128 * bj + 32 * wc + 8 * fq);
            asm volatile("" ::: "memory");
#pragma unroll
            for (int m = 0; m < 4; ++m) {
                const int t = u.pm * 256 + 128 * ai + 64 * wr + 16 * m + fr;
#pragma unroll
                for (int bj = 0; bj < 2; ++bj) {
                    const int c = 256 * u.pn + 128 * bj + 32 * wc + 8 * fq;
                    float xv[8]; unpack8(xin[m][bj], xv);
                    const f32x4 v0 = acc[ai][bj][m][0], v1 = acc[ai][bj][m][1];
                    u32x4 w; w[0] = cvt_pk_bf16(xv[0] + v0[0], xv[1] + v0[1]); w[1] = cvt_pk_bf16(xv[2] + v0[2], xv[3] + v0[3]); w[2] = cvt_pk_bf16(xv[4] + v1[0], xv[5] + v1[1]); w[3] = cvt_pk_bf16(xv[6] + v1[2], xv[7] + v1[3]);
                    *(u32x4*)(x + (size_t)t * DM + c) = w;
                }
            }
        }
    }
};
struct EpiQKV {
    bf16_t* q; const float* rstd; const float* qg; const float* kg;
    DI void operator()(const f32x4 (&acc)[2][2][4][2], const Unit& u, int wr, int wc, int fr, int fq) const {
        const int which = u.pn >> 2, head = (u.pn & 3) * 4 + wc;
        bf16_t* out = q + (size_t)which * ((WS_K - WS_Q) / 2);
        const float* gn = which == 0 ? qg : kg;
        const float post = which == 0 ? 0.125f * 1.4426950408889634f : 1.0f;
        f32x4 g[2][2];
#pragma unroll
        for (int bj = 0; bj < 2; ++bj)
#pragma unroll
            for (int n = 0; n < 2; ++n) g[bj][n] = (which < 2) ? *(const f32x4*)(gn + 32 * bj + 8 * fq + 4 * n) * post : (f32x4){1.f, 1.f, 1.f, 1.f};
        float rsv[2][4];
#pragma unroll
        for (int ai = 0; ai < 2; ++ai)
#pragma unroll
            for (int m = 0; m < 4; ++m) rsv[ai][m] = rstd[u.pm * 256 + 128 * ai + 64 * wr + 16 * m + fr];
#pragma unroll
        for (int ai = 0; ai < 2; ++ai)
#pragma unroll
            for (int m = 0; m < 4; ++m) {
                const int t = u.pm * 256 + 128 * ai + 64 * wr + 16 * m + fr;
                const float rs = rsv[ai][m];
                f32x4 v4[2][2]; float ss = 0.f;
#pragma unroll
                for (int bj = 0; bj < 2; ++bj)
#pragma unroll
                    for (int n = 0; n < 2; ++n) { v4[bj][n] = acc[ai][bj][m][n] * rs; const f32x4 s = v4[bj][n] * v4[bj][n]; ss += (s[0] + s[1]) + (s[2] + s[3]); }
                ss += shflx(ss, fr + 16 * fq, 16); ss += shflx(ss, fr + 16 * fq, 32);
                const float r2 = (which < 2) ? rsqrtf(ss * (1.0f / HD) + EPS) : 1.0f;
#pragma unroll
                for (int bj = 0; bj < 2; ++bj) {
                    const f32x4 a = v4[bj][0] * r2 * g[bj][0], b = v4[bj][1] * r2 * g[bj][1];
                    u32x4 w; w[0] = cvt_pk_bf16(a[0], a[1]); w[1] = cvt_pk_bf16(a[2], a[3]); w[2] = cvt_pk_bf16(b[0], b[1]); w[3] = cvt_pk_bf16(b[2], b[3]);
                    *(u32x4*)(out + (size_t)t * DM + head * HD + 32 * bj + 8 * fq) = w;
                }
            }
    }
};

typedef short v4i16_t __attribute__((ext_vector_type(4)));
constexpr int AT_VPITCH = 192;
constexpr int AT_VTILE = 32 * AT_VPITCH;
DI void ph_attn(LAS unsigned char* ldsb) {
    LOAD_PARAMS();
    const int tid = tid_(), bid = bid_(), wid = tid >> 6, lane = tid & 63, l31 = lane & 31, h2 = lane >> 5;
    const bf16_t* Q = (const bf16_t*)(p.ws + WS_Q); const bf16_t* K = (const bf16_t*)(p.ws + WS_K); const bf16_t* V = (const bf16_t*)(p.ws + WS_V);
    bf16_t* O = (bf16_t*)(p.ws + WS_O);
    LAS unsigned char* vl = ldsb + wid * AT_VTILE;
    LAS unsigned char* vw = vl + (lane >> 3) * AT_VPITCH + (lane & 7) * 16;
    const LAS unsigned char* vr = vl + (4 * h2 + ((lane & 15) >> 2)) * AT_VPITCH + (16 * ((lane >> 4) & 1) + 4 * (lane & 3)) * 2;
    for (int it = 0; it < 4 * ((2 * NH * 256 / 32 - bid + (int)gridDim.x - 1) / (int)gridDim.x); ++it) {
        const int tsk = (bid + (it >> 2) * gridDim.x) * 32 + (it & 3) * 8 + wid;
        const int bh = tsk >> 8, qb = tsk & 255, b = bh >> 4, h = bh & 15;
        const size_t tb = (size_t)b * SEQ;
        const int q0 = qb * 32;
        bf16x8 qf[4];
#pragma unroll
        for (int s = 0; s < 4; ++s) qf[s] = *(const bf16x8*)(Q + (tb + q0 + l31) * DM + h * HD + 16 * s + 8 * h2);
        f32x16 o0, o1;
#pragma unroll
        for (int r = 0; r < 16; ++r) { o0[r] = 0.f; o1[r] = 0.f; }
        float R = 1.f;
        const bf16_t* kp = K + (tb + q0 + l31) * DM + h * HD + 8 * h2;
        const bf16_t* vp = V + (tb + q0 + (lane >> 3)) * DM + h * HD + (lane & 7) * 8;
        bf16x8 kn[4], kq[4]; u32x4 vn[4], vq[4];
#pragma unroll
        for (int s = 0; s < 4; ++s) { kn[s] = *(const bf16x8*)(kp + 16 * s); vn[s] = *(const u32x4*)(vp + (size_t)8 * s * DM); }
        if (qb > 0) {
            kp -= (size_t)32 * DM; vp -= (size_t)32 * DM;
#pragma unroll
            for (int s = 0; s < 4; ++s) { kq[s] = *(const bf16x8*)(kp + 16 * s); vq[s] = *(const u32x4*)(vp + (size_t)8 * s * DM); }
        }
        for (int kt = qb; kt >= 0; --kt) {
            bf16x8 kf[4];
#pragma unroll
            for (int s = 0; s < 4; ++s) { kf[s] = kn[s]; *(LAS u32x4*)(vw + 8 * s * AT_VPITCH) = vn[s]; kn[s] = kq[s]; vn[s] = vq[s]; }
            if (kt > 1) {
                kp -= (size_t)32 * DM; vp -= (size_t)32 * DM;
#pragma unroll
                for (int s = 0; s < 4; ++s) { kq[s] = *(const bf16x8*)(kp + 16 * s); vq[s] = *(const u32x4*)(vp + (size_t)8 * s * DM); }
            }
            f32x16 z;
#pragma unroll
            for (int r = 0; r < 16; ++r) z[r] = 0.f;
#pragma unroll
            for (int s = 0; s < 4; ++s) z = __builtin_amdgcn_mfma_f32_32x32x16_bf16(kf[s], qf[s], z, 0, 0, 0);
            float kp_[16], gs[4], ot[4];
#pragma unroll
            for (int r = 0; r < 16; ++r) kp_[r] = __builtin_amdgcn_rcpf(1.0f + __builtin_amdgcn_exp2f(z[r]));
            if (kt == qb) {
#pragma unroll
                for (int r = 0; r < 16; ++r) { const int kl = (r & 3) + 8 * (r >> 2) + 4 * h2; kp_[r] = (kl < l31) ? kp_[r] : 1.0f; }
            }
#pragma unroll
            for (int bb = 0; bb < 4; ++bb) { gs[bb] = (kp_[4 * bb] * kp_[4 * bb + 1]) * (kp_[4 * bb + 2] * kp_[4 * bb + 3]); ot[bb] = shflx(gs[bb], lane, 32); }
            const float tot_own = (gs[0] * gs[1]) * (gs[2] * gs[3]);
            const float tot_oth = (ot[0] * ot[1]) * (ot[2] * ot[3]);
            float later[4];
            {
                float own_tail = 1.f, oth_tail = 1.f;
#pragma unroll
                for (int bb = 3; bb >= 0; --bb) {
                    later[bb] = own_tail * oth_tail * (h2 == 0 ? ot[bb] : 1.f);
                    own_tail *= gs[bb]; oth_tail *= ot[bb];
                }
            }
            float a[16];
#pragma unroll
            for (int bb = 0; bb < 4; ++bb) {
                const float x3 = R * later[bb];
                const float x2 = x3 * kp_[4 * bb + 3], x1 = x2 * kp_[4 * bb + 2], x0 = x1 * kp_[4 * bb + 1];
                a[4 * bb] = x0 - x0 * kp_[4 * bb]; a[4 * bb + 1] = x1 - x1 * kp_[4 * bb + 1]; a[4 * bb + 2] = x2 - x2 * kp_[4 * bb + 2]; a[4 * bb + 3] = x3 - x3 * kp_[4 * bb + 3];
            }
            R *= (h2 == 0) ? (tot_own * tot_oth) : (tot_oth * tot_own);
#pragma unroll
            for (int s = 0; s < 2; ++s) {
                u32x4 pw;
#pragma unroll
                for (int i = 0; i < 4; ++i) pw[i] = cvt_pk_bf16(a[8 * s + 2 * i], a[8 * s + 2 * i + 1]);
                const bf16x8 pa = __builtin_bit_cast(bf16x8, pw);
#pragma unroll
                for (int db = 0; db < 2; ++db) {
                    const v4i16_t lo4 = __builtin_amdgcn_ds_read_tr16_b64_v4i16((LAS v4i16_t*)(vr + (16 * s) * AT_VPITCH + 64 * db));
                    const v4i16_t hi4 = __builtin_amdgcn_ds_read_tr16_b64_v4i16((LAS v4i16_t*)(vr + (16 * s + 8) * AT_VPITCH + 64 * db));
                    bf16x8 vf; vf[0] = lo4[0]; vf[1] = lo4[1]; vf[2] = lo4[2]; vf[3] = lo4[3]; vf[4] = hi4[0]; vf[5] = hi4[1]; vf[6] = hi4[2]; vf[7] = hi4[3];
                    if (db == 0) o0 = __builtin_amdgcn_mfma_f32_32x32x16_bf16(vf, pa, o0, 0, 0, 0);
                    else o1 = __builtin_amdgcn_mfma_f32_32x32x16_bf16(vf, pa, o1, 0, 0, 0);
                }
            }
            if (__all(R < 1.0e-36f)) break;
        }
#pragma unroll
        for (int db = 0; db < 2; ++db)
#pragma unroll
            for (int rb = 0; rb < 4; ++rb) {
                const f32x16& o = db == 0 ? o0 : o1;
                u32x2 w; w[0] = cvt_pk_bf16(o[4 * rb], o[4 * rb + 1]); w[1] = cvt_pk_bf16(o[4 * rb + 2], o[4 * rb + 3]);
                *(u32x2*)(O + (tb + q0 + l31) * DM + h * HD + 32 * db + 8 * rb + 4 * h2) = w;
            }
    }
}

constexpr int RT_PART = 0;
constexpr int RT_SSQ = RT_PART + 4 * 64 * 52 * 4;
constexpr int RT_LCNT = RT_SSQ + 4 * 64 * 4;
constexpr int RT_GB = RT_LCNT + 128;
DI void ph_router(LAS unsigned char* lds, int li) {
    LOAD_PARAMS();
    const bf16_t* xcur = (const bf16_t*)(p.ws + ((li & 1) ? WS_XB1 : WS_XB));
    const int tid = tid_(), bid = bid_(), wid = tid >> 6, lane = tid & 63, fr = lane & 15, fq = lane >> 4;
    const bf16_t* wh = (const bf16_t*)(p.ws + WS_WRH) + (size_t)li * 48 * DM;
    const bf16_t* wl = (const bf16_t*)(p.ws + WS_WRL) + (size_t)li * 48 * DM;
    const float* bg = p.moe_bg + li * 4;
    const float* br = p.moe_br + li * 32;
    unsigned* cnt = (unsigned*)(p.ws + WS_CTL) + CW_CNT + 32 * li;
    Entry* list = (Entry*)(p.ws + WS_LIST);
    LAS float* part = (LAS float*)(lds + RT_PART); LAS float* ssq = (LAS float*)(lds + RT_SSQ);
    LAS int* lcnt = (LAS int*)(lds + RT_LCNT); LAS int* gb = (LAS int*)(lds + RT_GB);
    const int th = wid & 1, kq = wid >> 1;
    for (int chunk = bid; chunk < T / 64; chunk += gridDim.x) {
        const int t = chunk * 64 + th * 32 + fr;
        const bf16_t* xr = xcur + (size_t)t * DM + kq * 256 + fq * 8;
        const bf16_t* whr = wh + (size_t)fr * DM + kq * 256 + fq * 8;
        const bf16_t* wlr = wl + (size_t)fr * DM + kq * 256 + fq * 8;
        f32x4 acc[2][3]; float ss[2] = {0.f, 0.f};
#pragma unroll
        for (int b = 0; b < 2; ++b)
#pragma unroll
            for (int nb = 0; nb < 3; ++nb) acc[b][nb] = (f32x4){0.f, 0.f, 0.f, 0.f};
#pragma unroll 4
        for (int ks = 0; ks < 8; ++ks) {
            bf16x8 xh[2];
#pragma unroll
            for (int b = 0; b < 2; ++b) {
                const u32x4 xw = *(const u32x4*)(xr + (size_t)b * 16 * DM + ks * 32);
                float xf[8]; unpack8(xw, xf);
#pragma unroll
                for (int e = 0; e < 8; ++e) ss[b] += xf[e] * xf[e];
                xh[b] = __builtin_bit_cast(bf16x8, xw);
            }
#pragma unroll
            for (int nb = 0; nb < 3; ++nb) {
                const bf16x8 wH = *(const bf16x8*)(whr + (size_t)nb * 16 * DM + ks * 32), wL = *(const bf16x8*)(wlr + (size_t)nb * 16 * DM + ks * 32);
#pragma unroll
                for (int b = 0; b < 2; ++b) {
                    acc[b][nb] = __builtin_amdgcn_mfma_f32_16x16x32_bf16(wH, xh[b], acc[b][nb], 0, 0, 0);
                    acc[b][nb] = __builtin_amdgcn_mfma_f32_16x16x32_bf16(wL, xh[b], acc[b][nb], 0, 0, 0);
                }
            }
        }
#pragma unroll
        for (int b = 0; b < 2; ++b) {
            float sv = ss[b]; sv += shflx(sv, lane, 16); sv += shflx(sv, lane, 32);
            const int tl = th * 32 + 16 * b + fr;
#pragma unroll
            for (int nb = 0; nb < 3; ++nb) *(LAS f32x4*)(part + (kq * 64 + tl) * 52 + 16 * nb + 4 * fq) = acc[b][nb];
            if (fq == 0) ssq[kq * 64 + tl] = sv;
        }
        if (tid < 32) lcnt[tid] = 0;
        __syncthreads();
        int ea = 0, eb = 0, la = 0, lb = 0; float w1 = 0.f, w2 = 0.f, rs = 0.f;
        if (tid < 64) {
            rs = rsqrtf(((ssq[tid] + ssq[64 + tid]) + (ssq[128 + tid] + ssq[192 + tid])) * (1.0f / DM) + EPS);
            float lg[36];
#pragma unroll
            for (int q = 0; q < 9; ++q) {
                const f32x4 u0 = *(const LAS f32x4*)(part + tid * 52 + 4 * q), u1 = *(const LAS f32x4*)(part + (64 + tid) * 52 + 4 * q);
                const f32x4 u2 = *(const LAS f32x4*)(part + (128 + tid) * 52 + 4 * q), u3 = *(const LAS f32x4*)(part + (192 + tid) * 52 + 4 * q);
#pragma unroll
                for (int e = 0; e < 4; ++e) lg[4 * q + e] = ((u0[e] + u1[e]) + (u2[e] + u3[e])) * rs;
            }
            float gl[4];
#pragma unroll
            for (int n = 0; n < 4; ++n) gl[n] = lg[n] + bg[n];
            int g = 0; float gm = gl[0];
#pragma unroll
            for (int n = 1; n < 4; ++n) if (gl[n] > gm) { gm = gl[n]; g = n; }
            float den = 0.f;
#pragma unroll
            for (int n = 0; n < 4; ++n) den += __expf(gl[n] - gm);
            const float gprob = 1.0f / den;
            float el[8];
#pragma unroll
            for (int n = 0; n < 8; ++n) {
                float v = 0.f;
#pragma unroll
                for (int gg = 0; gg < 4; ++gg) v = (g == gg) ? lg[4 + 8 * gg + n] + br[8 * gg + n] : v;
                el[n] = v;
            }
            int e1 = 0; float m1 = el[0];
#pragma unroll
            for (int n = 1; n < 8; ++n) if (el[n] > m1) { m1 = el[n]; e1 = n; }
            int e2 = -1; float m2 = -3.0e38f;
#pragma unroll
            for (int n = 0; n < 8; ++n) if (n != e1 && (e2 < 0 || el[n] > m2)) { m2 = el[n]; e2 = n; }
            const float ex = __expf(m2 - m1);
            w1 = gprob / (1.0f + ex); w2 = gprob * ex / (1.0f + ex);
            ea = 8 * g + e1; eb = 8 * g + e2;
            la = __hip_atomic_fetch_add(lcnt + ea, 1, __ATOMIC_RELAXED, __HIP_MEMORY_SCOPE_WORKGROUP);
            lb = __hip_atomic_fetch_add(lcnt + eb, 1, __ATOMIC_RELAXED, __HIP_MEMORY_SCOPE_WORKGROUP);
        }
        __syncthreads();
        if (tid < 32) { const int c = lcnt[tid]; gb[tid] = c ? (int)atomicAdd(&cnt[tid], (unsigned)c) : 0; }
        __syncthreads();
        if (tid < 64) {
            const int tt = chunk * 64 + tid;
            Entry A; A.dst = tt; A.rstd = rs; A.w = w1; A.tok = tt;
            Entry B; B.dst = T + tt; B.rstd = rs; B.w = w2; B.tok = tt;
            list[(size_t)ea * LIST_CAP + gb[ea] + la] = A;
            list[(size_t)eb * LIST_CAP + gb[eb] + lb] = B;
        }
        __syncthreads();
    }
}

constexpr int MOE_MAXU = 4;
constexpr int LDS_ROWTAB = STAGE_BYTES;
constexpr int LDS_EPITAB = LDS_ROWTAB + MOE_MAXU * 1024;
constexpr int LDS_UTAB = LDS_EPITAB + MOE_MAXU * 2048;
constexpr int LDS_XBW = LDS_UTAB + MOE_MAXU * 32;
constexpr int LDS_BYTES = 147456;
static_assert(LDS_XBW + 16 <= LDS_BYTES, "LDS map");
struct SchedMoe {
    LAS unsigned char* lds; const bf16_t* A; const bf16_t* W; bool gather; size_t w_estride; int w_pnrows, ldb;
    DI void build(const unsigned* cnt, const Entry* list, int npn, int lo, int hi, int first, int stride, int tid) {
        LAS int* ut = (LAS int*)(lds + LDS_UTAB); LAS unsigned* rt = (LAS unsigned*)(lds + LDS_ROWTAB);
        const int lane = tid & 63;
        if (tid < 64) {
            const int c = (int)cnt[lane & 31], ntl = (c + 255) >> 8;
            int inc = ntl;
#pragma unroll
            for (int d = 1; d < 32; d <<= 1) { const int v = __builtin_amdgcn_ds_bpermute(((lane - d) & 63) << 2, inc); if ((lane & 31) >= d) inc += v; }
            const int exc = inc - ntl;
#pragma unroll
            for (int i = 0; i < MOE_MAXU; ++i) {
                const int L = lo + first + i * stride, rtile = L / npn, pn = L % npn;
                const bool hit = (first >= 0) && (L < hi) && (lane < 32) && (rtile >= exc) && (rtile < inc);
                const unsigned long long mask = __ballot(hit);
                int found = 0, e = 0, j = 0, nv = 0;
                if (mask) {
                    found = 1; e = __builtin_ctzll(mask);
                    j = rtile - __builtin_amdgcn_readlane(exc, e); nv = __builtin_amdgcn_readlane(c, e) - 256 * j; nv = nv > 256 ? 256 : nv;
                }
                if (lane == 0) { ut[i * 8 + 0] = found; ut[i * 8 + 1] = e; ut[i * 8 + 2] = nv; ut[i * 8 + 3] = 256 * rtile; ut[i * 8 + 4] = e * LIST_CAP + 256 * j; ut[i * 8 + 5] = pn; }
            }
        }
        __syncthreads();
        if (tid < 256) {
#pragma unroll
            for (int i = 0; i < MOE_MAXU; ++i) {
                if (!ut[i * 8]) continue;
                const int nv = ut[i * 8 + 2], lb = ut[i * 8 + 4];
                Entry en; en.dst = DUMMY_ROW; en.rstd = 0.f; en.w = 0.f; en.tok = 0;
                if (tid < nv) en = list[lb + tid];
                LAS float* et = (LAS float*)(lds + LDS_EPITAB) + (i * 256 + tid) * 2;
                if (gather) { rt[i * 256 + tid] = (unsigned)en.tok; et[0] = en.rstd; et[1] = en.w; }
                else { et[0] = __int_as_float(en.dst); et[1] = 0.f; }
            }
        }
        asm volatile("s_waitcnt vmcnt(0) lgkmcnt(0)" ::: "memory");
        __syncthreads();
    }
    DI bool next(int i, Unit& u) const {
        if (i >= MOE_MAXU) return false;
        const LAS int* ut = (const LAS int*)(lds + LDS_UTAB) + i * 8;
        const int found = __builtin_amdgcn_readfirstlane(ut[0]);
        if (!found) return false;
        u.e = __builtin_amdgcn_readfirstlane(ut[1]); u.nvalid = __builtin_amdgcn_readfirstlane(ut[2]); u.row0 = __builtin_amdgcn_readfirstlane(ut[3]);
        u.lbase = i * 256; u.pn = __builtin_amdgcn_readfirstlane(ut[5]); u.pm = u.row0 >> 8;
        u.A = gather ? A : A + (size_t)u.row0 * DE;
        u.B = W + (size_t)u.e * w_estride + (size_t)u.pn * w_pnrows * ldb;
        return true;
    }
    DI int arow(int ui, const Unit&, int r) const { if (!gather) return r; return (int)((const LAS unsigned*)(lds + LDS_ROWTAB))[ui * 256 + r]; }
};
struct EpiGU {
    bf16_t* hid; LAS unsigned char* lds;
    DI void operator()(const f32x4 (&acc)[2][2][4][2], const Unit& u, int wr, int wc, int fr, int fq) const {
        typedef float f32x2 __attribute__((ext_vector_type(2)));
#pragma unroll
        for (int ai = 0; ai < 2; ++ai)
#pragma unroll
            for (int m = 0; m < 4; ++m) {
                const int r = 128 * ai + 64 * wr + 16 * m + fr;
                const f32x2 rw = *(const LAS f32x2*)(lds + LDS_EPITAB + (u.lbase + r) * 8);
                const float rs = rw[0], w = rw[1];
                unsigned pk[4];
#pragma unroll
                for (int n = 0; n < 2; ++n) {
                    float hv[4];
#pragma unroll
                    for (int e = 0; e < 4; ++e) { const float g = acc[ai][0][m][n][e] * rs, up = acc[ai][1][m][n][e] * rs; hv[e] = g * __builtin_amdgcn_rcpf(1.0f + __builtin_amdgcn_exp2f(-1.4426950408889634f * g)) * up * w; }
                    pk[2 * n] = cvt_pk_bf16(hv[0], hv[1]); pk[2 * n + 1] = cvt_pk_bf16(hv[2], hv[3]);
                }
                u32x4 wv; wv[0] = pk[0]; wv[1] = pk[1]; wv[2] = pk[2]; wv[3] = pk[3];
                *(u32x4*)(hid + (size_t)(u.row0 + r) * DE + 128 * u.pn + 32 * wc + 8 * fq) = wv;
            }
    }
};
struct EpiDown {
    bf16_t* yb; LAS unsigned char* lds;
    DI void operator()(const f32x4 (&acc)[2][2][4][2], const Unit& u, int wr, int wc, int fr, int fq) const {
#pragma unroll
        for (int ai = 0; ai < 2; ++ai)
#pragma unroll
            for (int m = 0; m < 4; ++m) {
                const int r = 128 * ai + 64 * wr + 16 * m + fr;
                const int dst = *(const LAS int*)(lds + LDS_EPITAB + (u.lbase + r) * 8);
                if (dst == DUMMY_ROW) continue;
#pragma unroll
                for (int bj = 0; bj < 2; ++bj) {
                    const f32x4 a = acc[ai][bj][m][0], b = acc[ai][bj][m][1];
                    u32x4 w; w[0] = cvt_pk_bf16(a[0], a[1]); w[1] = cvt_pk_bf16(a[2], a[3]); w[2] = cvt_pk_bf16(b[0], b[1]); w[3] = cvt_pk_bf16(b[2], b[3]);
                    *(u32x4*)(yb + (size_t)dst * DM + 256 * u.pn + 128 * bj + 32 * wc + 8 * fq) = w;
                }
            }
    }
};

DI void ph_poolgemm(LAS unsigned char* lds, int j) {
    LOAD_PARAMS();
    SchedPool S; S.bid = xbid_(); S.diff = (const bf16_t*)(p.ws + WS_DIFF); S.w = (const bf16_t*)(p.ws + WS_WPOOL) + (size_t)j * 4 * 65536;
    EpiPool E; E.x = (bf16_t*)(p.ws + WS_XB); E.pb = p.pool_b + j * DM; E.ps = p.pool_scale + j * DM;
    gemm_phase<GCfg<1024, 256, 256, 128, false>>(lds, S, E);
}
DI void ph_qkv(LAS unsigned char* lds, int j) {
    LOAD_PARAMS();
    SchedDense S; S.bid = xbid_(); S.A = (const bf16_t*)(p.ws + WS_XB1); S.B = (const bf16_t*)(p.ws + WS_WQKV) + (size_t)j * 3072 * 1024; S.npn = 12; S.ldb = 1024;
    EpiQKV E; E.q = (bf16_t*)(p.ws + WS_Q); E.rstd = (const float*)(p.ws + WS_RSTD); E.qg = p.sb_qg + j * HD; E.kg = p.sb_kg + j * HD;
    gemm_phase<GCfg<1024, 1024, 1024, 32, true>>(lds, S, E);
}
DI void ph_wo(LAS unsigned char* lds, int j) {
    LOAD_PARAMS();
    SchedDense S; S.bid = xbid_(); S.A = (const bf16_t*)(p.ws + WS_O); S.B = (const bf16_t*)(p.ws + WS_WO) + (size_t)j * 1024 * 1024; S.npn = 4; S.ldb = 1024;
    EpiWo E; E.x = (bf16_t*)(p.ws + WS_XB1);
    gemm_phase<GCfg<1024, 1024, 1024, 128, false>>(lds, S, E);
}
struct MoePlan { int NT, R1, nB, D1; };
DI MoePlan moe_plan(const unsigned* cnt) {
    const int lane = tid_() & 63;
    int nt = ((int)cnt[lane & 31] + 255) >> 8;
#pragma unroll
    for (int o = 1; o < 32; o <<= 1) nt += __builtin_amdgcn_ds_bpermute((lane ^ o) << 2, nt);
    nt = __builtin_amdgcn_readfirstlane(nt);
    MoePlan m; m.NT = nt; const int G = gridDim.x; m.R1 = nt < G / 2 ? nt : G / 2;
    const int late = 2 * (nt - m.R1); m.nB = late < G ? late : G;
    const int cap = 2 * (G - m.nB); m.D1 = 4 * m.R1 < cap ? 4 * m.R1 : cap;
    return m;
}
DI void ph_gu(LAS unsigned char* lds, int li, int stage, const MoePlan m) {
    LOAD_PARAMS();
    const Entry* list = (const Entry*)(p.ws + WS_LIST);
    const unsigned* cnt = (const unsigned*)(p.ws + WS_CTL) + CW_CNT + 32 * li;
    const int bid = xbid_();
    if (stage == 2 || (stage == 1 && bid >= m.nB)) return;
    SchedMoe S; S.lds = lds; S.A = (const bf16_t*)(p.ws + ((li & 1) ? WS_XB1 : WS_XB));
    S.W = (const bf16_t*)(p.ws + WS_WGU) + (size_t)li * NE * 512 * 1024; S.gather = true; S.w_estride = (size_t)512 * 1024; S.w_pnrows = 128; S.ldb = 1024;
    const int lo = stage == 0 ? 0 : 2 * m.R1, hi = stage == 0 ? 2 * m.R1 : 2 * m.NT, G = gridDim.x;
    EpiGU E; E.hid = (bf16_t*)(p.ws + WS_HID); E.lds = lds;
    for (int first = bid; lo + first < hi; first += MOE_MAXU * G) {
        S.build(cnt, list, 2, lo, hi, first, G, tid_());
        gemm_phase<GCfg<1024, 1024, 1024, 256, false>>(lds, S, E);
        __syncthreads();
    }
}
DI void ph_down(LAS unsigned char* lds, int li, int stage, const MoePlan m) {
    LOAD_PARAMS();
    const Entry* list = (const Entry*)(p.ws + WS_LIST);
    const unsigned* cnt = (const unsigned*)(p.ws + WS_CTL) + CW_CNT + 32 * li;
    const int bid = xbid_(), G = gridDim.x;
    if (stage == 0 || (stage == 1 && bid < m.nB)) return;
    SchedMoe S; S.lds = lds; S.A = (const bf16_t*)(p.ws + WS_HID);
    S.W = (const bf16_t*)(p.ws + WS_WD) + (size_t)li * NE * 1024 * 256; S.gather = false; S.w_estride = (size_t)1024 * 256; S.w_pnrows = 256; S.ldb = 256;
    const int lo = stage == 1 ? 0 : m.D1, hi = stage == 1 ? m.D1 : 4 * m.NT, stride = stage == 1 ? G - m.nB : G;
    EpiDown E; E.yb = (bf16_t*)(p.ws + WS_YBUF); E.lds = lds;
    for (int first = stage == 1 ? bid - m.nB : bid; lo + first < hi; first += MOE_MAXU * stride) {
        S.build(cnt, list, 4, lo, hi, first, stride, tid_());
        gemm_phase<GCfg<256, 256, 256, 128, false>>(lds, S, E);
        __syncthreads();
    }
}
DI MoePlan moe_layer_plan(int li) {
    LOAD_PARAMS();
    return moe_plan((const unsigned*)(p.ws + WS_CTL) + CW_CNT + 32 * li);
}

#define XB_TMO      128
#define XB_XCNT(j)  (256  + 64 * (j))
#define XB_XSUB(j)  (1280 + 64 * (j))
#define XB_XGEN(j)  (2304 + 64 * (j))
#define XB_TOP      3328
#define XB_TOPGEN   3392
#define XCD_BAR_WORDS 3456
#define XB_SPIN_CAP (1u << 18)

__device__ __forceinline__ unsigned xb_ld(unsigned* p)              { return __hip_atomic_load(p, __ATOMIC_RELAXED, __HIP_MEMORY_SCOPE_AGENT); }
__device__ __forceinline__ unsigned xb_add(unsigned* p, unsigned v) { return __hip_atomic_fetch_add(p, v, __ATOMIC_RELAXED, __HIP_MEMORY_SCOPE_AGENT); }
__device__ __forceinline__ unsigned xb_xcc_id() { return (unsigned)__builtin_amdgcn_s_getreg((3 << 11) | 20) & 0xFu; }
#define XB_SPIN(cond, bar) do { unsigned _sp = 0; while (cond) { __builtin_amdgcn_s_sleep(1); \
    if ((++_sp & 255u) == 0u) { if (xb_ld(&(bar)[XB_TMO])) break; if (_sp > XB_SPIN_CAP) { atomicAdd(&(bar)[XB_TMO], 1u); break; } } } } while (0)

struct XcdBarrier {
    unsigned* bar; unsigned x;
    volatile LAS unsigned* st;
};

__device__ __forceinline__ XcdBarrier xcd_barrier_post(unsigned* bar, volatile LAS unsigned* st) {
    XcdBarrier b; b.bar = bar; b.x = xb_xcc_id(); b.st = st;
    if (threadIdx.x == 0) (void)xb_add(&bar[XB_XCNT(b.x)], 1u);
    return b;
}
__device__ __forceinline__ void xcd_barrier_complete(unsigned* bar, unsigned x, unsigned& nloc, unsigned& nx) {
    const unsigned G = gridDim.x * gridDim.y * gridDim.z;
    unsigned sum, cnt, mine, sp = 0u;
    for (;;) {
        sum = 0u; cnt = 0u; mine = 0u;
#pragma unroll
        for (unsigned j = 0; j < 16; ++j) { const unsigned c = xb_ld(&bar[XB_XCNT(j)]); sum += c; cnt += (c > 0u) ? 1u : 0u; mine = (j == x) ? c : mine; }
        if (sum == G) break;
        __builtin_amdgcn_s_sleep(1);
        if ((++sp & 255u) == 0u) { if (xb_ld(&bar[XB_TMO])) break; if (sp > XB_SPIN_CAP) { atomicAdd(&bar[XB_TMO], 1u); break; } }
    }
    nloc = mine > 0u ? mine : 1u; nx = cnt > 0u ? cnt : 1u;
}

__device__ __forceinline__ void xcd_barrier(const XcdBarrier& b) {
    asm volatile("s_waitcnt vmcnt(0)" ::: "memory");
    __syncthreads();
    if (threadIdx.x == 0) {
        unsigned* bar = b.bar; unsigned bx = b.x;
        asm volatile("" : "+s"(bar), "+s"(bx));
        __builtin_amdgcn_s_waitcnt(0);
        unsigned nloc = b.st[0], nx = b.st[1];
        if (nloc == 0u) { xcd_barrier_complete(bar, bx, nloc, nx); b.st[0] = nloc; b.st[1] = nx; }
        const unsigned old = xb_add(&bar[XB_XSUB(bx)], 1u);
        const unsigned gen = old / nloc;
        if (old + 1u == (gen + 1u) * nloc) {
            __builtin_amdgcn_fence(__ATOMIC_RELEASE, "agent");
            asm volatile("s_waitcnt vmcnt(0)" ::: "memory");
            const unsigned og = xb_add(&bar[XB_TOP], 1u);
            const unsigned tg = og / nx;
            if (og + 1u == (tg + 1u) * nx) xb_add(&bar[XB_TOPGEN], 1u);
            else XB_SPIN(xb_ld(&bar[XB_TOPGEN]) == tg, bar);
            __builtin_amdgcn_fence(__ATOMIC_ACQUIRE, "agent");
            xb_add(&bar[XB_XGEN(bx)], 1u);
            asm volatile("s_waitcnt vmcnt(0)" ::: "memory");
        } else {
            XB_SPIN(xb_ld(&bar[XB_XGEN(bx)]) == gen, bar);
            __builtin_amdgcn_fence(__ATOMIC_ACQUIRE, "agent");
            asm volatile("s_waitcnt vmcnt(0)" ::: "memory");
        }
    }
    __syncthreads();
}
constexpr int CW_BAR = 4096;

extern __shared__ __attribute__((aligned(16))) unsigned char smem_raw[];
__global__ void __launch_bounds__(NTHR, 2) fwd(Params pk) {
    LAS unsigned char* smem = (LAS unsigned char*)smem_raw;
    if (threadIdx.x < 4) ((LAS unsigned*)(smem + LDS_XBW))[threadIdx.x] = 0u;
    __syncthreads();
    XcdBarrier bar;
    { LOAD_PARAMS(); bar = xcd_barrier_post((unsigned*)(p.ws + WS_CTL) + CW_BAR, (volatile LAS unsigned*)(smem + LDS_XBW)); }
    ph_prologue(smem);
    __syncthreads();
    for (int i = 0; i < DEPTH; ++i) {
        const int j = i >> 1;
        if ((i & 1) == 0) {
            ph_poolfuse(smem, j, i == 0);
            xcd_barrier(bar);
            ph_poolgemm(smem, j);
        } else {
            ph_combine<false>(0);
            xcd_barrier(bar);
            ph_qkv(smem, j);
            xcd_barrier(bar);
            ph_attn(smem);
            xcd_barrier(bar);
            ph_wo(smem, j);
        }
        xcd_barrier(bar);
        ph_router(smem, i);
        xcd_barrier(bar);
        const MoePlan mp = moe_layer_plan(i);
        for (int st = 0; st < 3; ++st) {
            const int ns2 = 4 * mp.NT - mp.D1;
            if (st == 2 && ns2 <= 0 && i == DEPTH - 1) break;
            ph_gu(smem, i, st, mp);
            ph_down(smem, i, st, mp);
            if (st == 2 && i < DEPTH - 1) ph_cvt_deferred(smem, i + 1, ns2 < 0 ? 0 : (ns2 > (int)gridDim.x ? (int)gridDim.x : ns2));
            xcd_barrier(bar);
        }
    }
    ph_combine<true>(1);
}

extern "C" void kernel_launch(void* const* d_in, const int* in_sizes, int n_in, void* d_out, int out_size, void* d_ws, size_t ws_size, hipStream_t stream) {
    if (ws_size < WS_NEED || n_in < 18) return;
    Params p{};
    p.x_in = (const float*)d_in[0]; p.pool_norm = (const float*)d_in[1]; p.pool_w = (const float*)d_in[2]; p.pool_b = (const float*)d_in[3]; p.pool_scale = (const float*)d_in[4];
    p.sb_norm = (const float*)d_in[5]; p.sb_wqkv = (const float*)d_in[6]; p.sb_qg = (const float*)d_in[7]; p.sb_kg = (const float*)d_in[8]; p.sb_wo = (const float*)d_in[9];
    p.moe_norm = (const float*)d_in[10]; p.moe_wg = (const float*)d_in[11]; p.moe_bg = (const float*)d_in[12]; p.moe_wr = (const float*)d_in[13]; p.moe_br = (const float*)d_in[14];
    p.moe_wgate = (const float*)d_in[15]; p.moe_wup = (const float*)d_in[16]; p.moe_wdown = (const float*)d_in[17];
    p.x = (float*)d_out; p.ws = (unsigned char*)d_ws;
    static int grid = 0;
    if (!grid) {
        int dev = 0, cus = 0, per_cu = 0;
        if (hipGetDevice(&dev) != hipSuccess || hipDeviceGetAttribute(&cus, hipDeviceAttributeMultiprocessorCount, dev) != hipSuccess) { grid = -1; return; }
        if (hipFuncSetAttribute((const void*)fwd, hipFuncAttributeMaxDynamicSharedMemorySize, LDS_BYTES) != hipSuccess) { grid = -1; return; }
        if (hipOccupancyMaxActiveBlocksPerMultiprocessor(&per_cu, (const void*)fwd, NTHR, LDS_BYTES) != hipSuccess || per_cu < 1) { (void)hipGetLastError(); }
        grid = cus;
    }
    if (grid <= 0) return;
    (void)hipMemsetAsync((char*)d_ws + WS_CTL, 0, CTL_BYTES, stream);
    hipLaunchKernelGGL(fwd, dim3(grid), dim3(NTHR), LDS_BYTES, stream, p);
}
```

```cpp
#include <hip/hip_runtime.h>
#include <stdint.h>

#define DI __device__ __forceinline__
#define LAS __attribute__((address_space(3)))
typedef unsigned short bf16_t;
typedef short bf16x8 __attribute__((ext_vector_type(8)));
typedef float f32x4 __attribute__((ext_vector_type(4)));
typedef float f32x16 __attribute__((ext_vector_type(16)));
typedef unsigned u32x4 __attribute__((ext_vector_type(4)));
typedef unsigned u32x2 __attribute__((ext_vector_type(2)));

constexpr int T = 16384, DM = 1024, SEQ = 8192, NH = 16, HD = 64, DEPTH = 4, NE = 32, DE = 256;
constexpr float EPS = 1e-6f;
constexpr int NTHR = 512, NWAVE = 8;
constexpr int LIST_CAP = 16384;
constexpr int DUMMY_ROW = 2 * T;

constexpr size_t MiB = 1u << 20;
constexpr size_t WS_CTL = 0, CTL_BYTES = 1 * MiB;
constexpr size_t WS_WQKV = 1 * MiB;
constexpr size_t WS_WO = 13 * MiB;
constexpr size_t WS_WPOOL = 17 * MiB;
constexpr size_t WS_RSTD = 18 * MiB;
constexpr size_t WS_WRH = 19 * MiB, WS_WRL = WS_WRH + 512 * 1024;
constexpr size_t WS_WGU = 20 * MiB;
constexpr size_t WS_WD = 148 * MiB;
constexpr size_t WS_XB = 212 * MiB;
constexpr size_t WS_XB1 = 384 * MiB;
constexpr size_t WS_NEED = 416 * MiB;
constexpr size_t WS_LIST = 244 * MiB;
constexpr size_t WS_Q = 256 * MiB;
constexpr size_t WS_DIFF = WS_Q;
constexpr size_t WS_K = 288 * MiB, WS_V = 320 * MiB, WS_O = 352 * MiB;
constexpr size_t WS_YBUF = 288 * MiB;
constexpr size_t WS_HID = 354 * MiB;
constexpr size_t WS_END = 384 * MiB;
static_assert(WS_V - WS_K == WS_K - WS_Q, "Q, K, V equally spaced");
static_assert(WS_YBUF + (size_t)(2 * T + 1) * DM * 2 <= WS_HID, "ybuf");
static_assert(WS_HID + (size_t)(2 * T + NE * 256) * DE * 2 <= WS_END, "hid");
constexpr int CW_CNT = 1024;

struct Entry { int dst; float rstd; float w; int tok; };

struct Params {
    const float* x_in; const float* pool_norm; const float* pool_w; const float* pool_b; const float* pool_scale;
    const float* sb_norm; const float* sb_wqkv; const float* sb_qg; const float* sb_kg; const float* sb_wo;
    const float* moe_norm; const float* moe_wg; const float* moe_bg; const float* moe_wr; const float* moe_br;
    const float* moe_wgate; const float* moe_wup; const float* moe_wdown;
    float* x;
    unsigned char* ws;
};

typedef const unsigned long long __attribute__((address_space(4)))* KArgPtr;
#define GP(T, i) ((T*)(T __attribute__((address_space(1)))*)q[i])
DI Params load_params() {
    KArgPtr q = (KArgPtr)__builtin_amdgcn_kernarg_segment_ptr(); asm volatile("" : "+s"(q));
    Params p;
    p.x_in = GP(const float, 0); p.pool_norm = GP(const float, 1); p.pool_w = GP(const float, 2); p.pool_b = GP(const float, 3); p.pool_scale = GP(const float, 4);
    p.sb_norm = GP(const float, 5); p.sb_wqkv = GP(const float, 6); p.sb_qg = GP(const float, 7); p.sb_kg = GP(const float, 8); p.sb_wo = GP(const float, 9);
    p.moe_norm = GP(const float, 10); p.moe_wg = GP(const float, 11); p.moe_bg = GP(const float, 12); p.moe_wr = GP(const float, 13); p.moe_br = GP(const float, 14);
    p.moe_wgate = GP(const float, 15); p.moe_wup = GP(const float, 16); p.moe_wdown = GP(const float, 17);
    p.x = GP(float, 18); p.ws = GP(unsigned char, 19);
    return p;
}
#define LOAD_PARAMS() const Params p = load_params()
DI int tid_() { int t = threadIdx.x; asm volatile("" : "+v"(t)); return t; }
DI int bid_() { int b = blockIdx.x; asm volatile("" : "+s"(b)); return b; }
DI int xbid_() { const int b = bid_(), G = gridDim.x; return (G % 8 == 0) ? (b % 8) * (G / 8) + b / 8 : b; }

DI unsigned cvt_pk_bf16(float lo, float hi) { unsigned r; asm volatile("v_cvt_pk_bf16_f32 %0, %1, %2" : "=v"(r) : "v"(lo), "v"(hi)); return r; }
DI float bf_lo(unsigned u) { return __uint_as_float(u << 16); }
DI float bf_hi(unsigned u) { return __uint_as_float(u & 0xffff0000u); }
DI float shflx(float v, int lane, int m) { return __int_as_float(__builtin_amdgcn_ds_bpermute((lane ^ m) << 2, __float_as_int(v))); }
DI float wave_sum(float v, int lane) {
#pragma unroll
    for (int o = 32; o >= 1; o >>= 1) v += shflx(v, lane, o);
    return v;
}
DI int perm32(int rho) { const int n = rho >> 4, i = rho & 15; return 8 * (i >> 2) + 4 * n + (i & 3); }

struct CvtTile { const float* src; bf16_t* dst; const float* scale; int K, N; };
DI CvtTile cvt_locate(const Params& p, int g) {
    int K, N, sdiv = 1; const float* sb; bf16_t* db; const float* scb = nullptr; size_t sms, dms;
    if (g < 384) { K = 1024; N = 3072; sb = p.sb_wqkv; db = (bf16_t*)(p.ws + WS_WQKV); scb = p.sb_norm; sms = (size_t)1024 * 3072; dms = sms; }
    else if ((g -= 384) < 128) { K = 1024; N = 1024; sb = p.sb_wo; db = (bf16_t*)(p.ws + WS_WO); sms = (size_t)1024 * 1024; dms = sms; }
    else if ((g -= 128) < 32) { K = 256; N = 256; sb = p.pool_w; db = (bf16_t*)(p.ws + WS_WPOOL); sms = 65536; dms = 65536; }
    else if ((g -= 32) < 2048) { K = 1024; N = 256; sb = p.moe_wgate; db = (bf16_t*)(p.ws + WS_WGU); scb = p.moe_norm; sdiv = 32; sms = (size_t)1024 * 256; dms = (size_t)512 * 1024; }
    else if ((g -= 2048) < 2048) { K = 1024; N = 256; sb = p.moe_wup; db = (bf16_t*)(p.ws + WS_WGU) + (size_t)256 * 1024; scb = p.moe_norm; sdiv = 32; sms = (size_t)1024 * 256; dms = (size_t)512 * 1024; }
    else { g -= 2048; K = 256; N = 1024; sb = p.moe_wdown; db = (bf16_t*)(p.ws + WS_WD); sms = (size_t)256 * 1024; dms = sms; }
    const int tn = N / 256, per = (K / 64) * tn, mat = g / per, rem = g % per, k0 = (rem / tn) * 64, n0 = (rem % tn) * 256;
    CvtTile t; t.K = K; t.N = N;
    t.src = sb + (size_t)mat * sms + (size_t)k0 * N + n0;
    t.dst = db + (size_t)mat * dms + (size_t)n0 * K + k0;
    t.scale = scb ? scb + (size_t)(mat / sdiv) * K + k0 : nullptr;
    return t;
}
constexpr int CVT_TILES = 384 + 128 + 32 + 2048 + 2048 + 2048;
constexpr int CVT_NONMOE = 384 + 128 + 32, CVT_LAYER = 3 * 512, CVT_S1 = 224, CVT_U0 = 1152 - CVT_S1, CVT_PRO = CVT_NONMOE + CVT_LAYER + 3 * CVT_U0;
DI int cvt_moe_tile(int L, int u) { return CVT_NONMOE + (u / 512) * 2048 + 512 * L + (u % 512); }
DI int cvt_map(int mode, int L, int q) {
    if (mode == 1) return cvt_moe_tile(L, CVT_U0 + q);
    if (mode == 2) return cvt_moe_tile(L, CVT_U0 + CVT_S1 + q);
    if (q < CVT_NONMOE) return q;
    q -= CVT_NONMOE;
    if (q < CVT_LAYER) return cvt_moe_tile(0, q);
    q -= CVT_LAYER;
    return cvt_moe_tile(1 + q / CVT_U0, q % CVT_U0);
}
DI void cvt_run(LAS unsigned char* ldsb, const Params& p, int mode, int L, int count, int rank, int nranks, int tid) {
    LAS float* lds = (LAS float*)ldsb;
    const int n4 = tid & 63, kq = tid >> 6;
    f32x4 regs[8]; float scl[8];
    int q = rank;
    CvtTile cur{};
    if (q < count) {
        cur = cvt_locate(p, cvt_map(mode, L, q));
#pragma unroll
        for (int i = 0; i < 8; ++i) { regs[i] = __builtin_nontemporal_load((const f32x4*)(cur.src + (size_t)(kq + 8 * i) * cur.N + 4 * n4)); scl[i] = cur.scale ? cur.scale[kq + 8 * i] : 1.0f; }
    }
    for (; q < count; q += nranks) {
        __syncthreads();
#pragma unroll
        for (int i = 0; i < 8; ++i) { const int k = kq + 8 * i; *(LAS f32x4*)(lds + k * 256 + ((4 * n4) ^ (4 * ((k >> 3) & 7)))) = regs[i] * scl[i]; }
        __syncthreads();
        const CvtTile now = cur;
        if (q + nranks < count) {
            cur = cvt_locate(p, cvt_map(mode, L, q + nranks));
#pragma unroll
            for (int i = 0; i < 8; ++i) { regs[i] = __builtin_nontemporal_load((const f32x4*)(cur.src + (size_t)(kq + 8 * i) * cur.N + 4 * n4)); scl[i] = cur.scale ? cur.scale[kq + 8 * i] : 1.0f; }
        }
#pragma unroll
        for (int it = 0; it < 4; ++it) {
            const int qq = tid + 512 * it, ko = qq & 7, n = qq >> 3;
            float v[8];
#pragma unroll
            for (int j = 0; j < 8; ++j) v[j] = lds[(8 * ko + j) * 256 + (n ^ (4 * ko))];
            u32x4 w; w[0] = cvt_pk_bf16(v[0], v[1]); w[1] = cvt_pk_bf16(v[2], v[3]); w[2] = cvt_pk_bf16(v[4], v[5]); w[3] = cvt_pk_bf16(v[6], v[7]);
            __builtin_nontemporal_store(w, (u32x4*)(now.dst + (size_t)n * now.K + 8 * ko));
        }
    }
    __syncthreads();
}
DI void ph_cvt_deferred(LAS unsigned char* ldsb, int L, int ns2) {
    LOAD_PARAMS();
    const int G = gridDim.x, bid = xbid_(), nidle = G - ns2;
    if (nidle >= 32) { if (bid >= ns2) cvt_run(ldsb, p, 2, L, CVT_LAYER - CVT_U0 - CVT_S1, bid - ns2, nidle, tid_()); }
    else cvt_run(ldsb, p, 2, L, CVT_LAYER - CVT_U0 - CVT_S1, bid, G, tid_());
}
DI void ph_prologue(LAS unsigned char* ldsb) {
    LOAD_PARAMS();
    const int tid = tid_(), bid = bid_();
    cvt_run(ldsb, p, 0, 0, CVT_PRO, bid, gridDim.x, tid);
    bf16_t* wh = (bf16_t*)(p.ws + WS_WRH); bf16_t* wl = (bf16_t*)(p.ws + WS_WRL);
    for (int idx = bid * NTHR + tid; idx < DEPTH * 48 * DM; idx += gridDim.x * NTHR) {
        const int l = idx / (48 * DM), n = (idx / DM) % 48, k = idx % DM;
        float v = 0.f;
        if (n < 4) v = p.moe_wg[((size_t)l * DM + k) * 4 + n]; else if (n < 36) v = p.moe_wr[((size_t)l * DM + k) * 32 + (n - 4)];
        v *= p.moe_norm[l * DM + k];
        const unsigned h = cvt_pk_bf16(v, 0.f), lo = cvt_pk_bf16(v - bf_lo(h), 0.f);
        wh[idx] = (bf16_t)(h & 0xffffu); wl[idx] = (bf16_t)(lo & 0xffffu);
    }
}

DI void unpack8(const u32x4 u, float (&f)[8]) {
#pragma unroll
    for (int i = 0; i < 4; ++i) { f[2 * i] = bf_lo(u[i]); f[2 * i + 1] = bf_hi(u[i]); }
}
template <bool FINAL>
DI void ph_combine(int src_buf) {
    LOAD_PARAMS();
    const int tid = tid_(), bid = bid_(), wid = tid >> 6, lane = tid & 63;
    const bf16_t* xs = (const bf16_t*)(p.ws + (src_buf ? WS_XB1 : WS_XB));
    bf16_t* xd = (bf16_t*)(p.ws + (src_buf ? WS_XB : WS_XB1));
    const bf16_t* yb = (const bf16_t*)(p.ws + WS_YBUF);
    float* rstd = (float*)(p.ws + WS_RSTD);
    for (int t = bid * NWAVE + wid; t < T; t += gridDim.x * NWAVE) {
        float ss = 0.f;
#pragma unroll
        for (int i = 0; i < 2; ++i) {
            const size_t o = (size_t)t * DM + lane * 8 + 512 * i;
            float a[8], b[8], c[8];
            unpack8(*(const u32x4*)(xs + o), a); unpack8(*(const u32x4*)(yb + o), b); unpack8(*(const u32x4*)(yb + (size_t)T * DM + o), c);
#pragma unroll
            for (int e = 0; e < 8; ++e) a[e] += b[e] + c[e];
            if (FINAL) {
                __builtin_nontemporal_store((f32x4){a[0], a[1], a[2], a[3]}, (f32x4*)(p.x + o)); __builtin_nontemporal_store((f32x4){a[4], a[5], a[6], a[7]}, (f32x4*)(p.x + o + 4));
            } else {
                u32x4 w; w[0] = cvt_pk_bf16(a[0], a[1]); w[1] = cvt_pk_bf16(a[2], a[3]); w[2] = cvt_pk_bf16(a[4], a[5]); w[3] = cvt_pk_bf16(a[6], a[7]);
                *(u32x4*)(xd + o) = w;
                float r[8]; unpack8(w, r);
#pragma unroll
                for (int e = 0; e < 8; ++e) ss += r[e] * r[e];
            }
        }
        if (!FINAL) { ss = wave_sum(ss, lane); if (lane == 0) rstd[t] = rsqrtf(ss * (1.0f / DM) + EPS); }
    }
}

constexpr int PF_ROWS = 47, PF_TOK = 32;
DI void ph_poolfuse(LAS unsigned char* ldsb, int j, bool first) {
    LOAD_PARAMS();
    const int tid = tid_(), bid = bid_(), wid = tid >> 6, lane = tid & 63;
    const bf16_t* xs = (const bf16_t*)(p.ws + WS_XB1);
    bf16_t* xd = (bf16_t*)(p.ws + WS_XB);
    const bf16_t* yb = (const bf16_t*)(p.ws + WS_YBUF);
    const float* gain = p.pool_norm + j * DM;
    bf16_t* diff = (bf16_t*)(p.ws + WS_DIFF);
    LAS unsigned char* ht = ldsb;
    for (int tile = bid; tile < T / PF_TOK; tile += gridDim.x) {
        const int t0 = tile * PF_TOK, s0 = t0 & (SEQ - 1);
        for (int rr = wid; rr < PF_ROWS; rr += NWAVE) {
            const int t = t0 - 15 + rr;
            if (s0 == 0 && rr < 15) {
#pragma unroll
                for (int i = 0; i < 2; ++i) *(LAS u32x4*)(ht + rr * 2048 + (lane * 8 + 512 * i) * 2) = (u32x4){0u, 0u, 0u, 0u};
                continue;
            }
            float v[2][8]; u32x4 w[2]; float ss = 0.f;
#pragma unroll
            for (int i = 0; i < 2; ++i) {
                const size_t o = (size_t)t * DM + lane * 8 + 512 * i;
                if (first) {
                    const f32x4 a = *(const f32x4*)(p.x_in + o), b = *(const f32x4*)(p.x_in + o + 4);
#pragma unroll
                    for (int e = 0; e < 4; ++e) { v[i][e] = a[e]; v[i][4 + e] = b[e]; }
                } else {
                    float b[8], c[8];
                    unpack8(*(const u32x4*)(xs + o), v[i]); unpack8(*(const u32x4*)(yb + o), b); unpack8(*(const u32x4*)(yb + (size_t)T * DM + o), c);
#pragma unroll
                    for (int e = 0; e < 8; ++e) v[i][e] += b[e] + c[e];
                }
                w[i][0] = cvt_pk_bf16(v[i][0], v[i][1]); w[i][1] = cvt_pk_bf16(v[i][2], v[i][3]); w[i][2] = cvt_pk_bf16(v[i][4], v[i][5]); w[i][3] = cvt_pk_bf16(v[i][6], v[i][7]);
                if (rr >= 15) *(u32x4*)(xd + o) = w[i];
                unpack8(w[i], v[i]);
#pragma unroll
                for (int e = 0; e < 8; ++e) ss += v[i][e] * v[i][e];
            }
            ss = wave_sum(ss, lane);
            const float rs = rsqrtf(ss * (1.0f / DM) + EPS);
#pragma unroll
            for (int i = 0; i < 2; ++i) {
                u32x4 hw; hw[0] = cvt_pk_bf16(v[i][0] * rs, v[i][1] * rs); hw[1] = cvt_pk_bf16(v[i][2] * rs, v[i][3] * rs); hw[2] = cvt_pk_bf16(v[i][4] * rs, v[i][5] * rs); hw[3] = cvt_pk_bf16(v[i][6] * rs, v[i][7] * rs);
                *(LAS u32x4*)(ht + rr * 2048 + (lane * 8 + 512 * i) * 2) = hw;
            }
        }
        __syncthreads();
        {
            const int c = 2 * tid, win = 2 << (c >> 8);
            const float g0 = gain[c], g1 = gain[c + 1];
            float S0 = 0.f, S1 = 0.f;
            const LAS unsigned char* col = ht + c * 2;
#pragma unroll 4
            for (int rr = 0; rr < PF_ROWS; ++rr) {
                const unsigned hv = *(const LAS unsigned*)(col + rr * 2048);
                const float h0 = bf_lo(hv), h1 = bf_hi(hv);
                S0 += h0; S1 += h1;
                if (rr >= win) { const unsigned ov = *(const LAS unsigned*)(col + (rr - win) * 2048); S0 -= bf_lo(ov); S1 -= bf_hi(ov); }
                if (rr >= 15) {
                    const int s = s0 + rr - 15;
                    const float inv = 1.0f / (float)((s + 1 < win) ? s + 1 : win);
                    *(unsigned*)(diff + (size_t)(t0 + rr - 15) * DM + c) = cvt_pk_bf16((S0 * inv - h0) * g0, (S1 * inv - h1) * g1);
                }
            }
        }
        __syncthreads();
    }
}

struct Unit { const bf16_t* A; const bf16_t* B; int pm, pn, e, nvalid, row0, lbase; };
template <int LDA_, int LDB_, int K_, int BH_, bool HEADMAP_> struct GCfg { static constexpr int LDA = LDA_, LDB = LDB_, K = K_, BH = BH_; static constexpr bool HEADMAP = HEADMAP_; };

constexpr int BK = 64, HTB = 128 * BK * 2  , STAGE_BYTES = 8 * HTB;
DI int lds_byte(int r, int c) { const int st = (r >> 4) * 2 + (c >> 5), rr = r & 15, cc = c & 31, ob = rr * 64 + cc * 2; return st * 1024 + (ob ^ (((ob >> 9) & 1) << 5)); }
DI void stage_rc(int b, int& R, int& C) { const int st = b / 1024, sb = b % 1024, swz = sb ^ (((sb >> 9) & 1) << 5); R = (st >> 1) * 16 + swz / 64; C = (st & 1) * 32 + (swz % 64) / 2; }

template <class Cfg, class Sched, class Epi>
DI void gemm_phase(LAS unsigned char* lds, const Sched& S, const Epi& E) {
    const int tid = tid_(), wid = __builtin_amdgcn_readfirstlane(tid >> 6), lane = tid & 63, wr = wid >> 2, wc = wid & 3, fr = lane & 15, fq = lane >> 4;
    constexpr int nt = Cfg::K / BK;
    static_assert(Cfg::K % 128 == 0 && Cfg::K >= 256, "K");
    unsigned voffA[2][2], voffB[2];
    int R0, C0, R1, C1; stage_rc(tid * 16, R0, C0); stage_rc(tid * 16 + 8192, R1, C1);
    voffB[0] = (unsigned)(((Cfg::HEADMAP ? 64 * (R0 >> 5) : (R0 & ~31)) + perm32(R0 & 31)) * Cfg::LDB + C0) * 2u;
    voffB[1] = (unsigned)(((Cfg::HEADMAP ? 64 * (R1 >> 5) : (R1 & ~31)) + perm32(R1 & 31)) * Cfg::LDB + C1) * 2u;
    constexpr size_t kstep = (size_t)(BK * 2);
    constexpr size_t bhstep = (size_t)Cfg::BH * Cfg::LDB * 2;
    const unsigned ldsw = (unsigned)wid * 1024u;
    const int aoff = lds_byte(wr * 64 + fr, fq * 8), boff = lds_byte(wc * 32 + fr, fq * 8);
#define PG8_SA(b, h) (((b) * 2 + (h)) * HTB)
#define PG8_SB(b, h) ((4 + (b) * 2 + (h)) * HTB)
#define PG8_STAGE(bufoff, gbase, voff) do { _Pragma("unroll") for (int _i = 0; _i < 2; ++_i) \
        __builtin_amdgcn_global_load_lds((const unsigned*)((const char*)(gbase) + (voff)[_i]), (LAS unsigned*)(lds + (bufoff) + ldsw + _i * 8192), 16, 0, 0); } while (0)
#define PG8_LDA(dst, b, h) do { _Pragma("unroll") for (int m = 0; m < 4; ++m) _Pragma("unroll") for (int k = 0; k < 2; ++k) dst[m][k] = *(const LAS bf16x8*)(lds + PG8_SA(b, h) + aoff + m * 2048 + k * 1024); } while (0)
#define PG8_LDB(dst, b, h) do { _Pragma("unroll") for (int n = 0; n < 2; ++n) _Pragma("unroll") for (int k = 0; k < 2; ++k) dst[n][k] = *(const LAS bf16x8*)(lds + PG8_SB(b, h) + boff + n * 2048 + k * 1024); } while (0)
#define PG8_MMA(ai, bj, At, Bt) do { __builtin_amdgcn_s_setprio(1); _Pragma("unroll") for (int m = 0; m < 4; ++m) _Pragma("unroll") for (int n = 0; n < 2; ++n) _Pragma("unroll") for (int k = 0; k < 2; ++k) \
        acc[ai][bj][m][n] = __builtin_amdgcn_mfma_f32_16x16x32_bf16(Bt[n][k], At[m][k], acc[ai][bj][m][n], 0, 0, 0); __builtin_amdgcn_s_setprio(0); } while (0)
#define PG8_WAIT_V(n) asm volatile("s_waitcnt vmcnt(" #n ")" ::: "memory")
#define PG8_WAIT_L(n) asm volatile("s_waitcnt lgkmcnt(" #n ")" ::: "memory")
#define PG8_BAR __builtin_amdgcn_s_barrier()
#define PG8_SCHED __builtin_amdgcn_sched_barrier(0)
#define PG8_AROWS(uidx, un) do { voffA[0][0] = (unsigned)S.arow(uidx, un, R0) * (unsigned)(Cfg::LDA * 2) + (unsigned)(C0 * 2); voffA[0][1] = (unsigned)S.arow(uidx, un, R1) * (unsigned)(Cfg::LDA * 2) + (unsigned)(C1 * 2); \
        voffA[1][0] = (unsigned)S.arow(uidx, un, 128 + R0) * (unsigned)(Cfg::LDA * 2) + (unsigned)(C0 * 2); voffA[1][1] = (unsigned)S.arow(uidx, un, 128 + R1) * (unsigned)(Cfg::LDA * 2) + (unsigned)(C1 * 2); } while (0)
    Unit cur, nxt; int ui = 0;
    if (!S.next(0, cur)) return;
    f32x4 acc[2][2][4][2];
#pragma unroll
    for (int a = 0; a < 2; ++a)
#pragma unroll
        for (int b = 0; b < 2; ++b)
#pragma unroll
            for (int m = 0; m < 4; ++m)
#pragma unroll
                for (int n = 0; n < 2; ++n) acc[a][b][m][n] = (f32x4){0.f, 0.f, 0.f, 0.f};
    bf16x8 At[4][2], B0[2][2], B1[2][2];
    PG8_AROWS(0, cur);
    const char* cA = (const char*)cur.A; const char* cB = (const char*)cur.B;
    PG8_STAGE(PG8_SB(0, 0), cB, voffB); PG8_STAGE(PG8_SB(0, 1), cB + bhstep, voffB); PG8_STAGE(PG8_SA(0, 0), cA, voffA[0]); PG8_STAGE(PG8_SA(0, 1), cA, voffA[1]);
    if (wr == 1) PG8_BAR;
    PG8_WAIT_V(2); PG8_BAR;
    PG8_STAGE(PG8_SB(1, 0), cB + kstep, voffB); PG8_STAGE(PG8_SA(1, 0), cA + kstep, voffA[0]); PG8_STAGE(PG8_SB(1, 1), cB + bhstep + kstep, voffB);
    PG8_WAIT_V(6); PG8_BAR;
    for (;;) {
        const bool has_next = S.next(ui + 1, nxt);
        const char* nA = has_next ? (const char*)nxt.A : cA; const char* nB = has_next ? (const char*)nxt.B : cB;
#pragma unroll 1
        for (int t = 0; t < nt; t += 2) {
            const bool last = (t == nt - 2);
            const char* a1 = cA + (size_t)(t + 1) * kstep;
            const char* a2 = last ? nA : cA + (size_t)(t + 2) * kstep; const char* b2 = last ? nB : cB + (size_t)(t + 2) * kstep;
            const char* a3 = a2 + kstep; const char* b3 = b2 + kstep;
            PG8_LDB(B0, 0, 0); PG8_LDB(B1, 0, 1); PG8_SCHED; PG8_LDA(At, 0, 0); PG8_STAGE(PG8_SA(1, 1), a1, voffA[1]);
            if (last && has_next) PG8_AROWS(ui + 1, nxt);
            PG8_WAIT_V(8); PG8_WAIT_L(0); PG8_BAR; PG8_MMA(0, 0, At, B0); PG8_MMA(0, 1, At, B1); PG8_BAR; PG8_SCHED;
            PG8_LDA(At, 0, 1); PG8_STAGE(PG8_SB(0, 0), b2, voffB); PG8_STAGE(PG8_SB(0, 1), b2 + bhstep, voffB); PG8_STAGE(PG8_SA(0, 0), a2, voffA[0]);
            PG8_WAIT_V(8); PG8_WAIT_L(0); PG8_BAR; PG8_MMA(1, 0, At, B0); PG8_MMA(1, 1, At, B1); PG8_BAR; PG8_SCHED;
            PG8_LDB(B0, 1, 0); PG8_LDB(B1, 1, 1); PG8_SCHED; PG8_LDA(At, 1, 0); PG8_STAGE(PG8_SA(0, 1), a2, voffA[1]);
            PG8_WAIT_V(8); PG8_WAIT_L(0); PG8_BAR; PG8_MMA(0, 0, At, B0); PG8_MMA(0, 1, At, B1); PG8_BAR; PG8_SCHED;
            PG8_LDA(At, 1, 1); PG8_STAGE(PG8_SB(1, 0), b3, voffB); PG8_STAGE(PG8_SB(1, 1), b3 + bhstep, voffB); PG8_STAGE(PG8_SA(1, 0), a3, voffA[0]);
            PG8_WAIT_V(8); PG8_WAIT_L(0); PG8_BAR; PG8_MMA(1, 0, At, B0); PG8_MMA(1, 1, At, B1); PG8_BAR; PG8_SCHED;
        }
        if (wr == 0) PG8_BAR;
        E(acc, cur, wr, wc, fr, fq);
        if (!has_next) break;
#pragma unroll
        for (int a = 0; a < 2; ++a)
#pragma unroll
            for (int b = 0; b < 2; ++b)
#pragma unroll
                for (int m = 0; m < 4; ++m)
#pragma unroll
                    for (int n = 0; n < 2; ++n) acc[a][b][m][n] = (f32x4){0.f, 0.f, 0.f, 0.f};
        cur = nxt; cA = nA; cB = nB; ++ui;
        if (wr == 1) PG8_BAR;
    }
    PG8_WAIT_V(0);
    PG8_BAR;
#undef PG8_SA
#undef PG8_SB
#undef PG8_STAGE
#undef PG8_LDA
#undef PG8_LDB
#undef PG8_MMA
#undef PG8_WAIT_V
#undef PG8_WAIT_L
#undef PG8_BAR
#undef PG8_SCHED
#undef PG8_AROWS
}

struct SchedPool {
    const bf16_t* diff; const bf16_t* w; int bid;
    DI bool next(int i, Unit& u) const { const int L = i * gridDim.x + bid; if (L >= 256) return false; u.pm = L >> 2; u.pn = L & 3; u.A = diff + 256 * u.pn; u.B = w + (size_t)u.pn * 65536; return true; }
    DI int arow(int, const Unit& u, int r) const { return u.pm * 256 + r; }
};
struct SchedDense {
    const bf16_t* A; const bf16_t* B; int npn, ldb, bid;
    DI bool next(int i, Unit& u) const { const int L = i * gridDim.x + bid; if (L >= 64 * npn) return false; u.pm = L / npn; u.pn = L % npn; u.A = A; u.B = B + (size_t)u.pn * 256 * ldb; return true; }
    DI int arow(int, const Unit& u, int r) const { return u.pm * 256 + r; }
};

struct EpiPool {
    bf16_t* x; const float* pb; const float* ps;
    DI void operator()(const f32x4 (&acc)[2][2][4][2], const Unit& u, int wr, int wc, int fr, int fq) const {
        f32x4 bb[2][2], sc[2][2];
#pragma unroll
        for (int bj = 0; bj < 2; ++bj) {
            const int c = 256 * u.pn + 128 * bj + 32 * wc + 8 * fq;
            bb[bj][0] = *(const f32x4*)(pb + c); bb[bj][1] = *(const f32x4*)(pb + c + 4); sc[bj][0] = *(const f32x4*)(ps + c); sc[bj][1] = *(const f32x4*)(ps + c + 4);
        }
#pragma unroll
        for (int ai = 0; ai < 2; ++ai) {
            u32x4 xin[4][2];
#pragma unroll
            for (int m = 0; m < 4; ++m)
#pragma unroll
                for (int bj = 0; bj < 2; ++bj)
                    xin[m][bj] = *(const u32x4*)(x + (size_t)(u.pm * 256 + 128 * ai + 64 * wr + 16 * m + fr) * DM + 256 * u.pn + 128 * bj + 32 * wc + 8 * fq);
            asm volatile("" ::: "memory");
#pragma unroll
            for (int m = 0; m < 4; ++m) {
                const int t = u.pm * 256 + 128 * ai + 64 * wr + 16 * m + fr;
#pragma unroll
                for (int bj = 0; bj < 2; ++bj) {
                    const int c = 256 * u.pn + 128 * bj + 32 * wc + 8 * fq;
                    float xv[8]; unpack8(xin[m][bj], xv);
                    const f32x4 v0 = (acc[ai][bj][m][0] + bb[bj][0]) * sc[bj][0];
                    const f32x4 v1 = (acc[ai][bj][m][1] + bb[bj][1]) * sc[bj][1];
                    u32x4 w; w[0] = cvt_pk_bf16(xv[0] + v0[0], xv[1] + v0[1]); w[1] = cvt_pk_bf16(xv[2] + v0[2], xv[3] + v0[3]); w[2] = cvt_pk_bf16(xv[4] + v1[0], xv[5] + v1[1]); w[3] = cvt_pk_bf16(xv[6] + v1[2], xv[7] + v1[3]);
                    *(u32x4*)(x + (size_t)t * DM + c) = w;
                }
            }
        }
    }
};
struct EpiWo {
    bf16_t* x;
    DI void operator()(const f32x4 (&acc)[2][2][4][2], const Unit& u, int wr, int wc, int fr, int fq) const {
#pragma unroll
        for (int ai = 0; ai < 2; ++ai) {
            u32x4 xin[4][2];
#pragma unroll
            for (int m = 0; m < 4; ++m)
#pragma unroll
                for (int bj = 0; bj < 2; ++bj)
                    xin[m][bj] = *(const u32x4*)(x + (size_t)(u.pm * 256 + 128 * ai + 64 * wr + 16 * m + fr) * DM + 256 * u.pn + 128 * bj + 32 * wc + 8 * fq);
            asm volatile("" ::: "memory");
#pragma unroll
            for (int m = 0; m < 4; ++m) {
                const int t = u.pm * 256 + 128 * ai + 64 * wr + 16 * m + fr;
#pragma unroll
                for (int bj = 0; bj < 2; ++bj) {
                    const int c = 256 * u.pn + 128 * bj + 32 * wc + 8 * fq;
                    float xv[8]; unpack8(xin[m][bj], xv);
                    const f32x4 v0 = acc[ai][bj][m][0], v1 = acc[ai][bj][m][1];
                    u32x4 w; w[0] = cvt_pk_bf16(xv[0] + v0[0], xv[1] + v0[1]); w[1] = cvt_pk_bf16(xv[2] + v0[2], xv[3] + v0[3]); w[2] = cvt_pk_bf16(xv[4] + v1[0], xv[5] + v1[1]); w[3] = cvt_pk_bf16(xv[6] + v1[2], xv[7] + v1[3]);
                    *(u32x4*)(x + (size_t)t * DM + c) = w;
                }
            }
        }
    }
};
struct EpiQKV {
    bf16_t* q; const float* rstd; const float* qg; const float* kg;
    DI void operator()(const f32x4 (&acc)[2][2][4][2], const Unit& u, int wr, int wc, int fr, int fq) const {
        const int which = u.pn >> 2, head = (u.pn & 3) * 4 + wc;
        bf16_t* out = q + (size_t)which * ((WS_K - WS_Q) / 2);
        const float* gn = which == 0 ? qg : kg;
        const float post = which == 0 ? 0.125f * 1.4426950408889634f : 1.0f;
        f32x4 g[2][2];
#pragma unroll
        for (int bj = 0; bj < 2; ++bj)
#pragma unroll
            for (int n = 0; n < 2; ++n) g[bj][n] = (which < 2) ? *(const f32x4*)(gn + 32 * bj + 8 * fq + 4 * n) * post : (f32x4){1.f, 1.f, 1.f, 1.f};
        float rsv[2][4];
#pragma unroll
        for (int ai = 0; ai < 2; ++ai)
#pragma unroll
            for (int m = 0; m < 4; ++m) rsv[ai][m] = rstd[u.pm * 256 + 128 * ai + 64 * wr + 16 * m + fr];
#pragma unroll
        for (int ai = 0; ai < 2; ++ai)
#pragma unroll
            for (int m = 0; m < 4; ++m) {
                const int t = u.pm * 256 + 128 * ai + 64 * wr + 16 * m + fr;
                const float rs = rsv[ai][m];
                f32x4 v4[2][2]; float ss = 0.f;
#pragma unroll
                for (int bj = 0; bj < 2; ++bj)
#pragma unroll
                    for (int n = 0; n < 2; ++n) { v4[bj][n] = acc[ai][bj][m][n] * rs; const f32x4 s = v4[bj][n] * v4[bj][n]; ss += (s[0] + s[1]) + (s[2] + s[3]); }
                ss += shflx(ss, fr + 16 * fq, 16); ss += shflx(ss, fr + 16 * fq, 32);
                const float r2 = (which < 2) ? rsqrtf(ss * (1.0f / HD) + EPS) : 1.0f;
#pragma unroll
                for (int bj = 0; bj < 2; ++bj) {
                    const f32x4 a = v4[bj][0] * r2 * g[bj][0], b = v4[bj][1] * r2 * g[bj][1];
                    u32x4 w; w[0] = cvt_pk_bf16(a[0], a[1]); w[1] = cvt_pk_bf16(a[2], a[3]); w[2] = cvt_pk_bf16(b[0], b[1]); w[3] = cvt_pk_bf16(b[2], b[3]);
                    *(u32x4*)(out + (size_t)t * DM + head * HD + 32 * bj + 8 * fq) = w;
                }
            }
    }
};

typedef short v4i16_t __attribute__((ext_vector_type(4)));
constexpr int AT_VPITCH = 192;
constexpr int AT_VTILE = 32 * AT_VPITCH;
DI void ph_attn(LAS unsigned char* ldsb) {
    LOAD_PARAMS();
    const int tid = tid_(), bid = bid_(), wid = tid >> 6, lane = tid & 63, l31 = lane & 31, h2 = lane >> 5;
    const bf16_t* Q = (const bf16_t*)(p.ws + WS_Q); const bf16_t* K = (const bf16_t*)(p.ws + WS_K); const bf16_t* V = (const bf16_t*)(p.ws + WS_V);
    bf16_t* O = (bf16_t*)(p.ws + WS_O);
    LAS unsigned char* vl = ldsb + wid * AT_VTILE;
    LAS unsigned char* vw = vl + (lane >> 3) * AT_VPITCH + (lane & 7) * 16;
    const LAS unsigned char* vr = vl + (4 * h2 + ((lane & 15) >> 2)) * AT_VPITCH + (16 * ((lane >> 4) & 1) + 4 * (lane & 3)) * 2;
    for (int it = 0; it < 4 * ((2 * NH * 256 / 32 - bid + (int)gridDim.x - 1) / (int)gridDim.x); ++it) {
        const int tsk = (bid + (it >> 2) * gridDim.x) * 32 + (it & 3) * 8 + wid;
        const int bh = tsk >> 8, qb = tsk & 255, b = bh >> 4, h = bh & 15;
        const size_t tb = (size_t)b * SEQ;
        const int q0 = qb * 32;
        bf16x8 qf[4];
#pragma unroll
        for (int s = 0; s < 4; ++s) qf[s] = *(const bf16x8*)(Q + (tb + q0 + l31) * DM + h * HD + 16 * s + 8 * h2);
        f32x16 o0, o1;
#pragma unroll
        for (int r = 0; r < 16; ++r) { o0[r] = 0.f; o1[r] = 0.f; }
        float R = 1.f;
        const bf16_t* kp = K + (tb + q0 + l31) * DM + h * HD + 8 * h2;
        const bf16_t* vp = V + (tb + q0 + (lane >> 3)) * DM + h * HD + (lane & 7) * 8;
        bf16x8 kn[4], kq[4]; u32x4 vn[4], vq[4];
#pragma unroll
        for (int s = 0; s < 4; ++s) { kn[s] = *(const bf16x8*)(kp + 16 * s); vn[s] = *(const u32x4*)(vp + (size_t)8 * s * DM); }
        if (qb > 0) {
            kp -= (size_t)32 * DM; vp -= (size_t)32 * DM;
#pragma unroll
            for (int s = 0; s < 4; ++s) { kq[s] = *(const bf16x8*)(kp + 16 * s); vq[s] = *(const u32x4*)(vp + (size_t)8 * s * DM); }
        }
        for (int kt = qb; kt >= 0; --kt) {
            bf16x8 kf[4];
#pragma unroll
            for (int s = 0; s < 4; ++s) { kf[s] = kn[s]; *(LAS u32x4*)(vw + 8 * s * AT_VPITCH) = vn[s]; kn[s] = kq[s]; vn[s] = vq[s]; }
            if (kt > 1) {
                kp -= (size_t)32 * DM; vp -= (size_t)32 * DM;
#pragma unroll
                for (int s = 0; s < 4; ++s) { kq[s] = *(const bf16x8*)(kp + 16 * s); vq[s] = *(const u32x4*)(vp + (size_t)8 * s * DM); }
            }
            f32x16 z;
#pragma unroll
            for (int r = 0; r < 16; ++r) z[r] = 0.f;
#pragma unroll
            for (int s = 0; s < 4; ++s) z = __builtin_amdgcn_mfma_f32_32x32x16_bf16(kf[s], qf[s], z, 0, 0, 0);
            float kp_[16], gs[4], ot[4];
#pragma unroll
            for (int r = 0; r < 16; ++r) kp_[r] = __builtin_amdgcn_rcpf(1.0f + __builtin_amdgcn_exp2f(z[r]));
            if (kt == qb) {
#pragma unroll
                for (int r = 0; r < 16; ++r) { const int kl = (r & 3) + 8 * (r >> 2) + 4 * h2; kp_[r] = (kl < l31) ? kp_[r] : 1.0f; }
            }
#pragma unroll
            for (int bb = 0; bb < 4; ++bb) { gs[bb] = (kp_[4 * bb] * kp_[4 * bb + 1]) * (kp_[4 * bb + 2] * kp_[4 * bb + 3]); ot[bb] = shflx(gs[bb], lane, 32); }
            const float tot_own = (gs[0] * gs[1]) * (gs[2] * gs[3]);
            const float tot_oth = (ot[0] * ot[1]) * (ot[2] * ot[3]);
            float later[4];
            {
                float own_tail = 1.f, oth_tail = 1.f;
#pragma unroll
                for (int bb = 3; bb >= 0; --bb) {
                    later[bb] = own_tail * oth_tail * (h2 == 0 ? ot[bb] : 1.f);
                    own_tail *= gs[bb]; oth_tail *= ot[bb];
                }
            }
            float a[16];
#pragma unroll
            for (int bb = 0; bb < 4; ++bb) {
                const float x3 = R * later[bb];
                const float x2 = x3 * kp_[4 * bb + 3], x1 = x2 * kp_[4 * bb + 2], x0 = x1 * kp_[4 * bb + 1];
                a[4 * bb] = x0 - x0 * kp_[4 * bb]; a[4 * bb + 1] = x1 - x1 * kp_[4 * bb + 1]; a[4 * bb + 2] = x2 - x2 * kp_[4 * bb + 2]; a[4 * bb + 3] = x3 - x3 * kp_[4 * bb + 3];
            }
            R *= (h2 == 0) ? (tot_own * tot_oth) : (tot_oth * tot_own);
#pragma unroll
            for (int s = 0; s < 2; ++s) {
                u32x4 pw;
#pragma unroll
                for (int i = 0; i < 4; ++i) pw[i] = cvt_pk_bf16(a[8 * s + 2 * i], a[8 * s + 2 * i + 1]);
                const bf16x8 pa = __builtin_bit_cast(bf16x8, pw);
#pragma unroll
                for (int db = 0; db < 2; ++db) {
                    const v4i16_t lo4 = __builtin_amdgcn_ds_read_tr16_b64_v4i16((LAS v4i16_t*)(vr + (16 * s) * AT_VPITCH + 64 * db));
                    const v4i16_t hi4 = __builtin_amdgcn_ds_read_tr16_b64_v4i16((LAS v4i16_t*)(vr + (16 * s + 8) * AT_VPITCH + 64 * db));
                    bf16x8 vf; vf[0] = lo4[0]; vf[1] = lo4[1]; vf[2] = lo4[2]; vf[3] = lo4[3]; vf[4] = hi4[0]; vf[5] = hi4[1]; vf[6] = hi4[2]; vf[7] = hi4[3];
                    if (db == 0) o0 = __builtin_amdgcn_mfma_f32_32x32x16_bf16(vf, pa, o0, 0, 0, 0);
                    else o1 = __builtin_amdgcn_mfma_f32_32x32x16_bf16(vf, pa, o1, 0, 0, 0);
                }
            }
            if (__all(R < 1.0e-36f)) break;
        }
#pragma unroll
        for (int db = 0; db < 2; ++db)
#pragma unroll
            for (int rb = 0; rb < 4; ++rb) {
                const f32x16& o = db == 0 ? o0 : o1;
                u32x2 w; w[0] = cvt_pk_bf16(o[4 * rb], o[4 * rb + 1]); w[1] = cvt_pk_bf16(o[4 * rb + 2], o[4 * rb + 3]);
                *(u32x2*)(O + (tb + q0 + l31) * DM + h * HD + 32 * db + 8 * rb + 4 * h2) = w;
            }
    }
}

constexpr int RT_PART = 0;
constexpr int RT_SSQ = RT_PART + 4 * 64 * 52 * 4;
constexpr int RT_LCNT = RT_SSQ + 4 * 64 * 4;
constexpr int RT_GB = RT_LCNT + 128;
DI void ph_router(LAS unsigned char* lds, int li) {
    LOAD_PARAMS();
    const bf16_t* xcur = (const bf16_t*)(p.ws + ((li & 1) ? WS_XB1 : WS_XB));
    const int tid = tid_(), bid = bid_(), wid = tid >> 6, lane = tid & 63, fr = lane & 15, fq = lane >> 4;
    const bf16_t* wh = (const bf16_t*)(p.ws + WS_WRH) + (size_t)li * 48 * DM;
    const bf16_t* wl = (const bf16_t*)(p.ws + WS_WRL) + (size_t)li * 48 * DM;
    const float* bg = p.moe_bg + li * 4;
    const float* br = p.moe_br + li * 32;
    unsigned* cnt = (unsigned*)(p.ws + WS_CTL) + CW_CNT + 32 * li;
    Entry* list = (Entry*)(p.ws + WS_LIST);
    LAS float* part = (LAS float*)(lds + RT_PART); LAS float* ssq = (LAS float*)(lds + RT_SSQ);
    LAS int* lcnt = (LAS int*)(lds + RT_LCNT); LAS int* gb = (LAS int*)(lds + RT_GB);
    const int th = wid & 1, kq = wid >> 1;
    for (int chunk = bid; chunk < T / 64; chunk += gridDim.x) {
        const int t = chunk * 64 + th * 32 + fr;
        const bf16_t* xr = xcur + (size_t)t * DM + kq * 256 + fq * 8;
        const bf16_t* whr = wh + (size_t)fr * DM + kq * 256 + fq * 8;
        const bf16_t* wlr = wl + (size_t)fr * DM + kq * 256 + fq * 8;
        f32x4 acc[2][3]; float ss[2] = {0.f, 0.f};
#pragma unroll
        for (int b = 0; b < 2; ++b)
#pragma unroll
            for (int nb = 0; nb < 3; ++nb) acc[b][nb] = (f32x4){0.f, 0.f, 0.f, 0.f};
#pragma unroll 4
        for (int ks = 0; ks < 8; ++ks) {
            bf16x8 xh[2];
#pragma unroll
            for (int b = 0; b < 2; ++b) {
                const u32x4 xw = *(const u32x4*)(xr + (size_t)b * 16 * DM + ks * 32);
                float xf[8]; unpack8(xw, xf);
#pragma unroll
                for (int e = 0; e < 8; ++e) ss[b] += xf[e] * xf[e];
                xh[b] = __builtin_bit_cast(bf16x8, xw);
            }
#pragma unroll
            for (int nb = 0; nb < 3; ++nb) {
                const bf16x8 wH = *(const bf16x8*)(whr + (size_t)nb * 16 * DM + ks * 32), wL = *(const bf16x8*)(wlr + (size_t)nb * 16 * DM + ks * 32);
#pragma unroll
                for (int b = 0; b < 2; ++b) {
                    acc[b][nb] = __builtin_amdgcn_mfma_f32_16x16x32_bf16(wH, xh[b], acc[b][nb], 0, 0, 0);
                    acc[b][nb] = __builtin_amdgcn_mfma_f32_16x16x32_bf16(wL, xh[b], acc[b][nb], 0, 0, 0);
                }
            }
        }
#pragma unroll
        for (int b = 0; b < 2; ++b) {
            float sv = ss[b]; sv += shflx(sv, lane, 16); sv += shflx(sv, lane, 32);
            const int tl = th * 32 + 16 * b + fr;
#pragma unroll
            for (int nb = 0; nb < 3; ++nb) *(LAS f32x4*)(part + (kq * 64 + tl) * 52 + 16 * nb + 4 * fq) = acc[b][nb];
            if (fq == 0) ssq[kq * 64 + tl] = sv;
        }
        if (tid < 32) lcnt[tid] = 0;
        __syncthreads();
        int ea = 0, eb = 0, la = 0, lb = 0; float w1 = 0.f, w2 = 0.f, rs = 0.f;
        if (tid < 64) {
            rs = rsqrtf(((ssq[tid] + ssq[64 + tid]) + (ssq[128 + tid] + ssq[192 + tid])) * (1.0f / DM) + EPS);
            float lg[36];
#pragma unroll
            for (int q = 0; q < 9; ++q) {
                const f32x4 u0 = *(const LAS f32x4*)(part + tid * 52 + 4 * q), u1 = *(const LAS f32x4*)(part + (64 + tid) * 52 + 4 * q);
                const f32x4 u2 = *(const LAS f32x4*)(part + (128 + tid) * 52 + 4 * q), u3 = *(const LAS f32x4*)(part + (192 + tid) * 52 + 4 * q);
#pragma unroll
                for (int e = 0; e < 4; ++e) lg[4 * q + e] = ((u0[e] + u1[e]) + (u2[e] + u3[e])) * rs;
            }
            float gl[4];
#pragma unroll
            for (int n = 0; n < 4; ++n) gl[n] = lg[n] + bg[n];
            int g = 0; float gm = gl[0];
#pragma unroll
            for (int n = 1; n < 4; ++n) if (gl[n] > gm) { gm = gl[n]; g = n; }
            float den = 0.f;
#pragma unroll
            for (int n = 0; n < 4; ++n) den += __expf(gl[n] - gm);
            const float gprob = 1.0f / den;
            float el[8];
#pragma unroll
            for (int n = 0; n < 8; ++n) {
                float v = 0.f;
#pragma unroll
                for (int gg = 0; gg < 4; ++gg) v = (g == gg) ? lg[4 + 8 * gg + n] + br[8 * gg + n] : v;
                el[n] = v;
            }
            int e1 = 0; float m1 = el[0];
#pragma unroll
            for (int n = 1; n < 8; ++n) if (el[n] > m1) { m1 = el[n]; e1 = n; }
            int e2 = -1; float m2 = -3.0e38f;
#pragma unroll
            for (int n = 0; n < 8; ++n) if (n != e1 && (e2 < 0 || el[n] > m2)) { m2 = el[n]; e2 = n; }
            const float ex = __expf(m2 - m1);
            w1 = gprob / (1.0f + ex); w2 = gprob * ex / (1.0f + ex);
            ea = 8 * g + e1; eb = 8 * g + e2;
            la = __hip_atomic_fetch_add(lcnt + ea, 1, __ATOMIC_RELAXED, __HIP_MEMORY_SCOPE_WORKGROUP);
            lb = __hip_atomic_fetch_add(lcnt + eb, 1, __ATOMIC_RELAXED, __HIP_MEMORY_SCOPE_WORKGROUP);
        }
        __syncthreads();
        if (tid < 32) { const int c = lcnt[tid]; gb[tid] = c ? (int)atomicAdd(&cnt[tid], (unsigned)c) : 0; }
        __syncthreads();
        if (tid < 64) {
            const int tt = chunk * 64 + tid;
            Entry A; A.dst = tt; A.rstd = rs; A.w = w1; A.tok = tt;
            Entry B; B.dst = T + tt; B.rstd = rs; B.w = w2; B.tok = tt;
            list[(size_t)ea * LIST_CAP + gb[ea] + la] = A;
            list[(size_t)eb * LIST_CAP + gb[eb] + lb] = B;
        }
        __syncthreads();
    }
}

constexpr int MOE_MAXU = 4;
constexpr int LDS_ROWTAB = STAGE_BYTES;
constexpr int LDS_EPITAB = LDS_ROWTAB + MOE_MAXU * 1024;
constexpr int LDS_UTAB = LDS_EPITAB + MOE_MAXU * 2048;
constexpr int LDS_XBW = LDS_UTAB + MOE_MAXU * 32;
constexpr int LDS_BYTES = 147456;
static_assert(LDS_XBW + 16 <= LDS_BYTES, "LDS map");
struct SchedMoe {
    LAS unsigned char* lds; const bf16_t* A; const bf16_t* W; bool gather; size_t w_estride; int w_pnrows, ldb;
    DI void build(const unsigned* cnt, const Entry* list, int npn, int lo, int hi, int first, int stride, int tid) {
        LAS int* ut = (LAS int*)(lds + LDS_UTAB); LAS unsigned* rt = (LAS unsigned*)(lds + LDS_ROWTAB);
        const int lane = tid & 63;
        if (tid < 64) {
            const int c = (int)cnt[lane & 31], ntl = (c + 255) >> 8;
            int inc = ntl;
#pragma unroll
            for (int d = 1; d < 32; d <<= 1) { const int v = __builtin_amdgcn_ds_bpermute(((lane - d) & 63) << 2, inc); if ((lane & 31) >= d) inc += v; }
            const int exc = inc - ntl;
#pragma unroll
            for (int i = 0; i < MOE_MAXU; ++i) {
                const int L = lo + first + i * stride, rtile = L / npn, pn = L % npn;
                const bool hit = (first >= 0) && (L < hi) && (lane < 32) && (rtile >= exc) && (rtile < inc);
                const unsigned long long mask = __ballot(hit);
                int found = 0, e = 0, j = 0, nv = 0;
                if (mask) {
                    found = 1; e = __builtin_ctzll(mask);
                    j = rtile - __builtin_amdgcn_readlane(exc, e); nv = __builtin_amdgcn_readlane(c, e) - 256 * j; nv = nv > 256 ? 256 : nv;
                }
                if (lane == 0) { ut[i * 8 + 0] = found; ut[i * 8 + 1] = e; ut[i * 8 + 2] = nv; ut[i * 8 + 3] = 256 * rtile; ut[i * 8 + 4] = e * LIST_CAP + 256 * j; ut[i * 8 + 5] = pn; }
            }
        }
        __syncthreads();
        if (tid < 256) {
#pragma unroll
            for (int i = 0; i < MOE_MAXU; ++i) {
                if (!ut[i * 8]) continue;
                const int nv = ut[i * 8 + 2], lb = ut[i * 8 + 4];
                Entry en; en.dst = DUMMY_ROW; en.rstd = 0.f; en.w = 0.f; en.tok = 0;
                if (tid < nv) en = list[lb + tid];
                LAS float* et = (LAS float*)(lds + LDS_EPITAB) + (i * 256 + tid) * 2;
                if (gather) { rt[i * 256 + tid] = (unsigned)en.tok; et[0] = en.rstd; et[1] = en.w; }
                else { et[0] = __int_as_float(en.dst); et[1] = 0.f; }
            }
        }
        asm volatile("s_waitcnt vmcnt(0) lgkmcnt(0)" ::: "memory");
        __syncthreads();
    }
    DI bool next(int i, Unit& u) const {
        if (i >= MOE_MAXU) return false;
        const LAS int* ut = (const LAS int*)(lds + LDS_UTAB) + i * 8;
        const int found = __builtin_amdgcn_readfirstlane(ut[0]);
        if (!found) return false;
        u.e = __builtin_amdgcn_readfirstlane(ut[1]); u.nvalid = __builtin_amdgcn_readfirstlane(ut[2]); u.row0 = __builtin_amdgcn_readfirstlane(ut[3]);
        u.lbase = i * 256; u.pn = __builtin_amdgcn_readfirstlane(ut[5]); u.pm = u.row0 >> 8;
        u.A = gather ? A : A + (size_t)u.row0 * DE;
        u.B = W + (size_t)u.e * w_estride + (size_t)u.pn * w_pnrows * ldb;
        return true;
    }
    DI int arow(int ui, const Unit&, int r) const { if (!gather) return r; return (int)((const LAS unsigned*)(lds + LDS_ROWTAB))[ui * 256 + r]; }
};
struct EpiGU {
    bf16_t* hid; LAS unsigned char* lds;
    DI void operator()(const f32x4 (&acc)[2][2][4][2], const Unit& u, int wr, int wc, int fr, int fq) const {
        typedef float f32x2 __attribute__((ext_vector_type(2)));
#pragma unroll
        for (int ai = 0; ai < 2; ++ai)
#pragma unroll
            for (int m = 0; m < 4; ++m) {
                const int r = 128 * ai + 64 * wr + 16 * m + fr;
                const f32x2 rw = *(const LAS f32x2*)(lds + LDS_EPITAB + (u.lbase + r) * 8);
                const float rs = rw[0], w = rw[1];
                unsigned pk[4];
#pragma unroll
                for (int n = 0; n < 2; ++n) {
                    float hv[4];
#pragma unroll
                    for (int e = 0; e < 4; ++e) { const float g = acc[ai][0][m][n][e] * rs, up = acc[ai][1][m][n][e] * rs; hv[e] = g * __builtin_amdgcn_rcpf(1.0f + __builtin_amdgcn_exp2f(-1.4426950408889634f * g)) * up * w; }
                    pk[2 * n] = cvt_pk_bf16(hv[0], hv[1]); pk[2 * n + 1] = cvt_pk_bf16(hv[2], hv[3]);
                }
                u32x4 wv; wv[0] = pk[0]; wv[1] = pk[1]; wv[2] = pk[2]; wv[3] = pk[3];
                *(u32x4*)(hid + (size_t)(u.row0 + r) * DE + 128 * u.pn + 32 * wc + 8 * fq) = wv;
            }
    }
};
struct EpiDown {
    bf16_t* yb; LAS unsigned char* lds;
    DI void operator()(const f32x4 (&acc)[2][2][4][2], const Unit& u, int wr, int wc, int fr, int fq) const {
#pragma unroll
        for (int ai = 0; ai < 2; ++ai)
#pragma unroll
            for (int m = 0; m < 4; ++m) {
                const int r = 128 * ai + 64 * wr + 16 * m + fr;
                const int dst = *(const LAS int*)(lds + LDS_EPITAB + (u.lbase + r) * 8);
                if (dst == DUMMY_ROW) continue;
#pragma unroll
                for (int bj = 0; bj < 2; ++bj) {
                    const f32x4 a = acc[ai][bj][m][0], b = acc[ai][bj][m][1];
                    u32x4 w; w[0] = cvt_pk_bf16(a[0], a[1]); w[1] = cvt_pk_bf16(a[2], a[3]); w[2] = cvt_pk_bf16(b[0], b[1]); w[3] = cvt_pk_bf16(b[2], b[3]);
                    *(u32x4*)(yb + (size_t)dst * DM + 256 * u.pn + 128 * bj + 32 * wc + 8 * fq) = w;
                }
            }
    }
};

DI void ph_poolgemm(LAS unsigned char* lds, int j) {
    LOAD_PARAMS();
    SchedPool S; S.bid = xbid_(); S.diff = (const bf16_t*)(p.ws + WS_DIFF); S.w = (const bf16_t*)(p.ws + WS_WPOOL) + (size_t)j * 4 * 65536;
    EpiPool E; E.x = (bf16_t*)(p.ws + WS_XB); E.pb = p.pool_b + j * DM; E.ps = p.pool_scale + j * DM;
    gemm_phase<GCfg<1024, 256, 256, 128, false>>(lds, S, E);
}
DI void ph_qkv(LAS unsigned char* lds, int j) {
    LOAD_PARAMS();
    SchedDense S; S.bid = xbid_(); S.A = (const bf16_t*)(p.ws + WS_XB1); S.B = (const bf16_t*)(p.ws + WS_WQKV) + (size_t)j * 3072 * 1024; S.npn = 12; S.ldb = 1024;
    EpiQKV E; E.q = (bf16_t*)(p.ws + WS_Q); E.rstd = (const float*)(p.ws + WS_RSTD); E.qg = p.sb_qg + j * HD; E.kg = p.sb_kg + j * HD;
    gemm_phase<GCfg<1024, 1024, 1024, 32, true>>(lds, S, E);
}
DI void ph_wo(LAS unsigned char* lds, int j) {
    LOAD_PARAMS();
    SchedDense S; S.bid = xbid_(); S.A = (const bf16_t*)(p.ws + WS_O); S.B = (const bf16_t*)(p.ws + WS_WO) + (size_t)j * 1024 * 1024; S.npn = 4; S.ldb = 1024;
    EpiWo E; E.x = (bf16_t*)(p.ws + WS_XB1);
    gemm_phase<GCfg<1024, 1024, 1024, 128, false>>(lds, S, E);
}
struct MoePlan { int NT, R1, nB, D1; };
DI MoePlan moe_plan(const unsigned* cnt) {
    const int lane = tid_() & 63;
    int nt = ((int)cnt[lane & 31] + 255) >> 8;
#pragma unroll
    for (int o = 1; o < 32; o <<= 1) nt += __builtin_amdgcn_ds_bpermute((lane ^ o) << 2, nt);
    nt = __builtin_amdgcn_readfirstlane(nt);
    MoePlan m; m.NT = nt; const int G = gridDim.x; m.R1 = nt < G / 2 ? nt : G / 2;
    const int late = 2 * (nt - m.R1); m.nB = late < G ? late : G;
    const int cap = 2 * (G - m.nB); m.D1 = 4 * m.R1 < cap ? 4 * m.R1 : cap;
    return m;
}
DI void ph_cvt_stage1(LAS unsigned char* ldsb, int L, const MoePlan m) {
    LOAD_PARAMS();
    const int bid = xbid_(), r = bid >= m.nB ? bid - m.nB : -1;
    const int n = (int)gridDim.x - m.nB;
    if (n >= 32) { if (r >= 0) cvt_run(ldsb, p, 1, L, CVT_S1, r, n, tid_()); }
    else cvt_run(ldsb, p, 1, L, CVT_S1, xbid_(), gridDim.x, tid_());
}
DI void ph_gu(LAS unsigned char* lds, int li, int stage, const MoePlan m) {
    LOAD_PARAMS();
    const Entry* list = (const Entry*)(p.ws + WS_LIST);
    const unsigned* cnt = (const unsigned*)(p.ws + WS_CTL) + CW_CNT + 32 * li;
    const int bid = xbid_();
    if (stage == 2 || (stage == 1 && bid >= m.nB)) return;
    SchedMoe S; S.lds = lds; S.A = (const bf16_t*)(p.ws + ((li & 1) ? WS_XB1 : WS_XB));
    S.W = (const bf16_t*)(p.ws + WS_WGU) + (size_t)li * NE * 512 * 1024; S.gather = true; S.w_estride = (size_t)512 * 1024; S.w_pnrows = 128; S.ldb = 1024;
    const int lo = stage == 0 ? 0 : 2 * m.R1, hi = stage == 0 ? 2 * m.R1 : 2 * m.NT, G = gridDim.x;
    EpiGU E; E.hid = (bf16_t*)(p.ws + WS_HID); E.lds = lds;
    for (int first = bid; lo + first < hi; first += MOE_MAXU * G) {
        S.build(cnt, list, 2, lo, hi, first, G, tid_());
        gemm_phase<GCfg<1024, 1024, 1024, 256, false>>(lds, S, E);
        __syncthreads();
    }
}
DI void ph_down(LAS unsigned char* lds, int li, int stage, const MoePlan m) {
    LOAD_PARAMS();
    const Entry* list = (const Entry*)(p.ws + WS_LIST);
    const unsigned* cnt = (const unsigned*)(p.ws + WS_CTL) + CW_CNT + 32 * li;
    const int bid = xbid_(), G = gridDim.x;
    if (stage == 0 || (stage == 1 && bid < m.nB)) return;
    SchedMoe S; S.lds = lds; S.A = (const bf16_t*)(p.ws + WS_HID);
    S.W = (const bf16_t*)(p.ws + WS_WD) + (size_t)li * NE * 1024 * 256; S.gather = false; S.w_estride = (size_t)1024 * 256; S.w_pnrows = 256; S.ldb = 256;
    const int lo = stage == 1 ? 0 : m.D1, hi = stage == 1 ? m.D1 : 4 * m.NT, stride = stage == 1 ? G - m.nB : G;
    EpiDown E; E.yb = (bf16_t*)(p.ws + WS_YBUF); E.lds = lds;
    for (int first = stage == 1 ? bid - m.nB : bid; lo + first < hi; first += MOE_MAXU * stride) {
        S.build(cnt, list, 4, lo, hi, first, stride, tid_());
        gemm_phase<GCfg<256, 256, 256, 128, false>>(lds, S, E);
        __syncthreads();
    }
}
DI MoePlan moe_layer_plan(int li) {
    LOAD_PARAMS();
    return moe_plan((const unsigned*)(p.ws + WS_CTL) + CW_CNT + 32 * li);
}

#define XB_TMO      128
#define XB_XCNT(j)  (256  + 64 * (j))
#define XB_XSUB(j)  (1280 + 64 * (j))
#define XB_XGEN(j)  (2304 + 64 * (j))
#define XB_TOP      3328
#define XB_TOPGEN   3392
#define XCD_BAR_WORDS 3456
#define XB_SPIN_CAP (1u << 18)

__device__ __forceinline__ unsigned xb_ld(unsigned* p)              { return __hip_atomic_load(p, __ATOMIC_RELAXED, __HIP_MEMORY_SCOPE_AGENT); }
__device__ __forceinline__ unsigned xb_add(unsigned* p, unsigned v) { return __hip_atomic_fetch_add(p, v, __ATOMIC_RELAXED, __HIP_MEMORY_SCOPE_AGENT); }
__device__ __forceinline__ unsigned xb_xcc_id() { return (unsigned)__builtin_amdgcn_s_getreg((3 << 11) | 20) & 0xFu; }
#define XB_SPIN(cond, bar) do { unsigned _sp = 0; while (cond) { __builtin_amdgcn_s_sleep(1); \
    if ((++_sp & 255u) == 0u) { if (xb_ld(&(bar)[XB_TMO])) break; if (_sp > XB_SPIN_CAP) { atomicAdd(&(bar)[XB_TMO], 1u); break; } } } } while (0)

struct XcdBarrier {
    unsigned* bar; unsigned x;
    volatile LAS unsigned* st;
};

__device__ __forceinline__ XcdBarrier xcd_barrier_post(unsigned* bar, volatile LAS unsigned* st) {
    XcdBarrier b; b.bar = bar; b.x = xb_xcc_id(); b.st = st;
    if (threadIdx.x == 0) (void)xb_add(&bar[XB_XCNT(b.x)], 1u);
    return b;
}
__device__ __forceinline__ void xcd_barrier_complete(unsigned* bar, unsigned x, unsigned& nloc, unsigned& nx) {
    const unsigned G = gridDim.x * gridDim.y * gridDim.z;
    unsigned sum, cnt, mine, sp = 0u;
    for (;;) {
        sum = 0u; cnt = 0u; mine = 0u;
#pragma unroll
        for (unsigned j = 0; j < 16; ++j) { const unsigned c = xb_ld(&bar[XB_XCNT(j)]); sum += c; cnt += (c > 0u) ? 1u : 0u; mine = (j == x) ? c : mine; }
        if (sum == G) break;
        __builtin_amdgcn_s_sleep(1);
        if ((++sp & 255u) == 0u) { if (xb_ld(&bar[XB_TMO])) break; if (sp > XB_SPIN_CAP) { atomicAdd(&bar[XB_TMO], 1u); break; } }
    }
    nloc = mine > 0u ? mine : 1u; nx = cnt > 0u ? cnt : 1u;
}

__device__ __forceinline__ void xcd_barrier(const XcdBarrier& b) {
    asm volatile("s_waitcnt vmcnt(0)" ::: "memory");
    __syncthreads();
    if (threadIdx.x == 0) {
        unsigned* bar = b.bar; unsigned bx = b.x;
        asm volatile("" : "+s"(bar), "+s"(bx));
        __builtin_amdgcn_s_waitcnt(0);
        unsigned nloc = b.st[0], nx = b.st[1];
        if (nloc == 0u) { xcd_barrier_complete(bar, bx, nloc, nx); b.st[0] = nloc; b.st[1] = nx; }
        const unsigned old = xb_add(&bar[XB_XSUB(bx)], 1u);
        const unsigned gen = old / nloc;
        if (old + 1u == (gen + 1u) * nloc) {
            __builtin_amdgcn_fence(__ATOMIC_RELEASE, "agent");
            asm volatile("s_waitcnt vmcnt(0)" ::: "memory");
            const unsigned og = xb_add(&bar[XB_TOP], 1u);
            const unsigned tg = og / nx;
            if (og + 1u == (tg + 1u) * nx) xb_add(&bar[XB_TOPGEN], 1u);
            else XB_SPIN(xb_ld(&bar[XB_TOPGEN]) == tg, bar);
            __builtin_amdgcn_fence(__ATOMIC_ACQUIRE, "agent");
            xb_add(&bar[XB_XGEN(bx)], 1u);
            asm volatile("s_waitcnt vmcnt(0)" ::: "memory");
        } else {
            XB_SPIN(xb_ld(&bar[XB_XGEN(bx)]) == gen, bar);
            __builtin_amdgcn_fence(__ATOMIC_ACQUIRE, "agent");
            asm volatile("s_waitcnt vmcnt(0)" ::: "memory");
        }
    }
    __syncthreads();
}
constexpr int CW_BAR = 4096;

extern __shared__ __attribute__((aligned(16))) unsigned char smem_raw[];
__global__ void __launch_bounds__(NTHR, 2) fwd(Params pk) {
    LAS unsigned char* smem = (LAS unsigned char*)smem_raw;
    if (threadIdx.x < 4) ((LAS unsigned*)(smem + LDS_XBW))[threadIdx.x] = 0u;
    __syncthreads();
    XcdBarrier bar;
    { LOAD_PARAMS(); bar = xcd_barrier_post((unsigned*)(p.ws + WS_CTL) + CW_BAR, (volatile LAS unsigned*)(smem + LDS_XBW)); }
    ph_prologue(smem);
    __syncthreads();
    for (int i = 0; i < DEPTH; ++i) {
        const int j = i >> 1;
        if ((i & 1) == 0) {
            ph_poolfuse(smem, j, i == 0);
            xcd_barrier(bar);
            ph_poolgemm(smem, j);
        } else {
            ph_combine<false>(0);
            xcd_barrier(bar);
            ph_qkv(smem, j);
            xcd_barrier(bar);
            ph_attn(smem);
            xcd_barrier(bar);
            ph_wo(smem, j);
        }
        xcd_barrier(bar);
        ph_router(smem, i);
        xcd_barrier(bar);
        const MoePlan mp = moe_layer_plan(i);
        for (int st = 0; st < 3; ++st) {
            const int ns2 = 4 * mp.NT - mp.D1;
            if (st == 2 && ns2 <= 0 && i == DEPTH - 1) break;
            ph_gu(smem, i, st, mp);
            ph_down(smem, i, st, mp);
            if (st == 1 && i < DEPTH - 1) ph_cvt_stage1(smem, i + 1, mp);
            if (st == 2 && i < DEPTH - 1) ph_cvt_deferred(smem, i + 1, ns2 < 0 ? 0 : (ns2 > (int)gridDim.x ? (int)gridDim.x : ns2));
            xcd_barrier(bar);
        }
    }
    ph_combine<true>(1);
}

extern "C" void kernel_launch(void* const* d_in, const int* in_sizes, int n_in, void* d_out, int out_size, void* d_ws, size_t ws_size, hipStream_t stream) {
    if (ws_size < WS_NEED || n_in < 18) return;
    Params p{};
    p.x_in = (const float*)d_in[0]; p.pool_norm = (const float*)d_in[1]; p.pool_w = (const float*)d_in[2]; p.pool_b = (const float*)d_in[3]; p.pool_scale = (const float*)d_in[4];
    p.sb_norm = (const float*)d_in[5]; p.sb_wqkv = (const float*)d_in[6]; p.sb_qg = (const float*)d_in[7]; p.sb_kg = (const float*)d_in[8]; p.sb_wo = (const float*)d_in[9];
    p.moe_norm = (const float*)d_in[10]; p.moe_wg = (const float*)d_in[11]; p.moe_bg = (const float*)d_in[12]; p.moe_wr = (const float*)d_in[13]; p.moe_br = (const float*)d_in[14];
    p.moe_wgate = (const float*)d_in[15]; p.moe_wup = (const float*)d_in[16]; p.moe_wdown = (const float*)d_in[17];
    p.x = (float*)d_out; p.ws = (unsigned char*)d_ws;
    static int grid = 0;
    if (!grid) {
        int dev = 0, cus = 0, per_cu = 0;
        if (hipGetDevice(&dev) != hipSuccess || hipDeviceGetAttribute(&cus, hipDeviceAttributeMultiprocessorCount, dev) != hipSuccess) { grid = -1; return; }
        if (hipFuncSetAttribute((const void*)fwd, hipFuncAttributeMaxDynamicSharedMemorySize, LDS_BYTES) != hipSuccess) { grid = -1; return; }
        if (hipOccupancyMaxActiveBlocksPerMultiprocessor(&per_cu, (const void*)fwd, NTHR, LDS_BYTES) != hipSuccess || per_cu < 1) { (void)hipGetLastError(); }
        grid = cus;
    }
    if (grid <= 0) return;
    (void)hipMemsetAsync((char*)d_ws + WS_CTL, 0, CTL_BYTES, stream);
    hipLaunchKernelGGL(fwd, dim3(grid), dim3(NTHR), LDS_BYTES, stream, p);
}
```

```cpp
#include <hip/hip_runtime.h>
#include <stdint.h>

#define DI __device__ __forceinline__
#define LAS __attribute__((address_space(3)))
typedef unsigned short bf16_t;
typedef short bf16x8 __attribute__((ext_vector_type(8)));
typedef float f32x4 __attribute__((ext_vector_type(4)));
typedef float f32x16 __attribute__((ext_vector_type(16)));
typedef unsigned u32x4 __attribute__((ext_vector_type(4)));
typedef unsigned u32x2 __attribute__((ext_vector_type(2)));

constexpr int T = 16384, DM = 1024, SEQ = 8192, NH = 16, HD = 64, DEPTH = 4, NE = 32, DE = 256;
constexpr float EPS = 1e-6f;
constexpr int NTHR = 512, NWAVE = 8;
constexpr int LIST_CAP = 16384;
constexpr int DUMMY_ROW = 2 * T;

constexpr size_t MiB = 1u << 20;
constexpr size_t WS_CTL = 0, CTL_BYTES = 1 * MiB;
constexpr size_t WS_WQKV = 1 * MiB;
constexpr size_t WS_WO = 13 * MiB;
constexpr size_t WS_WPOOL = 17 * MiB;
constexpr size_t WS_RSTD = 18 * MiB;
constexpr size_t WS_WRH = 19 * MiB, WS_WRL = WS_WRH + 512 * 1024;
constexpr size_t WS_WGU = 20 * MiB;
constexpr size_t WS_WD = 148 * MiB;
constexpr size_t WS_XB = 212 * MiB;
constexpr size_t WS_XB1 = 384 * MiB;
constexpr size_t WS_NEED = 416 * MiB;
constexpr size_t WS_LIST = 244 * MiB;
constexpr size_t WS_Q = 256 * MiB;
constexpr size_t WS_DIFF = WS_Q;
constexpr size_t WS_K = 288 * MiB, WS_V = 320 * MiB, WS_O = 352 * MiB;
constexpr size_t WS_YBUF = 288 * MiB;
constexpr size_t WS_HID = 354 * MiB;
constexpr size_t WS_END = 384 * MiB;
static_assert(WS_V - WS_K == WS_K - WS_Q, "Q, K, V equally spaced");
static_assert(WS_YBUF + (size_t)(2 * T + 1) * DM * 2 <= WS_HID, "ybuf");
static_assert(WS_HID + (size_t)(2 * T + NE * 256) * DE * 2 <= WS_END, "hid");
constexpr int CW_CNT = 1024;

struct Entry { int dst; float rstd; float w; int tok; };

struct Params {
    const float* x_in; const float* pool_norm; const float* pool_w; const float* pool_b; const float* pool_scale;
    const float* sb_norm; const float* sb_wqkv; const float* sb_qg; const float* sb_kg; const float* sb_wo;
    const float* moe_norm; const float* moe_wg; const float* moe_bg; const float* moe_wr; const float* moe_br;
    const float* moe_wgate; const float* moe_wup; const float* moe_wdown;
    float* x;
    unsigned char* ws;
};

typedef const unsigned long long __attribute__((address_space(4)))* KArgPtr;
#define GP(T, i) ((T*)(T __attribute__((address_space(1)))*)q[i])
DI Params load_params() {
    KArgPtr q = (KArgPtr)__builtin_amdgcn_kernarg_segment_ptr(); asm volatile("" : "+s"(q));
    Params p;
    p.x_in = GP(const float, 0); p.pool_norm = GP(const float, 1); p.pool_w = GP(const float, 2); p.pool_b = GP(const float, 3); p.pool_scale = GP(const float, 4);
    p.sb_norm = GP(const float, 5); p.sb_wqkv = GP(const float, 6); p.sb_qg = GP(const float, 7); p.sb_kg = GP(const float, 8); p.sb_wo = GP(const float, 9);
    p.moe_norm = GP(const float, 10); p.moe_wg = GP(const float, 11); p.moe_bg = GP(const float, 12); p.moe_wr = GP(const float, 13); p.moe_br = GP(const float, 14);
    p.moe_wgate = GP(const float, 15); p.moe_wup = GP(const float, 16); p.moe_wdown = GP(const float, 17);
    p.x = GP(float, 18); p.ws = GP(unsigned char, 19);
    return p;
}
#define LOAD_PARAMS() const Params p = load_params()
DI int tid_() { int t = threadIdx.x; asm volatile("" : "+v"(t)); return t; }
DI int bid_() { int b = blockIdx.x; asm volatile("" : "+s"(b)); return b; }
DI int xbid_() { const int b = bid_(), G = gridDim.x; return (G % 8 == 0) ? (b % 8) * (G / 8) + b / 8 : b; }

DI unsigned cvt_pk_bf16(float lo, float hi) { unsigned r; asm volatile("v_cvt_pk_bf16_f32 %0, %1, %2" : "=v"(r) : "v"(lo), "v"(hi)); return r; }
DI float bf_lo(unsigned u) { return __uint_as_float(u << 16); }
DI float bf_hi(unsigned u) { return __uint_as_float(u & 0xffff0000u); }
DI float shflx(float v, int lane, int m) { return __int_as_float(__builtin_amdgcn_ds_bpermute((lane ^ m) << 2, __float_as_int(v))); }
DI float wave_sum(float v, int lane) {
#pragma unroll
    for (int o = 32; o >= 1; o >>= 1) v += shflx(v, lane, o);
    return v;
}
DI int perm32(int rho) { const int n = rho >> 4, i = rho & 15; return 8 * (i >> 2) + 4 * n + (i & 3); }

struct CvtTile { const float* src; bf16_t* dst; const float* scale; int K, N; };
DI CvtTile cvt_locate(const Params& p, int g) {
    int K, N, sdiv = 1; const float* sb; bf16_t* db; const float* scb = nullptr; size_t sms, dms;
    if (g < 384) { K = 1024; N = 3072; sb = p.sb_wqkv; db = (bf16_t*)(p.ws + WS_WQKV); scb = p.sb_norm; sms = (size_t)1024 * 3072; dms = sms; }
    else if ((g -= 384) < 128) { K = 1024; N = 1024; sb = p.sb_wo; db = (bf16_t*)(p.ws + WS_WO); sms = (size_t)1024 * 1024; dms = sms; }
    else if ((g -= 128) < 32) { K = 256; N = 256; sb = p.pool_w; db = (bf16_t*)(p.ws + WS_WPOOL); sms = 65536; dms = 65536; }
    else if ((g -= 32) < 2048) { K = 1024; N = 256; sb = p.moe_wgate; db = (bf16_t*)(p.ws + WS_WGU); scb = p.moe_norm; sdiv = 32; sms = (size_t)1024 * 256; dms = (size_t)512 * 1024; }
    else if ((g -= 2048) < 2048) { K = 1024; N = 256; sb = p.moe_wup; db = (bf16_t*)(p.ws + WS_WGU) + (size_t)256 * 1024; scb = p.moe_norm; sdiv = 32; sms = (size_t)1024 * 256; dms = (size_t)512 * 1024; }
    else { g -= 2048; K = 256; N = 1024; sb = p.moe_wdown; db = (bf16_t*)(p.ws + WS_WD); sms = (size_t)256 * 1024; dms = sms; }
    const int tn = N / 256, per = (K / 64) * tn, mat = g / per, rem = g % per, k0 = (rem / tn) * 64, n0 = (rem % tn) * 256;
    CvtTile t; t.K = K; t.N = N;
    t.src = sb + (size_t)mat * sms + (size_t)k0 * N + n0;
    t.dst = db + (size_t)mat * dms + (size_t)n0 * K + k0;
    t.scale = scb ? scb + (size_t)(mat / sdiv) * K + k0 : nullptr;
    return t;
}
constexpr int CVT_TILES = 384 + 128 + 32 + 2048 + 2048 + 2048;
constexpr int CVT_NONMOE = 384 + 128 + 32, CVT_LAYER = 3 * 512, CVT_S1 = 224, CVT_U0 = 1152 - CVT_S1, CVT_PRO = CVT_NONMOE + CVT_LAYER + 3 * CVT_U0;
DI int cvt_moe_tile(int L, int u) { return CVT_NONMOE + (u / 512) * 2048 + 512 * L + (u % 512); }
DI int cvt_map(int mode, int L, int q) {
    if (mode == 1) return cvt_moe_tile(L, CVT_U0 + q);
    if (mode == 2) return cvt_moe_tile(L, CVT_U0 + CVT_S1 + q);
    if (q < CVT_NONMOE) return q;
    q -= CVT_NONMOE;
    if (q < CVT_LAYER) return cvt_moe_tile(0, q);
    q -= CVT_LAYER;
    return cvt_moe_tile(1 + q / CVT_U0, q % CVT_U0);
}
DI void cvt_run(LAS unsigned char* ldsb, const Params& p, int mode, int L, int count, int rank, int nranks, int tid) {
    LAS float* lds = (LAS float*)ldsb;
    const int n4 = tid & 63, kq = tid >> 6;
    f32x4 regs[8]; float scl[8];
    int q = rank;
    CvtTile cur{};
    if (q < count) {
        cur = cvt_locate(p, cvt_map(mode, L, q));
#pragma unroll
        for (int i = 0; i < 8; ++i) { regs[i] = __builtin_nontemporal_load((const f32x4*)(cur.src + (size_t)(kq + 8 * i) * cur.N + 4 * n4)); scl[i] = cur.scale ? cur.scale[kq + 8 * i] : 1.0f; }
    }
    for (; q < count; q += nranks) {
        __syncthreads();
#pragma unroll
        for (int i = 0; i < 8; ++i) { const int k = kq + 8 * i; *(LAS f32x4*)(lds + k * 256 + ((4 * n4) ^ (4 * ((k >> 3) & 7)))) = regs[i] * scl[i]; }
        __syncthreads();
        const CvtTile now = cur;
        if (q + nranks < count) {
            cur = cvt_locate(p, cvt_map(mode, L, q + nranks));
#pragma unroll
            for (int i = 0; i < 8; ++i) { regs[i] = __builtin_nontemporal_load((const f32x4*)(cur.src + (size_t)(kq + 8 * i) * cur.N + 4 * n4)); scl[i] = cur.scale ? cur.scale[kq + 8 * i] : 1.0f; }
        }
#pragma unroll
        for (int it = 0; it < 4; ++it) {
            const int qq = tid + 512 * it, ko = qq & 7, n = qq >> 3;
            float v[8];
#pragma unroll
            for (int j = 0; j < 8; ++j) v[j] = lds[(8 * ko + j) * 256 + (n ^ (4 * ko))];
            u32x4 w; w[0] = cvt_pk_bf16(v[0], v[1]); w[1] = cvt_pk_bf16(v[2], v[3]); w[2] = cvt_pk_bf16(v[4], v[5]); w[3] = cvt_pk_bf16(v[6], v[7]);
            __builtin_nontemporal_store(w, (u32x4*)(now.dst + (size_t)n * now.K + 8 * ko));
        }
    }
    __syncthreads();
}
DI void ph_cvt_deferred(LAS unsigned char* ldsb, int L, int ns2) {
    LOAD_PARAMS();
    const int G = gridDim.x, bid = xbid_(), nidle = G - ns2;
    if (nidle >= 32) { if (bid >= ns2) cvt_run(ldsb, p, 2, L, CVT_LAYER - CVT_U0 - CVT_S1, bid - ns2, nidle, tid_()); }
    else cvt_run(ldsb, p, 2, L, CVT_LAYER - CVT_U0 - CVT_S1, bid, G, tid_());
}
DI void ph_prologue(LAS unsigned char* ldsb) {
    LOAD_PARAMS();
    const int tid = tid_(), bid = bid_();
    cvt_run(ldsb, p, 0, 0, CVT_PRO, bid, gridDim.x, tid);
    bf16_t* wh = (bf16_t*)(p.ws + WS_WRH); bf16_t* wl = (bf16_t*)(p.ws + WS_WRL);
    for (int idx = bid * NTHR + tid; idx < DEPTH * 48 * DM; idx += gridDim.x * NTHR) {
        const int l = idx / (48 * DM), n = (idx / DM) % 48, k = idx % DM;
        float v = 0.f;
        if (n < 4) v = p.moe_wg[((size_t)l * DM + k) * 4 + n]; else if (n < 36) v = p.moe_wr[((size_t)l * DM + k) * 32 + (n - 4)];
        v *= p.moe_norm[l * DM + k];
        const unsigned h = cvt_pk_bf16(v, 0.f), lo = cvt_pk_bf16(v - bf_lo(h), 0.f);
        wh[idx] = (bf16_t)(h & 0xffffu); wl[idx] = (bf16_t)(lo & 0xffffu);
    }
}

DI void unpack8(const u32x4 u, float (&f)[8]) {
#pragma unroll
    for (int i = 0; i < 4; ++i) { f[2 * i] = bf_lo(u[i]); f[2 * i + 1] = bf_hi(u[i]); }
}
template <bool FINAL>
DI void ph_combine(int src_buf) {
    LOAD_PARAMS();
    const int tid = tid_(), bid = bid_(), wid = tid >> 6, lane = tid & 63;
    const bf16_t* xs = (const bf16_t*)(p.ws + (src_buf ? WS_XB1 : WS_XB));
    bf16_t* xd = (bf16_t*)(p.ws + (src_buf ? WS_XB : WS_XB1));
    const bf16_t* yb = (const bf16_t*)(p.ws + WS_YBUF);
    float* rstd = (float*)(p.ws + WS_RSTD);
    for (int t = bid * NWAVE + wid; t < T; t += gridDim.x * NWAVE) {
        float ss = 0.f;
#pragma unroll
        for (int i = 0; i < 2; ++i) {
            const size_t o = (size_t)t * DM + lane * 8 + 512 * i;
            float a[8], b[8], c[8];
            unpack8(*(const u32x4*)(xs + o), a); unpack8(*(const u32x4*)(yb + o), b); unpack8(*(const u32x4*)(yb + (size_t)T * DM + o), c);
#pragma unroll
            for (int e = 0; e < 8; ++e) a[e] += b[e] + c[e];
            if (FINAL) {
                __builtin_nontemporal_store((f32x4){a[0], a[1], a[2], a[3]}, (f32x4*)(p.x + o)); __builtin_nontemporal_store((f32x4){a[4], a[5], a[6], a[7]}, (f32x4*)(p.x + o + 4));
            } else {
                u32x4 w; w[0] = cvt_pk_bf16(a[0], a[1]); w[1] = cvt_pk_bf16(a[2], a[3]); w[2] = cvt_pk_bf16(a[4], a[5]); w[3] = cvt_pk_bf16(a[6], a[7]);
                *(u32x4*)(xd + o) = w;
                float r[8]; unpack8(w, r);
#pragma unroll
                for (int e = 0; e < 8; ++e) ss += r[e] * r[e];
            }
        }
        if (!FINAL) { ss = wave_sum(ss, lane); if (lane == 0) rstd[t] = rsqrtf(ss * (1.0f / DM) + EPS); }
    }
}

constexpr int PF_ROWS = 47, PF_TOK = 32;
DI void ph_poolfuse(LAS unsigned char* ldsb, int j, bool first) {
    LOAD_PARAMS();
    const int tid = tid_(), bid = bid_(), wid = tid >> 6, lane = tid & 63;
    const bf16_t* xs = (const bf16_t*)(p.ws + WS_XB1);
    bf16_t* xd = (bf16_t*)(p.ws + WS_XB);
    const bf16_t* yb = (const bf16_t*)(p.ws + WS_YBUF);
    const float* gain = p.pool_norm + j * DM;
    bf16_t* diff = (bf16_t*)(p.ws + WS_DIFF);
    LAS unsigned char* ht = ldsb;
    for (int tix = 0; tix < 2 * ((T / (2 * PF_TOK) - bid + (int)gridDim.x - 1) / (int)gridDim.x); ++tix) {
        const int tile = 2 * (bid + (tix >> 1) * (int)gridDim.x) + (tix & 1);
        const int t0 = tile * PF_TOK, s0 = t0 & (SEQ - 1);
        const bool reuse = (tix & 1) != 0;
        if (reuse) {
            for (int q = tid; q < 15 * 128; q += NTHR) { const int r = q >> 7, c = (q & 127) * 16; *(LAS u32x4*)(ht + r * 2048 + c) = *(const LAS u32x4*)(ht + (32 + r) * 2048 + c); }
            __syncthreads();
        }
        for (int rr = (reuse ? 15 : 0) + wid; rr < PF_ROWS; rr += NWAVE) {
            const int t = t0 - 15 + rr;
            if (s0 == 0 && rr < 15) {
#pragma unroll
                for (int i = 0; i < 2; ++i) *(LAS u32x4*)(ht + rr * 2048 + (lane * 8 + 512 * i) * 2) = (u32x4){0u, 0u, 0u, 0u};
                continue;
            }
            float v[2][8]; u32x4 w[2]; float ss = 0.f;
#pragma unroll
            for (int i = 0; i < 2; ++i) {
                const size_t o = (size_t)t * DM + lane * 8 + 512 * i;
                if (first) {
                    const f32x4 a = *(const f32x4*)(p.x_in + o), b = *(const f32x4*)(p.x_in + o + 4);
#pragma unroll
                    for (int e = 0; e < 4; ++e) { v[i][e] = a[e]; v[i][4 + e] = b[e]; }
                } else {
                    float b[8], c[8];
                    unpack8(*(const u32x4*)(xs + o), v[i]); unpack8(*(const u32x4*)(yb + o), b); unpack8(*(const u32x4*)(yb + (size_t)T * DM + o), c);
#pragma unroll
                    for (int e = 0; e < 8; ++e) v[i][e] += b[e] + c[e];
                }
                w[i][0] = cvt_pk_bf16(v[i][0], v[i][1]); w[i][1] = cvt_pk_bf16(v[i][2], v[i][3]); w[i][2] = cvt_pk_bf16(v[i][4], v[i][5]); w[i][3] = cvt_pk_bf16(v[i][6], v[i][7]);
                if (rr >= 15) *(u32x4*)(xd + o) = w[i];
                unpack8(w[i], v[i]);
#pragma unroll
                for (int e = 0; e < 8; ++e) ss += v[i][e] * v[i][e];
            }
            ss = wave_sum(ss, lane);
            const float rs = rsqrtf(ss * (1.0f / DM) + EPS);
#pragma unroll
            for (int i = 0; i < 2; ++i) {
                u32x4 hw; hw[0] = cvt_pk_bf16(v[i][0] * rs, v[i][1] * rs); hw[1] = cvt_pk_bf16(v[i][2] * rs, v[i][3] * rs); hw[2] = cvt_pk_bf16(v[i][4] * rs, v[i][5] * rs); hw[3] = cvt_pk_bf16(v[i][6] * rs, v[i][7] * rs);
                *(LAS u32x4*)(ht + rr * 2048 + (lane * 8 + 512 * i) * 2) = hw;
            }
        }
        __syncthreads();
        {
            const int c = 2 * tid, win = 2 << (c >> 8);
            const float g0 = gain[c], g1 = gain[c + 1];
            float S0 = 0.f, S1 = 0.f;
            const LAS unsigned char* col = ht + c * 2;
#pragma unroll 4
            for (int rr = 0; rr < PF_ROWS; ++rr) {
                const unsigned hv = *(const LAS unsigned*)(col + rr * 2048);
                const float h0 = bf_lo(hv), h1 = bf_hi(hv);
                S0 += h0; S1 += h1;
                if (rr >= win) { const unsigned ov = *(const LAS unsigned*)(col + (rr - win) * 2048); S0 -= bf_lo(ov); S1 -= bf_hi(ov); }
                if (rr >= 15) {
                    const int s = s0 + rr - 15;
                    const float inv = 1.0f / (float)((s + 1 < win) ? s + 1 : win);
                    *(unsigned*)(diff + (size_t)(t0 + rr - 15) * DM + c) = cvt_pk_bf16((S0 * inv - h0) * g0, (S1 * inv - h1) * g1);
                }
            }
        }
        __syncthreads();
    }
}

struct Unit { const bf16_t* A; const bf16_t* B; int pm, pn, e, nvalid, row0, lbase; };
template <int LDA_, int LDB_, int K_, int BH_, bool HEADMAP_> struct GCfg { static constexpr int LDA = LDA_, LDB = LDB_, K = K_, BH = BH_; static constexpr bool HEADMAP = HEADMAP_; };

constexpr int BK = 64, HTB = 128 * BK * 2  , STAGE_BYTES = 8 * HTB;
DI int lds_byte(int r, int c) { const int st = (r >> 4) * 2 + (c >> 5), rr = r & 15, cc = c & 31, ob = rr * 64 + cc * 2; return st * 1024 + (ob ^ (((ob >> 9) & 1) << 5)); }
DI void stage_rc(int b, int& R, int& C) { const int st = b / 1024, sb = b % 1024, swz = sb ^ (((sb >> 9) & 1) << 5); R = (st >> 1) * 16 + swz / 64; C = (st & 1) * 32 + (swz % 64) / 2; }

template <class Cfg, class Sched, class Epi>
DI void gemm_phase(LAS unsigned char* lds, const Sched& S, const Epi& E) {
    const int tid = tid_(), wid = __builtin_amdgcn_readfirstlane(tid >> 6), lane = tid & 63, wr = wid >> 2, wc = wid & 3, fr = lane & 15, fq = lane >> 4;
    constexpr int nt = Cfg::K / BK;
    static_assert(Cfg::K % 128 == 0 && Cfg::K >= 256, "K");
    unsigned voffA[2][2], voffB[2];
    int R0, C0, R1, C1; stage_rc(tid * 16, R0, C0); stage_rc(tid * 16 + 8192, R1, C1);
    voffB[0] = (unsigned)(((Cfg::HEADMAP ? 64 * (R0 >> 5) : (R0 & ~31)) + perm32(R0 & 31)) * Cfg::LDB + C0) * 2u;
    voffB[1] = (unsigned)(((Cfg::HEADMAP ? 64 * (R1 >> 5) : (R1 & ~31)) + perm32(R1 & 31)) * Cfg::LDB + C1) * 2u;
    constexpr size_t kstep = (size_t)(BK * 2);
    constexpr size_t bhstep = (size_t)Cfg::BH * Cfg::LDB * 2;
    const unsigned ldsw = (unsigned)wid * 1024u;
    const int aoff = lds_byte(wr * 64 + fr, fq * 8), boff = lds_byte(wc * 32 + fr, fq * 8);
#define PG8_SA(b, h) (((b) * 2 + (h)) * HTB)
#define PG8_SB(b, h) ((4 + (b) * 2 + (h)) * HTB)
#define PG8_STAGE(bufoff, gbase, voff) do { _Pragma("unroll") for (int _i = 0; _i < 2; ++_i) \
        __builtin_amdgcn_global_load_lds((const unsigned*)((const char*)(gbase) + (voff)[_i]), (LAS unsigned*)(lds + (bufoff) + ldsw + _i * 8192), 16, 0, 0); } while (0)
#define PG8_LDA(dst, b, h) do { _Pragma("unroll") for (int m = 0; m < 4; ++m) _Pragma("unroll") for (int k = 0; k < 2; ++k) dst[m][k] = *(const LAS bf16x8*)(lds + PG8_SA(b, h) + aoff + m * 2048 + k * 1024); } while (0)
#define PG8_LDB(dst, b, h) do { _Pragma("unroll") for (int n = 0; n < 2; ++n) _Pragma("unroll") for (int k = 0; k < 2; ++k) dst[n][k] = *(const LAS bf16x8*)(lds + PG8_SB(b, h) + boff + n * 2048 + k * 1024); } while (0)
#define PG8_MMA(ai, bj, At, Bt) do { __builtin_amdgcn_s_setprio(1); _Pragma("unroll") for (int m = 0; m < 4; ++m) _Pragma("unroll") for (int n = 0; n < 2; ++n) _Pragma("unroll") for (int k = 0; k < 2; ++k) \
        acc[ai][bj][m][n] = __builtin_amdgcn_mfma_f32_16x16x32_bf16(Bt[n][k], At[m][k], acc[ai][bj][m][n], 0, 0, 0); __builtin_amdgcn_s_setprio(0); } while (0)
#define PG8_WAIT_V(n) asm volatile("s_waitcnt vmcnt(" #n ")" ::: "memory")
#define PG8_WAIT_L(n) asm volatile("s_waitcnt lgkmcnt(" #n ")" ::: "memory")
#define PG8_BAR __builtin_amdgcn_s_barrier()
#define PG8_SCHED __builtin_amdgcn_sched_barrier(0)
#define PG8_AROWS(uidx, un) do { voffA[0][0] = (unsigned)S.arow(uidx, un, R0) * (unsigned)(Cfg::LDA * 2) + (unsigned)(C0 * 2); voffA[0][1] = (unsigned)S.arow(uidx, un, R1) * (unsigned)(Cfg::LDA * 2) + (unsigned)(C1 * 2); \
        voffA[1][0] = (unsigned)S.arow(uidx, un, 128 + R0) * (unsigned)(Cfg::LDA * 2) + (unsigned)(C0 * 2); voffA[1][1] = (unsigned)S.arow(uidx, un, 128 + R1) * (unsigned)(Cfg::LDA * 2) + (unsigned)(C1 * 2); } while (0)
    Unit cur, nxt; int ui = 0;
    if (!S.next(0, cur)) return;
    f32x4 acc[2][2][4][2];
#pragma unroll
    for (int a = 0; a < 2; ++a)
#pragma unroll
        for (int b = 0; b < 2; ++b)
#pragma unroll
            for (int m = 0; m < 4; ++m)
#pragma unroll
                for (int n = 0; n < 2; ++n) acc[a][b][m][n] = (f32x4){0.f, 0.f, 0.f, 0.f};
    bf16x8 At[4][2], B0[2][2], B1[2][2];
    PG8_AROWS(0, cur);
    const char* cA = (const char*)cur.A; const char* cB = (const char*)cur.B;
    PG8_STAGE(PG8_SB(0, 0), cB, voffB); PG8_STAGE(PG8_SB(0, 1), cB + bhstep, voffB); PG8_STAGE(PG8_SA(0, 0), cA, voffA[0]); PG8_STAGE(PG8_SA(0, 1), cA, voffA[1]);
    if (wr == 1) PG8_BAR;
    PG8_WAIT_V(2); PG8_BAR;
    PG8_STAGE(PG8_SB(1, 0), cB + kstep, voffB); PG8_STAGE(PG8_SA(1, 0), cA + kstep, voffA[0]); PG8_STAGE(PG8_SB(1, 1), cB + bhstep + kstep, voffB);
    PG8_WAIT_V(6); PG8_BAR;
    for (;;) {
        const bool has_next = S.next(ui + 1, nxt);
        const char* nA = has_next ? (const char*)nxt.A : cA; const char* nB = has_next ? (const char*)nxt.B : cB;
#pragma unroll 1
        for (int t = 0; t < nt; t += 2) {
            const bool last = (t == nt - 2);
            const char* a1 = cA + (size_t)(t + 1) * kstep;
            const char* a2 = last ? nA : cA + (size_t)(t + 2) * kstep; const char* b2 = last ? nB : cB + (size_t)(t + 2) * kstep;
            const char* a3 = a2 + kstep; const char* b3 = b2 + kstep;
            PG8_LDB(B0, 0, 0); PG8_LDB(B1, 0, 1); PG8_SCHED; PG8_LDA(At, 0, 0); PG8_STAGE(PG8_SA(1, 1), a1, voffA[1]);
            if (last && has_next) PG8_AROWS(ui + 1, nxt);
            PG8_WAIT_V(8); PG8_WAIT_L(0); PG8_BAR; PG8_MMA(0, 0, At, B0); PG8_MMA(0, 1, At, B1); PG8_BAR; PG8_SCHED;
            PG8_LDA(At, 0, 1); PG8_STAGE(PG8_SB(0, 0), b2, voffB); PG8_STAGE(PG8_SB(0, 1), b2 + bhstep, voffB); PG8_STAGE(PG8_SA(0, 0), a2, voffA[0]);
            PG8_WAIT_V(8); PG8_WAIT_L(0); PG8_BAR; PG8_MMA(1, 0, At, B0); PG8_MMA(1, 1, At, B1); PG8_BAR; PG8_SCHED;
            PG8_LDB(B0, 1, 0); PG8_LDB(B1, 1, 1); PG8_SCHED; PG8_LDA(At, 1, 0); PG8_STAGE(PG8_SA(0, 1), a2, voffA[1]);
            PG8_WAIT_V(8); PG8_WAIT_L(0); PG8_BAR; PG8_MMA(0, 0, At, B0); PG8_MMA(0, 1, At, B1); PG8_BAR; PG8_SCHED;
            PG8_LDA(At, 1, 1); PG8_STAGE(PG8_SB(1, 0), b3, voffB); PG8_STAGE(PG8_SB(1, 1), b3 + bhstep, voffB); PG8_STAGE(PG8_SA(1, 0), a3, voffA[0]);
            PG8_WAIT_V(8); PG8_WAIT_L(0); PG8_BAR; PG8_MMA(1, 0, At, B0); PG8_MMA(1, 1, At, B1); PG8_BAR; PG8_SCHED;
        }
        if (wr == 0) PG8_BAR;
        E(acc, cur, wr, wc, fr, fq);
        if (!has_next) break;
#pragma unroll
        for (int a = 0; a < 2; ++a)
#pragma unroll
            for (int b = 0; b < 2; ++b)
#pragma unroll
                for (int m = 0; m < 4; ++m)
#pragma unroll
                    for (int n = 0; n < 2; ++n) acc[a][b][m][n] = (f32x4){0.f, 0.f, 0.f, 0.f};
        cur = nxt; cA = nA; cB = nB; ++ui;
        if (wr == 1) PG8_BAR;
    }
    PG8_WAIT_V(0);
    PG8_BAR;
#undef PG8_SA
#undef PG8_SB
#undef PG8_STAGE
#undef PG8_LDA
#undef PG8_LDB
#undef PG8_MMA
#undef PG8_WAIT_V
#undef PG8_WAIT_L
#undef PG8_BAR
#undef PG8_SCHED
#undef PG8_AROWS
}

struct SchedPool {
    const bf16_t* diff; const bf16_t* w; int bid;
    DI bool next(int i, Unit& u) const { const int L = i * gridDim.x + bid; if (L >= 256) return false; u.pm = L >> 2; u.pn = L & 3; u.A = diff + 256 * u.pn; u.B = w + (size_t)u.pn * 65536; return true; }
    DI int arow(int, const Unit& u, int r) const { return u.pm * 256 + r; }
};
struct SchedDense {
    const bf16_t* A; const bf16_t* B; int npn, ldb, bid;
    DI bool next(int i, Unit& u) const { const int L = i * gridDim.x + bid; if (L >= 64 * npn) return false; u.pm = L / npn; u.pn = L % npn; u.A = A; u.B = B + (size_t)u.pn * 256 * ldb; return true; }
    DI int arow(int, const Unit& u, int r) const { return u.pm * 256 + r; }
};

struct EpiPool {
    bf16_t* x; const float* pb; const float* ps;
    DI void operator()(const f32x4 (&acc)[2][2][4][2], const Unit& u, int wr, int wc, int fr, int fq) const {
        f32x4 bb[2][2], sc[2][2];
#pragma unroll
        for (int bj = 0; bj < 2; ++bj) {
            const int c = 256 * u.pn + 128 * bj + 32 * wc + 8 * fq;
            bb[bj][0] = *(const f32x4*)(pb + c); bb[bj][1] = *(const f32x4*)(pb + c + 4); sc[bj][0] = *(const f32x4*)(ps + c); sc[bj][1] = *(const f32x4*)(ps + c + 4);
        }
#pragma unroll
        for (int ai = 0; ai < 2; ++ai) {
            u32x4 xin[4][2];
#pragma unroll
            for (int m = 0; m < 4; ++m)
#pragma unroll
                for (int bj = 0; bj < 2; ++bj)
                    xin[m][bj] = *(const u32x4*)(x + (size_t)(u.pm * 256 + 128 * ai + 64 * wr + 16 * m + fr) * DM + 256 * u.pn + 128 * bj + 32 * wc + 8 * fq);
            asm volatile("" ::: "memory");
#pragma unroll
            for (int m = 0; m < 4; ++m) {
                const int t = u.pm * 256 + 128 * ai + 64 * wr + 16 * m + fr;
#pragma unroll
                for (int bj = 0; bj < 2; ++bj) {
                    const int c = 256 * u.pn + 128 * bj + 32 * wc + 8 * fq;
                    float xv[8]; unpack8(xin[m][bj], xv);
                    const f32x4 v0 = (acc[ai][bj][m][0] + bb[bj][0]) * sc[bj][0];
                    const f32x4 v1 = (acc[ai][bj][m][1] + bb[bj][1]) * sc[bj][1];
                    u32x4 w; w[0] = cvt_pk_bf16(xv[0] + v0[0], xv[1] + v0[1]); w[1] = cvt_pk_bf16(xv[2] + v0[2], xv[3] + v0[3]); w[2] = cvt_pk_bf16(xv[4] + v1[0], xv[5] + v1[1]); w[3] = cvt_pk_bf16(xv[6] + v1[2], xv[7] + v1[3]);
                    *(u32x4*)(x + (size_t)t * DM + c) = w;
                }
            }
        }
    }
};
struct EpiWo {
    bf16_t* x;
    DI void operator()(const f32x4 (&acc)[2][2][4][2], const Unit& u, int wr, int wc, int fr, int fq) const {
#pragma unroll
        for (int ai = 0; ai < 2; ++ai) {
            u32x4 xin[4][2];
#pragma unroll
            for (int m = 0; m < 4; ++m)
#pragma unroll
                for (int bj = 0; bj < 2; ++bj)
                    xin[m][bj] = *(const u32x4*)(x + (size_t)(u.pm * 256 + 128 * ai + 64 * wr + 16 * m + fr) * DM + 256 * u.pn + 128 * bj + 32 * wc + 8 * fq);
            asm volatile("" ::: "memory");
#pragma unroll
            for (int m = 0; m < 4; ++m) {
                const int t = u.pm * 256 + 128 * ai + 64 * wr + 16 * m + fr;
#pragma unroll
                for (int bj = 0; bj < 2; ++bj) {
                    const int c = 256 * u.pn + 128 * bj + 32 * wc + 8 * fq;
                    float xv[8]; unpack8(xin[m][bj], xv);
                    const f32x4 v0 = acc[ai][bj][m][0], v1 = acc[ai][bj][m][1];
                    u32x4 w; w[0] = cvt_pk_bf16(xv[0] + v0[0], xv[1] + v0[1]); w[1] = cvt_pk_bf16(xv[2] + v0[2], xv[3] + v0[3]); w[2] = cvt_pk_bf16(xv[4] + v1[0], xv[5] + v1[1]); w[3] = cvt_pk_bf16(xv[6] + v1[2], xv[7] + v1[3]);
                    *(u32x4*)(x + (size_t)t * DM + c) = w;
                }
            }
        }
    }
};
struct EpiQKV {
    bf16_t* q; const float* rstd; const float* qg; const float* kg;
    DI void operator()(const f32x4 (&acc)[2][2][4][2], const Unit& u, int wr, int wc, int fr, int fq) const {
        const int which = u.pn >> 2, head = (u.pn & 3) * 4 + wc;
        bf16_t* out = q + (size_t)which * ((WS_K - WS_Q) / 2);
        const float* gn = which == 0 ? qg : kg;
        const float post = which == 0 ? 0.125f * 1.4426950408889634f : 1.0f;
        f32x4 g[2][2];
#pragma unroll
        for (int bj = 0; bj < 2; ++bj)
#pragma unroll
            for (int n = 0; n < 2; ++n) g[bj][n] = (which < 2) ? *(const f32x4*)(gn + 32 * bj + 8 * fq + 4 * n) * post : (f32x4){1.f, 1.f, 1.f, 1.f};
        float rsv[2][4];
#pragma unroll
        for (int ai = 0; ai < 2; ++ai)
#pragma unroll
            for (int m = 0; m < 4; ++m) rsv[ai][m] = rstd[u.pm * 256 + 128 * ai + 64 * wr + 16 * m + fr];
#pragma unroll
        for (int ai = 0; ai < 2; ++ai)
#pragma unroll
            for (int m = 0; m < 4; ++m) {
                const int t = u.pm * 256 + 128 * ai + 64 * wr + 16 * m + fr;
                const float rs = rsv[ai][m];
                f32x4 v4[2][2]; float ss = 0.f;
#pragma unroll
                for (int bj = 0; bj < 2; ++bj)
#pragma unroll
                    for (int n = 0; n < 2; ++n) { v4[bj][n] = acc[ai][bj][m][n] * rs; const f32x4 s = v4[bj][n] * v4[bj][n]; ss += (s[0] + s[1]) + (s[2] + s[3]); }
                ss += shflx(ss, fr + 16 * fq, 16); ss += shflx(ss, fr + 16 * fq, 32);
                const float r2 = (which < 2) ? rsqrtf(ss * (1.0f / HD) + EPS) : 1.0f;
#pragma unroll
                for (int bj = 0; bj < 2; ++bj) {
                    const f32x4 a = v4[bj][0] * r2 * g[bj][0], b = v4[bj][1] * r2 * g[bj][1];
                    u32x4 w; w[0] = cvt_pk_bf16(a[0], a[1]); w[1] = cvt_pk_bf16(a[2], a[3]); w[2] = cvt_pk_bf16(b[0], b[1]); w[3] = cvt_pk_bf16(b[2], b[3]);
                    *(u32x4*)(out + (size_t)t * DM + head * HD + 32 * bj + 8 * fq) = w;
                }
            }
    }
};

typedef short v4i16_t __attribute__((ext_vector_type(4)));
constexpr int AT_VPITCH = 192;
constexpr int AT_VTILE = 32 * AT_VPITCH;
DI void ph_attn(LAS unsigned char* ldsb) {
    LOAD_PARAMS();
    const int tid = tid_(), bid = bid_(), wid = tid >> 6, lane = tid & 63, l31 = lane & 31, h2 = lane >> 5;
    const bf16_t* Q = (const bf16_t*)(p.ws + WS_Q); const bf16_t* K = (const bf16_t*)(p.ws + WS_K); const bf16_t* V = (const bf16_t*)(p.ws + WS_V);
    bf16_t* O = (bf16_t*)(p.ws + WS_O);
    LAS unsigned char* vl = ldsb + wid * AT_VTILE;
    LAS unsigned char* vw = vl + (lane >> 3) * AT_VPITCH + (lane & 7) * 16;
    const LAS unsigned char* vr = vl + (4 * h2 + ((lane & 15) >> 2)) * AT_VPITCH + (16 * ((lane >> 4) & 1) + 4 * (lane & 3)) * 2;
    for (int it = 0; it < 4 * ((2 * NH * 256 / 32 - bid + (int)gridDim.x - 1) / (int)gridDim.x); ++it) {
        const int tsk = (bid + (it >> 2) * gridDim.x) * 32 + (it & 3) * 8 + wid;
        const int bh = tsk >> 8, qb = tsk & 255, b = bh >> 4, h = bh & 15;
        const size_t tb = (size_t)b * SEQ;
        const int q0 = qb * 32;
        bf16x8 qf[4];
#pragma unroll
        for (int s = 0; s < 4; ++s) qf[s] = *(const bf16x8*)(Q + (tb + q0 + l31) * DM + h * HD + 16 * s + 8 * h2);
        f32x16 o0, o1;
#pragma unroll
        for (int r = 0; r < 16; ++r) { o0[r] = 0.f; o1[r] = 0.f; }
        float R = 1.f;
        const bf16_t* kp = K + (tb + q0 + l31) * DM + h * HD + 8 * h2;
        const bf16_t* vp = V + (tb + q0 + (lane >> 3)) * DM + h * HD + (lane & 7) * 8;
        bf16x8 kn[4], kq[4]; u32x4 vn[4], vq[4];
#pragma unroll
        for (int s = 0; s < 4; ++s) { kn[s] = *(const bf16x8*)(kp + 16 * s); vn[s] = *(const u32x4*)(vp + (size_t)8 * s * DM); }
        if (qb > 0) {
            kp -= (size_t)32 * DM; vp -= (size_t)32 * DM;
#pragma unroll
            for (int s = 0; s < 4; ++s) { kq[s] = *(const bf16x8*)(kp + 16 * s); vq[s] = *(const u32x4*)(vp + (size_t)8 * s * DM); }
        }
        for (int kt = qb; kt >= 0; --kt) {
            bf16x8 kf[4];
#pragma unroll
            for (int s = 0; s < 4; ++s) { kf[s] = kn[s]; *(LAS u32x4*)(vw + 8 * s * AT_VPITCH) = vn[s]; kn[s] = kq[s]; vn[s] = vq[s]; }
            if (kt > 1) {
                kp -= (size_t)32 * DM; vp -= (size_t)32 * DM;
#pragma unroll
                for (int s = 0; s < 4; ++s) { kq[s] = *(const bf16x8*)(kp + 16 * s); vq[s] = *(const u32x4*)(vp + (size_t)8 * s * DM); }
            }
            f32x16 z;
#pragma unroll
            for (int r = 0; r < 16; ++r) z[r] = 0.f;
#pragma unroll
            for (int s = 0; s < 4; ++s) z = __builtin_amdgcn_mfma_f32_32x32x16_bf16(kf[s], qf[s], z, 0, 0, 0);
            float kp_[16], gs[4], ot[4];
#pragma unroll
            for (int r = 0; r < 16; ++r) kp_[r] = __builtin_amdgcn_rcpf(1.0f + __builtin_amdgcn_exp2f(z[r]));
            if (kt == qb) {
#pragma unroll
                for (int r = 0; r < 16; ++r) { const int kl = (r & 3) + 8 * (r >> 2) + 4 * h2; kp_[r] = (kl < l31) ? kp_[r] : 1.0f; }
            }
#pragma unroll
            for (int bb = 0; bb < 4; ++bb) { gs[bb] = (kp_[4 * bb] * kp_[4 * bb + 1]) * (kp_[4 * bb + 2] * kp_[4 * bb + 3]); ot[bb] = shflx(gs[bb], lane, 32); }
            const float tot_own = (gs[0] * gs[1]) * (gs[2] * gs[3]);
            const float tot_oth = (ot[0] * ot[1]) * (ot[2] * ot[3]);
            float later[4];
            {
                float own_tail = 1.f, oth_tail = 1.f;
#pragma unroll
                for (int bb = 3; bb >= 0; --bb) {
                    later[bb] = own_tail * oth_tail * (h2 == 0 ? ot[bb] : 1.f);
                    own_tail *= gs[bb]; oth_tail *= ot[bb];
                }
            }
            float a[16];
#pragma unroll
            for (int bb = 0; bb < 4; ++bb) {
                const float x3 = R * later[bb];
                const float x2 = x3 * kp_[4 * bb + 3], x1 = x2 * kp_[4 * bb + 2], x0 = x1 * kp_[4 * bb + 1];
                a[4 * bb] = x0 - x0 * kp_[4 * bb]; a[4 * bb + 1] = x1 - x1 * kp_[4 * bb + 1]; a[4 * bb + 2] = x2 - x2 * kp_[4 * bb + 2]; a[4 * bb + 3] = x3 - x3 * kp_[4 * bb + 3];
            }
            R *= (h2 == 0) ? (tot_own * tot_oth) : (tot_oth * tot_own);
#pragma unroll
            for (int s = 0; s < 2; ++s) {
                u32x4 pw;
#pragma unroll
                for (int i = 0; i < 4; ++i) pw[i] = cvt_pk_bf16(a[8 * s + 2 * i], a[8 * s + 2 * i + 1]);
                const bf16x8 pa = __builtin_bit_cast(bf16x8, pw);
#pragma unroll
                for (int db = 0; db < 2; ++db) {
                    const v4i16_t lo4 = __builtin_amdgcn_ds_read_tr16_b64_v4i16((LAS v4i16_t*)(vr + (16 * s) * AT_VPITCH + 64 * db));
                    const v4i16_t hi4 = __builtin_amdgcn_ds_read_tr16_b64_v4i16((LAS v4i16_t*)(vr + (16 * s + 8) * AT_VPITCH + 64 * db));
                    bf16x8 vf; vf[0] = lo4[0]; vf[1] = lo4[1]; vf[2] = lo4[2]; vf[3] = lo4[3]; vf[4] = hi4[0]; vf[5] = hi4[1]; vf[6] = hi4[2]; vf[7] = hi4[3];
                    if (db == 0) o0 = __builtin_amdgcn_mfma_f32_32x32x16_bf16(vf, pa, o0, 0, 0, 0);
                    else o1 = __builtin_amdgcn_mfma_f32_32x32x16_bf16(vf, pa, o1, 0, 0, 0);
                }
            }
            if (__all(R < 1.0e-36f)) break;
        }
#pragma unroll
        for (int db = 0; db < 2; ++db)
#pragma unroll
            for (int rb = 0; rb < 4; ++rb) {
                const f32x16& o = db == 0 ? o0 : o1;
                u32x2 w; w[0] = cvt_pk_bf16(o[4 * rb], o[4 * rb + 1]); w[1] = cvt_pk_bf16(o[4 * rb + 2], o[4 * rb + 3]);
                *(u32x2*)(O + (tb + q0 + l31) * DM + h * HD + 32 * db + 8 * rb + 4 * h2) = w;
            }
    }
}

constexpr int RT_PART = 0;
constexpr int RT_SSQ = RT_PART + 4 * 64 * 52 * 4;
constexpr int RT_LCNT = RT_SSQ + 4 * 64 * 4;
constexpr int RT_GB = RT_LCNT + 128;
DI void ph_router(LAS unsigned char* lds, int li) {
    LOAD_PARAMS();
    const bf16_t* xcur = (const bf16_t*)(p.ws + ((li & 1) ? WS_XB1 : WS_XB));
    const int tid = tid_(), bid = bid_(), wid = tid >> 6, lane = tid & 63, fr = lane & 15, fq = lane >> 4;
    const bf16_t* wh = (const bf16_t*)(p.ws + WS_WRH) + (size_t)li * 48 * DM;
    const bf16_t* wl = (const bf16_t*)(p.ws + WS_WRL) + (size_t)li * 48 * DM;
    const float* bg = p.moe_bg + li * 4;
    const float* br = p.moe_br + li * 32;
    unsigned* cnt = (unsigned*)(p.ws + WS_CTL) + CW_CNT + 32 * li;
    Entry* list = (Entry*)(p.ws + WS_LIST);
    LAS float* part = (LAS float*)(lds + RT_PART); LAS float* ssq = (LAS float*)(lds + RT_SSQ);
    LAS int* lcnt = (LAS int*)(lds + RT_LCNT); LAS int* gb = (LAS int*)(lds + RT_GB);
    const int th = wid & 1, kq = wid >> 1;
    for (int chunk = bid; chunk < T / 64; chunk += gridDim.x) {
        const int t = chunk * 64 + th * 32 + fr;
        const bf16_t* xr = xcur + (size_t)t * DM + kq * 256 + fq * 8;
        const bf16_t* whr = wh + (size_t)fr * DM + kq * 256 + fq * 8;
        const bf16_t* wlr = wl + (size_t)fr * DM + kq * 256 + fq * 8;
        f32x4 acc[2][3]; float ss[2] = {0.f, 0.f};
#pragma unroll
        for (int b = 0; b < 2; ++b)
#pragma unroll
            for (int nb = 0; nb < 3; ++nb) acc[b][nb] = (f32x4){0.f, 0.f, 0.f, 0.f};
#pragma unroll 4
        for (int ks = 0; ks < 8; ++ks) {
            bf16x8 xh[2];
#pragma unroll
            for (int b = 0; b < 2; ++b) {
                const u32x4 xw = *(const u32x4*)(xr + (size_t)b * 16 * DM + ks * 32);
                float xf[8]; unpack8(xw, xf);
#pragma unroll
                for (int e = 0; e < 8; ++e) ss[b] += xf[e] * xf[e];
                xh[b] = __builtin_bit_cast(bf16x8, xw);
            }
#pragma unroll
            for (int nb = 0; nb < 3; ++nb) {
                const bf16x8 wH = *(const bf16x8*)(whr + (size_t)nb * 16 * DM + ks * 32), wL = *(const bf16x8*)(wlr + (size_t)nb * 16 * DM + ks * 32);
#pragma unroll
                for (int b = 0; b < 2; ++b) {
                    acc[b][nb] = __builtin_amdgcn_mfma_f32_16x16x32_bf16(wH, xh[b], acc[b][nb], 0, 0, 0);
                    acc[b][nb] = __builtin_amdgcn_mfma_f32_16x16x32_bf16(wL, xh[b], acc[b][nb], 0, 0, 0);
                }
            }
        }
#pragma unroll
        for (int b = 0; b < 2; ++b) {
            float sv = ss[b]; sv += shflx(sv, lane, 16); sv += shflx(sv, lane, 32);
            const int tl = th * 32 + 16 * b + fr;
#pragma unroll
            for (int nb = 0; nb < 3; ++nb) *(LAS f32x4*)(part + (kq * 64 + tl) * 52 + 16 * nb + 4 * fq) = acc[b][nb];
            if (fq == 0) ssq[kq * 64 + tl] = sv;
        }
        if (tid < 32) lcnt[tid] = 0;
        __syncthreads();
        int ea = 0, eb = 0, la = 0, lb = 0; float w1 = 0.f, w2 = 0.f, rs = 0.f;
        if (tid < 64) {
            rs = rsqrtf(((ssq[tid] + ssq[64 + tid]) + (ssq[128 + tid] + ssq[192 + tid])) * (1.0f / DM) + EPS);
            float lg[36];
#pragma unroll
            for (int q = 0; q < 9; ++q) {
                const f32x4 u0 = *(const LAS f32x4*)(part + tid * 52 + 4 * q), u1 = *(const LAS f32x4*)(part + (64 + tid) * 52 + 4 * q);
                const f32x4 u2 = *(const LAS f32x4*)(part + (128 + tid) * 52 + 4 * q), u3 = *(const LAS f32x4*)(part + (192 + tid) * 52 + 4 * q);
#pragma unroll
                for (int e = 0; e < 4; ++e) lg[4 * q + e] = ((u0[e] + u1[e]) + (u2[e] + u3[e])) * rs;
            }
            float gl[4];
#pragma unroll
            for (int n = 0; n < 4; ++n) gl[n] = lg[n] + bg[n];
            int g = 0; float gm = gl[0];
#pragma unroll
            for (int n = 1; n < 4; ++n) if (gl[n] > gm) { gm = gl[n]; g = n; }
            float den = 0.f;
#pragma unroll
            for (int n = 0; n < 4; ++n) den += __expf(gl[n] - gm);
            const float gprob = 1.0f / den;
            float el[8];
#pragma unroll
            for (int n = 0; n < 8; ++n) {
                float v = 0.f;
#pragma unroll
                for (int gg = 0; gg < 4; ++gg) v = (g == gg) ? lg[4 + 8 * gg + n] + br[8 * gg + n] : v;
                el[n] = v;
            }
            int e1 = 0; float m1 = el[0];
#pragma unroll
            for (int n = 1; n < 8; ++n) if (el[n] > m1) { m1 = el[n]; e1 = n; }
            int e2 = -1; float m2 = -3.0e38f;
#pragma unroll
            for (int n = 0; n < 8; ++n) if (n != e1 && (e2 < 0 || el[n] > m2)) { m2 = el[n]; e2 = n; }
            const float ex = __expf(m2 - m1);
            w1 = gprob / (1.0f + ex); w2 = gprob * ex / (1.0f + ex);
            ea = 8 * g + e1; eb = 8 * g + e2;
            la = __hip_atomic_fetch_add(lcnt + ea, 1, __ATOMIC_RELAXED, __HIP_MEMORY_SCOPE_WORKGROUP);
            lb = __hip_atomic_fetch_add(lcnt + eb, 1, __ATOMIC_RELAXED, __HIP_MEMORY_SCOPE_WORKGROUP);
        }
        __syncthreads();
        if (tid < 32) { const int c = lcnt[tid]; gb[tid] = c ? (int)atomicAdd(&cnt[tid], (unsigned)c) : 0; }
        __syncthreads();
        if (tid < 64) {
            const int tt = chunk * 64 + tid;
            Entry A; A.dst = tt; A.rstd = rs; A.w = w1; A.tok = tt;
            Entry B; B.dst = T + tt; B.rstd = rs; B.w = w2; B.tok = tt;
            list[(size_t)ea * LIST_CAP + gb[ea] + la] = A;
            list[(size_t)eb * LIST_CAP + gb[eb] + lb] = B;
        }
        __syncthreads();
    }
}

constexpr int MOE_MAXU = 4;
constexpr int LDS_ROWTAB = STAGE_BYTES;
constexpr int LDS_EPITAB = LDS_ROWTAB + MOE_MAXU * 1024;
constexpr int LDS_UTAB = LDS_EPITAB + MOE_MAXU * 2048;
constexpr int LDS_XBW = LDS_UTAB + MOE_MAXU * 32;
constexpr int LDS_BYTES = 147456;
static_assert(LDS_XBW + 16 <= LDS_BYTES, "LDS map");
struct SchedMoe {
    LAS unsigned char* lds; const bf16_t* A; const bf16_t* W; bool gather; size_t w_estride; int w_pnrows, ldb;
    DI void build(const unsigned* cnt, const Entry* list, int npn, int lo, int hi, int first, int stride, int tid) {
        LAS int* ut = (LAS int*)(lds + LDS_UTAB); LAS unsigned* rt = (LAS unsigned*)(lds + LDS_ROWTAB);
        const int lane = tid & 63;
        if (tid < 64) {
            const int c = (int)cnt[lane & 31], ntl = (c + 255) >> 8;
            int inc = ntl;
#pragma unroll
            for (int d = 1; d < 32; d <<= 1) { const int v = __builtin_amdgcn_ds_bpermute(((lane - d) & 63) << 2, inc); if ((lane & 31) >= d) inc += v; }
            const int exc = inc - ntl;
#pragma unroll
            for (int i = 0; i < MOE_MAXU; ++i) {
                const int L = lo + first + i * stride, rtile = L / npn, pn = L % npn;
                const bool hit = (first >= 0) && (L < hi) && (lane < 32) && (rtile >= exc) && (rtile < inc);
                const unsigned long long mask = __ballot(hit);
                int found = 0, e = 0, j = 0, nv = 0;
                if (mask) {
                    found = 1; e = __builtin_ctzll(mask);
                    j = rtile - __builtin_amdgcn_readlane(exc, e); nv = __builtin_amdgcn_readlane(c, e) - 256 * j; nv = nv > 256 ? 256 : nv;
                }
                if (lane == 0) { ut[i * 8 + 0] = found; ut[i * 8 + 1] = e; ut[i * 8 + 2] = nv; ut[i * 8 + 3] = 256 * rtile; ut[i * 8 + 4] = e * LIST_CAP + 256 * j; ut[i * 8 + 5] = pn; }
            }
        }
        __syncthreads();
        if (tid < 256) {
#pragma unroll
            for (int i = 0; i < MOE_MAXU; ++i) {
                if (!ut[i * 8]) continue;
                const int nv = ut[i * 8 + 2], lb = ut[i * 8 + 4];
                Entry en; en.dst = DUMMY_ROW; en.rstd = 0.f; en.w = 0.f; en.tok = 0;
                if (tid < nv) en = list[lb + tid];
                LAS float* et = (LAS float*)(lds + LDS_EPITAB) + (i * 256 + tid) * 2;
                if (gather) { rt[i * 256 + tid] = (unsigned)en.tok; et[0] = en.rstd; et[1] = en.w; }
                else { et[0] = __int_as_float(en.dst); et[1] = 0.f; }
            }
        }
        asm volatile("s_waitcnt vmcnt(0) lgkmcnt(0)" ::: "memory");
        __syncthreads();
    }
    DI bool next(int i, Unit& u) const {
        if (i >= MOE_MAXU) return false;
        const LAS int* ut = (const LAS int*)(lds + LDS_UTAB) + i * 8;
        const int found = __builtin_amdgcn_readfirstlane(ut[0]);
        if (!found) return false;
        u.e = __builtin_amdgcn_readfirstlane(ut[1]); u.nvalid = __builtin_amdgcn_readfirstlane(ut[2]); u.row0 = __builtin_amdgcn_readfirstlane(ut[3]);
        u.lbase = i * 256; u.pn = __builtin_amdgcn_readfirstlane(ut[5]); u.pm = u.row0 >> 8;
        u.A = gather ? A : A + (size_t)u.row0 * DE;
        u.B = W + (size_t)u.e * w_estride + (size_t)u.pn * w_pnrows * ldb;
        return true;
    }
    DI int arow(int ui, const Unit&, int r) const { if (!gather) return r; return (int)((const LAS unsigned*)(lds + LDS_ROWTAB))[ui * 256 + r]; }
};
struct EpiGU {
    bf16_t* hid; LAS unsigned char* lds;
    DI void operator()(const f32x4 (&acc)[2][2][4][2], const Unit& u, int wr, int wc, int fr, int fq) const {
        typedef float f32x2 __attribute__((ext_vector_type(2)));
#pragma unroll
        for (int ai = 0; ai < 2; ++ai)
#pragma unroll
            for (int m = 0; m < 4; ++m) {
                const int r = 128 * ai + 64 * wr + 16 * m + fr;
                const f32x2 rw = *(const LAS f32x2*)(lds + LDS_EPITAB + (u.lbase + r) * 8);
                const float rs = rw[0], w = rw[1];
                unsigned pk[4];
#pragma unroll
                for (int n = 0; n < 2; ++n) {
                    float hv[4];
#pragma unroll
                    for (int e = 0; e < 4; ++e) { const float g = acc[ai][0][m][n][e] * rs, up = acc[ai][1][m][n][e] * rs; hv[e] = g * __builtin_amdgcn_rcpf(1.0f + __builtin_amdgcn_exp2f(-1.4426950408889634f * g)) * up * w; }
                    pk[2 * n] = cvt_pk_bf16(hv[0], hv[1]); pk[2 * n + 1] = cvt_pk_bf16(hv[2], hv[3]);
                }
                u32x4 wv; wv[0] = pk[0]; wv[1] = pk[1]; wv[2] = pk[2]; wv[3] = pk[3];
                *(u32x4*)(hid + (size_t)(u.row0 + r) * DE + 128 * u.pn + 32 * wc + 8 * fq) = wv;
            }
    }
};
struct EpiDown {
    bf16_t* yb; LAS unsigned char* lds;
    DI void operator()(const f32x4 (&acc)[2][2][4][2], const Unit& u, int wr, int wc, int fr, int fq) const {
#pragma unroll
        for (int ai = 0; ai < 2; ++ai)
#pragma unroll
            for (int m = 0; m < 4; ++m) {
                const int r = 128 * ai + 64 * wr + 16 * m + fr;
                const int dst = *(const LAS int*)(lds + LDS_EPITAB + (u.lbase + r) * 8);
                if (dst == DUMMY_ROW) continue;
#pragma unroll
                for (int bj = 0; bj < 2; ++bj) {
                    const f32x4 a = acc[ai][bj][m][0], b = acc[ai][bj][m][1];
                    u32x4 w; w[0] = cvt_pk_bf16(a[0], a[1]); w[1] = cvt_pk_bf16(a[2], a[3]); w[2] = cvt_pk_bf16(b[0], b[1]); w[3] = cvt_pk_bf16(b[2], b[3]);
                    *(u32x4*)(yb + (size_t)dst * DM + 256 * u.pn + 128 * bj + 32 * wc + 8 * fq) = w;
                }
            }
    }
};

DI void ph_poolgemm(LAS unsigned char* lds, int j) {
    LOAD_PARAMS();
    SchedPool S; S.bid = xbid_(); S.diff = (const bf16_t*)(p.ws + WS_DIFF); S.w = (const bf16_t*)(p.ws + WS_WPOOL) + (size_t)j * 4 * 65536;
    EpiPool E; E.x = (bf16_t*)(p.ws + WS_XB); E.pb = p.pool_b + j * DM; E.ps = p.pool_scale + j * DM;
    gemm_phase<GCfg<1024, 256, 256, 128, false>>(lds, S, E);
}
DI void ph_qkv(LAS unsigned char* lds, int j) {
    LOAD_PARAMS();
    SchedDense S; S.bid = xbid_(); S.A = (const bf16_t*)(p.ws + WS_XB1); S.B = (const bf16_t*)(p.ws + WS_WQKV) + (size_t)j * 3072 * 1024; S.npn = 12; S.ldb = 1024;
    EpiQKV E; E.q = (bf16_t*)(p.ws + WS_Q); E.rstd = (const float*)(p.ws + WS_RSTD); E.qg = p.sb_qg + j * HD; E.kg = p.sb_kg + j * HD;
    gemm_phase<GCfg<1024, 1024, 1024, 32, true>>(lds, S, E);
}
DI void ph_wo(LAS unsigned char* lds, int j) {
    LOAD_PARAMS();
    SchedDense S; S.bid = xbid_(); S.A = (const bf16_t*)(p.ws + WS_O); S.B = (const bf16_t*)(p.ws + WS_WO) + (size_t)j * 1024 * 1024; S.npn = 4; S.ldb = 1024;
    EpiWo E; E.x = (bf16_t*)(p.ws + WS_XB1);
    gemm_phase<GCfg<1024, 1024, 1024, 128, false>>(lds, S, E);
}
struct MoePlan { int NT, R1, nB, D1; };
DI MoePlan moe_plan(const unsigned* cnt) {
    const int lane = tid_() & 63;
    int nt = ((int)cnt[lane & 31] + 255) >> 8;
#pragma unroll
    for (int o = 1; o < 32; o <<= 1) nt += __builtin_amdgcn_ds_bpermute((lane ^ o) << 2, nt);
    nt = __builtin_amdgcn_readfirstlane(nt);
    MoePlan m; m.NT = nt; const int G = gridDim.x; m.R1 = nt < G / 2 ? nt : G / 2;
    const int late = 2 * (nt - m.R1); m.nB = late < G ? late : G;
    const int cap = 2 * (G - m.nB); m.D1 = 4 * m.R1 < cap ? 4 * m.R1 : cap;
    return m;
}
DI void ph_cvt_stage1(LAS unsigned char* ldsb, int L, const MoePlan m) {
    LOAD_PARAMS();
    const int bid = xbid_(), r = bid >= m.nB ? bid - m.nB : -1;
    const int n = (int)gridDim.x - m.nB;
    if (n >= 32) { if (r >= 0) cvt_run(ldsb, p, 1, L, CVT_S1, r, n, tid_()); }
    else cvt_run(ldsb, p, 1, L, CVT_S1, xbid_(), gridDim.x, tid_());
}
DI void ph_gu(LAS unsigned char* lds, int li, int stage, const MoePlan m) {
    LOAD_PARAMS();
    const Entry* list = (const Entry*)(p.ws + WS_LIST);
    const unsigned* cnt = (const unsigned*)(p.ws + WS_CTL) + CW_CNT + 32 * li;
    const int bid = xbid_();
    if (stage == 2 || (stage == 1 && bid >= m.nB)) return;
    SchedMoe S; S.lds = lds; S.A = (const bf16_t*)(p.ws + ((li & 1) ? WS_XB1 : WS_XB));
    S.W = (const bf16_t*)(p.ws + WS_WGU) + (size_t)li * NE * 512 * 1024; S.gather = true; S.w_estride = (size_t)512 * 1024; S.w_pnrows = 128; S.ldb = 1024;
    const int lo = stage == 0 ? 0 : 2 * m.R1, hi = stage == 0 ? 2 * m.R1 : 2 * m.NT, G = gridDim.x;
    EpiGU E; E.hid = (bf16_t*)(p.ws + WS_HID); E.lds = lds;
    for (int first = bid; lo + first < hi; first += MOE_MAXU * G) {
        S.build(cnt, list, 2, lo, hi, first, G, tid_());
        gemm_phase<GCfg<1024, 1024, 1024, 256, false>>(lds, S, E);
        __syncthreads();
    }
}
DI void ph_down(LAS unsigned char* lds, int li, int stage, const MoePlan m) {
    LOAD_PARAMS();
    const Entry* list = (const Entry*)(p.ws + WS_LIST);
    const unsigned* cnt = (const unsigned*)(p.ws + WS_CTL) + CW_CNT + 32 * li;
    const int bid = xbid_(), G = gridDim.x;
    if (stage == 0 || (stage == 1 && bid < m.nB)) return;
    SchedMoe S; S.lds = lds; S.A = (const bf16_t*)(p.ws + WS_HID);
    S.W = (const bf16_t*)(p.ws + WS_WD) + (size_t)li * NE * 1024 * 256; S.gather = false; S.w_estride = (size_t)1024 * 256; S.w_pnrows = 256; S.ldb = 256;
    const int lo = stage == 1 ? 0 : m.D1, hi = stage == 1 ? m.D1 : 4 * m.NT, stride = stage == 1 ? G - m.nB : G;
    EpiDown E; E.yb = (bf16_t*)(p.ws + WS_YBUF); E.lds = lds;
    for (int first = stage == 1 ? bid - m.nB : bid; lo + first < hi; first += MOE_MAXU * stride) {
        S.build(cnt, list, 4, lo, hi, first, stride, tid_());
        gemm_phase<GCfg<256, 256, 256, 128, false>>(lds, S, E);
        __syncthreads();
    }
}
DI MoePlan moe_layer_plan(int li) {
    LOAD_PARAMS();
    return moe_plan((const unsigned*)(p.ws + WS_CTL) + CW_CNT + 32 * li);
}

#define XB_TMO      128
#define XB_XCNT(j)  (256  + 64 * (j))
#define XB_XSUB(j)  (1280 + 64 * (j))
#define XB_XGEN(j)  (2304 + 64 * (j))
#define XB_TOP      3328
#define XB_TOPGEN   3392
#define XCD_BAR_WORDS 3456
#define XB_SPIN_CAP (1u << 18)

__device__ __forceinline__ unsigned xb_ld(unsigned* p)              { return __hip_atomic_load(p, __ATOMIC_RELAXED, __HIP_MEMORY_SCOPE_AGENT); }
__device__ __forceinline__ unsigned xb_add(unsigned* p, unsigned v) { return __hip_atomic_fetch_add(p, v, __ATOMIC_RELAXED, __HIP_MEMORY_SCOPE_AGENT); }
__device__ __forceinline__ unsigned xb_xcc_id() { return (unsigned)__builtin_amdgcn_s_getreg((3 << 11) | 20) & 0xFu; }
#define XB_SPIN(cond, bar) do { unsigned _sp = 0; while (cond) { __builtin_amdgcn_s_sleep(1); \
    if ((++_sp & 255u) == 0u) { if (xb_ld(&(bar)[XB_TMO])) break; if (_sp > XB_SPIN_CAP) { atomicAdd(&(bar)[XB_TMO], 1u); break; } } } } while (0)

struct XcdBarrier {
    unsigned* bar; unsigned x;
    volatile LAS unsigned* st;
};

__device__ __forceinline__ XcdBarrier xcd_barrier_post(unsigned* bar, volatile LAS unsigned* st) {
    XcdBarrier b; b.bar = bar; b.x = xb_xcc_id(); b.st = st;
    if (threadIdx.x == 0) (void)xb_add(&bar[XB_XCNT(b.x)], 1u);
    return b;
}
__device__ __forceinline__ void xcd_barrier_complete(unsigned* bar, unsigned x, unsigned& nloc, unsigned& nx) {
    const unsigned G = gridDim.x * gridDim.y * gridDim.z;
    unsigned sum, cnt, mine, sp = 0u;
    for (;;) {
        sum = 0u; cnt = 0u; mine = 0u;
#pragma unroll
        for (unsigned j = 0; j < 16; ++j) { const unsigned c = xb_ld(&bar[XB_XCNT(j)]); sum += c; cnt += (c > 0u) ? 1u : 0u; mine = (j == x) ? c : mine; }
        if (sum == G) break;
        __builtin_amdgcn_s_sleep(1);
        if ((++sp & 255u) == 0u) { if (xb_ld(&bar[XB_TMO])) break; if (sp > XB_SPIN_CAP) { atomicAdd(&bar[XB_TMO], 1u); break; } }
    }
    nloc = mine > 0u ? mine : 1u; nx = cnt > 0u ? cnt : 1u;
}

__device__ __forceinline__ void xcd_barrier(const XcdBarrier& b) {
    asm volatile("s_waitcnt vmcnt(0)" ::: "memory");
    __syncthreads();
    if (threadIdx.x == 0) {
        unsigned* bar = b.bar; unsigned bx = b.x;
        asm volatile("" : "+s"(bar), "+s"(bx));
        __builtin_amdgcn_s_waitcnt(0);
        unsigned nloc = b.st[0], nx = b.st[1];
        if (nloc == 0u) { xcd_barrier_complete(bar, bx, nloc, nx); b.st[0] = nloc; b.st[1] = nx; }
        const unsigned old = xb_add(&bar[XB_XSUB(bx)], 1u);
        const unsigned gen = old / nloc;
        if (old + 1u == (gen + 1u) * nloc) {
            __builtin_amdgcn_fence(__ATOMIC_RELEASE, "agent");
            asm volatile("s_waitcnt vmcnt(0)" ::: "memory");
            const unsigned og = xb_add(&bar[XB_TOP], 1u);
            const unsigned tg = og / nx;
            if (og + 1u == (tg + 1u) * nx) xb_add(&bar[XB_TOPGEN], 1u);
            else XB_SPIN(xb_ld(&bar[XB_TOPGEN]) == tg, bar);
            __builtin_amdgcn_fence(__ATOMIC_ACQUIRE, "agent");
            xb_add(&bar[XB_XGEN(bx)], 1u);
            asm volatile("s_waitcnt vmcnt(0)" ::: "memory");
        } else {
            XB_SPIN(xb_ld(&bar[XB_XGEN(bx)]) == gen, bar);
            __builtin_amdgcn_fence(__ATOMIC_ACQUIRE, "agent");
            asm volatile("s_waitcnt vmcnt(0)" ::: "memory");
        }
    }
    __syncthreads();
}
constexpr int CW_BAR = 4096;

extern __shared__ __attribute__((aligned(16))) unsigned char smem_raw[];
__global__ void __launch_bounds__(NTHR, 2) fwd(Params pk) {
    LAS unsigned char* smem = (LAS unsigned char*)smem_raw;
    if (threadIdx.x < 4) ((LAS unsigned*)(smem + LDS_XBW))[threadIdx.x] = 0u;
    __syncthreads();
    XcdBarrier bar;
    { LOAD_PARAMS(); bar = xcd_barrier_post((unsigned*)(p.ws + WS_CTL) + CW_BAR, (volatile LAS unsigned*)(smem + LDS_XBW)); }
    ph_prologue(smem);
    __syncthreads();
    for (int i = 0; i < DEPTH; ++i) {
        const int j = i >> 1;
        if ((i & 1) == 0) {
            ph_poolfuse(smem, j, i == 0);
            xcd_barrier(bar);
            ph_poolgemm(smem, j);
        } else {
            ph_combine<false>(0);
            xcd_barrier(bar);
            ph_qkv(smem, j);
            xcd_barrier(bar);
            ph_attn(smem);
            xcd_barrier(bar);
            ph_wo(smem, j);
        }
        xcd_barrier(bar);
        ph_router(smem, i);
        xcd_barrier(bar);
        const MoePlan mp = moe_layer_plan(i);
        for (int st = 0; st < 3; ++st) {
            const int ns2 = 4 * mp.NT - mp.D1;
            if (st == 2 && ns2 <= 0 && i == DEPTH - 1) break;
            ph_gu(smem, i, st, mp);
            ph_down(smem, i, st, mp);
            if (st == 1 && i < DEPTH - 1) ph_cvt_stage1(smem, i + 1, mp);
            if (st == 2 && i < DEPTH - 1) ph_cvt_deferred(smem, i + 1, ns2 < 0 ? 0 : (ns2 > (int)gridDim.x ? (int)gridDim.x : ns2));
            xcd_barrier(bar);
        }
    }
    ph_combine<true>(1);
}

extern "C" void kernel_launch(void* const* d_in, const int* in_sizes, int n_in, void* d_out, int out_size, void* d_ws, size_t ws_size, hipStream_t stream) {
    if (ws_size < WS_NEED || n_in < 18) return;
    Params p{};
    p.x_in = (const float*)d_in[0]; p.pool_norm = (const float*)d_in[1]; p.pool_w = (const float*)d_in[2]; p.pool_b = (const float*)d_in[3]; p.pool_scale = (const float*)d_in[4];
    p.sb_norm = (const float*)d_in[5]; p.sb_wqkv = (const float*)d_in[6]; p.sb_qg = (const float*)d_in[7]; p.sb_kg = (const float*)d_in[8]; p.sb_wo = (const float*)d_in[9];
    p.moe_norm = (const float*)d_in[10]; p.moe_wg = (const float*)d_in[11]; p.moe_bg = (const float*)d_in[12]; p.moe_wr = (const float*)d_in[13]; p.moe_br = (const float*)d_in[14];
    p.moe_wgate = (const float*)d_in[15]; p.moe_wup = (const float*)d_in[16]; p.moe_wdown = (const float*)d_in[17];
    p.x = (float*)d_out; p.ws = (unsigned char*)d_ws;
    static int grid = 0;
    if (!grid) {
        int dev = 0, cus = 0, per_cu = 0;
        if (hipGetDevice(&dev) != hipSuccess || hipDeviceGetAttribute(&cus, hipDeviceAttributeMultiprocessorCount, dev) != hipSuccess) { grid = -1; return; }
        if (hipFuncSetAttribute((const void*)fwd, hipFuncAttributeMaxDynamicSharedMemorySize, LDS_BYTES) != hipSuccess) { grid = -1; return; }
        if (hipOccupancyMaxActiveBlocksPerMultiprocessor(&per_cu, (const void*)fwd, NTHR, LDS_BYTES) != hipSuccess || per_cu < 1) { (void)hipGetLastError(); }
        grid = cus;
    }
    if (grid <= 0) return;
    (void)hipMemsetAsync((char*)d_ws + WS_CTL, 0, CTL_BYTES, stream);
    hipLaunchKernelGGL(fwd, dim3(grid), dim3(NTHR), LDS_BYTES, stream, p);
}
```

```cpp
#include <hip/hip_runtime.h>
#include <stdint.h>

#define DI __device__ __forceinline__
#define LAS __attribute__((address_space(3)))
typedef unsigned short bf16_t;
typedef short bf16x8 __attribute__((ext_vector_type(8)));
typedef float f32x4 __attribute__((ext_vector_type(4)));
typedef float f32x16 __attribute__((ext_vector_type(16)));
typedef unsigned u32x4 __attribute__((ext_vector_type(4)));
typedef unsigned u32x2 __attribute__((ext_vector_type(2)));

constexpr int T = 16384, DM = 1024, SEQ = 8192, NH = 16, HD = 64, DEPTH = 4, NE = 32, DE = 256;
constexpr float EPS = 1e-6f;
constexpr int NTHR = 512, NWAVE = 8;
constexpr int LIST_CAP = 16384;
constexpr int DUMMY_ROW = 2 * T;

constexpr size_t MiB = 1u << 20;
constexpr size_t WS_CTL = 0, CTL_BYTES = 1 * MiB;
constexpr size_t WS_WQKV = 1 * MiB;
constexpr size_t WS_WO = 13 * MiB;
constexpr size_t WS_WPOOL = 17 * MiB;
constexpr size_t WS_RSTD = 18 * MiB;
constexpr size_t WS_WRH = 19 * MiB, WS_WRL = WS_WRH + 512 * 1024;
constexpr size_t WS_WGU = 20 * MiB;
constexpr size_t WS_WD = 148 * MiB;
constexpr size_t WS_XB = 212 * MiB;
constexpr size_t WS_XB1 = 384 * MiB;
constexpr size_t WS_NEED = 416 * MiB;
constexpr size_t WS_LIST = 244 * MiB;
constexpr size_t WS_Q = 256 * MiB;
constexpr size_t WS_DIFF = WS_Q;
constexpr size_t WS_K = 288 * MiB, WS_V = 320 * MiB, WS_O = 352 * MiB;
constexpr size_t WS_YBUF = 288 * MiB;
constexpr size_t WS_HID = 354 * MiB;
constexpr size_t WS_END = 384 * MiB;
static_assert(WS_V - WS_K == WS_K - WS_Q, "Q, K, V equally spaced");
static_assert(WS_YBUF + (size_t)(2 * T + 1) * DM * 2 <= WS_HID, "ybuf");
static_assert(WS_HID + (size_t)(2 * T + NE * 256) * DE * 2 <= WS_END, "hid");
constexpr int CW_CNT = 1024;

struct Entry { int dst; float rstd; float w; int tok; };

struct Params {
    const float* x_in; const float* pool_norm; const float* pool_w; const float* pool_b; const float* pool_scale;
    const float* sb_norm; const float* sb_wqkv; const float* sb_qg; const float* sb_kg; const float* sb_wo;
    const float* moe_norm; const float* moe_wg; const float* moe_bg; const float* moe_wr; const float* moe_br;
    const float* moe_wgate; const float* moe_wup; const float* moe_wdown;
    float* x;
    unsigned char* ws;
};

typedef const unsigned long long __attribute__((address_space(4)))* KArgPtr;
#define GP(T, i) ((T*)(T __attribute__((address_space(1)))*)q[i])
DI Params load_params() {
    KArgPtr q = (KArgPtr)__builtin_amdgcn_kernarg_segment_ptr(); asm volatile("" : "+s"(q));
    Params p;
    p.x_in = GP(const float, 0); p.pool_norm = GP(const float, 1); p.pool_w = GP(const float, 2); p.pool_b = GP(const float, 3); p.pool_scale = GP(const float, 4);
    p.sb_norm = GP(const float, 5); p.sb_wqkv = GP(const float, 6); p.sb_qg = GP(const float, 7); p.sb_kg = GP(const float, 8); p.sb_wo = GP(const float, 9);
    p.moe_norm = GP(const float, 10); p.moe_wg = GP(const float, 11); p.moe_bg = GP(const float, 12); p.moe_wr = GP(const float, 13); p.moe_br = GP(const float, 14);
    p.moe_wgate = GP(const float, 15); p.moe_wup = GP(const float, 16); p.moe_wdown = GP(const float, 17);
    p.x = GP(float, 18); p.ws = GP(unsigned char, 19);
    return p;
}
#define LOAD_PARAMS() const Params p = load_params()
DI int tid_() { int t = threadIdx.x; asm volatile("" : "+v"(t)); return t; }
DI int bid_() { int b = blockIdx.x; asm volatile("" : "+s"(b)); return b; }
DI int xbid_() { const int b = bid_(), G = gridDim.x; return (G % 8 == 0) ? (b % 8) * (G / 8) + b / 8 : b; }

DI unsigned cvt_pk_bf16(float lo, float hi) { unsigned r; asm volatile("v_cvt_pk_bf16_f32 %0, %1, %2" : "=v"(r) : "v"(lo), "v"(hi)); return r; }
DI float bf_lo(unsigned u) { return __uint_as_float(u << 16); }
DI float bf_hi(unsigned u) { return __uint_as_float(u & 0xffff0000u); }
DI float shflx(float v, int lane, int m) { return __int_as_float(__builtin_amdgcn_ds_bpermute((lane ^ m) << 2, __float_as_int(v))); }
DI float wave_sum(float v, int lane) {
#pragma unroll
    for (int o = 32; o >= 1; o >>= 1) v += shflx(v, lane, o);
    return v;
}
DI int perm32(int rho) { const int n = rho >> 4, i = rho & 15; return 8 * (i >> 2) + 4 * n + (i & 3); }

struct CvtTile { const float* src; bf16_t* dst; const float* scale; int K, N; };
DI CvtTile cvt_locate(const Params& p, int g) {
    int K, N, sdiv = 1; const float* sb; bf16_t* db; const float* scb = nullptr; size_t sms, dms;
    if (g < 384) { K = 1024; N = 3072; sb = p.sb_wqkv; db = (bf16_t*)(p.ws + WS_WQKV); scb = p.sb_norm; sms = (size_t)1024 * 3072; dms = sms; }
    else if ((g -= 384) < 128) { K = 1024; N = 1024; sb = p.sb_wo; db = (bf16_t*)(p.ws + WS_WO); sms = (size_t)1024 * 1024; dms = sms; }
    else if ((g -= 128) < 32) { K = 256; N = 256; sb = p.pool_w; db = (bf16_t*)(p.ws + WS_WPOOL); sms = 65536; dms = 65536; }
    else if ((g -= 32) < 2048) { K = 1024; N = 256; sb = p.moe_wgate; db = (bf16_t*)(p.ws + WS_WGU); scb = p.moe_norm; sdiv = 32; sms = (size_t)1024 * 256; dms = (size_t)512 * 1024; }
    else if ((g -= 2048) < 2048) { K = 1024; N = 256; sb = p.moe_wup; db = (bf16_t*)(p.ws + WS_WGU) + (size_t)256 * 1024; scb = p.moe_norm; sdiv = 32; sms = (size_t)1024 * 256; dms = (size_t)512 * 1024; }
    else { g -= 2048; K = 256; N = 1024; sb = p.moe_wdown; db = (bf16_t*)(p.ws + WS_WD); sms = (size_t)256 * 1024; dms = sms; }
    const int tn = N / 256, per = (K / 64) * tn, mat = g / per, rem = g % per, k0 = (rem / tn) * 64, n0 = (rem % tn) * 256;
    CvtTile t; t.K = K; t.N = N;
    t.src = sb + (size_t)mat * sms + (size_t)k0 * N + n0;
    t.dst = db + (size_t)mat * dms + (size_t)n0 * K + k0;
    t.scale = scb ? scb + (size_t)(mat / sdiv) * K + k0 : nullptr;
    return t;
}
constexpr int CVT_TILES = 384 + 128 + 32 + 2048 + 2048 + 2048;
constexpr int CVT_NONMOE = 384 + 128 + 32, CVT_L0PRO = 1088;
constexpr int CVT_PRO = 32 + CVT_L0PRO;
constexpr int CVT_E0 = 1536 - CVT_L0PRO, CVT_E1 = CVT_E0 + 192 + 64, CVT_E2 = CVT_E1 + 1536, CVT_E3 = CVT_E2 + 1536, CVT_E4 = CVT_E3 + 192 + 64, CVT_E5 = CVT_E4 + 1536;
constexpr int CVT_DTOTAL = CVT_E5;
constexpr int CW_CVT = 512;
DI int cvt_moe_tile(int L, int u) { return CVT_NONMOE + (u / 512) * 2048 + 512 * L + (u % 512); }
DI int cvt_map(int mode, int q) {
    if (mode == 0) return q < 32 ? 512 + q : cvt_moe_tile(0, q - 32);
    if (q < CVT_E0) return cvt_moe_tile(0, CVT_L0PRO + q);
    if (q < CVT_E0 + 192) return q - CVT_E0;
    if (q < CVT_E1) return 384 + (q - CVT_E0 - 192);
    if (q < CVT_E2) return cvt_moe_tile(1, q - CVT_E1);
    if (q < CVT_E3) return cvt_moe_tile(2, q - CVT_E2);
    if (q < CVT_E3 + 192) return 192 + (q - CVT_E3);
    if (q < CVT_E4) return 448 + (q - CVT_E3 - 192);
    return cvt_moe_tile(3, q - CVT_E4);
}
DI void cvt_run(LAS unsigned char* ldsb, const Params& p, int mode, int lo, int hi, int first, int stride, int tid) {
    LAS float* lds = (LAS float*)ldsb;
    const int n4 = tid & 63, kq = tid >> 6;
    f32x4 regs[8]; float scl[8];
    int q = lo + first;
    CvtTile cur{};
    if (q < hi) {
        cur = cvt_locate(p, cvt_map(mode, q));
#pragma unroll
        for (int i = 0; i < 8; ++i) { regs[i] = __builtin_nontemporal_load((const f32x4*)(cur.src + (size_t)(kq + 8 * i) * cur.N + 4 * n4)); scl[i] = cur.scale ? cur.scale[kq + 8 * i] : 1.0f; }
    }
    for (; q < hi; q += stride) {
        __syncthreads();
#pragma unroll
        for (int i = 0; i < 8; ++i) { const int k = kq + 8 * i; *(LAS f32x4*)(lds + k * 256 + ((4 * n4) ^ (4 * ((k >> 3) & 7)))) = regs[i] * scl[i]; }
        __syncthreads();
        const CvtTile now = cur;
        if (q + stride < hi) {
            cur = cvt_locate(p, cvt_map(mode, q + stride));
#pragma unroll
            for (int i = 0; i < 8; ++i) { regs[i] = __builtin_nontemporal_load((const f32x4*)(cur.src + (size_t)(kq + 8 * i) * cur.N + 4 * n4)); scl[i] = cur.scale ? cur.scale[kq + 8 * i] : 1.0f; }
        }
#pragma unroll
        for (int it = 0; it < 4; ++it) {
            const int qq = tid + 512 * it, ko = qq & 7, n = qq >> 3;
            float v[8];
#pragma unroll
            for (int j = 0; j < 8; ++j) v[j] = lds[(8 * ko + j) * 256 + (n ^ (4 * ko))];
            u32x4 w; w[0] = cvt_pk_bf16(v[0], v[1]); w[1] = cvt_pk_bf16(v[2], v[3]); w[2] = cvt_pk_bf16(v[4], v[5]); w[3] = cvt_pk_bf16(v[6], v[7]);
            __builtin_nontemporal_store(w, (u32x4*)(now.dst + (size_t)n * now.K + 8 * ko));
        }
    }
    __syncthreads();
}
DI void ph_prologue(LAS unsigned char* ldsb) {
    LOAD_PARAMS();
    const int tid = tid_(), bid = bid_();
    cvt_run(ldsb, p, 0, 0, CVT_PRO, bid, gridDim.x, tid);
    bf16_t* wh = (bf16_t*)(p.ws + WS_WRH); bf16_t* wl = (bf16_t*)(p.ws + WS_WRL);
    for (int idx = bid * NTHR + tid; idx < DEPTH * 48 * DM; idx += gridDim.x * NTHR) {
        const int l = idx / (48 * DM), n = (idx / DM) % 48, k = idx % DM;
        float v = 0.f;
        if (n < 4) v = p.moe_wg[((size_t)l * DM + k) * 4 + n]; else if (n < 36) v = p.moe_wr[((size_t)l * DM + k) * 32 + (n - 4)];
        v *= p.moe_norm[l * DM + k];
        const unsigned h = cvt_pk_bf16(v, 0.f), lo = cvt_pk_bf16(v - bf_lo(h), 0.f);
        wh[idx] = (bf16_t)(h & 0xffffu); wl[idx] = (bf16_t)(lo & 0xffffu);
    }
}

DI void unpack8(const u32x4 u, float (&f)[8]) {
#pragma unroll
    for (int i = 0; i < 4; ++i) { f[2 * i] = bf_lo(u[i]); f[2 * i + 1] = bf_hi(u[i]); }
}
template <bool FINAL>
DI void ph_combine(int src_buf) {
    LOAD_PARAMS();
    const int tid = tid_(), bid = bid_(), wid = tid >> 6, lane = tid & 63;
    const bf16_t* xs = (const bf16_t*)(p.ws + (src_buf ? WS_XB1 : WS_XB));
    bf16_t* xd = (bf16_t*)(p.ws + (src_buf ? WS_XB : WS_XB1));
    const bf16_t* yb = (const bf16_t*)(p.ws + WS_YBUF);
    float* rstd = (float*)(p.ws + WS_RSTD);
    for (int t = bid * NWAVE + wid; t < T; t += gridDim.x * NWAVE) {
        float ss = 0.f;
#pragma unroll
        for (int i = 0; i < 2; ++i) {
            const size_t o = (size_t)t * DM + lane * 8 + 512 * i;
            float a[8], b[8], c[8];
            unpack8(*(const u32x4*)(xs + o), a); unpack8(*(const u32x4*)(yb + o), b); unpack8(*(const u32x4*)(yb + (size_t)T * DM + o), c);
#pragma unroll
            for (int e = 0; e < 8; ++e) a[e] += b[e] + c[e];
            if (FINAL) {
                __builtin_nontemporal_store((f32x4){a[0], a[1], a[2], a[3]}, (f32x4*)(p.x + o)); __builtin_nontemporal_store((f32x4){a[4], a[5], a[6], a[7]}, (f32x4*)(p.x + o + 4));
            } else {
                u32x4 w; w[0] = cvt_pk_bf16(a[0], a[1]); w[1] = cvt_pk_bf16(a[2], a[3]); w[2] = cvt_pk_bf16(a[4], a[5]); w[3] = cvt_pk_bf16(a[6], a[7]);
                *(u32x4*)(xd + o) = w;
                float r[8]; unpack8(w, r);
#pragma unroll
                for (int e = 0; e < 8; ++e) ss += r[e] * r[e];
            }
        }
        if (!FINAL) { ss = wave_sum(ss, lane); if (lane == 0) rstd[t] = rsqrtf(ss * (1.0f / DM) + EPS); }
    }
}

constexpr int PF_ROWS = 47, PF_TOK = 32;
DI void ph_poolfuse(LAS unsigned char* ldsb, int j, bool first) {
    LOAD_PARAMS();
    const int tid = tid_(), bid = bid_(), wid = tid >> 6, lane = tid & 63;
    const bf16_t* xs = (const bf16_t*)(p.ws + WS_XB1);
    bf16_t* xd = (bf16_t*)(p.ws + WS_XB);
    const bf16_t* yb = (const bf16_t*)(p.ws + WS_YBUF);
    const float* gain = p.pool_norm + j * DM;
    bf16_t* diff = (bf16_t*)(p.ws + WS_DIFF);
    LAS unsigned char* ht = ldsb;
    for (int tix = 0; tix < 2 * ((T / (2 * PF_TOK) - bid + (int)gridDim.x - 1) / (int)gridDim.x); ++tix) {
        const int tile = 2 * (bid + (tix >> 1) * (int)gridDim.x) + (tix & 1);
        const int t0 = tile * PF_TOK, s0 = t0 & (SEQ - 1);
        const bool reuse = (tix & 1) != 0;
        if (reuse) {
            for (int q = tid; q < 15 * 128; q += NTHR) { const int r = q >> 7, c = (q & 127) * 16; *(LAS u32x4*)(ht + r * 2048 + c) = *(const LAS u32x4*)(ht + (32 + r) * 2048 + c); }
            __syncthreads();
        }
        for (int rr = (reuse ? 15 : 0) + wid; rr < PF_ROWS; rr += NWAVE) {
            const int t = t0 - 15 + rr;
            if (s0 == 0 && rr < 15) {
#pragma unroll
                for (int i = 0; i < 2; ++i) *(LAS u32x4*)(ht + rr * 2048 + (lane * 8 + 512 * i) * 2) = (u32x4){0u, 0u, 0u, 0u};
                continue;
            }
            float v[2][8]; u32x4 w[2]; float ss = 0.f;
#pragma unroll
            for (int i = 0; i < 2; ++i) {
                const size_t o = (size_t)t * DM + lane * 8 + 512 * i;
                if (first) {
                    const f32x4 a = *(const f32x4*)(p.x_in + o), b = *(const f32x4*)(p.x_in + o + 4);
#pragma unroll
                    for (int e = 0; e < 4; ++e) { v[i][e] = a[e]; v[i][4 + e] = b[e]; }
                } else {
                    float b[8], c[8];
                    unpack8(*(const u32x4*)(xs + o), v[i]); unpack8(*(const u32x4*)(yb + o), b); unpack8(*(const u32x4*)(yb + (size_t)T * DM + o), c);
#pragma unroll
                    for (int e = 0; e < 8; ++e) v[i][e] += b[e] + c[e];
                }
                w[i][0] = cvt_pk_bf16(v[i][0], v[i][1]); w[i][1] = cvt_pk_bf16(v[i][2], v[i][3]); w[i][2] = cvt_pk_bf16(v[i][4], v[i][5]); w[i][3] = cvt_pk_bf16(v[i][6], v[i][7]);
                if (rr >= 15) *(u32x4*)(xd + o) = w[i];
                unpack8(w[i], v[i]);
#pragma unroll
                for (int e = 0; e < 8; ++e) ss += v[i][e] * v[i][e];
            }
            ss = wave_sum(ss, lane);
            const float rs = rsqrtf(ss * (1.0f / DM) + EPS);
#pragma unroll
            for (int i = 0; i < 2; ++i) {
                u32x4 hw; hw[0] = cvt_pk_bf16(v[i][0] * rs, v[i][1] * rs); hw[1] = cvt_pk_bf16(v[i][2] * rs, v[i][3] * rs); hw[2] = cvt_pk_bf16(v[i][4] * rs, v[i][5] * rs); hw[3] = cvt_pk_bf16(v[i][6] * rs, v[i][7] * rs);
                *(LAS u32x4*)(ht + rr * 2048 + (lane * 8 + 512 * i) * 2) = hw;
            }
        }
        __syncthreads();
        {
            const int c = 2 * tid, win = 2 << (c >> 8);
            const float g0 = gain[c], g1 = gain[c + 1];
            float S0 = 0.f, S1 = 0.f;
            const LAS unsigned char* col = ht + c * 2;
#pragma unroll 4
            for (int rr = 0; rr < PF_ROWS; ++rr) {
                const unsigned hv = *(const LAS unsigned*)(col + rr * 2048);
                const float h0 = bf_lo(hv), h1 = bf_hi(hv);
                S0 += h0; S1 += h1;
                if (rr >= win) { const unsigned ov = *(const LAS unsigned*)(col + (rr - win) * 2048); S0 -= bf_lo(ov); S1 -= bf_hi(ov); }
                if (rr >= 15) {
                    const int s = s0 + rr - 15;
                    const float inv = 1.0f / (float)((s + 1 < win) ? s + 1 : win);
                    *(unsigned*)(diff + (size_t)(t0 + rr - 15) * DM + c) = cvt_pk_bf16((S0 * inv - h0) * g0, (S1 * inv - h1) * g1);
                }
            }
        }
        __syncthreads();
    }
}

struct Unit { const bf16_t* A; const bf16_t* B; int pm, pn, e, nvalid, row0, lbase; };
template <int LDA_, int LDB_, int K_, int BH_, bool HEADMAP_> struct GCfg { static constexpr int LDA = LDA_, LDB = LDB_, K = K_, BH = BH_; static constexpr bool HEADMAP = HEADMAP_; };

constexpr int BK = 64, HTB = 128 * BK * 2  , STAGE_BYTES = 8 * HTB;
DI int lds_byte(int r, int c) { const int st = (r >> 4) * 2 + (c >> 5), rr = r & 15, cc = c & 31, ob = rr * 64 + cc * 2; return st * 1024 + (ob ^ (((ob >> 9) & 1) << 5)); }
DI void stage_rc(int b, int& R, int& C) { const int st = b / 1024, sb = b % 1024, swz = sb ^ (((sb >> 9) & 1) << 5); R = (st >> 1) * 16 + swz / 64; C = (st & 1) * 32 + (swz % 64) / 2; }

template <class Cfg, class Sched, class Epi>
DI void gemm_phase(LAS unsigned char* lds, const Sched& S, const Epi& E) {
    const int tid = tid_(), wid = __builtin_amdgcn_readfirstlane(tid >> 6), lane = tid & 63, wr = wid >> 2, wc = wid & 3, fr = lane & 15, fq = lane >> 4;
    constexpr int nt = Cfg::K / BK;
    static_assert(Cfg::K % 128 == 0 && Cfg::K >= 256, "K");
    unsigned voffA[2][2], voffB[2];
    int R0, C0, R1, C1; stage_rc(tid * 16, R0, C0); stage_rc(tid * 16 + 8192, R1, C1);
    voffB[0] = (unsigned)(((Cfg::HEADMAP ? 64 * (R0 >> 5) : (R0 & ~31)) + perm32(R0 & 31)) * Cfg::LDB + C0) * 2u;
    voffB[1] = (unsigned)(((Cfg::HEADMAP ? 64 * (R1 >> 5) : (R1 & ~31)) + perm32(R1 & 31)) * Cfg::LDB + C1) * 2u;
    constexpr size_t kstep = (size_t)(BK * 2);
    constexpr size_t bhstep = (size_t)Cfg::BH * Cfg::LDB * 2;
    const unsigned ldsw = (unsigned)wid * 1024u;
    const int aoff = lds_byte(wr * 64 + fr, fq * 8), boff = lds_byte(wc * 32 + fr, fq * 8);
#define PG8_SA(b, h) (((b) * 2 + (h)) * HTB)
#define PG8_SB(b, h) ((4 + (b) * 2 + (h)) * HTB)
#define PG8_STAGE(bufoff, gbase, voff) do { _Pragma("unroll") for (int _i = 0; _i < 2; ++_i) \
        __builtin_amdgcn_global_load_lds((const unsigned*)((const char*)(gbase) + (voff)[_i]), (LAS unsigned*)(lds + (bufoff) + ldsw + _i * 8192), 16, 0, 0); } while (0)
#define PG8_LDA(dst, b, h) do { _Pragma("unroll") for (int m = 0; m < 4; ++m) _Pragma("unroll") for (int k = 0; k < 2; ++k) dst[m][k] = *(const LAS bf16x8*)(lds + PG8_SA(b, h) + aoff + m * 2048 + k * 1024); } while (0)
#define PG8_LDB(dst, b, h) do { _Pragma("unroll") for (int n = 0; n < 2; ++n) _Pragma("unroll") for (int k = 0; k < 2; ++k) dst[n][k] = *(const LAS bf16x8*)(lds + PG8_SB(b, h) + boff + n * 2048 + k * 1024); } while (0)
#define PG8_MMA(ai, bj, At, Bt) do { __builtin_amdgcn_s_setprio(1); _Pragma("unroll") for (int m = 0; m < 4; ++m) _Pragma("unroll") for (int n = 0; n < 2; ++n) _Pragma("unroll") for (int k = 0; k < 2; ++k) \
        acc[ai][bj][m][n] = __builtin_amdgcn_mfma_f32_16x16x32_bf16(Bt[n][k], At[m][k], acc[ai][bj][m][n], 0, 0, 0); __builtin_amdgcn_s_setprio(0); } while (0)
#define PG8_WAIT_V(n) asm volatile("s_waitcnt vmcnt(" #n ")" ::: "memory")
#define PG8_WAIT_L(n) asm volatile("s_waitcnt lgkmcnt(" #n ")" ::: "memory")
#define PG8_BAR __builtin_amdgcn_s_barrier()
#define PG8_SCHED __builtin_amdgcn_sched_barrier(0)
#define PG8_AROWS(uidx, un) do { voffA[0][0] = (unsigned)S.arow(uidx, un, R0) * (unsigned)(Cfg::LDA * 2) + (unsigned)(C0 * 2); voffA[0][1] = (unsigned)S.arow(uidx, un, R1) * (unsigned)(Cfg::LDA * 2) + (unsigned)(C1 * 2); \
        voffA[1][0] = (unsigned)S.arow(uidx, un, 128 + R0) * (unsigned)(Cfg::LDA * 2) + (unsigned)(C0 * 2); voffA[1][1] = (unsigned)S.arow(uidx, un, 128 + R1) * (unsigned)(Cfg::LDA * 2) + (unsigned)(C1 * 2); } while (0)
    Unit cur, nxt; int ui = 0;
    if (!S.next(0, cur)) return;
    f32x4 acc[2][2][4][2];
#pragma unroll
    for (int a = 0; a < 2; ++a)
#pragma unroll
        for (int b = 0; b < 2; ++b)
#pragma unroll
            for (int m = 0; m < 4; ++m)
#pragma unroll
                for (int n = 0; n < 2; ++n) acc[a][b][m][n] = (f32x4){0.f, 0.f, 0.f, 0.f};
    bf16x8 At[4][2], B0[2][2], B1[2][2];
    PG8_AROWS(0, cur);
    const char* cA = (const char*)cur.A; const char* cB = (const char*)cur.B;
    PG8_STAGE(PG8_SB(0, 0), cB, voffB); PG8_STAGE(PG8_SB(0, 1), cB + bhstep, voffB); PG8_STAGE(PG8_SA(0, 0), cA, voffA[0]); PG8_STAGE(PG8_SA(0, 1), cA, voffA[1]);
    if (wr == 1) PG8_BAR;
    PG8_WAIT_V(2); PG8_BAR;
    PG8_STAGE(PG8_SB(1, 0), cB + kstep, voffB); PG8_STAGE(PG8_SA(1, 0), cA + kstep, voffA[0]); PG8_STAGE(PG8_SB(1, 1), cB + bhstep + kstep, voffB);
    PG8_WAIT_V(6); PG8_BAR;
    for (;;) {
        const bool has_next = S.next(ui + 1, nxt);
        const char* nA = has_next ? (const char*)nxt.A : cA; const char* nB = has_next ? (const char*)nxt.B : cB;
#pragma unroll 1
        for (int t = 0; t < nt; t += 2) {
            const bool last = (t == nt - 2);
            const char* a1 = cA + (size_t)(t + 1) * kstep;
            const char* a2 = last ? nA : cA + (size_t)(t + 2) * kstep; const char* b2 = last ? nB : cB + (size_t)(t + 2) * kstep;
            const char* a3 = a2 + kstep; const char* b3 = b2 + kstep;
            PG8_LDB(B0, 0, 0); PG8_LDB(B1, 0, 1); PG8_SCHED; PG8_LDA(At, 0, 0); PG8_STAGE(PG8_SA(1, 1), a1, voffA[1]);
            if (last && has_next) PG8_AROWS(ui + 1, nxt);
            PG8_WAIT_V(8); PG8_WAIT_L(0); PG8_BAR; PG8_MMA(0, 0, At, B0); PG8_MMA(0, 1, At, B1); PG8_BAR; PG8_SCHED;
            PG8_LDA(At, 0, 1); PG8_STAGE(PG8_SB(0, 0), b2, voffB); PG8_STAGE(PG8_SB(0, 1), b2 + bhstep, voffB); PG8_STAGE(PG8_SA(0, 0), a2, voffA[0]);
            PG8_WAIT_V(8); PG8_WAIT_L(0); PG8_BAR; PG8_MMA(1, 0, At, B0); PG8_MMA(1, 1, At, B1); PG8_BAR; PG8_SCHED;
            PG8_LDB(B0, 1, 0); PG8_LDB(B1, 1, 1); PG8_SCHED; PG8_LDA(At, 1, 0); PG8_STAGE(PG8_SA(0, 1), a2, voffA[1]);
            PG8_WAIT_V(8); PG8_WAIT_L(0); PG8_BAR; PG8_MMA(0, 0, At, B0); PG8_MMA(0, 1, At, B1); PG8_BAR; PG8_SCHED;
            PG8_LDA(At, 1, 1); PG8_STAGE(PG8_SB(1, 0), b3, voffB); PG8_STAGE(PG8_SB(1, 1), b3 + bhstep, voffB); PG8_STAGE(PG8_SA(1, 0), a3, voffA[0]);
            PG8_WAIT_V(8); PG8_WAIT_L(0); PG8_BAR; PG8_MMA(1, 0, At, B0); PG8_MMA(1, 1, At, B1); PG8_BAR; PG8_SCHED;
        }
        if (wr == 0) PG8_BAR;
        E(acc, cur, wr, wc, fr, fq);
        if (!has_next) break;
#pragma unroll
        for (int a = 0; a < 2; ++a)
#pragma unroll
            for (int b = 0; b < 2; ++b)
#pragma unroll
                for (int m = 0; m < 4; ++m)
#pragma unroll
                    for (int n = 0; n < 2; ++n) acc[a][b][m][n] = (f32x4){0.f, 0.f, 0.f, 0.f};
        cur = nxt; cA = nA; cB = nB; ++ui;
        if (wr == 1) PG8_BAR;
    }
    PG8_WAIT_V(0);
    PG8_BAR;
#undef PG8_SA
#undef PG8_SB
#undef PG8_STAGE
#undef PG8_LDA
#undef PG8_LDB
#undef PG8_MMA
#undef PG8_WAIT_V
#undef PG8_WAIT_L
#undef PG8_BAR
#undef PG8_SCHED
#undef PG8_AROWS
}

struct SchedPool {
    const bf16_t* diff; const bf16_t* w; int bid;
    DI bool next(int i, Unit& u) const { const int L = i * gridDim.x + bid; if (L >= 256) return false; u.pm = L >> 2; u.pn = L & 3; u.A = diff + 256 * u.pn; u.B = w + (size_t)u.pn * 65536; return true; }
    DI int arow(int, const Unit& u, int r) const { return u.pm * 256 + r; }
};
struct SchedDense {
    const bf16_t* A; const bf16_t* B; int npn, ldb, bid;
    DI bool next(int i, Unit& u) const { const int L = i * gridDim.x + bid; if (L >= 64 * npn) return false; u.pm = L / npn; u.pn = L % npn; u.A = A; u.B = B + (size_t)u.pn * 256 * ldb; return true; }
    DI int arow(int, const Unit& u, int r) const { return u.pm * 256 + r; }
};

struct EpiPool {
    bf16_t* x; const float* pb; const float* ps;
    DI void operator()(const f32x4 (&acc)[2][2][4][2], const Unit& u, int wr, int wc, int fr, int fq) const {
        f32x4 bb[2][2], sc[2][2];
#pragma unroll
        for (int bj = 0; bj < 2; ++bj) {
            const int c = 256 * u.pn + 128 * bj + 32 * wc + 8 * fq;
            bb[bj][0] = *(const f32x4*)(pb + c); bb[bj][1] = *(const f32x4*)(pb + c + 4); sc[bj][0] = *(const f32x4*)(ps + c); sc[bj][1] = *(const f32x4*)(ps + c + 4);
        }
#pragma unroll
        for (int ai = 0; ai < 2; ++ai) {
            u32x4 xin[4][2];
#pragma unroll
            for (int m = 0; m < 4; ++m)
#pragma unroll
                for (int bj = 0; bj < 2; ++bj)
                    xin[m][bj] = *(const u32x4*)(x + (size_t)(u.pm * 256 + 128 * ai + 64 * wr + 16 * m + fr) * DM + 256 * u.pn + 128 * bj + 32 * wc + 8 * fq);
            asm volatile("" ::: "memory");
#pragma unroll
            for (int m = 0; m < 4; ++m) {
                const int t = u.pm * 256 + 128 * ai + 64 * wr + 16 * m + fr;
#pragma unroll
                for (int bj = 0; bj < 2; ++bj) {
                    const int c = 256 * u.pn + 128 * bj + 32 * wc + 8 * fq;
                    float xv[8]; unpack8(xin[m][bj], xv);
                    const f32x4 v0 = (acc[ai][bj][m][0] + bb[bj][0]) * sc[bj][0];
                    const f32x4 v1 = (acc[ai][bj][m][1] + bb[bj][1]) * sc[bj][1];
                    u32x4 w; w[0] = cvt_pk_bf16(xv[0] + v0[0], xv[1] + v0[1]); w[1] = cvt_pk_bf16(xv[2] + v0[2], xv[3] + v0[3]); w[2] = cvt_pk_bf16(xv[4] + v1[0], xv[5] + v1[1]); w[3] = cvt_pk_bf16(xv[6] + v1[2], xv[7] + v1[3]);
                    *(u32x4*)(x + (size_t)t * DM + c) = w;
                }
            }
        }
    }
};
struct EpiWo {
    bf16_t* x;
    DI void operator()(const f32x4 (&acc)[2][2][4][2], const Unit& u, int wr, int wc, int fr, int fq) const {
#pragma unroll
        for (int ai = 0; ai < 2; ++ai) {
            u32x4 xin[4][2];
#pragma unroll
            for (int m = 0; m < 4; ++m)
#pragma unroll
                for (int bj = 0; bj < 2; ++bj)
                    xin[m][bj] = *(const u32x4*)(x + (size_t)(u.pm * 256 + 128 * ai + 64 * wr + 16 * m + fr) * DM + 256 * u.pn + 128 * bj + 32 * wc + 8 * fq);
            asm volatile("" ::: "memory");
#pragma unroll
            for (int m = 0; m < 4; ++m) {
                const int t = u.pm * 256 + 128 * ai + 64 * wr + 16 * m + fr;
#pragma unroll
                for (int bj = 0; bj < 2; ++bj) {
                    const int c = 256 * u.pn + 128 * bj + 32 * wc + 8 * fq;
                    float xv[8]; unpack8(xin[m][bj], xv);
                    const f32x4 v0 = acc[ai][bj][m][0], v1 = acc[ai][bj][m][1];
                    u32x4 w; w[0] = cvt_pk_bf16(xv[0] + v0[0], xv[1] + v0[1]); w[1] = cvt_pk_bf16(xv[2] + v0[2], xv[3] + v0[3]); w[2] = cvt_pk_bf16(xv[4] + v1[0], xv[5] + v1[1]); w[3] = cvt_pk_bf16(xv[6] + v1[2], xv[7] + v1[3]);
                    *(u32x4*)(x + (size_t)t * DM + c) = w;
                }
            }
        }
    }
};
struct EpiQKV {
    bf16_t* q; const float* rstd; const float* qg; const float* kg;
    DI void operator()(const f32x4 (&acc)[2][2][4][2], const Unit& u, int wr, int wc, int fr, int fq) const {
        const int which = u.pn >> 2, head = (u.pn & 3) * 4 + wc;
        bf16_t* out = q + (size_t)which * ((WS_K - WS_Q) / 2);
        const float* gn = which == 0 ? qg : kg;
        const float post = which == 0 ? 0.125f * 1.4426950408889634f : 1.0f;
        f32x4 g[2][2];
#pragma unroll
        for (int bj = 0; bj < 2; ++bj)
#pragma unroll
            for (int n = 0; n < 2; ++n) g[bj][n] = (which < 2) ? *(const f32x4*)(gn + 32 * bj + 8 * fq + 4 * n) * post : (f32x4){1.f, 1.f, 1.f, 1.f};
        float rsv[2][4];
#pragma unroll
        for (int ai = 0; ai < 2; ++ai)
#pragma unroll
            for (int m = 0; m < 4; ++m) rsv[ai][m] = rstd[u.pm * 256 + 128 * ai + 64 * wr + 16 * m + fr];
#pragma unroll
        for (int ai = 0; ai < 2; ++ai)
#pragma unroll
            for (int m = 0; m < 4; ++m) {
                const int t = u.pm * 256 + 128 * ai + 64 * wr + 16 * m + fr;
                const float rs = rsv[ai][m];
                f32x4 v4[2][2]; float ss = 0.f;
#pragma unroll
                for (int bj = 0; bj < 2; ++bj)
#pragma unroll
                    for (int n = 0; n < 2; ++n) { v4[bj][n] = acc[ai][bj][m][n] * rs; const f32x4 s = v4[bj][n] * v4[bj][n]; ss += (s[0] + s[1]) + (s[2] + s[3]); }
                ss += shflx(ss, fr + 16 * fq, 16); ss += shflx(ss, fr + 16 * fq, 32);
                const float r2 = (which < 2) ? rsqrtf(ss * (1.0f / HD) + EPS) : 1.0f;
#pragma unroll
                for (int bj = 0; bj < 2; ++bj) {
                    const f32x4 a = v4[bj][0] * r2 * g[bj][0], b = v4[bj][1] * r2 * g[bj][1];
                    u32x4 w; w[0] = cvt_pk_bf16(a[0], a[1]); w[1] = cvt_pk_bf16(a[2], a[3]); w[2] = cvt_pk_bf16(b[0], b[1]); w[3] = cvt_pk_bf16(b[2], b[3]);
                    *(u32x4*)(out + (size_t)t * DM + head * HD + 32 * bj + 8 * fq) = w;
                }
            }
    }
};

typedef short v4i16_t __attribute__((ext_vector_type(4)));
constexpr int AT_VPITCH = 192;
constexpr int AT_VTILE = 32 * AT_VPITCH;
DI void ph_attn(LAS unsigned char* ldsb) {
    LOAD_PARAMS();
    const int tid = tid_(), bid = bid_(), wid = tid >> 6, lane = tid & 63, l31 = lane & 31, h2 = lane >> 5;
    const bf16_t* Q = (const bf16_t*)(p.ws + WS_Q); const bf16_t* K = (const bf16_t*)(p.ws + WS_K); const bf16_t* V = (const bf16_t*)(p.ws + WS_V);
    bf16_t* O = (bf16_t*)(p.ws + WS_O);
    LAS unsigned char* vl = ldsb + wid * AT_VTILE;
    LAS unsigned char* vw = vl + (lane >> 3) * AT_VPITCH + (lane & 7) * 16;
    const LAS unsigned char* vr = vl + (4 * h2 + ((lane & 15) >> 2)) * AT_VPITCH + (16 * ((lane >> 4) & 1) + 4 * (lane & 3)) * 2;
    for (int it = 0; it < 4 * ((2 * NH * 256 / 32 - bid + (int)gridDim.x - 1) / (int)gridDim.x); ++it) {
        const int tsk = (bid + (it >> 2) * gridDim.x) * 32 + (it & 3) * 8 + wid;
        const int bh = tsk >> 8, qb = tsk & 255, b = bh >> 4, h = bh & 15;
        const size_t tb = (size_t)b * SEQ;
        const int q0 = qb * 32;
        bf16x8 qf[4];
#pragma unroll
        for (int s = 0; s < 4; ++s) qf[s] = *(const bf16x8*)(Q + (tb + q0 + l31) * DM + h * HD + 16 * s + 8 * h2);
        f32x16 o0, o1;
#pragma unroll
        for (int r = 0; r < 16; ++r) { o0[r] = 0.f; o1[r] = 0.f; }
        float R = 1.f;
        const bf16_t* kp = K + (tb + q0 + l31) * DM + h * HD + 8 * h2;
        const bf16_t* vp = V + (tb + q0 + (lane >> 3)) * DM + h * HD + (lane & 7) * 8;
        bf16x8 kn[4], kq[4]; u32x4 vn[4], vq[4];
#pragma unroll
        for (int s = 0; s < 4; ++s) { kn[s] = *(const bf16x8*)(kp + 16 * s); vn[s] = *(const u32x4*)(vp + (size_t)8 * s * DM); }
        if (qb > 0) {
            kp -= (size_t)32 * DM; vp -= (size_t)32 * DM;
#pragma unroll
            for (int s = 0; s < 4; ++s) { kq[s] = *(const bf16x8*)(kp + 16 * s); vq[s] = *(const u32x4*)(vp + (size_t)8 * s * DM); }
        }
        for (int kt = qb; kt >= 0; --kt) {
            bf16x8 kf[4];
#pragma unroll
            for (int s = 0; s < 4; ++s) { kf[s] = kn[s]; *(LAS u32x4*)(vw + 8 * s * AT_VPITCH) = vn[s]; kn[s] = kq[s]; vn[s] = vq[s]; }
            if (kt > 1) {
                kp -= (size_t)32 * DM; vp -= (size_t)32 * DM;
#pragma unroll
                for (int s = 0; s < 4; ++s) { kq[s] = *(const bf16x8*)(kp + 16 * s); vq[s] = *(const u32x4*)(vp + (size_t)8 * s * DM); }
            }
            f32x16 z;
#pragma unroll
            for (int r = 0; r < 16; ++r) z[r] = 0.f;
#pragma unroll
            for (int s = 0; s < 4; ++s) z = __builtin_amdgcn_mfma_f32_32x32x16_bf16(kf[s], qf[s], z, 0, 0, 0);
            float kp_[16], gs[4], ot[4];
#pragma unroll
            for (int r = 0; r < 16; ++r) kp_[r] = __builtin_amdgcn_rcpf(1.0f + __builtin_amdgcn_exp2f(z[r]));
            if (kt == qb) {
#pragma unroll
                for (int r = 0; r < 16; ++r) { const int kl = (r & 3) + 8 * (r >> 2) + 4 * h2; kp_[r] = (kl < l31) ? kp_[r] : 1.0f; }
            }
#pragma unroll
            for (int bb = 0; bb < 4; ++bb) { gs[bb] = (kp_[4 * bb] * kp_[4 * bb + 1]) * (kp_[4 * bb + 2] * kp_[4 * bb + 3]); ot[bb] = shflx(gs[bb], lane, 32); }
            const float tot_own = (gs[0] * gs[1]) * (gs[2] * gs[3]);
            const float tot_oth = (ot[0] * ot[1]) * (ot[2] * ot[3]);
            float later[4];
            {
                float own_tail = 1.f, oth_tail = 1.f;
#pragma unroll
                for (int bb = 3; bb >= 0; --bb) {
                    later[bb] = own_tail * oth_tail * (h2 == 0 ? ot[bb] : 1.f);
                    own_tail *= gs[bb]; oth_tail *= ot[bb];
                }
            }
            float a[16];
#pragma unroll
            for (int bb = 0; bb < 4; ++bb) {
                const float x3 = R * later[bb];
                const float x2 = x3 * kp_[4 * bb + 3], x1 = x2 * kp_[4 * bb + 2], x0 = x1 * kp_[4 * bb + 1];
                a[4 * bb] = x0 - x0 * kp_[4 * bb]; a[4 * bb + 1] = x1 - x1 * kp_[4 * bb + 1]; a[4 * bb + 2] = x2 - x2 * kp_[4 * bb + 2]; a[4 * bb + 3] = x3 - x3 * kp_[4 * bb + 3];
            }
            R *= (h2 == 0) ? (tot_own * tot_oth) : (tot_oth * tot_own);
#pragma unroll
            for (int s = 0; s < 2; ++s) {
                u32x4 pw;
#pragma unroll
                for (int i = 0; i < 4; ++i) pw[i] = cvt_pk_bf16(a[8 * s + 2 * i], a[8 * s + 2 * i + 1]);
                const bf16x8 pa = __builtin_bit_cast(bf16x8, pw);
#pragma unroll
                for (int db = 0; db < 2; ++db) {
                    const v4i16_t lo4 = __builtin_amdgcn_ds_read_tr16_b64_v4i16((LAS v4i16_t*)(vr + (16 * s) * AT_VPITCH + 64 * db));
                    const v4i16_t hi4 = __builtin_amdgcn_ds_read_tr16_b64_v4i16((LAS v4i16_t*)(vr + (16 * s + 8) * AT_VPITCH + 64 * db));
                    bf16x8 vf; vf[0] = lo4[0]; vf[1] = lo4[1]; vf[2] = lo4[2]; vf[3] = lo4[3]; vf[4] = hi4[0]; vf[5] = hi4[1]; vf[6] = hi4[2]; vf[7] = hi4[3];
                    if (db == 0) o0 = __builtin_amdgcn_mfma_f32_32x32x16_bf16(vf, pa, o0, 0, 0, 0);
                    else o1 = __builtin_amdgcn_mfma_f32_32x32x16_bf16(vf, pa, o1, 0, 0, 0);
                }
            }
            if (__all(R < 1.0e-36f)) break;
        }
#pragma unroll
        for (int db = 0; db < 2; ++db)
#pragma unroll
            for (int rb = 0; rb < 4; ++rb) {
                const f32x16& o = db == 0 ? o0 : o1;
                u32x2 w; w[0] = cvt_pk_bf16(o[4 * rb], o[4 * rb + 1]); w[1] = cvt_pk_bf16(o[4 * rb + 2], o[4 * rb + 3]);
                *(u32x2*)(O + (tb + q0 + l31) * DM + h * HD + 32 * db + 8 * rb + 4 * h2) = w;
            }
    }
}

constexpr int RT_PART = 0;
constexpr int RT_SSQ = RT_PART + 4 * 64 * 52 * 4;
constexpr int RT_LCNT = RT_SSQ + 4 * 64 * 4;
constexpr int RT_GB = RT_LCNT + 128;
DI void ph_router(LAS unsigned char* lds, int li) {
    LOAD_PARAMS();
    const bf16_t* xcur = (const bf16_t*)(p.ws + ((li & 1) ? WS_XB1 : WS_XB));
    const int tid = tid_(), bid = bid_(), wid = tid >> 6, lane = tid & 63, fr = lane & 15, fq = lane >> 4;
    const bf16_t* wh = (const bf16_t*)(p.ws + WS_WRH) + (size_t)li * 48 * DM;
    const bf16_t* wl = (const bf16_t*)(p.ws + WS_WRL) + (size_t)li * 48 * DM;
    const float* bg = p.moe_bg + li * 4;
    const float* br = p.moe_br + li * 32;
    unsigned* cnt = (unsigned*)(p.ws + WS_CTL) + CW_CNT + 32 * li;
    Entry* list = (Entry*)(p.ws + WS_LIST);
    LAS float* part = (LAS float*)(lds + RT_PART); LAS float* ssq = (LAS float*)(lds + RT_SSQ);
    LAS int* lcnt = (LAS int*)(lds + RT_LCNT); LAS int* gb = (LAS int*)(lds + RT_GB);
    const int th = wid & 1, kq = wid >> 1;
    for (int chunk = bid; chunk < T / 64; chunk += gridDim.x) {
        const int t = chunk * 64 + th * 32 + fr;
        const bf16_t* xr = xcur + (size_t)t * DM + kq * 256 + fq * 8;
        const bf16_t* whr = wh + (size_t)fr * DM + kq * 256 + fq * 8;
        const bf16_t* wlr = wl + (size_t)fr * DM + kq * 256 + fq * 8;
        f32x4 acc[2][3]; float ss[2] = {0.f, 0.f};
#pragma unroll
        for (int b = 0; b < 2; ++b)
#pragma unroll
            for (int nb = 0; nb < 3; ++nb) acc[b][nb] = (f32x4){0.f, 0.f, 0.f, 0.f};
#pragma unroll 4
        for (int ks = 0; ks < 8; ++ks) {
            bf16x8 xh[2];
#pragma unroll
            for (int b = 0; b < 2; ++b) {
                const u32x4 xw = *(const u32x4*)(xr + (size_t)b * 16 * DM + ks * 32);
                float xf[8]; unpack8(xw, xf);
#pragma unroll
                for (int e = 0; e < 8; ++e) ss[b] += xf[e] * xf[e];
                xh[b] = __builtin_bit_cast(bf16x8, xw);
            }
#pragma unroll
            for (int nb = 0; nb < 3; ++nb) {
                const bf16x8 wH = *(const bf16x8*)(whr + (size_t)nb * 16 * DM + ks * 32), wL = *(const bf16x8*)(wlr + (size_t)nb * 16 * DM + ks * 32);
#pragma unroll
                for (int b = 0; b < 2; ++b) {
                    acc[b][nb] = __builtin_amdgcn_mfma_f32_16x16x32_bf16(wH, xh[b], acc[b][nb], 0, 0, 0);
                    acc[b][nb] = __builtin_amdgcn_mfma_f32_16x16x32_bf16(wL, xh[b], acc[b][nb], 0, 0, 0);
                }
            }
        }
#pragma unroll
        for (int b = 0; b < 2; ++b) {
            float sv = ss[b]; sv += shflx(sv, lane, 16); sv += shflx(sv, lane, 32);
            const int tl = th * 32 + 16 * b + fr;
#pragma unroll
            for (int nb = 0; nb < 3; ++nb) *(LAS f32x4*)(part + (kq * 64 + tl) * 52 + 16 * nb + 4 * fq) = acc[b][nb];
            if (fq == 0) ssq[kq * 64 + tl] = sv;
        }
        if (tid < 32) lcnt[tid] = 0;
        __syncthreads();
        int ea = 0, eb = 0, la = 0, lb = 0; float w1 = 0.f, w2 = 0.f, rs = 0.f;
        if (tid < 64) {
            rs = rsqrtf(((ssq[tid] + ssq[64 + tid]) + (ssq[128 + tid] + ssq[192 + tid])) * (1.0f / DM) + EPS);
            float lg[36];
#pragma unroll
            for (int q = 0; q < 9; ++q) {
                const f32x4 u0 = *(const LAS f32x4*)(part + tid * 52 + 4 * q), u1 = *(const LAS f32x4*)(part + (64 + tid) * 52 + 4 * q);
                const f32x4 u2 = *(const LAS f32x4*)(part + (128 + tid) * 52 + 4 * q), u3 = *(const LAS f32x4*)(part + (192 + tid) * 52 + 4 * q);
#pragma unroll
                for (int e = 0; e < 4; ++e) lg[4 * q + e] = ((u0[e] + u1[e]) + (u2[e] + u3[e])) * rs;
            }
            float gl[4];
#pragma unroll
            for (int n = 0; n < 4; ++n) gl[n] = lg[n] + bg[n];
            int g = 0; float gm = gl[0];
#pragma unroll
            for (int n = 1; n < 4; ++n) if (gl[n] > gm) { gm = gl[n]; g = n; }
            float den = 0.f;
#pragma unroll
            for (int n = 0; n < 4; ++n) den += __expf(gl[n] - gm);
            const float gprob = 1.0f / den;
            float el[8];
#pragma unroll
            for (int n = 0; n < 8; ++n) {
                float v = 0.f;
#pragma unroll
                for (int gg = 0; gg < 4; ++gg) v = (g == gg) ? lg[4 + 8 * gg + n] + br[8 * gg + n] : v;
                el[n] = v;
            }
            int e1 = 0; float m1 = el[0];
#pragma unroll
            for (int n = 1; n < 8; ++n) if (el[n] > m1) { m1 = el[n]; e1 = n; }
            int e2 = -1; float m2 = -3.0e38f;
#pragma unroll
            for (int n = 0; n < 8; ++n) if (n != e1 && (e2 < 0 || el[n] > m2)) { m2 = el[n]; e2 = n; }
            const float ex = __expf(m2 - m1);
            w1 = gprob / (1.0f + ex); w2 = gprob * ex / (1.0f + ex);
            ea = 8 * g + e1; eb = 8 * g + e2;
            la = __hip_atomic_fetch_add(lcnt + ea, 1, __ATOMIC_RELAXED, __HIP_MEMORY_SCOPE_WORKGROUP);
            lb = __hip_atomic_fetch_add(lcnt + eb, 1, __ATOMIC_RELAXED, __HIP_MEMORY_SCOPE_WORKGROUP);
        }
        __syncthreads();
        if (tid < 32) { const int c = lcnt[tid]; gb[tid] = c ? (int)atomicAdd(&cnt[tid], (unsigned)c) : 0; }
        __syncthreads();
        if (tid < 64) {
            const int tt = chunk * 64 + tid;
            Entry A; A.dst = tt; A.rstd = rs; A.w = w1; A.tok = tt;
            Entry B; B.dst = T + tt; B.rstd = rs; B.w = w2; B.tok = tt;
            list[(size_t)ea * LIST_CAP + gb[ea] + la] = A;
            list[(size_t)eb * LIST_CAP + gb[eb] + lb] = B;
        }
        __syncthreads();
    }
}

constexpr int MOE_MAXU = 4;
constexpr int LDS_ROWTAB = STAGE_BYTES;
constexpr int LDS_EPITAB = LDS_ROWTAB + MOE_MAXU * 1024;
constexpr int LDS_UTAB = LDS_EPITAB + MOE_MAXU * 2048;
constexpr int LDS_XBW = LDS_UTAB + MOE_MAXU * 32;
constexpr int LDS_BYTES = 147456;
static_assert(LDS_XBW + 32 <= LDS_BYTES, "LDS map");
struct SchedMoe {
    LAS unsigned char* lds; const bf16_t* A; const bf16_t* W; bool gather; size_t w_estride; int w_pnrows, ldb;
    DI void build(const unsigned* cnt, const Entry* list, int npn, int lo, int hi, int first, int stride, int tid) {
        LAS int* ut = (LAS int*)(lds + LDS_UTAB); LAS unsigned* rt = (LAS unsigned*)(lds + LDS_ROWTAB);
        const int lane = tid & 63;
        if (tid < 64) {
            const int c = (int)cnt[lane & 31], ntl = (c + 255) >> 8;
            int inc = ntl;
#pragma unroll
            for (int d = 1; d < 32; d <<= 1) { const int v = __builtin_amdgcn_ds_bpermute(((lane - d) & 63) << 2, inc); if ((lane & 31) >= d) inc += v; }
            const int exc = inc - ntl;
#pragma unroll
            for (int i = 0; i < MOE_MAXU; ++i) {
                const int L = lo + first + i * stride, rtile = L / npn, pn = L % npn;
                const bool hit = (first >= 0) && (L < hi) && (lane < 32) && (rtile >= exc) && (rtile < inc);
                const unsigned long long mask = __ballot(hit);
                int found = 0, e = 0, j = 0, nv = 0;
                if (mask) {
                    found = 1; e = __builtin_ctzll(mask);
                    j = rtile - __builtin_amdgcn_readlane(exc, e); nv = __builtin_amdgcn_readlane(c, e) - 256 * j; nv = nv > 256 ? 256 : nv;
                }
                if (lane == 0) { ut[i * 8 + 0] = found; ut[i * 8 + 1] = e; ut[i * 8 + 2] = nv; ut[i * 8 + 3] = 256 * rtile; ut[i * 8 + 4] = e * LIST_CAP + 256 * j; ut[i * 8 + 5] = pn; }
            }
        }
        __syncthreads();
        if (tid < 256) {
#pragma unroll
            for (int i = 0; i < MOE_MAXU; ++i) {
                if (!ut[i * 8]) continue;
                const int nv = ut[i * 8 + 2], lb = ut[i * 8 + 4];
                Entry en; en.dst = DUMMY_ROW; en.rstd = 0.f; en.w = 0.f; en.tok = 0;
                if (tid < nv) en = list[lb + tid];
                LAS float* et = (LAS float*)(lds + LDS_EPITAB) + (i * 256 + tid) * 2;
                if (gather) { rt[i * 256 + tid] = (unsigned)en.tok; et[0] = en.rstd; et[1] = en.w; }
                else { et[0] = __int_as_float(en.dst); et[1] = 0.f; }
            }
        }
        asm volatile("s_waitcnt vmcnt(0) lgkmcnt(0)" ::: "memory");
        __syncthreads();
    }
    DI bool next(int i, Unit& u) const {
        if (i >= MOE_MAXU) return false;
        const LAS int* ut = (const LAS int*)(lds + LDS_UTAB) + i * 8;
        const int found = __builtin_amdgcn_readfirstlane(ut[0]);
        if (!found) return false;
        u.e = __builtin_amdgcn_readfirstlane(ut[1]); u.nvalid = __builtin_amdgcn_readfirstlane(ut[2]); u.row0 = __builtin_amdgcn_readfirstlane(ut[3]);
        u.lbase = i * 256; u.pn = __builtin_amdgcn_readfirstlane(ut[5]); u.pm = u.row0 >> 8;
        u.A = gather ? A : A + (size_t)u.row0 * DE;
        u.B = W + (size_t)u.e * w_estride + (size_t)u.pn * w_pnrows * ldb;
        return true;
    }
    DI int arow(int ui, const Unit&, int r) const { if (!gather) return r; return (int)((const LAS unsigned*)(lds + LDS_ROWTAB))[ui * 256 + r]; }
};
struct EpiGU {
    bf16_t* hid; LAS unsigned char* lds;
    DI void operator()(const f32x4 (&acc)[2][2][4][2], const Unit& u, int wr, int wc, int fr, int fq) const {
        typedef float f32x2 __attribute__((ext_vector_type(2)));
#pragma unroll
        for (int ai = 0; ai < 2; ++ai)
#pragma unroll
            for (int m = 0; m < 4; ++m) {
                const int r = 128 * ai + 64 * wr + 16 * m + fr;
                const f32x2 rw = *(const LAS f32x2*)(lds + LDS_EPITAB + (u.lbase + r) * 8);
                const float rs = rw[0], w = rw[1];
                unsigned pk[4];
#pragma unroll
                for (int n = 0; n < 2; ++n) {
                    float hv[4];
#pragma unroll
                    for (int e = 0; e < 4; ++e) { const float g = acc[ai][0][m][n][e] * rs, up = acc[ai][1][m][n][e] * rs; hv[e] = g * __builtin_amdgcn_rcpf(1.0f + __builtin_amdgcn_exp2f(-1.4426950408889634f * g)) * up * w; }
                    pk[2 * n] = cvt_pk_bf16(hv[0], hv[1]); pk[2 * n + 1] = cvt_pk_bf16(hv[2], hv[3]);
                }
                u32x4 wv; wv[0] = pk[0]; wv[1] = pk[1]; wv[2] = pk[2]; wv[3] = pk[3];
                *(u32x4*)(hid + (size_t)(u.row0 + r) * DE + 128 * u.pn + 32 * wc + 8 * fq) = wv;
            }
    }
};
struct EpiDown {
    bf16_t* yb; LAS unsigned char* lds;
    DI void operator()(const f32x4 (&acc)[2][2][4][2], const Unit& u, int wr, int wc, int fr, int fq) const {
#pragma unroll
        for (int ai = 0; ai < 2; ++ai)
#pragma unroll
            for (int m = 0; m < 4; ++m) {
                const int r = 128 * ai + 64 * wr + 16 * m + fr;
                const int dst = *(const LAS int*)(lds + LDS_EPITAB + (u.lbase + r) * 8);
                if (dst == DUMMY_ROW) continue;
#pragma unroll
                for (int bj = 0; bj < 2; ++bj) {
                    const f32x4 a = acc[ai][bj][m][0], b = acc[ai][bj][m][1];
                    u32x4 w; w[0] = cvt_pk_bf16(a[0], a[1]); w[1] = cvt_pk_bf16(a[2], a[3]); w[2] = cvt_pk_bf16(b[0], b[1]); w[3] = cvt_pk_bf16(b[2], b[3]);
                    *(u32x4*)(yb + (size_t)dst * DM + 256 * u.pn + 128 * bj + 32 * wc + 8 * fq) = w;
                }
            }
    }
};

DI void ph_poolgemm(LAS unsigned char* lds, int j) {
    LOAD_PARAMS();
    SchedPool S; S.bid = xbid_(); S.diff = (const bf16_t*)(p.ws + WS_DIFF); S.w = (const bf16_t*)(p.ws + WS_WPOOL) + (size_t)j * 4 * 65536;
    EpiPool E; E.x = (bf16_t*)(p.ws + WS_XB); E.pb = p.pool_b + j * DM; E.ps = p.pool_scale + j * DM;
    gemm_phase<GCfg<1024, 256, 256, 128, false>>(lds, S, E);
}
DI void ph_qkv(LAS unsigned char* lds, int j) {
    LOAD_PARAMS();
    SchedDense S; S.bid = xbid_(); S.A = (const bf16_t*)(p.ws + WS_XB1); S.B = (const bf16_t*)(p.ws + WS_WQKV) + (size_t)j * 3072 * 1024; S.npn = 12; S.ldb = 1024;
    EpiQKV E; E.q = (bf16_t*)(p.ws + WS_Q); E.rstd = (const float*)(p.ws + WS_RSTD); E.qg = p.sb_qg + j * HD; E.kg = p.sb_kg + j * HD;
    gemm_phase<GCfg<1024, 1024, 1024, 32, true>>(lds, S, E);
}
DI void ph_wo(LAS unsigned char* lds, int j) {
    LOAD_PARAMS();
    SchedDense S; S.bid = xbid_(); S.A = (const bf16_t*)(p.ws + WS_O); S.B = (const bf16_t*)(p.ws + WS_WO) + (size_t)j * 1024 * 1024; S.npn = 4; S.ldb = 1024;
    EpiWo E; E.x = (bf16_t*)(p.ws + WS_XB1);
    gemm_phase<GCfg<1024, 1024, 1024, 128, false>>(lds, S, E);
}
struct MoePlan { int NT, R1, nB, D1; };
DI MoePlan moe_plan(const unsigned* cnt) {
    const int lane = tid_() & 63;
    int nt = ((int)cnt[lane & 31] + 255) >> 8;
#pragma unroll
    for (int o = 1; o < 32; o <<= 1) nt += __builtin_amdgcn_ds_bpermute((lane ^ o) << 2, nt);
    nt = __builtin_amdgcn_readfirstlane(nt);
    MoePlan m; m.NT = nt; const int G = gridDim.x; m.R1 = nt < G / 2 ? nt : G / 2;
    const int late = 2 * (nt - m.R1); m.nB = late < G ? late : G;
    const int cap = 2 * (G - m.nB); m.D1 = 4 * m.R1 < cap ? 4 * m.R1 : cap;
    return m;
}
DI void ph_gu(LAS unsigned char* lds, int li, int stage, const MoePlan m) {
    LOAD_PARAMS();
    const Entry* list = (const Entry*)(p.ws + WS_LIST);
    const unsigned* cnt = (const unsigned*)(p.ws + WS_CTL) + CW_CNT + 32 * li;
    const int bid = xbid_();
    if (stage == 2 || (stage == 1 && bid >= m.nB)) return;
    SchedMoe S; S.lds = lds; S.A = (const bf16_t*)(p.ws + ((li & 1) ? WS_XB1 : WS_XB));
    S.W = (const bf16_t*)(p.ws + WS_WGU) + (size_t)li * NE * 512 * 1024; S.gather = true; S.w_estride = (size_t)512 * 1024; S.w_pnrows = 128; S.ldb = 1024;
    const int lo = stage == 0 ? 0 : 2 * m.R1, hi = stage == 0 ? 2 * m.R1 : 2 * m.NT, G = gridDim.x;
    EpiGU E; E.hid = (bf16_t*)(p.ws + WS_HID); E.lds = lds;
    for (int first = bid; lo + first < hi; first += MOE_MAXU * G) {
        S.build(cnt, list, 2, lo, hi, first, G, tid_());
        gemm_phase<GCfg<1024, 1024, 1024, 256, false>>(lds, S, E);
        __syncthreads();
    }
}
DI void ph_down(LAS unsigned char* lds, int li, int stage, const MoePlan m) {
    LOAD_PARAMS();
    const Entry* list = (const Entry*)(p.ws + WS_LIST);
    const unsigned* cnt = (const unsigned*)(p.ws + WS_CTL) + CW_CNT + 32 * li;
    const int bid = xbid_(), G = gridDim.x;
    if (stage == 0 || (stage == 1 && bid < m.nB)) return;
    SchedMoe S; S.lds = lds; S.A = (const bf16_t*)(p.ws + WS_HID);
    S.W = (const bf16_t*)(p.ws + WS_WD) + (size_t)li * NE * 1024 * 256; S.gather = false; S.w_estride = (size_t)1024 * 256; S.w_pnrows = 256; S.ldb = 256;
    const int lo = stage == 1 ? 0 : m.D1, hi = stage == 1 ? m.D1 : 4 * m.NT, stride = stage == 1 ? G - m.nB : G;
    EpiDown E; E.yb = (bf16_t*)(p.ws + WS_YBUF); E.lds = lds;
    for (int first = stage == 1 ? bid - m.nB : bid; lo + first < hi; first += MOE_MAXU * stride) {
        S.build(cnt, list, 4, lo, hi, first, stride, tid_());
        gemm_phase<GCfg<256, 256, 256, 128, false>>(lds, S, E);
        __syncthreads();
    }
}
DI MoePlan moe_layer_plan(int li) {
    LOAD_PARAMS();
    return moe_plan((const unsigned*)(p.ws + WS_CTL) + CW_CNT + 32 * li);
}

#define XB_TMO      128
#define XB_XCNT(j)  (256  + 64 * (j))
#define XB_XSUB(j)  (1280 + 64 * (j))
#define XB_XGEN(j)  (2304 + 64 * (j))
#define XB_TOP      3328
#define XB_TOPGEN   3392
#define XCD_BAR_WORDS 3456
#define XB_SPIN_CAP (1u << 18)

__device__ __forceinline__ unsigned xb_ld(unsigned* p)              { return __hip_atomic_load(p, __ATOMIC_RELAXED, __HIP_MEMORY_SCOPE_AGENT); }
__device__ __forceinline__ unsigned xb_add(unsigned* p, unsigned v) { return __hip_atomic_fetch_add(p, v, __ATOMIC_RELAXED, __HIP_MEMORY_SCOPE_AGENT); }
__device__ __forceinline__ unsigned xb_xcc_id() { return (unsigned)__builtin_amdgcn_s_getreg((3 << 11) | 20) & 0xFu; }
#define XB_SPIN(cond, bar) do { unsigned _sp = 0; while (cond) { __builtin_amdgcn_s_sleep(1); \
    if ((++_sp & 255u) == 0u) { if (xb_ld(&(bar)[XB_TMO])) break; if (_sp > XB_SPIN_CAP) { atomicAdd(&(bar)[XB_TMO], 1u); break; } } } } while (0)

struct XcdBarrier {
    unsigned* bar; unsigned x;
    volatile LAS unsigned* st;
};

__device__ __forceinline__ XcdBarrier xcd_barrier_post(unsigned* bar, volatile LAS unsigned* st) {
    XcdBarrier b; b.bar = bar; b.x = xb_xcc_id(); b.st = st;
    if (threadIdx.x == 0) (void)xb_add(&bar[XB_XCNT(b.x)], 1u);
    return b;
}
__device__ __forceinline__ void xcd_barrier_complete(unsigned* bar, unsigned x, unsigned& nloc, unsigned& nx) {
    const unsigned G = gridDim.x * gridDim.y * gridDim.z;
    unsigned sum, cnt, mine, sp = 0u;
    for (;;) {
        sum = 0u; cnt = 0u; mine = 0u;
#pragma unroll
        for (unsigned j = 0; j < 16; ++j) { const unsigned c = xb_ld(&bar[XB_XCNT(j)]); sum += c; cnt += (c > 0u) ? 1u : 0u; mine = (j == x) ? c : mine; }
        if (sum == G) break;
        __builtin_amdgcn_s_sleep(1);
        if ((++sp & 255u) == 0u) { if (xb_ld(&bar[XB_TMO])) break; if (sp > XB_SPIN_CAP) { atomicAdd(&bar[XB_TMO], 1u); break; } }
    }
    nloc = mine > 0u ? mine : 1u; nx = cnt > 0u ? cnt : 1u;
}

__device__ __forceinline__ void xcd_barrier(const XcdBarrier& b) {
    asm volatile("s_waitcnt vmcnt(0)" ::: "memory");
    __syncthreads();
    if (threadIdx.x == 0) {
        unsigned* bar = b.bar; unsigned bx = b.x;
        asm volatile("" : "+s"(bar), "+s"(bx));
        __builtin_amdgcn_s_waitcnt(0);
        unsigned nloc = b.st[0], nx = b.st[1];
        if (nloc == 0u) { xcd_barrier_complete(bar, bx, nloc, nx); b.st[0] = nloc; b.st[1] = nx; }
        const unsigned old = xb_add(&bar[XB_XSUB(bx)], 1u);
        const unsigned gen = old / nloc;
        if (old + 1u == (gen + 1u) * nloc) {
            __builtin_amdgcn_fence(__ATOMIC_RELEASE, "agent");
            asm volatile("s_waitcnt vmcnt(0)" ::: "memory");
            const unsigned og = xb_add(&bar[XB_TOP], 1u);
            const unsigned tg = og / nx;
            if (og + 1u == (tg + 1u) * nx) xb_add(&bar[XB_TOPGEN], 1u);
            else XB_SPIN(xb_ld(&bar[XB_TOPGEN]) == tg, bar);
            __builtin_amdgcn_fence(__ATOMIC_ACQUIRE, "agent");
            xb_add(&bar[XB_XGEN(bx)], 1u);
            asm volatile("s_waitcnt vmcnt(0)" ::: "memory");
        } else {
            XB_SPIN(xb_ld(&bar[XB_XGEN(bx)]) == gen, bar);
            __builtin_amdgcn_fence(__ATOMIC_ACQUIRE, "agent");
            asm volatile("s_waitcnt vmcnt(0)" ::: "memory");
        }
    }
    __syncthreads();
}
constexpr int CW_BAR = 4096;

DI int cvt_claim(LAS unsigned char* smem, unsigned* ctl, int n, int tid) {
    volatile LAS unsigned* st = (volatile LAS unsigned*)(smem + LDS_XBW);
    if (tid == 0) { const unsigned d = xb_add(ctl + CW_CVT, (unsigned)n); st[4] = d; st[5] = d + (unsigned)n; }
    __syncthreads();
    const int d = (int)st[4];
    __syncthreads();
    return __builtin_amdgcn_readfirstlane(d);
}
DI void cvt_work(LAS unsigned char* smem, int n) {
    volatile LAS unsigned* st = (volatile LAS unsigned*)(smem + LDS_XBW);
    if (st[5] >= (unsigned)CVT_DTOTAL) return;
    LOAD_PARAMS();
    const int tid = tid_();
    const int d = cvt_claim(smem, (unsigned*)(p.ws + WS_CTL), n, tid);
    if (d < CVT_DTOTAL) cvt_run(smem, p, 1, d, (d + n < CVT_DTOTAL) ? d + n : CVT_DTOTAL, 0, 1, tid);
}
DI void cvt_require(LAS unsigned char* smem, int req) {
    volatile LAS unsigned* st = (volatile LAS unsigned*)(smem + LDS_XBW);
    __syncthreads();
    if (st[5] >= (unsigned)req) return;
    LOAD_PARAMS();
    unsigned* ctl = (unsigned*)(p.ws + WS_CTL);
    const int tid = tid_();
    for (;;) {
        __syncthreads();
        if (tid == 0) { const unsigned c = xb_ld(ctl + CW_CVT); if (c > st[5]) st[5] = c; }
        __syncthreads();
        if (st[5] >= (unsigned)req) break;
        const int d = cvt_claim(smem, ctl, 2, tid);
        if (d < CVT_DTOTAL) cvt_run(smem, p, 1, d, (d + 2 < CVT_DTOTAL) ? d + 2 : CVT_DTOTAL, 0, 1, tid);
    }
}
__device__ __forceinline__ void grid_sync(const XcdBarrier& b, LAS unsigned char* smem, int req) {
    if (req > 0) cvt_require(smem, req);
    asm volatile("s_waitcnt vmcnt(0)" ::: "memory");
    __syncthreads();
    if (threadIdx.x == 0) {
        unsigned* bar = b.bar; unsigned bx = b.x;
        asm volatile("" : "+s"(bar), "+s"(bx));
        __builtin_amdgcn_s_waitcnt(0);
        unsigned nloc = b.st[0], nx = b.st[1];
        if (nloc == 0u) { xcd_barrier_complete(bar, bx, nloc, nx); b.st[0] = nloc; b.st[1] = nx; }
        const unsigned old = xb_add(&bar[XB_XSUB(bx)], 1u);
        const unsigned gen = old / nloc;
        unsigned role;
        if (old + 1u == (gen + 1u) * nloc) {
            __builtin_amdgcn_fence(__ATOMIC_RELEASE, "agent");
            asm volatile("s_waitcnt vmcnt(0)" ::: "memory");
            const unsigned og = xb_add(&bar[XB_TOP], 1u);
            const unsigned tg = og / nx;
            if (og + 1u == (tg + 1u) * nx) xb_add(&bar[XB_TOPGEN], 1u);
            else XB_SPIN(xb_ld(&bar[XB_TOPGEN]) == tg, bar);
            __builtin_amdgcn_fence(__ATOMIC_ACQUIRE, "agent");
            xb_add(&bar[XB_XGEN(bx)], 1u);
            asm volatile("s_waitcnt vmcnt(0)" ::: "memory");
            role = 2u;
        } else role = ((old - gen * nloc) < nloc / 2u) ? 1u : 0u;
        b.st[2] = role; b.st[3] = gen;
    }
    __syncthreads();
    const unsigned role = b.st[2];
    if (role == 1u) cvt_work(smem, 2);
    if (threadIdx.x == 0 && role != 2u) {
        unsigned* bar = b.bar; unsigned bx = b.x;
        asm volatile("" : "+s"(bar), "+s"(bx));
        const unsigned gen = b.st[3];
        XB_SPIN(xb_ld(&bar[XB_XGEN(bx)]) == gen, bar);
        __builtin_amdgcn_fence(__ATOMIC_ACQUIRE, "agent");
        asm volatile("s_waitcnt vmcnt(0)" ::: "memory");
    }
    __syncthreads();
}

extern __shared__ __attribute__((aligned(16))) unsigned char smem_raw[];
__global__ void __launch_bounds__(NTHR, 2) fwd(Params pk) {
    LAS unsigned char* smem = (LAS unsigned char*)smem_raw;
    if (threadIdx.x < 8) ((LAS unsigned*)(smem + LDS_XBW))[threadIdx.x] = 0u;
    __syncthreads();
    XcdBarrier bar;
    { LOAD_PARAMS(); bar = xcd_barrier_post((unsigned*)(p.ws + WS_CTL) + CW_BAR, (volatile LAS unsigned*)(smem + LDS_XBW)); }
    ph_prologue(smem);
    __syncthreads();
    for (int i = 0; i < DEPTH; ++i) {
        const int j = i >> 1;
        if ((i & 1) == 0) {
            ph_poolfuse(smem, j, i == 0);
            grid_sync(bar, smem, 0);
            ph_poolgemm(smem, j);
            grid_sync(bar, smem, 0);
        } else {
            ph_combine<false>(0);
            grid_sync(bar, smem, i == 1 ? CVT_E1 : CVT_E4);
            ph_qkv(smem, j);
            grid_sync(bar, smem, 0);
            ph_attn(smem);
            grid_sync(bar, smem, 0);
            ph_wo(smem, j);
            grid_sync(bar, smem, 0);
        }
        ph_router(smem, i);
        grid_sync(bar, smem, i == 0 ? CVT_E0 : (i == 1 ? CVT_E2 : (i == 2 ? CVT_E3 : CVT_E5)));
        const MoePlan mp = moe_layer_plan(i);
        for (int st = 0; st < 3; ++st) {
            const int ns2 = 4 * mp.NT - mp.D1;
            if (st == 2 && ns2 <= 0 && i == DEPTH - 1) break;
            ph_gu(smem, i, st, mp);
            ph_down(smem, i, st, mp);
            if (st == 1 && xbid_() >= mp.nB) cvt_work(smem, 1);
            if (st == 2 && xbid_() >= ns2) cvt_work(smem, 3);
            grid_sync(bar, smem, 0);
        }
    }
    ph_combine<true>(1);
}

extern "C" void kernel_launch(void* const* d_in, const int* in_sizes, int n_in, void* d_out, int out_size, void* d_ws, size_t ws_size, hipStream_t stream) {
    if (ws_size < WS_NEED || n_in < 18) return;
    Params p{};
    p.x_in = (const float*)d_in[0]; p.pool_norm = (const float*)d_in[1]; p.pool_w = (const float*)d_in[2]; p.pool_b = (const float*)d_in[3]; p.pool_scale = (const float*)d_in[4];
    p.sb_norm = (const float*)d_in[5]; p.sb_wqkv = (const float*)d_in[6]; p.sb_qg = (const float*)d_in[7]; p.sb_kg = (const float*)d_in[8]; p.sb_wo = (const float*)d_in[9];
    p.moe_norm = (const float*)d_in[10]; p.moe_wg = (const float*)d_in[11]; p.moe_bg = (const float*)d_in[12]; p.moe_wr = (const float*)d_in[13]; p.moe_br = (const float*)d_in[14];
    p.moe_wgate = (const float*)d_in[15]; p.moe_wup = (const float*)d_in[16]; p.moe_wdown = (const float*)d_in[17];
    p.x = (float*)d_out; p.ws = (unsigned char*)d_ws;
    static int grid = 0;
    if (!grid) {
        int dev = 0, cus = 0, per_cu = 0;
        if (hipGetDevice(&dev) != hipSuccess || hipDeviceGetAttribute(&cus, hipDeviceAttributeMultiprocessorCount, dev) != hipSuccess) { grid = -1; return; }
        if (hipFuncSetAttribute((const void*)fwd, hipFuncAttributeMaxDynamicSharedMemorySize, LDS_BYTES) != hipSuccess) { grid = -1; return; }
        if (hipOccupancyMaxActiveBlocksPerMultiprocessor(&per_cu, (const void*)fwd, NTHR, LDS_BYTES) != hipSuccess || per_cu < 1) { (void)hipGetLastError(); }
        grid = cus;
    }
    if (grid <= 0) return;
    (void)hipMemsetAsync((char*)d_ws + WS_CTL, 0, CTL_BYTES, stream);
    hipLaunchKernelGGL(fwd, dim3(grid), dim3(NTHR), LDS_BYTES, stream, p);
}
```

```cpp
#include <hip/hip_runtime.h>
#include <stdint.h>

#define DI __device__ __forceinline__
#define LAS __attribute__((address_space(3)))
typedef unsigned short bf16_t;
typedef short bf16x8 __attribute__((ext_vector_type(8)));
typedef float f32x4 __attribute__((ext_vector_type(4)));
typedef float f32x16 __attribute__((ext_vector_type(16)));
typedef unsigned u32x4 __attribute__((ext_vector_type(4)));
typedef unsigned u32x2 __attribute__((ext_vector_type(2)));

constexpr int T = 16384, DM = 1024, SEQ = 8192, NH = 16, HD = 64, DEPTH = 4, NE = 32, DE = 256;
constexpr float EPS = 1e-6f;
constexpr int NTHR = 512, NWAVE = 8;
constexpr int LIST_CAP = 16384;
constexpr int DUMMY_ROW = 2 * T;

constexpr size_t MiB = 1u << 20;
constexpr size_t WS_CTL = 0, CTL_BYTES = 1 * MiB;
constexpr size_t WS_WQKV = 1 * MiB;
constexpr size_t WS_WO = 13 * MiB;
constexpr size_t WS_WPOOL = 17 * MiB;
constexpr size_t WS_RSTD = 18 * MiB;
constexpr size_t WS_WRH = 19 * MiB, WS_WRL = WS_WRH + 512 * 1024;
constexpr size_t WS_WGU = 20 * MiB;
constexpr size_t WS_WD = 148 * MiB;
constexpr size_t WS_XB = 212 * MiB;
constexpr size_t WS_XB1 = 384 * MiB;
constexpr size_t WS_NEED = 416 * MiB;
constexpr size_t WS_LIST = 244 * MiB;
constexpr size_t WS_Q = 256 * MiB;
constexpr size_t WS_DIFF = WS_Q;
constexpr size_t WS_K = 288 * MiB, WS_V = 320 * MiB, WS_O = 352 * MiB;
constexpr size_t WS_YBUF = 288 * MiB;
constexpr size_t WS_HID = 354 * MiB;
constexpr size_t WS_END = 384 * MiB;
static_assert(WS_V - WS_K == WS_K - WS_Q, "Q, K, V equally spaced");
static_assert(WS_YBUF + (size_t)(2 * T + 1) * DM * 2 <= WS_HID, "ybuf");
static_assert(WS_HID + (size_t)(2 * T + NE * 256) * DE * 2 <= WS_END, "hid");
constexpr int CW_CNT = 1024;

struct Entry { int dst; float rstd; float w; int tok; };

struct Params {
    const float* x_in; const float* pool_norm; const float* pool_w; const float* pool_b; const float* pool_scale;
    const float* sb_norm; const float* sb_wqkv; const float* sb_qg; const float* sb_kg; const float* sb_wo;
    const float* moe_norm; const float* moe_wg; const float* moe_bg; const float* moe_wr; const float* moe_br;
    const float* moe_wgate; const float* moe_wup; const float* moe_wdown;
    float* x;
    unsigned char* ws;
};

typedef const unsigned long long __attribute__((address_space(4)))* KArgPtr;
#define GP(T, i) ((T*)(T __attribute__((address_space(1)))*)q[i])
DI Params load_params() {
    KArgPtr q = (KArgPtr)__builtin_amdgcn_kernarg_segment_ptr(); asm volatile("" : "+s"(q));
    Params p;
    p.x_in = GP(const float, 0); p.pool_norm = GP(const float, 1); p.pool_w = GP(const float, 2); p.pool_b = GP(const float, 3); p.pool_scale = GP(const float, 4);
    p.sb_norm = GP(const float, 5); p.sb_wqkv = GP(const float, 6); p.sb_qg = GP(const float, 7); p.sb_kg = GP(const float, 8); p.sb_wo = GP(const float, 9);
    p.moe_norm = GP(const float, 10); p.moe_wg = GP(const float, 11); p.moe_bg = GP(const float, 12); p.moe_wr = GP(const float, 13); p.moe_br = GP(const float, 14);
    p.moe_wgate = GP(const float, 15); p.moe_wup = GP(const float, 16); p.moe_wdown = GP(const float, 17);
    p.x = GP(float, 18); p.ws = GP(unsigned char, 19);
    return p;
}
#define LOAD_PARAMS() const Params p = load_params()
DI int tid_() { int t = threadIdx.x; asm volatile("" : "+v"(t)); return t; }
DI int bid_() { int b = blockIdx.x; asm volatile("" : "+s"(b)); return b; }
DI int xbid_() { const int b = bid_(), G = gridDim.x; return (G % 8 == 0) ? (b % 8) * (G / 8) + b / 8 : b; }

DI unsigned cvt_pk_bf16(float lo, float hi) { unsigned r; asm volatile("v_cvt_pk_bf16_f32 %0, %1, %2" : "=v"(r) : "v"(lo), "v"(hi)); return r; }
DI float bf_lo(unsigned u) { return __uint_as_float(u << 16); }
DI float bf_hi(unsigned u) { return __uint_as_float(u & 0xffff0000u); }
DI float shflx(float v, int lane, int m) { return __int_as_float(__builtin_amdgcn_ds_bpermute((lane ^ m) << 2, __float_as_int(v))); }
DI float wave_sum(float v, int lane) {
#pragma unroll
    for (int o = 32; o >= 1; o >>= 1) v += shflx(v, lane, o);
    return v;
}
DI int perm32(int rho) { const int n = rho >> 4, i = rho & 15; return 8 * (i >> 2) + 4 * n + (i & 3); }

struct CvtTile { const float* src; bf16_t* dst; const float* scale; int K, N; };
DI CvtTile cvt_locate(const Params& p, int g) {
    int K, N, sdiv = 1; const float* sb; bf16_t* db; const float* scb = nullptr; size_t sms, dms;
    if (g < 384) { K = 1024; N = 3072; sb = p.sb_wqkv; db = (bf16_t*)(p.ws + WS_WQKV); scb = p.sb_norm; sms = (size_t)1024 * 3072; dms = sms; }
    else if ((g -= 384) < 128) { K = 1024; N = 1024; sb = p.sb_wo; db = (bf16_t*)(p.ws + WS_WO); sms = (size_t)1024 * 1024; dms = sms; }
    else if ((g -= 128) < 32) { K = 256; N = 256; sb = p.pool_w; db = (bf16_t*)(p.ws + WS_WPOOL); sms = 65536; dms = 65536; }
    else if ((g -= 32) < 2048) { K = 1024; N = 256; sb = p.moe_wgate; db = (bf16_t*)(p.ws + WS_WGU); scb = p.moe_norm; sdiv = 32; sms = (size_t)1024 * 256; dms = (size_t)512 * 1024; }
    else if ((g -= 2048) < 2048) { K = 1024; N = 256; sb = p.moe_wup; db = (bf16_t*)(p.ws + WS_WGU) + (size_t)256 * 1024; scb = p.moe_norm; sdiv = 32; sms = (size_t)1024 * 256; dms = (size_t)512 * 1024; }
    else { g -= 2048; K = 256; N = 1024; sb = p.moe_wdown; db = (bf16_t*)(p.ws + WS_WD); sms = (size_t)256 * 1024; dms = sms; }
    const int tn = N / 256, per = (K / 64) * tn, mat = g / per, rem = g % per, k0 = (rem / tn) * 64, n0 = (rem % tn) * 256;
    CvtTile t; t.K = K; t.N = N;
    t.src = sb + (size_t)mat * sms + (size_t)k0 * N + n0;
    t.dst = db + (size_t)mat * dms + (size_t)n0 * K + k0;
    t.scale = scb ? scb + (size_t)(mat / sdiv) * K + k0 : nullptr;
    return t;
}
constexpr int CVT_TILES = 384 + 128 + 32 + 2048 + 2048 + 2048;
constexpr int CVT_NONMOE = 384 + 128 + 32, CVT_L0PRO = 1088;
constexpr int CVT_PRO = 32 + CVT_L0PRO;
constexpr int CVT_E0 = 1536 - CVT_L0PRO, CVT_E1 = CVT_E0 + 192 + 64, CVT_E2 = CVT_E1 + 1536, CVT_E3 = CVT_E2 + 1536, CVT_E4 = CVT_E3 + 192 + 64, CVT_E5 = CVT_E4 + 1536;
constexpr int CVT_DTOTAL = CVT_E5;
constexpr int CW_CVT = 512;
DI int cvt_moe_tile(int L, int u) { return CVT_NONMOE + (u / 512) * 2048 + 512 * L + (u % 512); }
DI int cvt_map(int mode, int q) {
    if (mode == 0) return q < 32 ? 512 + q : cvt_moe_tile(0, q - 32);
    if (q < CVT_E0) return cvt_moe_tile(0, CVT_L0PRO + q);
    if (q < CVT_E0 + 192) return q - CVT_E0;
    if (q < CVT_E1) return 384 + (q - CVT_E0 - 192);
    if (q < CVT_E2) return cvt_moe_tile(1, q - CVT_E1);
    if (q < CVT_E3) return cvt_moe_tile(2, q - CVT_E2);
    if (q < CVT_E3 + 192) return 192 + (q - CVT_E3);
    if (q < CVT_E4) return 448 + (q - CVT_E3 - 192);
    return cvt_moe_tile(3, q - CVT_E4);
}
DI void cvt_run(LAS unsigned char* ldsb, const Params& p, int mode, int lo, int hi, int first, int stride, int tid) {
    LAS float* lds = (LAS float*)ldsb;
    const int n4 = tid & 63, kq = tid >> 6;
    f32x4 regs[8]; float scl[8];
    int q = lo + first;
    CvtTile cur{};
    if (q < hi) {
        cur = cvt_locate(p, cvt_map(mode, q));
#pragma unroll
        for (int i = 0; i < 8; ++i) { regs[i] = __builtin_nontemporal_load((const f32x4*)(cur.src + (size_t)(kq + 8 * i) * cur.N + 4 * n4)); scl[i] = cur.scale ? cur.scale[kq + 8 * i] : 1.0f; }
    }
    for (; q < hi; q += stride) {
        __syncthreads();
#pragma unroll
        for (int i = 0; i < 8; ++i) { const int k = kq + 8 * i; *(LAS f32x4*)(lds + k * 256 + ((4 * n4) ^ (4 * ((k >> 3) & 7)))) = regs[i] * scl[i]; }
        __syncthreads();
        const CvtTile now = cur;
        if (q + stride < hi) {
            cur = cvt_locate(p, cvt_map(mode, q + stride));
#pragma unroll
            for (int i = 0; i < 8; ++i) { regs[i] = __builtin_nontemporal_load((const f32x4*)(cur.src + (size_t)(kq + 8 * i) * cur.N + 4 * n4)); scl[i] = cur.scale ? cur.scale[kq + 8 * i] : 1.0f; }
        }
#pragma unroll
        for (int it = 0; it < 4; ++it) {
            const int qq = tid + 512 * it, ko = qq & 7, n = qq >> 3;
            float v[8];
#pragma unroll
            for (int j = 0; j < 8; ++j) v[j] = lds[(8 * ko + j) * 256 + (n ^ (4 * ko))];
            u32x4 w; w[0] = cvt_pk_bf16(v[0], v[1]); w[1] = cvt_pk_bf16(v[2], v[3]); w[2] = cvt_pk_bf16(v[4], v[5]); w[3] = cvt_pk_bf16(v[6], v[7]);
            __builtin_nontemporal_store(w, (u32x4*)(now.dst + (size_t)n * now.K + 8 * ko));
        }
    }
    __syncthreads();
}
DI void ph_prologue(LAS unsigned char* ldsb) {
    LOAD_PARAMS();
    const int tid = tid_(), bid = bid_();
    cvt_run(ldsb, p, 0, 0, CVT_PRO, bid, gridDim.x, tid);
    bf16_t* wh = (bf16_t*)(p.ws + WS_WRH); bf16_t* wl = (bf16_t*)(p.ws + WS_WRL);
    for (int idx = bid * NTHR + tid; idx < DEPTH * 48 * DM; idx += gridDim.x * NTHR) {
        const int l = idx / (48 * DM), n = (idx / DM) % 48, k = idx % DM;
        float v = 0.f;
        if (n < 4) v = p.moe_wg[((size_t)l * DM + k) * 4 + n]; else if (n < 36) v = p.moe_wr[((size_t)l * DM + k) * 32 + (n - 4)];
        v *= p.moe_norm[l * DM + k];
        const unsigned h = cvt_pk_bf16(v, 0.f), lo = cvt_pk_bf16(v - bf_lo(h), 0.f);
        wh[idx] = (bf16_t)(h & 0xffffu); wl[idx] = (bf16_t)(lo & 0xffffu);
    }
}

DI void unpack8(const u32x4 u, float (&f)[8]) {
#pragma unroll
    for (int i = 0; i < 4; ++i) { f[2 * i] = bf_lo(u[i]); f[2 * i + 1] = bf_hi(u[i]); }
}
template <bool FINAL>
DI void ph_combine(int src_buf) {
    LOAD_PARAMS();
    const int tid = tid_(), bid = bid_(), wid = tid >> 6, lane = tid & 63;
    const bf16_t* xs = (const bf16_t*)(p.ws + (src_buf ? WS_XB1 : WS_XB));
    bf16_t* xd = (bf16_t*)(p.ws + (src_buf ? WS_XB : WS_XB1));
    const bf16_t* yb = (const bf16_t*)(p.ws + WS_YBUF);
    float* rstd = (float*)(p.ws + WS_RSTD);
    for (int t = bid * NWAVE + wid; t < T; t += gridDim.x * NWAVE) {
        float ss = 0.f;
#pragma unroll
        for (int i = 0; i < 2; ++i) {
            const size_t o = (size_t)t * DM + lane * 8 + 512 * i;
            float a[8], b[8], c[8];
            unpack8(*(const u32x4*)(xs + o), a); unpack8(*(const u32x4*)(yb + o), b); unpack8(*(const u32x4*)(yb + (size_t)T * DM + o), c);
#pragma unroll
            for (int e = 0; e < 8; ++e) a[e] += b[e] + c[e];
            if (FINAL) {
                __builtin_nontemporal_store((f32x4){a[0], a[1], a[2], a[3]}, (f32x4*)(p.x + o)); __builtin_nontemporal_store((f32x4){a[4], a[5], a[6], a[7]}, (f32x4*)(p.x + o + 4));
            } else {
                u32x4 w; w[0] = cvt_pk_bf16(a[0], a[1]); w[1] = cvt_pk_bf16(a[2], a[3]); w[2] = cvt_pk_bf16(a[4], a[5]); w[3] = cvt_pk_bf16(a[6], a[7]);
                *(u32x4*)(xd + o) = w;
                float r[8]; unpack8(w, r);
#pragma unroll
                for (int e = 0; e < 8; ++e) ss += r[e] * r[e];
            }
        }
        if (!FINAL) { ss = wave_sum(ss, lane); if (lane == 0) rstd[t] = rsqrtf(ss * (1.0f / DM) + EPS); }
    }
}

constexpr int PF_ROWS = 47, PF_TOK = 32;
DI void ph_poolfuse(LAS unsigned char* ldsb, int j, bool first) {
    LOAD_PARAMS();
    const int tid = tid_(), bid = bid_(), wid = tid >> 6, lane = tid & 63;
    const bf16_t* xs = (const bf16_t*)(p.ws + WS_XB1);
    bf16_t* xd = (bf16_t*)(p.ws + WS_XB);
    const bf16_t* yb = (const bf16_t*)(p.ws + WS_YBUF);
    const float* gain = p.pool_norm + j * DM;
    bf16_t* diff = (bf16_t*)(p.ws + WS_DIFF);
    LAS unsigned char* ht = ldsb;
    for (int tix = 0; tix < 2 * ((T / (2 * PF_TOK) - bid + (int)gridDim.x - 1) / (int)gridDim.x); ++tix) {
        const int tile = 2 * (bid + (tix >> 1) * (int)gridDim.x) + (tix & 1);
        const int t0 = tile * PF_TOK, s0 = t0 & (SEQ - 1);
        const bool reuse = (tix & 1) != 0;
        if (reuse) {
            for (int q = tid; q < 15 * 128; q += NTHR) { const int r = q >> 7, c = (q & 127) * 16; *(LAS u32x4*)(ht + r * 2048 + c) = *(const LAS u32x4*)(ht + (32 + r) * 2048 + c); }
            __syncthreads();
        }
        for (int rr = (reuse ? 15 : 0) + wid; rr < PF_ROWS; rr += NWAVE) {
            const int t = t0 - 15 + rr;
            if (s0 == 0 && rr < 15) {
#pragma unroll
                for (int i = 0; i < 2; ++i) *(LAS u32x4*)(ht + rr * 2048 + (lane * 8 + 512 * i) * 2) = (u32x4){0u, 0u, 0u, 0u};
                continue;
            }
            float v[2][8]; u32x4 w[2]; float ss = 0.f;
#pragma unroll
            for (int i = 0; i < 2; ++i) {
                const size_t o = (size_t)t * DM + lane * 8 + 512 * i;
                if (first) {
                    const f32x4 a = *(const f32x4*)(p.x_in + o), b = *(const f32x4*)(p.x_in + o + 4);
#pragma unroll
                    for (int e = 0; e < 4; ++e) { v[i][e] = a[e]; v[i][4 + e] = b[e]; }
                } else {
                    float b[8], c[8];
                    unpack8(*(const u32x4*)(xs + o), v[i]); unpack8(*(const u32x4*)(yb + o), b); unpack8(*(const u32x4*)(yb + (size_t)T * DM + o), c);
#pragma unroll
                    for (int e = 0; e < 8; ++e) v[i][e] += b[e] + c[e];
                }
                w[i][0] = cvt_pk_bf16(v[i][0], v[i][1]); w[i][1] = cvt_pk_bf16(v[i][2], v[i][3]); w[i][2] = cvt_pk_bf16(v[i][4], v[i][5]); w[i][3] = cvt_pk_bf16(v[i][6], v[i][7]);
                if (rr >= 15) *(u32x4*)(xd + o) = w[i];
                unpack8(w[i], v[i]);
#pragma unroll
                for (int e = 0; e < 8; ++e) ss += v[i][e] * v[i][e];
            }
            ss = wave_sum(ss, lane);
            const float rs = rsqrtf(ss * (1.0f / DM) + EPS);
#pragma unroll
            for (int i = 0; i < 2; ++i) {
                u32x4 hw; hw[0] = cvt_pk_bf16(v[i][0] * rs, v[i][1] * rs); hw[1] = cvt_pk_bf16(v[i][2] * rs, v[i][3] * rs); hw[2] = cvt_pk_bf16(v[i][4] * rs, v[i][5] * rs); hw[3] = cvt_pk_bf16(v[i][6] * rs, v[i][7] * rs);
                *(LAS u32x4*)(ht + rr * 2048 + (lane * 8 + 512 * i) * 2) = hw;
            }
        }
        __syncthreads();
        {
            const int c = 2 * tid, win = 2 << (c >> 8);
            const float g0 = gain[c], g1 = gain[c + 1];
            float S0 = 0.f, S1 = 0.f;
            const LAS unsigned char* col = ht + c * 2;
#pragma unroll 4
            for (int rr = 0; rr < PF_ROWS; ++rr) {
                const unsigned hv = *(const LAS unsigned*)(col + rr * 2048);
                const float h0 = bf_lo(hv), h1 = bf_hi(hv);
                S0 += h0; S1 += h1;
                if (rr >= win) { const unsigned ov = *(const LAS unsigned*)(col + (rr - win) * 2048); S0 -= bf_lo(ov); S1 -= bf_hi(ov); }
                if (rr >= 15) {
                    const int s = s0 + rr - 15;
                    const float inv = 1.0f / (float)((s + 1 < win) ? s + 1 : win);
                    *(unsigned*)(diff + (size_t)(t0 + rr - 15) * DM + c) = cvt_pk_bf16((S0 * inv - h0) * g0, (S1 * inv - h1) * g1);
                }
            }
        }
        __syncthreads();
    }
}

struct Unit { const bf16_t* A; const bf16_t* B; int pm, pn, e, nvalid, row0, lbase; };
template <int LDA_, int LDB_, int K_, int BH_, bool HEADMAP_> struct GCfg { static constexpr int LDA = LDA_, LDB = LDB_, K = K_, BH = BH_; static constexpr bool HEADMAP = HEADMAP_; };

constexpr int BK = 64, HTB = 128 * BK * 2  , STAGE_BYTES = 8 * HTB;
DI int lds_byte(int r, int c) { const int st = (r >> 4) * 2 + (c >> 5), rr = r & 15, cc = c & 31, ob = rr * 64 + cc * 2; return st * 1024 + (ob ^ (((ob >> 9) & 1) << 5)); }
DI void stage_rc(int b, int& R, int& C) { const int st = b / 1024, sb = b % 1024, swz = sb ^ (((sb >> 9) & 1) << 5); R = (st >> 1) * 16 + swz / 64; C = (st & 1) * 32 + (swz % 64) / 2; }

template <class Cfg, class Sched, class Epi>
DI void gemm_phase(LAS unsigned char* lds, const Sched& S, const Epi& E) {
    const int tid = tid_(), wid = __builtin_amdgcn_readfirstlane(tid >> 6), lane = tid & 63, wr = wid >> 2, wc = wid & 3, fr = lane & 15, fq = lane >> 4;
    constexpr int nt = Cfg::K / BK;
    static_assert(Cfg::K % 128 == 0 && Cfg::K >= 256, "K");
    unsigned voffA[2][2], voffB[2];
    int R0, C0, R1, C1; stage_rc(tid * 16, R0, C0); stage_rc(tid * 16 + 8192, R1, C1);
    voffB[0] = (unsigned)(((Cfg::HEADMAP ? 64 * (R0 >> 5) : (R0 & ~31)) + perm32(R0 & 31)) * Cfg::LDB + C0) * 2u;
    voffB[1] = (unsigned)(((Cfg::HEADMAP ? 64 * (R1 >> 5) : (R1 & ~31)) + perm32(R1 & 31)) * Cfg::LDB + C1) * 2u;
    constexpr size_t kstep = (size_t)(BK * 2);
    constexpr size_t bhstep = (size_t)Cfg::BH * Cfg::LDB * 2;
    const unsigned ldsw = (unsigned)wid * 1024u;
    const int aoff = lds_byte(wr * 64 + fr, fq * 8), boff = lds_byte(wc * 32 + fr, fq * 8);
#define PG8_SA(b, h) (((b) * 2 + (h)) * HTB)
#define PG8_SB(b, h) ((4 + (b) * 2 + (h)) * HTB)
#define PG8_STAGE(bufoff, gbase, voff) do { _Pragma("unroll") for (int _i = 0; _i < 2; ++_i) \
        __builtin_amdgcn_global_load_lds((const unsigned*)((const char*)(gbase) + (voff)[_i]), (LAS unsigned*)(lds + (bufoff) + ldsw + _i * 8192), 16, 0, 0); } while (0)
#define PG8_LDA(dst, b, h) do { _Pragma("unroll") for (int m = 0; m < 4; ++m) _Pragma("unroll") for (int k = 0; k < 2; ++k) dst[m][k] = *(const LAS bf16x8*)(lds + PG8_SA(b, h) + aoff + m * 2048 + k * 1024); } while (0)
#define PG8_LDB(dst, b, h) do { _Pragma("unroll") for (int n = 0; n < 2; ++n) _Pragma("unroll") for (int k = 0; k < 2; ++k) dst[n][k] = *(const LAS bf16x8*)(lds + PG8_SB(b, h) + boff + n * 2048 + k * 1024); } while (0)
#define PG8_MMA(ai, bj, At, Bt) do { __builtin_amdgcn_s_setprio(1); _Pragma("unroll") for (int m = 0; m < 4; ++m) _Pragma("unroll") for (int n = 0; n < 2; ++n) _Pragma("unroll") for (int k = 0; k < 2; ++k) \
        acc[ai][bj][m][n] = __builtin_amdgcn_mfma_f32_16x16x32_bf16(Bt[n][k], At[m][k], acc[ai][bj][m][n], 0, 0, 0); __builtin_amdgcn_s_setprio(0); } while (0)
#define PG8_WAIT_V(n) asm volatile("s_waitcnt vmcnt(" #n ")" ::: "memory")
#define PG8_WAIT_L(n) asm volatile("s_waitcnt lgkmcnt(" #n ")" ::: "memory")
#define PG8_BAR __builtin_amdgcn_s_barrier()
#define PG8_SCHED __builtin_amdgcn_sched_barrier(0)
#define PG8_AROWS(uidx, un) do { voffA[0][0] = (unsigned)S.arow(uidx, un, R0) * (unsigned)(Cfg::LDA * 2) + (unsigned)(C0 * 2); voffA[0][1] = (unsigned)S.arow(uidx, un, R1) * (unsigned)(Cfg::LDA * 2) + (unsigned)(C1 * 2); \
        voffA[1][0] = (unsigned)S.arow(uidx, un, 128 + R0) * (unsigned)(Cfg::LDA * 2) + (unsigned)(C0 * 2); voffA[1][1] = (unsigned)S.arow(uidx, un, 128 + R1) * (unsigned)(Cfg::LDA * 2) + (unsigned)(C1 * 2); } while (0)
    Unit cur, nxt; int ui = 0;
    if (!S.next(0, cur)) return;
    f32x4 acc[2][2][4][2];
#pragma unroll
    for (int a = 0; a < 2; ++a)
#pragma unroll
        for (int b = 0; b < 2; ++b)
#pragma unroll
            for (int m = 0; m < 4; ++m)
#pragma unroll
                for (int n = 0; n < 2; ++n) acc[a][b][m][n] = (f32x4){0.f, 0.f, 0.f, 0.f};
    bf16x8 At[4][2], B0[2][2], B1[2][2];
    PG8_AROWS(0, cur);
    const char* cA = (const char*)cur.A; const char* cB = (const char*)cur.B;
    PG8_STAGE(PG8_SB(0, 0), cB, voffB); PG8_STAGE(PG8_SB(0, 1), cB + bhstep, voffB); PG8_STAGE(PG8_SA(0, 0), cA, voffA[0]); PG8_STAGE(PG8_SA(0, 1), cA, voffA[1]);
    if (wr == 1) PG8_BAR;
    PG8_WAIT_V(2); PG8_BAR;
    PG8_STAGE(PG8_SB(1, 0), cB + kstep, voffB); PG8_STAGE(PG8_SA(1, 0), cA + kstep, voffA[0]); PG8_STAGE(PG8_SB(1, 1), cB + bhstep + kstep, voffB);
    PG8_WAIT_V(6); PG8_BAR;
    for (;;) {
        const bool has_next = S.next(ui + 1, nxt);
        const char* nA = has_next ? (const char*)nxt.A : cA; const char* nB = has_next ? (const char*)nxt.B : cB;
#pragma unroll 1
        for (int t = 0; t < nt; t += 2) {
            const bool last = (t == nt - 2);
            const char* a1 = cA + (size_t)(t + 1) * kstep;
            const char* a2 = last ? nA : cA + (size_t)(t + 2) * kstep; const char* b2 = last ? nB : cB + (size_t)(t + 2) * kstep;
            const char* a3 = a2 + kstep; const char* b3 = b2 + kstep;
            PG8_LDB(B0, 0, 0); PG8_LDB(B1, 0, 1); PG8_SCHED; PG8_LDA(At, 0, 0); PG8_STAGE(PG8_SA(1, 1), a1, voffA[1]);
            if (last && has_next) PG8_AROWS(ui + 1, nxt);
            PG8_WAIT_V(8); PG8_WAIT_L(0); PG8_BAR; PG8_MMA(0, 0, At, B0); PG8_MMA(0, 1, At, B1); PG8_BAR; PG8_SCHED;
            PG8_LDA(At, 0, 1); PG8_STAGE(PG8_SB(0, 0), b2, voffB); PG8_STAGE(PG8_SB(0, 1), b2 + bhstep, voffB); PG8_STAGE(PG8_SA(0, 0), a2, voffA[0]);
            PG8_WAIT_V(8); PG8_WAIT_L(0); PG8_BAR; PG8_MMA(1, 0, At, B0); PG8_MMA(1, 1, At, B1); PG8_BAR; PG8_SCHED;
            PG8_LDB(B0, 1, 0); PG8_LDB(B1, 1, 1); PG8_SCHED; PG8_LDA(At, 1, 0); PG8_STAGE(PG8_SA(0, 1), a2, voffA[1]);
            PG8_WAIT_V(8); PG8_WAIT_L(0); PG8_BAR; PG8_MMA(0, 0, At, B0); PG8_MMA(0, 1, At, B1); PG8_BAR; PG8_SCHED;
            PG8_LDA(At, 1, 1); PG8_STAGE(PG8_SB(1, 0), b3, voffB); PG8_STAGE(PG8_SB(1, 1), b3 + bhstep, voffB); PG8_STAGE(PG8_SA(1, 0), a3, voffA[0]);
            PG8_WAIT_V(8); PG8_WAIT_L(0); PG8_BAR; PG8_MMA(1, 0, At, B0); PG8_MMA(1, 1, At, B1); PG8_BAR; PG8_SCHED;
        }
        if (wr == 0) PG8_BAR;
        E(acc, cur, wr, wc, fr, fq);
        if (!has_next) break;
#pragma unroll
        for (int a = 0; a < 2; ++a)
#pragma unroll
            for (int b = 0; b < 2; ++b)
#pragma unroll
                for (int m = 0; m < 4; ++m)
#pragma unroll
                    for (int n = 0; n < 2; ++n) acc[a][b][m][n] = (f32x4){0.f, 0.f, 0.f, 0.f};
        cur = nxt; cA = nA; cB = nB; ++ui;
        if (wr == 1) PG8_BAR;
    }
    PG8_WAIT_V(0);
    PG8_BAR;
#undef PG8_SA
#undef PG8_SB
#undef PG8_STAGE
#undef PG8_LDA
#undef PG8_LDB
#undef PG8_MMA
#undef PG8_WAIT_V
#undef PG8_WAIT_L
#undef PG8_BAR
#undef PG8_SCHED
#undef PG8_AROWS
}

struct SchedPool {
    const bf16_t* diff; const bf16_t* w; int bid;
    DI bool next(int i, Unit& u) const { const int L = i * gridDim.x + bid; if (L >= 256) return false; u.pm = L >> 2; u.pn = L & 3; u.A = diff + 256 * u.pn; u.B = w + (size_t)u.pn * 65536; return true; }
    DI int arow(int, const Unit& u, int r) const { return u.pm * 256 + r; }
};
struct SchedDense {
    const bf16_t* A; const bf16_t* B; int npn, ldb, bid;
    DI bool next(int i, Unit& u) const { const int L = i * gridDim.x + bid; if (L >= 64 * npn) return false; u.pm = L / npn; u.pn = L % npn; u.A = A; u.B = B + (size_t)u.pn * 256 * ldb; return true; }
    DI int arow(int, const Unit& u, int r) const { return u.pm * 256 + r; }
};

struct EpiPool {
    bf16_t* x; const float* pb; const float* ps;
    DI void operator()(const f32x4 (&acc)[2][2][4][2], const Unit& u, int wr, int wc, int fr, int fq) const {
        f32x4 bb[2][2], sc[2][2];
#pragma unroll
        for (int bj = 0; bj < 2; ++bj) {
            const int c = 256 * u.pn + 128 * bj + 32 * wc + 8 * fq;
            bb[bj][0] = *(const f32x4*)(pb + c); bb[bj][1] = *(const f32x4*)(pb + c + 4); sc[bj][0] = *(const f32x4*)(ps + c); sc[bj][1] = *(const f32x4*)(ps + c + 4);
        }
#pragma unroll
        for (int ai = 0; ai < 2; ++ai) {
            u32x4 xin[4][2];
#pragma unroll
            for (int m = 0; m < 4; ++m)
#pragma unroll
                for (int bj = 0; bj < 2; ++bj)
                    xin[m][bj] = *(const u32x4*)(x + (size_t)(u.pm * 256 + 128 * ai + 64 * wr + 16 * m + fr) * DM + 256 * u.pn + 128 * bj + 32 * wc + 8 * fq);
            asm volatile("" ::: "memory");
#pragma unroll
            for (int m = 0; m < 4; ++m) {
                const int t = u.pm * 256 + 128 * ai + 64 * wr + 16 * m + fr;
#pragma unroll
                for (int bj = 0; bj < 2; ++bj) {
                    const int c = 256 * u.pn + 128 * bj + 32 * wc + 8 * fq;
                    float xv[8]; unpack8(xin[m][bj], xv);
                    const f32x4 v0 = (acc[ai][bj][m][0] + bb[bj][0]) * sc[bj][0];
                    const f32x4 v1 = (acc[ai][bj][m][1] + bb[bj][1]) * sc[bj][1];
                    u32x4 w; w[0] = cvt_pk_bf16(xv[0] + v0[0], xv[1] + v0[1]); w[1] = cvt_pk_bf16(xv[2] + v0[2], xv[3] + v0[3]); w[2] = cvt_pk_bf16(xv[4] + v1[0], xv[5] + v1[1]); w[3] = cvt_pk_bf16(xv[6] + v1[2], xv[7] + v1[3]);
                    *(u32x4*)(x + (size_t)t * DM + c) = w;
                }
            }
        }
    }
};
struct EpiWo {
    bf16_t* x;
    DI void operator()(const f32x4 (&acc)[2][2][4][2], const Unit& u, int wr, int wc, int fr, int fq) const {
#pragma unroll
        for (int ai = 0; ai < 2; ++ai) {
            u32x4 xin[4][2];
#pragma unroll
            for (int m = 0; m < 4; ++m)
#pragma unroll
                for (int bj = 0; bj < 2; ++bj)
                    xin[m][bj] = *(const u32x4*)(x + (size_t)(u.pm * 256 + 128 * ai + 64 * wr + 16 * m + fr) * DM + 256 * u.pn + 128 * bj + 32 * wc + 8 * fq);
            asm volatile("" ::: "memory");
#pragma unroll
            for (int m = 0; m < 4; ++m) {
                const int t = u.pm * 256 + 128 * ai + 64 * wr + 16 * m + fr;
#pragma unroll
                for (int bj = 0; bj < 2; ++bj) {
                    const int c = 256 * u.pn + 128 * bj + 32 * wc + 8 * fq;
                    float xv[8]; unpack8(xin[m][bj], xv);
                    const f32x4 v0 = acc[ai][bj][m][0], v1 = acc[ai][bj][m][1];
                    u32x4 w; w[0] = cvt_pk_bf16(xv[0] + v0[0], xv[1] + v0[1]); w[1] = cvt_pk_bf16(xv[2] + v0[2], xv[3] + v0[3]); w[2] = cvt_pk_bf16(xv[4] + v1[0], xv[5] + v1[1]); w[3] = cvt_pk_bf16(xv[6] + v1[2], xv[7] + v1[3]);
                    *(u32x4*)(x + (size_t)t * DM + c) = w;
                }
            }
        }
    }
};
struct EpiQKV {
    bf16_t* q; const float* rstd; const float* qg; const float* kg;
    DI void operator()(const f32x4 (&acc)[2][2][4][2], const Unit& u, int wr, int wc, int fr, int fq) const {
        const int which = u.pn >> 2, head = (u.pn & 3) * 4 + wc;
        bf16_t* out = q + (size_t)which * ((WS_K - WS_Q) / 2);
        const float* gn = which == 0 ? qg : kg;
        const float post = which == 0 ? 0.125f * 1.4426950408889634f : 1.0f;
        f32x4 g[2][2];
#pragma unroll
        for (int bj = 0; bj < 2; ++bj)
#pragma unroll
            for (int n = 0; n < 2; ++n) g[bj][n] = (which < 2) ? *(const f32x4*)(gn + 32 * bj + 8 * fq + 4 * n) * post : (f32x4){1.f, 1.f, 1.f, 1.f};
        float rsv[2][4];
#pragma unroll
        for (int ai = 0; ai < 2; ++ai)
#pragma unroll
            for (int m = 0; m < 4; ++m) rsv[ai][m] = rstd[u.pm * 256 + 128 * ai + 64 * wr + 16 * m + fr];
#pragma unroll
        for (int ai = 0; ai < 2; ++ai)
#pragma unroll
            for (int m = 0; m < 4; ++m) {
                const int t = u.pm * 256 + 128 * ai + 64 * wr + 16 * m + fr;
                const float rs = rsv[ai][m];
                f32x4 v4[2][2]; float ss = 0.f;
#pragma unroll
                for (int bj = 0; bj < 2; ++bj)
#pragma unroll
                    for (int n = 0; n < 2; ++n) { v4[bj][n] = acc[ai][bj][m][n] * rs; const f32x4 s = v4[bj][n] * v4[bj][n]; ss += (s[0] + s[1]) + (s[2] + s[3]); }
                ss += shflx(ss, fr + 16 * fq, 16); ss += shflx(ss, fr + 16 * fq, 32);
                const float r2 = (which < 2) ? rsqrtf(ss * (1.0f / HD) + EPS) : 1.0f;
#pragma unroll
                for (int bj = 0; bj < 2; ++bj) {
                    const f32x4 a = v4[bj][0] * r2 * g[bj][0], b = v4[bj][1] * r2 * g[bj][1];
                    u32x4 w; w[0] = cvt_pk_bf16(a[0], a[1]); w[1] = cvt_pk_bf16(a[2], a[3]); w[2] = cvt_pk_bf16(b[0], b[1]); w[3] = cvt_pk_bf16(b[2], b[3]);
                    *(u32x4*)(out + (size_t)t * DM + head * HD + 32 * bj + 8 * fq) = w;
                }
            }
    }
};

typedef short v4i16_t __attribute__((ext_vector_type(4)));
constexpr int AT_VPITCH = 192;
constexpr int AT_VTILE = 32 * AT_VPITCH;
DI void ph_attn(LAS unsigned char* ldsb) {
    LOAD_PARAMS();
    const int tid = tid_(), bid = bid_(), wid = tid >> 6, lane = tid & 63, l31 = lane & 31, h2 = lane >> 5;
    const bf16_t* Q = (const bf16_t*)(p.ws + WS_Q); const bf16_t* K = (const bf16_t*)(p.ws + WS_K); const bf16_t* V = (const bf16_t*)(p.ws + WS_V);
    bf16_t* O = (bf16_t*)(p.ws + WS_O);
    LAS unsigned char* vl = ldsb + wid * AT_VTILE;
    LAS unsigned char* vw = vl + (lane >> 3) * AT_VPITCH + (lane & 7) * 16;
    const LAS unsigned char* vr = vl + (4 * h2 + ((lane & 15) >> 2)) * AT_VPITCH + (16 * ((lane >> 4) & 1) + 4 * (lane & 3)) * 2;
    for (int it = 0; it < 4 * ((2 * NH * 256 / 32 - bid + (int)gridDim.x - 1) / (int)gridDim.x); ++it) {
        const int chunk = bid + (it >> 2) * gridDim.x, k32 = (it & 3) * 8 + wid;
        const int b = chunk >> 7, h = k32 >> 1, qb = 2 * (chunk & 127) + (k32 & 1);
        const size_t tb = (size_t)b * SEQ;
        const int q0 = qb * 32;
        bf16x8 qf[4];
#pragma unroll
        for (int s = 0; s < 4; ++s) qf[s] = *(const bf16x8*)(Q + (tb + q0 + l31) * DM + h * HD + 16 * s + 8 * h2);
        f32x16 o0, o1;
#pragma unroll
        for (int r = 0; r < 16; ++r) { o0[r] = 0.f; o1[r] = 0.f; }
        float R = 1.f;
        const bf16_t* kp = K + (tb + q0 + l31) * DM + h * HD + 8 * h2;
        const bf16_t* vp = V + (tb + q0 + (lane >> 3)) * DM + h * HD + (lane & 7) * 8;
        bf16x8 kn[4], kq[4]; u32x4 vn[4], vq[4];
#pragma unroll
        for (int s = 0; s < 4; ++s) { kn[s] = *(const bf16x8*)(kp + 16 * s); vn[s] = *(const u32x4*)(vp + (size_t)8 * s * DM); }
        if (qb > 0) {
            kp -= (size_t)32 * DM; vp -= (size_t)32 * DM;
#pragma unroll
            for (int s = 0; s < 4; ++s) { kq[s] = *(const bf16x8*)(kp + 16 * s); vq[s] = *(const u32x4*)(vp + (size_t)8 * s * DM); }
        }
        for (int kt = qb; kt >= 0; --kt) {
            bf16x8 kf[4];
#pragma unroll
            for (int s = 0; s < 4; ++s) { kf[s] = kn[s]; *(LAS u32x4*)(vw + 8 * s * AT_VPITCH) = vn[s]; kn[s] = kq[s]; vn[s] = vq[s]; }
            if (kt > 1) {
                kp -= (size_t)32 * DM; vp -= (size_t)32 * DM;
#pragma unroll
                for (int s = 0; s < 4; ++s) { kq[s] = *(const bf16x8*)(kp + 16 * s); vq[s] = *(const u32x4*)(vp + (size_t)8 * s * DM); }
            }
            f32x16 z;
#pragma unroll
            for (int r = 0; r < 16; ++r) z[r] = 0.f;
#pragma unroll
            for (int s = 0; s < 4; ++s) z = __builtin_amdgcn_mfma_f32_32x32x16_bf16(kf[s], qf[s], z, 0, 0, 0);
            float kp_[16], gs[4], ot[4];
#pragma unroll
            for (int r = 0; r < 16; ++r) kp_[r] = __builtin_amdgcn_rcpf(1.0f + __builtin_amdgcn_exp2f(z[r]));
            if (kt == qb) {
#pragma unroll
                for (int r = 0; r < 16; ++r) { const int kl = (r & 3) + 8 * (r >> 2) + 4 * h2; kp_[r] = (kl < l31) ? kp_[r] : 1.0f; }
            }
#pragma unroll
            for (int bb = 0; bb < 4; ++bb) { gs[bb] = (kp_[4 * bb] * kp_[4 * bb + 1]) * (kp_[4 * bb + 2] * kp_[4 * bb + 3]); ot[bb] = shflx(gs[bb], lane, 32); }
            const float tot_own = (gs[0] * gs[1]) * (gs[2] * gs[3]);
            const float tot_oth = (ot[0] * ot[1]) * (ot[2] * ot[3]);
            float later[4];
            {
                float own_tail = 1.f, oth_tail = 1.f;
#pragma unroll
                for (int bb = 3; bb >= 0; --bb) {
                    later[bb] = own_tail * oth_tail * (h2 == 0 ? ot[bb] : 1.f);
                    own_tail *= gs[bb]; oth_tail *= ot[bb];
                }
            }
            float a[16];
#pragma unroll
            for (int bb = 0; bb < 4; ++bb) {
                const float x3 = R * later[bb];
                const float x2 = x3 * kp_[4 * bb + 3], x1 = x2 * kp_[4 * bb + 2], x0 = x1 * kp_[4 * bb + 1];
                a[4 * bb] = x0 - x0 * kp_[4 * bb]; a[4 * bb + 1] = x1 - x1 * kp_[4 * bb + 1]; a[4 * bb + 2] = x2 - x2 * kp_[4 * bb + 2]; a[4 * bb + 3] = x3 - x3 * kp_[4 * bb + 3];
            }
            R *= (h2 == 0) ? (tot_own * tot_oth) : (tot_oth * tot_own);
#pragma unroll
            for (int s = 0; s < 2; ++s) {
                u32x4 pw;
#pragma unroll
                for (int i = 0; i < 4; ++i) pw[i] = cvt_pk_bf16(a[8 * s + 2 * i], a[8 * s + 2 * i + 1]);
                const bf16x8 pa = __builtin_bit_cast(bf16x8, pw);
#pragma unroll
                for (int db = 0; db < 2; ++db) {
                    const v4i16_t lo4 = __builtin_amdgcn_ds_read_tr16_b64_v4i16((LAS v4i16_t*)(vr + (16 * s) * AT_VPITCH + 64 * db));
                    const v4i16_t hi4 = __builtin_amdgcn_ds_read_tr16_b64_v4i16((LAS v4i16_t*)(vr + (16 * s + 8) * AT_VPITCH + 64 * db));
                    bf16x8 vf; vf[0] = lo4[0]; vf[1] = lo4[1]; vf[2] = lo4[2]; vf[3] = lo4[3]; vf[4] = hi4[0]; vf[5] = hi4[1]; vf[6] = hi4[2]; vf[7] = hi4[3];
                    if (db == 0) o0 = __builtin_amdgcn_mfma_f32_32x32x16_bf16(vf, pa, o0, 0, 0, 0);
                    else o1 = __builtin_amdgcn_mfma_f32_32x32x16_bf16(vf, pa, o1, 0, 0, 0);
                }
            }
            if (__all(R < 1.0e-36f)) break;
        }
#pragma unroll
        for (int db = 0; db < 2; ++db)
#pragma unroll
            for (int rb = 0; rb < 4; ++rb) {
                const f32x16& o = db == 0 ? o0 : o1;
                u32x2 w; w[0] = cvt_pk_bf16(o[4 * rb], o[4 * rb + 1]); w[1] = cvt_pk_bf16(o[4 * rb + 2], o[4 * rb + 3]);
                *(u32x2*)(O + (tb + q0 + l31) * DM + h * HD + 32 * db + 8 * rb + 4 * h2) = w;
            }
    }
}

constexpr int RT_PART = 0;
constexpr int RT_SSQ = RT_PART + 4 * 64 * 52 * 4;
constexpr int RT_LCNT = RT_SSQ + 4 * 64 * 4;
constexpr int RT_GB = RT_LCNT + 128;
DI void ph_router(LAS unsigned char* lds, int li) {
    LOAD_PARAMS();
    const bf16_t* xcur = (const bf16_t*)(p.ws + ((li & 1) ? WS_XB1 : WS_XB));
    const int tid = tid_(), bid = bid_(), wid = tid >> 6, lane = tid & 63, fr = lane & 15, fq = lane >> 4;
    const bf16_t* wh = (const bf16_t*)(p.ws + WS_WRH) + (size_t)li * 48 * DM;
    const bf16_t* wl = (const bf16_t*)(p.ws + WS_WRL) + (size_t)li * 48 * DM;
    const float* bg = p.moe_bg + li * 4;
    const float* br = p.moe_br + li * 32;
    unsigned* cnt = (unsigned*)(p.ws + WS_CTL) + CW_CNT + 32 * li;
    Entry* list = (Entry*)(p.ws + WS_LIST);
    LAS float* part = (LAS float*)(lds + RT_PART); LAS float* ssq = (LAS float*)(lds + RT_SSQ);
    LAS int* lcnt = (LAS int*)(lds + RT_LCNT); LAS int* gb = (LAS int*)(lds + RT_GB);
    const int th = wid & 1, kq = wid >> 1;
    for (int chunk = bid; chunk < T / 64; chunk += gridDim.x) {
        const int t = chunk * 64 + th * 32 + fr;
        const bf16_t* xr = xcur + (size_t)t * DM + kq * 256 + fq * 8;
        const bf16_t* whr = wh + (size_t)fr * DM + kq * 256 + fq * 8;
        const bf16_t* wlr = wl + (size_t)fr * DM + kq * 256 + fq * 8;
        f32x4 acc[2][3]; float ss[2] = {0.f, 0.f};
#pragma unroll
        for (int b = 0; b < 2; ++b)
#pragma unroll
            for (int nb = 0; nb < 3; ++nb) acc[b][nb] = (f32x4){0.f, 0.f, 0.f, 0.f};
#pragma unroll 4
        for (int ks = 0; ks < 8; ++ks) {
            bf16x8 xh[2];
#pragma unroll
            for (int b = 0; b < 2; ++b) {
                const u32x4 xw = *(const u32x4*)(xr + (size_t)b * 16 * DM + ks * 32);
                float xf[8]; unpack8(xw, xf);
#pragma unroll
                for (int e = 0; e < 8; ++e) ss[b] += xf[e] * xf[e];
                xh[b] = __builtin_bit_cast(bf16x8, xw);
            }
#pragma unroll
            for (int nb = 0; nb < 3; ++nb) {
                const bf16x8 wH = *(const bf16x8*)(whr + (size_t)nb * 16 * DM + ks * 32), wL = *(const bf16x8*)(wlr + (size_t)nb * 16 * DM + ks * 32);
#pragma unroll
                for (int b = 0; b < 2; ++b) {
                    acc[b][nb] = __builtin_amdgcn_mfma_f32_16x16x32_bf16(wH, xh[b], acc[b][nb], 0, 0, 0);
                    acc[b][nb] = __builtin_amdgcn_mfma_f32_16x16x32_bf16(wL, xh[b], acc[b][nb], 0, 0, 0);
                }
            }
        }
#pragma unroll
        for (int b = 0; b < 2; ++b) {
            float sv = ss[b]; sv += shflx(sv, lane, 16); sv += shflx(sv, lane, 32);
            const int tl = th * 32 + 16 * b + fr;
#pragma unroll
            for (int nb = 0; nb < 3; ++nb) *(LAS f32x4*)(part + (kq * 64 + tl) * 52 + 16 * nb + 4 * fq) = acc[b][nb];
            if (fq == 0) ssq[kq * 64 + tl] = sv;
        }
        if (tid < 32) lcnt[tid] = 0;
        __syncthreads();
        int ea = 0, eb = 0, la = 0, lb = 0; float w1 = 0.f, w2 = 0.f, rs = 0.f;
        if (tid < 64) {
            rs = rsqrtf(((ssq[tid] + ssq[64 + tid]) + (ssq[128 + tid] + ssq[192 + tid])) * (1.0f / DM) + EPS);
            float lg[36];
#pragma unroll
            for (int q = 0; q < 9; ++q) {
                const f32x4 u0 = *(const LAS f32x4*)(part + tid * 52 + 4 * q), u1 = *(const LAS f32x4*)(part + (64 + tid) * 52 + 4 * q);
                const f32x4 u2 = *(const LAS f32x4*)(part + (128 + tid) * 52 + 4 * q), u3 = *(const LAS f32x4*)(part + (192 + tid) * 52 + 4 * q);
#pragma unroll
                for (int e = 0; e < 4; ++e) lg[4 * q + e] = ((u0[e] + u1[e]) + (u2[e] + u3[e])) * rs;
            }
            float gl[4];
#pragma unroll
            for (int n = 0; n < 4; ++n) gl[n] = lg[n] + bg[n];
            int g = 0; float gm = gl[0];
#pragma unroll
            for (int n = 1; n < 4; ++n) if (gl[n] > gm) { gm = gl[n]; g = n; }
            float den = 0.f;
#pragma unroll
            for (int n = 0; n < 4; ++n) den += __expf(gl[n] - gm);
            const float gprob = 1.0f / den;
            float el[8];
#pragma unroll
            for (int n = 0; n < 8; ++n) {
                float v = 0.f;
#pragma unroll
                for (int gg = 0; gg < 4; ++gg) v = (g == gg) ? lg[4 + 8 * gg + n] + br[8 * gg + n] : v;
                el[n] = v;
            }
            int e1 = 0; float m1 = el[0];
#pragma unroll
            for (int n = 1; n < 8; ++n) if (el[n] > m1) { m1 = el[n]; e1 = n; }
            int e2 = -1; float m2 = -3.0e38f;
#pragma unroll
            for (int n = 0; n < 8; ++n) if (n != e1 && (e2 < 0 || el[n] > m2)) { m2 = el[n]; e2 = n; }
            const float ex = __expf(m2 - m1);
            w1 = gprob / (1.0f + ex); w2 = gprob * ex / (1.0f + ex);
            ea = 8 * g + e1; eb = 8 * g + e2;
            la = __hip_atomic_fetch_add(lcnt + ea, 1, __ATOMIC_RELAXED, __HIP_MEMORY_SCOPE_WORKGROUP);
            lb = __hip_atomic_fetch_add(lcnt + eb, 1, __ATOMIC_RELAXED, __HIP_MEMORY_SCOPE_WORKGROUP);
        }
        __syncthreads();
        if (tid < 32) { const int c = lcnt[tid]; gb[tid] = c ? (int)atomicAdd(&cnt[tid], (unsigned)c) : 0; }
        __syncthreads();
        if (tid < 64) {
            const int tt = chunk * 64 + tid;
            Entry A; A.dst = tt; A.rstd = rs; A.w = w1; A.tok = tt;
            Entry B; B.dst = T + tt; B.rstd = rs; B.w = w2; B.tok = tt;
            list[(size_t)ea * LIST_CAP + gb[ea] + la] = A;
            list[(size_t)eb * LIST_CAP + gb[eb] + lb] = B;
        }
        __syncthreads();
    }
}

constexpr int MOE_MAXU = 4;
constexpr int LDS_ROWTAB = STAGE_BYTES;
constexpr int LDS_EPITAB = LDS_ROWTAB + MOE_MAXU * 1024;
constexpr int LDS_UTAB = LDS_EPITAB + MOE_MAXU * 2048;
constexpr int LDS_XBW = LDS_UTAB + MOE_MAXU * 32;
constexpr int LDS_BYTES = 147456;
static_assert(LDS_XBW + 32 <= LDS_BYTES, "LDS map");
struct SchedMoe {
    LAS unsigned char* lds; const bf16_t* A; const bf16_t* W; bool gather; size_t w_estride; int w_pnrows, ldb;
    DI void build(const unsigned* cnt, const Entry* list, int npn, int lo, int hi, int first, int stride, int tid) {
        LAS int* ut = (LAS int*)(lds + LDS_UTAB); LAS unsigned* rt = (LAS unsigned*)(lds + LDS_ROWTAB);
        const int lane = tid & 63;
        if (tid < 64) {
            const int c = (int)cnt[lane & 31], ntl = (c + 255) >> 8;
            int inc = ntl;
#pragma unroll
            for (int d = 1; d < 32; d <<= 1) { const int v = __builtin_amdgcn_ds_bpermute(((lane - d) & 63) << 2, inc); if ((lane & 31) >= d) inc += v; }
            const int exc = inc - ntl;
#pragma unroll
            for (int i = 0; i < MOE_MAXU; ++i) {
                const int L = lo + first + i * stride, rtile = L / npn, pn = L % npn;
                const bool hit = (first >= 0) && (L < hi) && (lane < 32) && (rtile >= exc) && (rtile < inc);
                const unsigned long long mask = __ballot(hit);
                int found = 0, e = 0, j = 0, nv = 0;
                if (mask) {
                    found = 1; e = __builtin_ctzll(mask);
                    j = rtile - __builtin_amdgcn_readlane(exc, e); nv = __builtin_amdgcn_readlane(c, e) - 256 * j; nv = nv > 256 ? 256 : nv;
                }
                if (lane == 0) { ut[i * 8 + 0] = found; ut[i * 8 + 1] = e; ut[i * 8 + 2] = nv; ut[i * 8 + 3] = 256 * rtile; ut[i * 8 + 4] = e * LIST_CAP + 256 * j; ut[i * 8 + 5] = pn; }
            }
        }
        __syncthreads();
        if (tid < 256) {
#pragma unroll
            for (int i = 0; i < MOE_MAXU; ++i) {
                if (!ut[i * 8]) continue;
                const int nv = ut[i * 8 + 2], lb = ut[i * 8 + 4];
                Entry en; en.dst = DUMMY_ROW; en.rstd = 0.f; en.w = 0.f; en.tok = 0;
                if (tid < nv) en = list[lb + tid];
                LAS float* et = (LAS float*)(lds + LDS_EPITAB) + (i * 256 + tid) * 2;
                if (gather) { rt[i * 256 + tid] = (unsigned)en.tok; et[0] = en.rstd; et[1] = en.w; }
                else { et[0] = __int_as_float(en.dst); et[1] = 0.f; }
            }
        }
        asm volatile("s_waitcnt vmcnt(0) lgkmcnt(0)" ::: "memory");
        __syncthreads();
    }
    DI bool next(int i, Unit& u) const {
        if (i >= MOE_MAXU) return false;
        const LAS int* ut = (const LAS int*)(lds + LDS_UTAB) + i * 8;
        const int found = __builtin_amdgcn_readfirstlane(ut[0]);
        if (!found) return false;
        u.e = __builtin_amdgcn_readfirstlane(ut[1]); u.nvalid = __builtin_amdgcn_readfirstlane(ut[2]); u.row0 = __builtin_amdgcn_readfirstlane(ut[3]);
        u.lbase = i * 256; u.pn = __builtin_amdgcn_readfirstlane(ut[5]); u.pm = u.row0 >> 8;
        u.A = gather ? A : A + (size_t)u.row0 * DE;
        u.B = W + (size_t)u.e * w_estride + (size_t)u.pn * w_pnrows * ldb;
        return true;
    }
    DI int arow(int ui, const Unit&, int r) const { if (!gather) return r; return (int)((const LAS unsigned*)(lds + LDS_ROWTAB))[ui * 256 + r]; }
};
struct EpiGU {
    bf16_t* hid; LAS unsigned char* lds;
    DI void operator()(const f32x4 (&acc)[2][2][4][2], const Unit& u, int wr, int wc, int fr, int fq) const {
        typedef float f32x2 __attribute__((ext_vector_type(2)));
#pragma unroll
        for (int ai = 0; ai < 2; ++ai)
#pragma unroll
            for (int m = 0; m < 4; ++m) {
                const int r = 128 * ai + 64 * wr + 16 * m + fr;
                const f32x2 rw = *(const LAS f32x2*)(lds + LDS_EPITAB + (u.lbase + r) * 8);
                const float rs = rw[0], w = rw[1];
                unsigned pk[4];
#pragma unroll
                for (int n = 0; n < 2; ++n) {
                    float hv[4];
#pragma unroll
                    for (int e = 0; e < 4; ++e) { const float g = acc[ai][0][m][n][e] * rs, up = acc[ai][1][m][n][e] * rs; hv[e] = g * __builtin_amdgcn_rcpf(1.0f + __builtin_amdgcn_exp2f(-1.4426950408889634f * g)) * up * w; }
                    pk[2 * n] = cvt_pk_bf16(hv[0], hv[1]); pk[2 * n + 1] = cvt_pk_bf16(hv[2], hv[3]);
                }
                u32x4 wv; wv[0] = pk[0]; wv[1] = pk[1]; wv[2] = pk[2]; wv[3] = pk[3];
                *(u32x4*)(hid + (size_t)(u.row0 + r) * DE + 128 * u.pn + 32 * wc + 8 * fq) = wv;
            }
    }
};
struct EpiDown {
    bf16_t* yb; LAS unsigned char* lds;
    DI void operator()(const f32x4 (&acc)[2][2][4][2], const Unit& u, int wr, int wc, int fr, int fq) const {
#pragma unroll
        for (int ai = 0; ai < 2; ++ai)
#pragma unroll
            for (int m = 0; m < 4; ++m) {
                const int r = 128 * ai + 64 * wr + 16 * m + fr;
                const int dst = *(const LAS int*)(lds + LDS_EPITAB + (u.lbase + r) * 8);
                if (dst == DUMMY_ROW) continue;
#pragma unroll
                for (int bj = 0; bj < 2; ++bj) {
                    const f32x4 a = acc[ai][bj][m][0], b = acc[ai][bj][m][1];
                    u32x4 w; w[0] = cvt_pk_bf16(a[0], a[1]); w[1] = cvt_pk_bf16(a[2], a[3]); w[2] = cvt_pk_bf16(b[0], b[1]); w[3] = cvt_pk_bf16(b[2], b[3]);
                    *(u32x4*)(yb + (size_t)dst * DM + 256 * u.pn + 128 * bj + 32 * wc + 8 * fq) = w;
                }
            }
    }
};

DI void ph_poolgemm(LAS unsigned char* lds, int j) {
    LOAD_PARAMS();
    SchedPool S; S.bid = xbid_(); S.diff = (const bf16_t*)(p.ws + WS_DIFF); S.w = (const bf16_t*)(p.ws + WS_WPOOL) + (size_t)j * 4 * 65536;
    EpiPool E; E.x = (bf16_t*)(p.ws + WS_XB); E.pb = p.pool_b + j * DM; E.ps = p.pool_scale + j * DM;
    gemm_phase<GCfg<1024, 256, 256, 128, false>>(lds, S, E);
}
DI void ph_qkv(LAS unsigned char* lds, int j) {
    LOAD_PARAMS();
    SchedDense S; S.bid = xbid_(); S.A = (const bf16_t*)(p.ws + WS_XB1); S.B = (const bf16_t*)(p.ws + WS_WQKV) + (size_t)j * 3072 * 1024; S.npn = 12; S.ldb = 1024;
    EpiQKV E; E.q = (bf16_t*)(p.ws + WS_Q); E.rstd = (const float*)(p.ws + WS_RSTD); E.qg = p.sb_qg + j * HD; E.kg = p.sb_kg + j * HD;
    gemm_phase<GCfg<1024, 1024, 1024, 32, true>>(lds, S, E);
}
DI void ph_wo(LAS unsigned char* lds, int j) {
    LOAD_PARAMS();
    SchedDense S; S.bid = xbid_(); S.A = (const bf16_t*)(p.ws + WS_O); S.B = (const bf16_t*)(p.ws + WS_WO) + (size_t)j * 1024 * 1024; S.npn = 4; S.ldb = 1024;
    EpiWo E; E.x = (bf16_t*)(p.ws + WS_XB1);
    gemm_phase<GCfg<1024, 1024, 1024, 128, false>>(lds, S, E);
}
struct MoePlan { int NT, R1, nB, D1; };
DI MoePlan moe_plan(const unsigned* cnt) {
    const int lane = tid_() & 63;
    int nt = ((int)cnt[lane & 31] + 255) >> 8;
#pragma unroll
    for (int o = 1; o < 32; o <<= 1) nt += __builtin_amdgcn_ds_bpermute((lane ^ o) << 2, nt);
    nt = __builtin_amdgcn_readfirstlane(nt);
    MoePlan m; m.NT = nt; const int G = gridDim.x; m.R1 = nt < G / 2 ? nt : G / 2;
    const int late = 2 * (nt - m.R1); m.nB = late < G ? late : G;
    const int cap = 2 * (G - m.nB); m.D1 = 4 * m.R1 < cap ? 4 * m.R1 : cap;
    return m;
}
DI void ph_gu(LAS unsigned char* lds, int li, int stage, const MoePlan m) {
    LOAD_PARAMS();
    const Entry* list = (const Entry*)(p.ws + WS_LIST);
    const unsigned* cnt = (const unsigned*)(p.ws + WS_CTL) + CW_CNT + 32 * li;
    const int bid = xbid_();
    if (stage == 2 || (stage == 1 && bid >= m.nB)) return;
    SchedMoe S; S.lds = lds; S.A = (const bf16_t*)(p.ws + ((li & 1) ? WS_XB1 : WS_XB));
    S.W = (const bf16_t*)(p.ws + WS_WGU) + (size_t)li * NE * 512 * 1024; S.gather = true; S.w_estride = (size_t)512 * 1024; S.w_pnrows = 128; S.ldb = 1024;
    const int lo = stage == 0 ? 0 : 2 * m.R1, hi = stage == 0 ? 2 * m.R1 : 2 * m.NT, G = gridDim.x;
    EpiGU E; E.hid = (bf16_t*)(p.ws + WS_HID); E.lds = lds;
    for (int first = bid; lo + first < hi; first += MOE_MAXU * G) {
        S.build(cnt, list, 2, lo, hi, first, G, tid_());
        gemm_phase<GCfg<1024, 1024, 1024, 256, false>>(lds, S, E);
        __syncthreads();
    }
}
DI void ph_down(LAS unsigned char* lds, int li, int stage, const MoePlan m) {
    LOAD_PARAMS();
    const Entry* list = (const Entry*)(p.ws + WS_LIST);
    const unsigned* cnt = (const unsigned*)(p.ws + WS_CTL) + CW_CNT + 32 * li;
    const int bid = xbid_(), G = gridDim.x;
    if (stage == 0 || (stage == 1 && bid < m.nB)) return;
    SchedMoe S; S.lds = lds; S.A = (const bf16_t*)(p.ws + WS_HID);
    S.W = (const bf16_t*)(p.ws + WS_WD) + (size_t)li * NE * 1024 * 256; S.gather = false; S.w_estride = (size_t)1024 * 256; S.w_pnrows = 256; S.ldb = 256;
    const int lo = stage == 1 ? 0 : m.D1, hi = stage == 1 ? m.D1 : 4 * m.NT, stride = stage == 1 ? G - m.nB : G;
    EpiDown E; E.yb = (bf16_t*)(p.ws + WS_YBUF); E.lds = lds;
    for (int first = stage == 1 ? bid - m.nB : bid; lo + first < hi; first += MOE_MAXU * stride) {
        S.build(cnt, list, 4, lo, hi, first, stride, tid_());
        gemm_phase<GCfg<256, 256, 256, 128, false>>(lds, S, E);
        __syncthreads();
    }
}
DI MoePlan moe_layer_plan(int li) {
    LOAD_PARAMS();
    return moe_plan((const unsigned*)(p.ws + WS_CTL) + CW_CNT + 32 * li);
}

#define XB_TMO      128
#define XB_XCNT(j)  (256  + 64 * (j))
#define XB_XSUB(j)  (1280 + 64 * (j))
#define XB_XGEN(j)  (2304 + 64 * (j))
#define XB_TOP      3328
#define XB_TOPGEN   3392
#define XCD_BAR_WORDS 3456
#define XB_SPIN_CAP (1u << 18)

__device__ __forceinline__ unsigned xb_ld(unsigned* p)              { return __hip_atomic_load(p, __ATOMIC_RELAXED, __HIP_MEMORY_SCOPE_AGENT); }
__device__ __forceinline__ unsigned xb_add(unsigned* p, unsigned v) { return __hip_atomic_fetch_add(p, v, __ATOMIC_RELAXED, __HIP_MEMORY_SCOPE_AGENT); }
__device__ __forceinline__ unsigned xb_xcc_id() { return (unsigned)__builtin_amdgcn_s_getreg((3 << 11) | 20) & 0xFu; }
#define XB_SPIN(cond, bar) do { unsigned _sp = 0; while (cond) { __builtin_amdgcn_s_sleep(1); \
    if ((++_sp & 255u) == 0u) { if (xb_ld(&(bar)[XB_TMO])) break; if (_sp > XB_SPIN_CAP) { atomicAdd(&(bar)[XB_TMO], 1u); break; } } } } while (0)

struct XcdBarrier {
    unsigned* bar; unsigned x;
    volatile LAS unsigned* st;
};

__device__ __forceinline__ XcdBarrier xcd_barrier_post(unsigned* bar, volatile LAS unsigned* st) {
    XcdBarrier b; b.bar = bar; b.x = xb_xcc_id(); b.st = st;
    if (threadIdx.x == 0) (void)xb_add(&bar[XB_XCNT(b.x)], 1u);
    return b;
}
__device__ __forceinline__ void xcd_barrier_complete(unsigned* bar, unsigned x, unsigned& nloc, unsigned& nx) {
    const unsigned G = gridDim.x * gridDim.y * gridDim.z;
    unsigned sum, cnt, mine, sp = 0u;
    for (;;) {
        sum = 0u; cnt = 0u; mine = 0u;
#pragma unroll
        for (unsigned j = 0; j < 16; ++j) { const unsigned c = xb_ld(&bar[XB_XCNT(j)]); sum += c; cnt += (c > 0u) ? 1u : 0u; mine = (j == x) ? c : mine; }
        if (sum == G) break;
        __builtin_amdgcn_s_sleep(1);
        if ((++sp & 255u) == 0u) { if (xb_ld(&bar[XB_TMO])) break; if (sp > XB_SPIN_CAP) { atomicAdd(&bar[XB_TMO], 1u); break; } }
    }
    nloc = mine > 0u ? mine : 1u; nx = cnt > 0u ? cnt : 1u;
}

__device__ __forceinline__ void xcd_barrier(const XcdBarrier& b) {
    asm volatile("s_waitcnt vmcnt(0)" ::: "memory");
    __syncthreads();
    if (threadIdx.x == 0) {
        unsigned* bar = b.bar; unsigned bx = b.x;
        asm volatile("" : "+s"(bar), "+s"(bx));
        __builtin_amdgcn_s_waitcnt(0);
        unsigned nloc = b.st[0], nx = b.st[1];
        if (nloc == 0u) { xcd_barrier_complete(bar, bx, nloc, nx); b.st[0] = nloc; b.st[1] = nx; }
        const unsigned old = xb_add(&bar[XB_XSUB(bx)], 1u);
        const unsigned gen = old / nloc;
        if (old + 1u == (gen + 1u) * nloc) {
            __builtin_amdgcn_fence(__ATOMIC_RELEASE, "agent");
            asm volatile("s_waitcnt vmcnt(0)" ::: "memory");
            const unsigned og = xb_add(&bar[XB_TOP], 1u);
            const unsigned tg = og / nx;
            if (og + 1u == (tg + 1u) * nx) xb_add(&bar[XB_TOPGEN], 1u);
            else XB_SPIN(xb_ld(&bar[XB_TOPGEN]) == tg, bar);
            __builtin_amdgcn_fence(__ATOMIC_ACQUIRE, "agent");
            xb_add(&bar[XB_XGEN(bx)], 1u);
            asm volatile("s_waitcnt vmcnt(0)" ::: "memory");
        } else {
            XB_SPIN(xb_ld(&bar[XB_XGEN(bx)]) == gen, bar);
            __builtin_amdgcn_fence(__ATOMIC_ACQUIRE, "agent");
            asm volatile("s_waitcnt vmcnt(0)" ::: "memory");
        }
    }
    __syncthreads();
}
constexpr int CW_BAR = 4096;

DI int cvt_claim(LAS unsigned char* smem, unsigned* ctl, int n, int tid) {
    volatile LAS unsigned* st = (volatile LAS unsigned*)(smem + LDS_XBW);
    if (tid == 0) { const unsigned d = xb_add(ctl + CW_CVT, (unsigned)n); st[4] = d; st[5] = d + (unsigned)n; }
    __syncthreads();
    const int d = (int)st[4];
    __syncthreads();
    return __builtin_amdgcn_readfirstlane(d);
}
DI void cvt_work(LAS unsigned char* smem, int n) {
    volatile LAS unsigned* st = (volatile LAS unsigned*)(smem + LDS_XBW);
    if (st[5] >= (unsigned)CVT_DTOTAL) return;
    LOAD_PARAMS();
    const int tid = tid_();
    const int d = cvt_claim(smem, (unsigned*)(p.ws + WS_CTL), n, tid);
    if (d < CVT_DTOTAL) cvt_run(smem, p, 1, d, (d + n < CVT_DTOTAL) ? d + n : CVT_DTOTAL, 0, 1, tid);
}
DI void cvt_require(LAS unsigned char* smem, int req) {
    volatile LAS unsigned* st = (volatile LAS unsigned*)(smem + LDS_XBW);
    __syncthreads();
    if (st[5] >= (unsigned)req) return;
    LOAD_PARAMS();
    unsigned* ctl = (unsigned*)(p.ws + WS_CTL);
    const int tid = tid_();
    for (;;) {
        __syncthreads();
        if (tid == 0) { const unsigned c = xb_ld(ctl + CW_CVT); if (c > st[5]) st[5] = c; }
        __syncthreads();
        if (st[5] >= (unsigned)req) break;
        const int d = cvt_claim(smem, ctl, 2, tid);
        if (d < CVT_DTOTAL) cvt_run(smem, p, 1, d, (d + 2 < CVT_DTOTAL) ? d + 2 : CVT_DTOTAL, 0, 1, tid);
    }
}
__device__ __forceinline__ void grid_sync(const XcdBarrier& b, LAS unsigned char* smem, int req) {
    if (req > 0) cvt_require(smem, req);
    asm volatile("s_waitcnt vmcnt(0)" ::: "memory");
    __syncthreads();
    if (threadIdx.x == 0) {
        unsigned* bar = b.bar; unsigned bx = b.x;
        asm volatile("" : "+s"(bar), "+s"(bx));
        __builtin_amdgcn_s_waitcnt(0);
        unsigned nloc = b.st[0], nx = b.st[1];
        if (nloc == 0u) { xcd_barrier_complete(bar, bx, nloc, nx); b.st[0] = nloc; b.st[1] = nx; }
        const unsigned old = xb_add(&bar[XB_XSUB(bx)], 1u);
        const unsigned gen = old / nloc;
        unsigned role;
        if (old + 1u == (gen + 1u) * nloc) {
            __builtin_amdgcn_fence(__ATOMIC_RELEASE, "agent");
            asm volatile("s_waitcnt vmcnt(0)" ::: "memory");
            const unsigned og = xb_add(&bar[XB_TOP], 1u);
            const unsigned tg = og / nx;
            if (og + 1u == (tg + 1u) * nx) xb_add(&bar[XB_TOPGEN], 1u);
            else XB_SPIN(xb_ld(&bar[XB_TOPGEN]) == tg, bar);
            __builtin_amdgcn_fence(__ATOMIC_ACQUIRE, "agent");
            xb_add(&bar[XB_XGEN(bx)], 1u);
            asm volatile("s_waitcnt vmcnt(0)" ::: "memory");
            role = 2u;
        } else role = ((old - gen * nloc) < nloc / 2u) ? 1u : 0u;
        b.st[2] = role; b.st[3] = gen;
    }
    __syncthreads();
    const unsigned role = b.st[2];
    if (role == 1u) cvt_work(smem, 2);
    if (threadIdx.x == 0 && role != 2u) {
        unsigned* bar = b.bar; unsigned bx = b.x;
        asm volatile("" : "+s"(bar), "+s"(bx));
        const unsigned gen = b.st[3];
        XB_SPIN(xb_ld(&bar[XB_XGEN(bx)]) == gen, bar);
        __builtin_amdgcn_fence(__ATOMIC_ACQUIRE, "agent");
        asm volatile("s_waitcnt vmcnt(0)" ::: "memory");
    }
    __syncthreads();
}

extern __shared__ __attribute__((aligned(16))) unsigned char smem_raw[];
__global__ void __launch_bounds__(NTHR, 2) fwd(Params pk) {
    LAS unsigned char* smem = (LAS unsigned char*)smem_raw;
    if (threadIdx.x < 8) ((LAS unsigned*)(smem + LDS_XBW))[threadIdx.x] = 0u;
    __syncthreads();
    XcdBarrier bar;
    { LOAD_PARAMS(); bar = xcd_barrier_post((unsigned*)(p.ws + WS_CTL) + CW_BAR, (volatile LAS unsigned*)(smem + LDS_XBW)); }
    ph_prologue(smem);
    __syncthreads();
    for (int i = 0; i < DEPTH; ++i) {
        const int j = i >> 1;
        if ((i & 1) == 0) {
            ph_poolfuse(smem, j, i == 0);
            grid_sync(bar, smem, 0);
            ph_poolgemm(smem, j);
            grid_sync(bar, smem, 0);
        } else {
            ph_combine<false>(0);
            grid_sync(bar, smem, i == 1 ? CVT_E1 : CVT_E4);
            ph_qkv(smem, j);
            grid_sync(bar, smem, 0);
            ph_attn(smem);
            grid_sync(bar, smem, 0);
            ph_wo(smem, j);
            grid_sync(bar, smem, 0);
        }
        ph_router(smem, i);
        grid_sync(bar, smem, i == 0 ? CVT_E0 : (i == 1 ? CVT_E2 : (i == 2 ? CVT_E3 : CVT_E5)));
        const MoePlan mp = moe_layer_plan(i);
        for (int st = 0; st < 3; ++st) {
            const int ns2 = 4 * mp.NT - mp.D1;
            if (st == 2 && ns2 <= 0 && i == DEPTH - 1) break;
            ph_gu(smem, i, st, mp);
            ph_down(smem, i, st, mp);
            if (st == 1 && xbid_() >= mp.nB) cvt_work(smem, 1);
            if (st == 2 && xbid_() >= ns2) cvt_work(smem, 3);
            grid_sync(bar, smem, 0);
        }
    }
    ph_combine<true>(1);
}

extern "C" void kernel_launch(void* const* d_in, const int* in_sizes, int n_in, void* d_out, int out_size, void* d_ws, size_t ws_size, hipStream_t stream) {
    if (ws_size < WS_NEED || n_in < 18) return;
    Params p{};
    p.x_in = (const float*)d_in[0]; p.pool_norm = (const float*)d_in[1]; p.pool_w = (const float*)d_in[2]; p.pool_b = (const float*)d_in[3]; p.pool_scale = (const float*)d_in[4];
    p.sb_norm = (const float*)d_in[5]; p.sb_wqkv = (const float*)d_in[6]; p.sb_qg = (const float*)d_in[7]; p.sb_kg = (const float*)d_in[8]; p.sb_wo = (const float*)d_in[9];
    p.moe_norm = (const float*)d_in[10]; p.moe_wg = (const float*)d_in[11]; p.moe_bg = (const float*)d_in[12]; p.moe_wr = (const float*)d_in[13]; p.moe_br = (const float*)d_in[14];
    p.moe_wgate = (const float*)d_in[15]; p.moe_wup = (const float*)d_in[16]; p.moe_wdown = (const float*)d_in[17];
    p.x = (float*)d_out; p.ws = (unsigned char*)d_ws;
    static int grid = 0;
    if (!grid) {
        int dev = 0, cus = 0, per_cu = 0;
        if (hipGetDevice(&dev) != hipSuccess || hipDeviceGetAttribute(&cus, hipDeviceAttributeMultiprocessorCount, dev) != hipSuccess) { grid = -1; return; }
        if (hipFuncSetAttribute((const void*)fwd, hipFuncAttributeMaxDynamicSharedMemorySize, LDS_BYTES) != hipSuccess) { grid = -1; return; }
        if (hipOccupancyMaxActiveBlocksPerMultiprocessor(&per_cu, (const void*)fwd, NTHR, LDS_BYTES) != hipSuccess || per_cu < 1) { (void)hipGetLastError(); }
        grid = cus;
    }
    if (grid <= 0) return;
    (void)hipMemsetAsync((char*)d_ws + WS_CTL, 0, CTL_BYTES, stream);
    hipLaunchKernelGGL(fwd, dim3(grid), dim3(NTHR), LDS_BYTES, stream, p);
}
```

```cpp
#include <hip/hip_runtime.h>
#include <stdint.h>

#define DI __device__ __forceinline__
#define LAS __attribute__((address_space(3)))
typedef unsigned short bf16_t;
typedef short bf16x8 __attribute__((ext_vector_type(8)));
typedef float f32x4 __attribute__((ext_vector_type(4)));
typedef float f32x16 __attribute__((ext_vector_type(16)));
typedef unsigned u32x4 __attribute__((ext_vector_type(4)));
typedef unsigned u32x2 __attribute__((ext_vector_type(2)));

constexpr int T = 16384, DM = 1024, SEQ = 8192, NH = 16, HD = 64, DEPTH = 4, NE = 32, DE = 256;
constexpr float EPS = 1e-6f;
constexpr int NTHR = 512, NWAVE = 8;
constexpr int LIST_CAP = 16384;
constexpr int DUMMY_ROW = 2 * T;

constexpr size_t MiB = 1u << 20;
constexpr size_t WS_CTL = 0, CTL_BYTES = 1 * MiB;
constexpr size_t WS_WQKV = 1 * MiB;
constexpr size_t WS_WO = 13 * MiB;
constexpr size_t WS_WPOOL = 17 * MiB;
constexpr size_t WS_RSTD = 18 * MiB;
constexpr size_t WS_WRH = 19 * MiB, WS_WRL = WS_WRH + 512 * 1024;
constexpr size_t WS_WGU = 20 * MiB;
constexpr size_t WS_WD = 148 * MiB;
constexpr size_t WS_XB = 212 * MiB;
constexpr size_t WS_XB1 = 384 * MiB;
constexpr size_t WS_NEED = 416 * MiB;
constexpr size_t WS_LIST = 244 * MiB;
constexpr size_t WS_Q = 256 * MiB;
constexpr size_t WS_DIFF = WS_Q;
constexpr size_t WS_K = 288 * MiB, WS_V = 320 * MiB, WS_O = 352 * MiB;
constexpr size_t WS_YBUF = 288 * MiB;
constexpr size_t WS_HID = 354 * MiB;
constexpr size_t WS_END = 384 * MiB;
static_assert(WS_V - WS_K == WS_K - WS_Q, "Q, K, V equally spaced");
static_assert(WS_YBUF + (size_t)(2 * T + 1) * DM * 2 <= WS_HID, "ybuf");
static_assert(WS_HID + (size_t)(2 * T + NE * 256) * DE * 2 <= WS_END, "hid");
constexpr int CW_CNT = 1024;

struct Entry { int dst; float rstd; float w; int tok; };

struct Params {
    const float* x_in; const float* pool_norm; const float* pool_w; const float* pool_b; const float* pool_scale;
    const float* sb_norm; const float* sb_wqkv; const float* sb_qg; const float* sb_kg; const float* sb_wo;
    const float* moe_norm; const float* moe_wg; const float* moe_bg; const float* moe_wr; const float* moe_br;
    const float* moe_wgate; const float* moe_wup; const float* moe_wdown;
    float* x;
    unsigned char* ws;
};

typedef const unsigned long long __attribute__((address_space(4)))* KArgPtr;
#define GP(T, i) ((T*)(T __attribute__((address_space(1)))*)q[i])
DI Params load_params() {
    KArgPtr q = (KArgPtr)__builtin_amdgcn_kernarg_segment_ptr(); asm volatile("" : "+s"(q));
    Params p;
    p.x_in = GP(const float, 0); p.pool_norm = GP(const float, 1); p.pool_w = GP(const float, 2); p.pool_b = GP(const float, 3); p.pool_scale = GP(const float, 4);
    p.sb_norm = GP(const float, 5); p.sb_wqkv = GP(const float, 6); p.sb_qg = GP(const float, 7); p.sb_kg = GP(const float, 8); p.sb_wo = GP(const float, 9);
    p.moe_norm = GP(const float, 10); p.moe_wg = GP(const float, 11); p.moe_bg = GP(const float, 12); p.moe_wr = GP(const float, 13); p.moe_br = GP(const float, 14);
    p.moe_wgate = GP(const float, 15); p.moe_wup = GP(const float, 16); p.moe_wdown = GP(const float, 17);
    p.x = GP(float, 18); p.ws = GP(unsigned char, 19);
    return p;
}
#define LOAD_PARAMS() const Params p = load_params()
DI int tid_() { int t = threadIdx.x; asm volatile("" : "+v"(t)); return t; }
DI int bid_() { int b = blockIdx.x; asm volatile("" : "+s"(b)); return b; }
DI int xbid_() { const int b = bid_(), G = gridDim.x; return (G % 8 == 0) ? (b % 8) * (G / 8) + b / 8 : b; }

DI unsigned cvt_pk_bf16(float lo, float hi) { unsigned r; asm volatile("v_cvt_pk_bf16_f32 %0, %1, %2" : "=v"(r) : "v"(lo), "v"(hi)); return r; }
DI float bf_lo(unsigned u) { return __uint_as_float(u << 16); }
DI float bf_hi(unsigned u) { return __uint_as_float(u & 0xffff0000u); }
DI float shflx(float v, int lane, int m) { return __int_as_float(__builtin_amdgcn_ds_bpermute((lane ^ m) << 2, __float_as_int(v))); }
DI float wave_sum(float v, int lane) {
#pragma unroll
    for (int o = 32; o >= 1; o >>= 1) v += shflx(v, lane, o);
    return v;
}
DI int perm32(int rho) { const int n = rho >> 4, i = rho & 15; return 8 * (i >> 2) + 4 * n + (i & 3); }

struct CvtTile { const float* src; bf16_t* dst; const float* scale; int K, N; };
DI CvtTile cvt_locate(const Params& p, int g) {
    int K, N, sdiv = 1; const float* sb; bf16_t* db; const float* scb = nullptr; size_t sms, dms;
    if (g < 384) { K = 1024; N = 3072; sb = p.sb_wqkv; db = (bf16_t*)(p.ws + WS_WQKV); scb = p.sb_norm; sms = (size_t)1024 * 3072; dms = sms; }
    else if ((g -= 384) < 128) { K = 1024; N = 1024; sb = p.sb_wo; db = (bf16_t*)(p.ws + WS_WO); sms = (size_t)1024 * 1024; dms = sms; }
    else if ((g -= 128) < 32) { K = 256; N = 256; sb = p.pool_w; db = (bf16_t*)(p.ws + WS_WPOOL); sms = 65536; dms = 65536; }
    else if ((g -= 32) < 2048) { K = 1024; N = 256; sb = p.moe_wgate; db = (bf16_t*)(p.ws + WS_WGU); scb = p.moe_norm; sdiv = 32; sms = (size_t)1024 * 256; dms = (size_t)512 * 1024; }
    else if ((g -= 2048) < 2048) { K = 1024; N = 256; sb = p.moe_wup; db = (bf16_t*)(p.ws + WS_WGU) + (size_t)256 * 1024; scb = p.moe_norm; sdiv = 32; sms = (size_t)1024 * 256; dms = (size_t)512 * 1024; }
    else { g -= 2048; K = 256; N = 1024; sb = p.moe_wdown; db = (bf16_t*)(p.ws + WS_WD); sms = (size_t)256 * 1024; dms = sms; }
    const int tn = N / 256, per = (K / 64) * tn, mat = g / per, rem = g % per, k0 = (rem / tn) * 64, n0 = (rem % tn) * 256;
    CvtTile t; t.K = K; t.N = N;
    t.src = sb + (size_t)mat * sms + (size_t)k0 * N + n0;
    t.dst = db + (size_t)mat * dms + (size_t)n0 * K + k0;
    t.scale = scb ? scb + (size_t)(mat / sdiv) * K + k0 : nullptr;
    return t;
}
constexpr int CVT_TILES = 384 + 128 + 32 + 2048 + 2048 + 2048;
constexpr int CVT_NONMOE = 384 + 128 + 32, CVT_L0PRO = 1088;
constexpr int CVT_PRO = 32 + CVT_L0PRO;
constexpr int CVT_E0 = 1536 - CVT_L0PRO, CVT_E1 = CVT_E0 + 192 + 64, CVT_E2 = CVT_E1 + 1536, CVT_E3 = CVT_E2 + 1536, CVT_E4 = CVT_E3 + 192 + 64, CVT_E5 = CVT_E4 + 1536;
constexpr int CVT_DTOTAL = CVT_E5;
constexpr int CW_CVT = 512;
DI int cvt_moe_tile(int L, int u) { return CVT_NONMOE + (u / 512) * 2048 + 512 * L + (u % 512); }
DI int cvt_map(int mode, int q) {
    if (mode == 0) return q < 32 ? 512 + q : cvt_moe_tile(0, q - 32);
    if (q < CVT_E0) return cvt_moe_tile(0, CVT_L0PRO + q);
    if (q < CVT_E0 + 192) return q - CVT_E0;
    if (q < CVT_E1) return 384 + (q - CVT_E0 - 192);
    if (q < CVT_E2) return cvt_moe_tile(1, q - CVT_E1);
    if (q < CVT_E3) return cvt_moe_tile(2, q - CVT_E2);
    if (q < CVT_E3 + 192) return 192 + (q - CVT_E3);
    if (q < CVT_E4) return 448 + (q - CVT_E3 - 192);
    return cvt_moe_tile(3, q - CVT_E4);
}
DI void cvt_run(LAS unsigned char* ldsb, const Params& p, int mode, int lo, int hi, int first, int stride, int tid) {
    LAS float* lds = (LAS float*)ldsb;
    const int n4 = tid & 63, kq = tid >> 6;
    f32x4 regs[8]; float scl[8];
    int q = lo + first;
    CvtTile cur{};
    if (q < hi) {
        cur = cvt_locate(p, cvt_map(mode, q));
#pragma unroll
        for (int i = 0; i < 8; ++i) { regs[i] = __builtin_nontemporal_load((const f32x4*)(cur.src + (size_t)(kq + 8 * i) * cur.N + 4 * n4)); scl[i] = cur.scale ? cur.scale[kq + 8 * i] : 1.0f; }
    }
    for (; q < hi; q += stride) {
        __syncthreads();
#pragma unroll
        for (int i = 0; i < 8; ++i) { const int k = kq + 8 * i; *(LAS f32x4*)(lds + k * 256 + ((4 * n4) ^ (4 * ((k >> 3) & 7)))) = regs[i] * scl[i]; }
        __syncthreads();
        const CvtTile now = cur;
        if (q + stride < hi) {
            cur = cvt_locate(p, cvt_map(mode, q + stride));
#pragma unroll
            for (int i = 0; i < 8; ++i) { regs[i] = __builtin_nontemporal_load((const f32x4*)(cur.src + (size_t)(kq + 8 * i) * cur.N + 4 * n4)); scl[i] = cur.scale ? cur.scale[kq + 8 * i] : 1.0f; }
        }
#pragma unroll
        for (int it = 0; it < 4; ++it) {
            const int qq = tid + 512 * it, ko = qq & 7, n = qq >> 3;
            float v[8];
#pragma unroll
            for (int j = 0; j < 8; ++j) v[j] = lds[(8 * ko + j) * 256 + (n ^ (4 * ko))];
            u32x4 w; w[0] = cvt_pk_bf16(v[0], v[1]); w[1] = cvt_pk_bf16(v[2], v[3]); w[2] = cvt_pk_bf16(v[4], v[5]); w[3] = cvt_pk_bf16(v[6], v[7]);
            __builtin_nontemporal_store(w, (u32x4*)(now.dst + (size_t)n * now.K + 8 * ko));
        }
    }
    __syncthreads();
}
DI void ph_prologue(LAS unsigned char* ldsb) {
    LOAD_PARAMS();
    const int tid = tid_(), bid = bid_();
    cvt_run(ldsb, p, 0, 0, CVT_PRO, bid, gridDim.x, tid);
    bf16_t* wh = (bf16_t*)(p.ws + WS_WRH); bf16_t* wl = (bf16_t*)(p.ws + WS_WRL);
    for (int idx = bid * NTHR + tid; idx < DEPTH * 48 * DM; idx += gridDim.x * NTHR) {
        const int l = idx / (48 * DM), n = (idx / DM) % 48, k = idx % DM;
        float v = 0.f;
        if (n < 4) v = p.moe_wg[((size_t)l * DM + k) * 4 + n]; else if (n < 36) v = p.moe_wr[((size_t)l * DM + k) * 32 + (n - 4)];
        v *= p.moe_norm[l * DM + k];
        const unsigned h = cvt_pk_bf16(v, 0.f), lo = cvt_pk_bf16(v - bf_lo(h), 0.f);
        wh[idx] = (bf16_t)(h & 0xffffu); wl[idx] = (bf16_t)(lo & 0xffffu);
    }
}

DI void unpack8(const u32x4 u, float (&f)[8]) {
#pragma unroll
    for (int i = 0; i < 4; ++i) { f[2 * i] = bf_lo(u[i]); f[2 * i + 1] = bf_hi(u[i]); }
}
template <bool FINAL>
DI void ph_combine(int src_buf) {
    LOAD_PARAMS();
    const int tid = tid_(), bid = bid_(), wid = tid >> 6, lane = tid & 63;
    const bf16_t* xs = (const bf16_t*)(p.ws + (src_buf ? WS_XB1 : WS_XB));
    bf16_t* xd = (bf16_t*)(p.ws + (src_buf ? WS_XB : WS_XB1));
    const bf16_t* yb = (const bf16_t*)(p.ws + WS_YBUF);
    float* rstd = (float*)(p.ws + WS_RSTD);
    for (int t = bid * NWAVE + wid; t < T; t += gridDim.x * NWAVE) {
        float ss = 0.f;
#pragma unroll
        for (int i = 0; i < 2; ++i) {
            const size_t o = (size_t)t * DM + lane * 8 + 512 * i;
            float a[8], b[8], c[8];
            unpack8(*(const u32x4*)(xs + o), a); unpack8(*(const u32x4*)(yb + o), b); unpack8(*(const u32x4*)(yb + (size_t)T * DM + o), c);
#pragma unroll
            for (int e = 0; e < 8; ++e) a[e] += b[e] + c[e];
            if (FINAL) {
                __builtin_nontemporal_store((f32x4){a[0], a[1], a[2], a[3]}, (f32x4*)(p.x + o)); __builtin_nontemporal_store((f32x4){a[4], a[5], a[6], a[7]}, (f32x4*)(p.x + o + 4));
            } else {
                u32x4 w; w[0] = cvt_pk_bf16(a[0], a[1]); w[1] = cvt_pk_bf16(a[2], a[3]); w[2] = cvt_pk_bf16(a[4], a[5]); w[3] = cvt_pk_bf16(a[6], a[7]);
                *(u32x4*)(xd + o) = w;
                float r[8]; unpack8(w, r);
#pragma unroll
                for (int e = 0; e < 8; ++e) ss += r[e] * r[e];
            }
        }
        if (!FINAL) { ss = wave_sum(ss, lane); if (lane == 0) rstd[t] = rsqrtf(ss * (1.0f / DM) + EPS); }
    }
}

constexpr int PF_ROWS = 47, PF_TOK = 32;
DI void ph_poolfuse(LAS unsigned char* ldsb, int j, bool first) {
    LOAD_PARAMS();
    const int tid = tid_(), bid = bid_(), wid = tid >> 6, lane = tid & 63;
    const bf16_t* xs = (const bf16_t*)(p.ws + WS_XB1);
    bf16_t* xd = (bf16_t*)(p.ws + WS_XB);
    const bf16_t* yb = (const bf16_t*)(p.ws + WS_YBUF);
    const float* gain = p.pool_norm + j * DM;
    bf16_t* diff = (bf16_t*)(p.ws + WS_DIFF);
    LAS unsigned char* ht = ldsb;
    for (int tix = 0; tix < 2 * ((T / (2 * PF_TOK) - bid + (int)gridDim.x - 1) / (int)gridDim.x); ++tix) {
        const int tile = 2 * (bid + (tix >> 1) * (int)gridDim.x) + (tix & 1);
        const int t0 = tile * PF_TOK, s0 = t0 & (SEQ - 1);
        const bool reuse = (tix & 1) != 0;
        if (reuse) {
            for (int q = tid; q < 15 * 128; q += NTHR) { const int r = q >> 7, c = (q & 127) * 16; *(LAS u32x4*)(ht + r * 2048 + c) = *(const LAS u32x4*)(ht + (32 + r) * 2048 + c); }
            __syncthreads();
        }
        for (int rr = (reuse ? 15 : 0) + wid; rr < PF_ROWS; rr += NWAVE) {
            const int t = t0 - 15 + rr;
            if (s0 == 0 && rr < 15) {
#pragma unroll
                for (int i = 0; i < 2; ++i) *(LAS u32x4*)(ht + rr * 2048 + (lane * 8 + 512 * i) * 2) = (u32x4){0u, 0u, 0u, 0u};
                continue;
            }
            float v[2][8]; u32x4 w[2]; float ss = 0.f;
#pragma unroll
            for (int i = 0; i < 2; ++i) {
                const size_t o = (size_t)t * DM + lane * 8 + 512 * i;
                if (first) {
                    const f32x4 a = *(const f32x4*)(p.x_in + o), b = *(const f32x4*)(p.x_in + o + 4);
#pragma unroll
                    for (int e = 0; e < 4; ++e) { v[i][e] = a[e]; v[i][4 + e] = b[e]; }
                } else {
                    float b[8], c[8];
                    unpack8(*(const u32x4*)(xs + o), v[i]); unpack8(*(const u32x4*)(yb + o), b); unpack8(*(const u32x4*)(yb + (size_t)T * DM + o), c);
#pragma unroll
                    for (int e = 0; e < 8; ++e) v[i][e] += b[e] + c[e];
                }
                w[i][0] = cvt_pk_bf16(v[i][0], v[i][1]); w[i][1] = cvt_pk_bf16(v[i][2], v[i][3]); w[i][2] = cvt_pk_bf16(v[i][4], v[i][5]); w[i][3] = cvt_pk_bf16(v[i][6], v[i][7]);
                if (rr >= 15) *(u32x4*)(xd + o) = w[i];
                unpack8(w[i], v[i]);
#pragma unroll
                for (int e = 0; e < 8; ++e) ss += v[i][e] * v[i][e];
            }
            ss = wave_sum(ss, lane);
            const float rs = rsqrtf(ss * (1.0f / DM) + EPS);
#pragma unroll
            for (int i = 0; i < 2; ++i) {
                u32x4 hw; hw[0] = cvt_pk_bf16(v[i][0] * rs, v[i][1] * rs); hw[1] = cvt_pk_bf16(v[i][2] * rs, v[i][3] * rs); hw[2] = cvt_pk_bf16(v[i][4] * rs, v[i][5] * rs); hw[3] = cvt_pk_bf16(v[i][6] * rs, v[i][7] * rs);
                *(LAS u32x4*)(ht + rr * 2048 + (lane * 8 + 512 * i) * 2) = hw;
            }
        }
        __syncthreads();
        {
            const int c = 2 * tid, win = 2 << (c >> 8);
            const float g0 = gain[c], g1 = gain[c + 1];
            float S0 = 0.f, S1 = 0.f;
            const LAS unsigned char* col = ht + c * 2;
#pragma unroll 4
            for (int rr = 0; rr < PF_ROWS; ++rr) {
                const unsigned hv = *(const LAS unsigned*)(col + rr * 2048);
                const float h0 = bf_lo(hv), h1 = bf_hi(hv);
                S0 += h0; S1 += h1;
                if (rr >= win) { const unsigned ov = *(const LAS unsigned*)(col + (rr - win) * 2048); S0 -= bf_lo(ov); S1 -= bf_hi(ov); }
                if (rr >= 15) {
                    const int s = s0 + rr - 15;
                    const float inv = 1.0f / (float)((s + 1 < win) ? s + 1 : win);
                    *(unsigned*)(diff + (size_t)(t0 + rr - 15) * DM + c) = cvt_pk_bf16((S0 * inv - h0) * g0, (S1 * inv - h1) * g1);
                }
            }
        }
        __syncthreads();
    }
}

struct Unit { const bf16_t* A; const bf16_t* B; int pm, pn, e, nvalid, row0, lbase; };
template <int LDA_, int LDB_, int K_, int BH_, bool HEADMAP_> struct GCfg { static constexpr int LDA = LDA_, LDB = LDB_, K = K_, BH = BH_; static constexpr bool HEADMAP = HEADMAP_; };

constexpr int BK = 64, HTB = 128 * BK * 2  , STAGE_BYTES = 8 * HTB;
DI int lds_byte(int r, int c) { const int st = (r >> 4) * 2 + (c >> 5), rr = r & 15, cc = c & 31, ob = rr * 64 + cc * 2; return st * 1024 + (ob ^ (((ob >> 9) & 1) << 5)); }
DI void stage_rc(int b, int& R, int& C) { const int st = b / 1024, sb = b % 1024, swz = sb ^ (((sb >> 9) & 1) << 5); R = (st >> 1) * 16 + swz / 64; C = (st & 1) * 32 + (swz % 64) / 2; }

template <class Cfg, class Sched, class Epi>
DI void gemm_phase(LAS unsigned char* lds, const Sched& S, const Epi& E) {
    const int tid = tid_(), wid = __builtin_amdgcn_readfirstlane(tid >> 6), lane = tid & 63, wr = wid >> 2, wc = wid & 3, fr = lane & 15, fq = lane >> 4;
    constexpr int nt = Cfg::K / BK;
    static_assert(Cfg::K % 128 == 0 && Cfg::K >= 256, "K");
    unsigned voffA[2][2], voffB[2];
    int R0, C0, R1, C1; stage_rc(tid * 16, R0, C0); stage_rc(tid * 16 + 8192, R1, C1);
    voffB[0] = (unsigned)(((Cfg::HEADMAP ? 64 * (R0 >> 5) : (R0 & ~31)) + perm32(R0 & 31)) * Cfg::LDB + C0) * 2u;
    voffB[1] = (unsigned)(((Cfg::HEADMAP ? 64 * (R1 >> 5) : (R1 & ~31)) + perm32(R1 & 31)) * Cfg::LDB + C1) * 2u;
    constexpr size_t kstep = (size_t)(BK * 2);
    constexpr size_t bhstep = (size_t)Cfg::BH * Cfg::LDB * 2;
    const unsigned ldsw = (unsigned)wid * 1024u;
    const int aoff = lds_byte(wr * 64 + fr, fq * 8), boff = lds_byte(wc * 32 + fr, fq * 8);
#define PG8_SA(b, h) (((b) * 2 + (h)) * HTB)
#define PG8_SB(b, h) ((4 + (b) * 2 + (h)) * HTB)
#define PG8_STAGE(bufoff, gbase, voff) do { _Pragma("unroll") for (int _i = 0; _i < 2; ++_i) \
        __builtin_amdgcn_global_load_lds((const unsigned*)((const char*)(gbase) + (voff)[_i]), (LAS unsigned*)(lds + (bufoff) + ldsw + _i * 8192), 16, 0, 0); } while (0)
#define PG8_LDA(dst, b, h) do { _Pragma("unroll") for (int m = 0; m < 4; ++m) _Pragma("unroll") for (int k = 0; k < 2; ++k) dst[m][k] = *(const LAS bf16x8*)(lds + PG8_SA(b, h) + aoff + m * 2048 + k * 1024); } while (0)
#define PG8_LDB(dst, b, h) do { _Pragma("unroll") for (int n = 0; n < 2; ++n) _Pragma("unroll") for (int k = 0; k < 2; ++k) dst[n][k] = *(const LAS bf16x8*)(lds + PG8_SB(b, h) + boff + n * 2048 + k * 1024); } while (0)
#define PG8_MMA(ai, bj, At, Bt) do { __builtin_amdgcn_s_setprio(1); _Pragma("unroll") for (int m = 0; m < 4; ++m) _Pragma("unroll") for (int n = 0; n < 2; ++n) _Pragma("unroll") for (int k = 0; k < 2; ++k) \
        acc[ai][bj][m][n] = __builtin_amdgcn_mfma_f32_16x16x32_bf16(Bt[n][k], At[m][k], acc[ai][bj][m][n], 0, 0, 0); __builtin_amdgcn_s_setprio(0); } while (0)
#define PG8_WAIT_V(n) asm volatile("s_waitcnt vmcnt(" #n ")" ::: "memory")
#define PG8_WAIT_L(n) asm volatile("s_waitcnt lgkmcnt(" #n ")" ::: "memory")
#define PG8_BAR __builtin_amdgcn_s_barrier()
#define PG8_SCHED __builtin_amdgcn_sched_barrier(0)
#define PG8_AROWS(uidx, un) do { voffA[0][0] = (unsigned)S.arow(uidx, un, R0) * (unsigned)(Cfg::LDA * 2) + (unsigned)(C0 * 2); voffA[0][1] = (unsigned)S.arow(uidx, un, R1) * (unsigned)(Cfg::LDA * 2) + (unsigned)(C1 * 2); \
        voffA[1][0] = (unsigned)S.arow(uidx, un, 128 + R0) * (unsigned)(Cfg::LDA * 2) + (unsigned)(C0 * 2); voffA[1][1] = (unsigned)S.arow(uidx, un, 128 + R1) * (unsigned)(Cfg::LDA * 2) + (unsigned)(C1 * 2); } while (0)
    Unit cur, nxt; int ui = 0;
    if (!S.next(0, cur)) return;
    f32x4 acc[2][2][4][2];
#pragma unroll
    for (int a = 0; a < 2; ++a)
#pragma unroll
        for (int b = 0; b < 2; ++b)
#pragma unroll
            for (int m = 0; m < 4; ++m)
#pragma unroll
                for (int n = 0; n < 2; ++n) acc[a][b][m][n] = (f32x4){0.f, 0.f, 0.f, 0.f};
    bf16x8 At[4][2], B0[2][2], B1[2][2];
    PG8_AROWS(0, cur);
    const char* cA = (const char*)cur.A; const char* cB = (const char*)cur.B;
    PG8_STAGE(PG8_SB(0, 0), cB, voffB); PG8_STAGE(PG8_SB(0, 1), cB + bhstep, voffB); PG8_STAGE(PG8_SA(0, 0), cA, voffA[0]); PG8_STAGE(PG8_SA(0, 1), cA, voffA[1]);
    if (wr == 1) PG8_BAR;
    PG8_WAIT_V(2); PG8_BAR;
    PG8_STAGE(PG8_SB(1, 0), cB + kstep, voffB); PG8_STAGE(PG8_SA(1, 0), cA + kstep, voffA[0]); PG8_STAGE(PG8_SB(1, 1), cB + bhstep + kstep, voffB);
    PG8_WAIT_V(6); PG8_BAR;
    for (;;) {
        const bool has_next = S.next(ui + 1, nxt);
        const char* nA = has_next ? (const char*)nxt.A : cA; const char* nB = has_next ? (const char*)nxt.B : cB;
#pragma unroll 1
        for (int t = 0; t < nt; t += 2) {
            const bool last = (t == nt - 2);
            const char* a1 = cA + (size_t)(t + 1) * kstep;
            const char* a2 = last ? nA : cA + (size_t)(t + 2) * kstep; const char* b2 = last ? nB : cB + (size_t)(t + 2) * kstep;
            const char* a3 = a2 + kstep; const char* b3 = b2 + kstep;
            PG8_LDB(B0, 0, 0); PG8_LDB(B1, 0, 1); PG8_SCHED; PG8_LDA(At, 0, 0); PG8_STAGE(PG8_SA(1, 1), a1, voffA[1]);
            if (last && has_next) PG8_AROWS(ui + 1, nxt);
            PG8_WAIT_V(8); PG8_WAIT_L(0); PG8_BAR; PG8_MMA(0, 0, At, B0); PG8_MMA(0, 1, At, B1); PG8_BAR; PG8_SCHED;
            PG8_LDA(At, 0, 1); PG8_STAGE(PG8_SB(0, 0), b2, voffB); PG8_STAGE(PG8_SB(0, 1), b2 + bhstep, voffB); PG8_STAGE(PG8_SA(0, 0), a2, voffA[0]);
            PG8_WAIT_V(8); PG8_WAIT_L(0); PG8_BAR; PG8_MMA(1, 0, At, B0); PG8_MMA(1, 1, At, B1); PG8_BAR; PG8_SCHED;
            PG8_LDB(B0, 1, 0); PG8_LDB(B1, 1, 1); PG8_SCHED; PG8_LDA(At, 1, 0); PG8_STAGE(PG8_SA(0, 1), a2, voffA[1]);
            PG8_WAIT_V(8); PG8_WAIT_L(0); PG8_BAR; PG8_MMA(0, 0, At, B0); PG8_MMA(0, 1, At, B1); PG8_BAR; PG8_SCHED;
            PG8_LDA(At, 1, 1); PG8_STAGE(PG8_SB(1, 0), b3, voffB); PG8_STAGE(PG8_SB(1, 1), b3 + bhstep, voffB); PG8_STAGE(PG8_SA(1, 0), a3, voffA[0]);
            PG8_WAIT_V(8); PG8_WAIT_L(0); PG8_BAR; PG8_MMA(1, 0, At, B0); PG8_MMA(1, 1, At, B1); PG8_BAR; PG8_SCHED;
        }
        if (wr == 0) PG8_BAR;
        E(acc, cur, wr, wc, fr, fq);
        if (!has_next) break;
#pragma unroll
        for (int a = 0; a < 2; ++a)
#pragma unroll
            for (int b = 0; b < 2; ++b)
#pragma unroll
                for (int m = 0; m < 4; ++m)
#pragma unroll
                    for (int n = 0; n < 2; ++n) acc[a][b][m][n] = (f32x4){0.f, 0.f, 0.f, 0.f};
        cur = nxt; cA = nA; cB = nB; ++ui;
        if (wr == 1) PG8_BAR;
    }
    PG8_WAIT_V(0);
    PG8_BAR;
#undef PG8_SA
#undef PG8_SB
#undef PG8_STAGE
#undef PG8_LDA
#undef PG8_LDB
#undef PG8_MMA
#undef PG8_WAIT_V
#undef PG8_WAIT_L
#undef PG8_BAR
#undef PG8_SCHED
#undef PG8_AROWS
}

struct SchedPool {
    const bf16_t* diff; const bf16_t* w; int bid;
    DI bool next(int i, Unit& u) const { const int L = i * gridDim.x + bid; if (L >= 256) return false; u.pm = L >> 2; u.pn = L & 3; u.A = diff + 256 * u.pn; u.B = w + (size_t)u.pn * 65536; return true; }
    DI int arow(int, const Unit& u, int r) const { return u.pm * 256 + r; }
};
struct SchedDense {
    const bf16_t* A; const bf16_t* B; int npn, ldb, bid;
    DI bool next(int i, Unit& u) const { const int L = i * gridDim.x + bid; if (L >= 64 * npn) return false; u.pm = L / npn; u.pn = L % npn; u.A = A; u.B = B + (size_t)u.pn * 256 * ldb; return true; }
    DI int arow(int, const Unit& u, int r) const { return u.pm * 256 + r; }
};

struct EpiPool {
    bf16_t* x; const float* pb; const float* ps;
    DI void operator()(const f32x4 (&acc)[2][2][4][2], const Unit& u, int wr, int wc, int fr, int fq) const {
        f32x4 bb[2][2], sc[2][2];
#pragma unroll
        for (int bj = 0; bj < 2; ++bj) {
            const int c = 256 * u.pn + 128 * bj + 32 * wc + 8 * fq;
            bb[bj][0] = *(const f32x4*)(pb + c); bb[bj][1] = *(const f32x4*)(pb + c + 4); sc[bj][0] = *(const f32x4*)(ps + c); sc[bj][1] = *(const f32x4*)(ps + c + 4);
        }
#pragma unroll
        for (int ai = 0; ai < 2; ++ai) {
            u32x4 xin[4][2];
#pragma unroll
            for (int m = 0; m < 4; ++m)
#pragma unroll
                for (int bj = 0; bj < 2; ++bj)
                    xin[m][bj] = *(const u32x4*)(x + (size_t)(u.pm * 256 + 128 * ai + 64 * wr + 16 * m + fr) * DM + 256 * u.pn + 128 * bj + 32 * wc + 8 * fq);
            asm volatile("" ::: "memory");
#pragma unroll
            for (int m = 0; m < 4; ++m) {
                const int t = u.pm * 256 + 128 * ai + 64 * wr + 16 * m + fr;
#pragma unroll
                for (int bj = 0; bj < 2; ++bj) {
                    const int c = 256 * u.pn + 128 * bj + 32 * wc + 8 * fq;
                    float xv[8]; unpack8(xin[m][bj], xv);
                    const f32x4 v0 = (acc[ai][bj][m][0] + bb[bj][0]) * sc[bj][0];
                    const f32x4 v1 = (acc[ai][bj][m][1] + bb[bj][1]) * sc[bj][1];
                    u32x4 w; w[0] = cvt_pk_bf16(xv[0] + v0[0], xv[1] + v0[1]); w[1] = cvt_pk_bf16(xv[2] + v0[2], xv[3] + v0[3]); w[2] = cvt_pk_bf16(xv[4] + v1[0], xv[5] + v1[1]); w[3] = cvt_pk_bf16(xv[6] + v1[2], xv[7] + v1[3]);
                    *(u32x4*)(x + (size_t)t * DM + c) = w;
                }
            }
        }
    }
};
struct EpiWo {
    bf16_t* x;
    DI void operator()(const f32x4 (&acc)[2][2][4][2], const Unit& u, int wr, int wc, int fr, int fq) const {
#pragma unroll
        for (int ai = 0; ai < 2; ++ai) {
            u32x4 xin[4][2];
#pragma unroll
            for (int m = 0; m < 4; ++m)
#pragma unroll
                for (int bj = 0; bj < 2; ++bj)
                    xin[m][bj] = *(const u32x4*)(x + (size_t)(u.pm * 256 + 128 * ai + 64 * wr + 16 * m + fr) * DM + 256 * u.pn + 128 * bj + 32 * wc + 8 * fq);
            asm volatile("" ::: "memory");
#pragma unroll
            for (int m = 0; m < 4; ++m) {
                const int t = u.pm * 256 + 128 * ai + 64 * wr + 16 * m + fr;
#pragma unroll
                for (int bj = 0; bj < 2; ++bj) {
                    const int c = 256 * u.pn + 128 * bj + 32 * wc + 8 * fq;
                    float xv[8]; unpack8(xin[m][bj], xv);
                    const f32x4 v0 = acc[ai][bj][m][0], v1 = acc[ai][bj][m][1];
                    u32x4 w; w[0] = cvt_pk_bf16(xv[0] + v0[0], xv[1] + v0[1]); w[1] = cvt_pk_bf16(xv[2] + v0[2], xv[3] + v0[3]); w[2] = cvt_pk_bf16(xv[4] + v1[0], xv[5] + v1[1]); w[3] = cvt_pk_bf16(xv[6] + v1[2], xv[7] + v1[3]);
                    *(u32x4*)(x + (size_t)t * DM + c) = w;
                }
            }
        }
    }
};
struct EpiQKV {
    bf16_t* q; const float* rstd; const float* qg; const float* kg;
    DI void operator()(const f32x4 (&acc)[2][2][4][2], const Unit& u, int wr, int wc, int fr, int fq) const {
        const int which = u.pn >> 2, head = (u.pn & 3) * 4 + wc;
        bf16_t* out = q + (size_t)which * ((WS_K - WS_Q) / 2);
        const float* gn = which == 0 ? qg : kg;
        const float post = which == 0 ? 0.125f * 1.4426950408889634f : 1.0f;
        f32x4 g[2][2];
#pragma unroll
        for (int bj = 0; bj < 2; ++bj)
#pragma unroll
            for (int n = 0; n < 2; ++n) g[bj][n] = (which < 2) ? *(const f32x4*)(gn + 32 * bj + 8 * fq + 4 * n) * post : (f32x4){1.f, 1.f, 1.f, 1.f};
        float rsv[2][4];
#pragma unroll
        for (int ai = 0; ai < 2; ++ai)
#pragma unroll
            for (int m = 0; m < 4; ++m) rsv[ai][m] = rstd[u.pm * 256 + 128 * ai + 64 * wr + 16 * m + fr];
#pragma unroll
        for (int ai = 0; ai < 2; ++ai)
#pragma unroll
            for (int m = 0; m < 4; ++m) {
                const int t = u.pm * 256 + 128 * ai + 64 * wr + 16 * m + fr;
                const float rs = rsv[ai][m];
                f32x4 v4[2][2]; float ss = 0.f;
#pragma unroll
                for (int bj = 0; bj < 2; ++bj)
#pragma unroll
                    for (int n = 0; n < 2; ++n) { v4[bj][n] = acc[ai][bj][m][n] * rs; const f32x4 s = v4[bj][n] * v4[bj][n]; ss += (s[0] + s[1]) + (s[2] + s[3]); }
                ss += shflx(ss, fr + 16 * fq, 16); ss += shflx(ss, fr + 16 * fq, 32);
                const float r2 = (which < 2) ? rsqrtf(ss * (1.0f / HD) + EPS) : 1.0f;
#pragma unroll
                for (int bj = 0; bj < 2; ++bj) {
                    const f32x4 a = v4[bj][0] * r2 * g[bj][0], b = v4[bj][1] * r2 * g[bj][1];
                    u32x4 w; w[0] = cvt_pk_bf16(a[0], a[1]); w[1] = cvt_pk_bf16(a[2], a[3]); w[2] = cvt_pk_bf16(b[0], b[1]); w[3] = cvt_pk_bf16(b[2], b[3]);
                    *(u32x4*)(out + (size_t)t * DM + head * HD + 32 * bj + 8 * fq) = w;
                }
            }
    }
};

typedef short v4i16_t __attribute__((ext_vector_type(4)));
constexpr int AT_VPITCH = 192;
constexpr int AT_VTILE = 32 * AT_VPITCH;
DI void ph_attn(LAS unsigned char* ldsb) {
    LOAD_PARAMS();
    const int tid = tid_(), bid = bid_(), wid = tid >> 6, lane = tid & 63, l31 = lane & 31, h2 = lane >> 5;
    const bf16_t* Q = (const bf16_t*)(p.ws + WS_Q); const bf16_t* K = (const bf16_t*)(p.ws + WS_K); const bf16_t* V = (const bf16_t*)(p.ws + WS_V);
    bf16_t* O = (bf16_t*)(p.ws + WS_O);
    LAS unsigned char* vl = ldsb + wid * AT_VTILE;
    LAS unsigned char* vw = vl + (lane >> 3) * AT_VPITCH + (lane & 7) * 16;
    const LAS unsigned char* vr = vl + (4 * h2 + ((lane & 15) >> 2)) * AT_VPITCH + (16 * ((lane >> 4) & 1) + 4 * (lane & 3)) * 2;
    for (int it = 0; it < 4 * ((2 * NH * 256 / 32 - bid + (int)gridDim.x - 1) / (int)gridDim.x); ++it) {
        const int chunk = bid + (it >> 2) * gridDim.x, k32 = (it & 3) * 8 + wid;
        const int b = chunk >> 7, h = k32 >> 1, qb = 2 * (chunk & 127) + (k32 & 1);
        const size_t tb = (size_t)b * SEQ;
        const int q0 = qb * 32;
        bf16x8 qf[4];
#pragma unroll
        for (int s = 0; s < 4; ++s) qf[s] = *(const bf16x8*)(Q + (tb + q0 + l31) * DM + h * HD + 16 * s + 8 * h2);
        f32x16 o0, o1;
#pragma unroll
        for (int r = 0; r < 16; ++r) { o0[r] = 0.f; o1[r] = 0.f; }
        float R = 1.f;
        const bf16_t* kp = K + (tb + q0 + l31) * DM + h * HD + 8 * h2;
        const bf16_t* vp = V + (tb + q0 + (lane >> 3)) * DM + h * HD + (lane & 7) * 8;
        bf16x8 kn[4], kq[4]; u32x4 vn[4], vq[4];
#pragma unroll
        for (int s = 0; s < 4; ++s) { kn[s] = *(const bf16x8*)(kp + 16 * s); vn[s] = *(const u32x4*)(vp + (size_t)8 * s * DM); }
        if (qb > 0) {
            kp -= (size_t)32 * DM; vp -= (size_t)32 * DM;
#pragma unroll
            for (int s = 0; s < 4; ++s) { kq[s] = *(const bf16x8*)(kp + 16 * s); vq[s] = *(const u32x4*)(vp + (size_t)8 * s * DM); }
        }
        for (int kt = qb; kt >= 0; --kt) {
            bf16x8 kf[4];
#pragma unroll
            for (int s = 0; s < 4; ++s) { kf[s] = kn[s]; *(LAS u32x4*)(vw + 8 * s * AT_VPITCH) = vn[s]; kn[s] = kq[s]; vn[s] = vq[s]; }
            if (kt > 1) {
                kp -= (size_t)32 * DM; vp -= (size_t)32 * DM;
#pragma unroll
                for (int s = 0; s < 4; ++s) { kq[s] = *(const bf16x8*)(kp + 16 * s); vq[s] = *(const u32x4*)(vp + (size_t)8 * s * DM); }
            }
            f32x16 z;
#pragma unroll
            for (int r = 0; r < 16; ++r) z[r] = 0.f;
#pragma unroll
            for (int s = 0; s < 4; ++s) z = __builtin_amdgcn_mfma_f32_32x32x16_bf16(kf[s], qf[s], z, 0, 0, 0);
            float kp_[16], gs[4], ot[4];
#pragma unroll
            for (int r = 0; r < 16; ++r) kp_[r] = __builtin_amdgcn_rcpf(1.0f + __builtin_amdgcn_exp2f(z[r]));
            if (kt == qb) {
#pragma unroll
                for (int r = 0; r < 16; ++r) { const int kl = (r & 3) + 8 * (r >> 2) + 4 * h2; kp_[r] = (kl < l31) ? kp_[r] : 1.0f; }
            }
#pragma unroll
            for (int bb = 0; bb < 4; ++bb) { gs[bb] = (kp_[4 * bb] * kp_[4 * bb + 1]) * (kp_[4 * bb + 2] * kp_[4 * bb + 3]); ot[bb] = shflx(gs[bb], lane, 32); }
            const float tot_own = (gs[0] * gs[1]) * (gs[2] * gs[3]);
            const float tot_oth = (ot[0] * ot[1]) * (ot[2] * ot[3]);
            float later[4];
            {
                float own_tail = 1.f, oth_tail = 1.f;
#pragma unroll
                for (int bb = 3; bb >= 0; --bb) {
                    later[bb] = own_tail * oth_tail * (h2 == 0 ? ot[bb] : 1.f);
                    own_tail *= gs[bb]; oth_tail *= ot[bb];
                }
            }
            float a[16];
#pragma unroll
            for (int bb = 0; bb < 4; ++bb) {
                const float x3 = R * later[bb];
                const float x2 = x3 * kp_[4 * bb + 3], x1 = x2 * kp_[4 * bb + 2], x0 = x1 * kp_[4 * bb + 1];
                a[4 * bb] = x0 - x0 * kp_[4 * bb]; a[4 * bb + 1] = x1 - x1 * kp_[4 * bb + 1]; a[4 * bb + 2] = x2 - x2 * kp_[4 * bb + 2]; a[4 * bb + 3] = x3 - x3 * kp_[4 * bb + 3];
            }
            R *= (h2 == 0) ? (tot_own * tot_oth) : (tot_oth * tot_own);
#pragma unroll
            for (int s = 0; s < 2; ++s) {
                u32x4 pw;
#pragma unroll
                for (int i = 0; i < 4; ++i) pw[i] = cvt_pk_bf16(a[8 * s + 2 * i], a[8 * s + 2 * i + 1]);
                const bf16x8 pa = __builtin_bit_cast(bf16x8, pw);
#pragma unroll
                for (int db = 0; db < 2; ++db) {
                    const v4i16_t lo4 = __builtin_amdgcn_ds_read_tr16_b64_v4i16((LAS v4i16_t*)(vr + (16 * s) * AT_VPITCH + 64 * db));
                    const v4i16_t hi4 = __builtin_amdgcn_ds_read_tr16_b64_v4i16((LAS v4i16_t*)(vr + (16 * s + 8) * AT_VPITCH + 64 * db));
                    bf16x8 vf; vf[0] = lo4[0]; vf[1] = lo4[1]; vf[2] = lo4[2]; vf[3] = lo4[3]; vf[4] = hi4[0]; vf[5] = hi4[1]; vf[6] = hi4[2]; vf[7] = hi4[3];
                    if (db == 0) o0 = __builtin_amdgcn_mfma_f32_32x32x16_bf16(vf, pa, o0, 0, 0, 0);
                    else o1 = __builtin_amdgcn_mfma_f32_32x32x16_bf16(vf, pa, o1, 0, 0, 0);
                }
            }
            if (__all(R < 1.0e-36f)) break;
        }
#pragma unroll
        for (int db = 0; db < 2; ++db)
#pragma unroll
            for (int rb = 0; rb < 4; ++rb) {
                const f32x16& o = db == 0 ? o0 : o1;
                u32x2 w; w[0] = cvt_pk_bf16(o[4 * rb], o[4 * rb + 1]); w[1] = cvt_pk_bf16(o[4 * rb + 2], o[4 * rb + 3]);
                *(u32x2*)(O + (tb + q0 + l31) * DM + h * HD + 32 * db + 8 * rb + 4 * h2) = w;
            }
    }
}

constexpr int RT_PART = 0;
constexpr int RT_SSQ = RT_PART + 4 * 64 * 52 * 4;
constexpr int RT_LCNT = RT_SSQ + 4 * 64 * 4;
constexpr int RT_GB = RT_LCNT + 128;
DI void ph_router(LAS unsigned char* lds, int li) {
    LOAD_PARAMS();
    const bf16_t* xcur = (const bf16_t*)(p.ws + ((li & 1) ? WS_XB1 : WS_XB));
    const int tid = tid_(), bid = bid_(), wid = tid >> 6, lane = tid & 63, fr = lane & 15, fq = lane >> 4;
    const bf16_t* wh = (const bf16_t*)(p.ws + WS_WRH) + (size_t)li * 48 * DM;
    const bf16_t* wl = (const bf16_t*)(p.ws + WS_WRL) + (size_t)li * 48 * DM;
    const float* bg = p.moe_bg + li * 4;
    const float* br = p.moe_br + li * 32;
    unsigned* cnt = (unsigned*)(p.ws + WS_CTL) + CW_CNT + 32 * li;
    Entry* list = (Entry*)(p.ws + WS_LIST);
    LAS float* part = (LAS float*)(lds + RT_PART); LAS float* ssq = (LAS float*)(lds + RT_SSQ);
    LAS int* lcnt = (LAS int*)(lds + RT_LCNT); LAS int* gb = (LAS int*)(lds + RT_GB);
    const int th = wid & 1, kq = wid >> 1;
    for (int chunk = bid; chunk < T / 64; chunk += gridDim.x) {
        const int t = chunk * 64 + th * 32 + fr;
        const bf16_t* xr = xcur + (size_t)t * DM + kq * 256 + fq * 8;
        const bf16_t* whr = wh + (size_t)fr * DM + kq * 256 + fq * 8;
        const bf16_t* wlr = wl + (size_t)fr * DM + kq * 256 + fq * 8;
        f32x4 acc[2][3]; float ss[2] = {0.f, 0.f};
#pragma unroll
        for (int b = 0; b < 2; ++b)
#pragma unroll
            for (int nb = 0; nb < 3; ++nb) acc[b][nb] = (f32x4){0.f, 0.f, 0.f, 0.f};
#pragma unroll 4
        for (int ks = 0; ks < 8; ++ks) {
            bf16x8 xh[2];
#pragma unroll
            for (int b = 0; b < 2; ++b) {
                const u32x4 xw = *(const u32x4*)(xr + (size_t)b * 16 * DM + ks * 32);
                float xf[8]; unpack8(xw, xf);
#pragma unroll
                for (int e = 0; e < 8; ++e) ss[b] += xf[e] * xf[e];
                xh[b] = __builtin_bit_cast(bf16x8, xw);
            }
#pragma unroll
            for (int nb = 0; nb < 3; ++nb) {
                const bf16x8 wH = *(const bf16x8*)(whr + (size_t)nb * 16 * DM + ks * 32), wL = *(const bf16x8*)(wlr + (size_t)nb * 16 * DM + ks * 32);
#pragma unroll
                for (int b = 0; b < 2; ++b) {
                    acc[b][nb] = __builtin_amdgcn_mfma_f32_16x16x32_bf16(wH, xh[b], acc[b][nb], 0, 0, 0);
                    acc[b][nb] = __builtin_amdgcn_mfma_f32_16x16x32_bf16(wL, xh[b], acc[b][nb], 0, 0, 0);
                }
            }
        }
#pragma unroll
        for (int b = 0; b < 2; ++b) {
            float sv = ss[b]; sv += shflx(sv, lane, 16); sv += shflx(sv, lane, 32);
            const int tl = th * 32 + 16 * b + fr;
#pragma unroll
            for (int nb = 0; nb < 3; ++nb) *(LAS f32x4*)(part + (kq * 64 + tl) * 52 + 16 * nb + 4 * fq) = acc[b][nb];
            if (fq == 0) ssq[kq * 64 + tl] = sv;
        }
        if (tid < 32) lcnt[tid] = 0;
        __syncthreads();
        int ea = 0, eb = 0, la = 0, lb = 0; float w1 = 0.f, w2 = 0.f, rs = 0.f;
        if (tid < 64) {
            rs = rsqrtf(((ssq[tid] + ssq[64 + tid]) + (ssq[128 + tid] + ssq[192 + tid])) * (1.0f / DM) + EPS);
            float lg[36];
#pragma unroll
            for (int q = 0; q < 9; ++q) {
                const f32x4 u0 = *(const LAS f32x4*)(part + tid * 52 + 4 * q), u1 = *(const LAS f32x4*)(part + (64 + tid) * 52 + 4 * q);
                const f32x4 u2 = *(const LAS f32x4*)(part + (128 + tid) * 52 + 4 * q), u3 = *(const LAS f32x4*)(part + (192 + tid) * 52 + 4 * q);
#pragma unroll
                for (int e = 0; e < 4; ++e) lg[4 * q + e] = ((u0[e] + u1[e]) + (u2[e] + u3[e])) * rs;
            }
            float gl[4];
#pragma unroll
            for (int n = 0; n < 4; ++n) gl[n] = lg[n] + bg[n];
            int g = 0; float gm = gl[0];
#pragma unroll
            for (int n = 1; n < 4; ++n) if (gl[n] > gm) { gm = gl[n]; g = n; }
            float den = 0.f;
#pragma unroll
            for (int n = 0; n < 4; ++n) den += __expf(gl[n] - gm);
            const float gprob = 1.0f / den;
            float el[8];
#pragma unroll
            for (int n = 0; n < 8; ++n) {
                float v = 0.f;
#pragma unroll
                for (int gg = 0; gg < 4; ++gg) v = (g == gg) ? lg[4 + 8 * gg + n] + br[8 * gg + n] : v;
                el[n] = v;
            }
            int e1 = 0; float m1 = el[0];
#pragma unroll
            for (int n = 1; n < 8; ++n) if (el[n] > m1) { m1 = el[n]; e1 = n; }
            int e2 = -1; float m2 = -3.0e38f;
#pragma unroll
            for (int n = 0; n < 8; ++n) if (n != e1 && (e2 < 0 || el[n] > m2)) { m2 = el[n]; e2 = n; }
            const float ex = __expf(m2 - m1);
            w1 = gprob / (1.0f + ex); w2 = gprob * ex / (1.0f + ex);
            ea = 8 * g + e1; eb = 8 * g + e2;
            la = __hip_atomic_fetch_add(lcnt + ea, 1, __ATOMIC_RELAXED, __HIP_MEMORY_SCOPE_WORKGROUP);
            lb = __hip_atomic_fetch_add(lcnt + eb, 1, __ATOMIC_RELAXED, __HIP_MEMORY_SCOPE_WORKGROUP);
        }
        __syncthreads();
        if (tid < 32) { const int c = lcnt[tid]; gb[tid] = c ? (int)atomicAdd(&cnt[tid], (unsigned)c) : 0; }
        __syncthreads();
        if (tid < 64) {
            const int tt = chunk * 64 + tid;
            Entry A; A.dst = tt; A.rstd = rs; A.w = w1; A.tok = tt;
            Entry B; B.dst = T + tt; B.rstd = rs; B.w = w2; B.tok = tt;
            list[(size_t)ea * LIST_CAP + gb[ea] + la] = A;
            list[(size_t)eb * LIST_CAP + gb[eb] + lb] = B;
        }
        __syncthreads();
    }
}

constexpr int MOE_MAXU = 4;
constexpr int LDS_ROWTAB = STAGE_BYTES;
constexpr int LDS_EPITAB = LDS_ROWTAB + MOE_MAXU * 1024;
constexpr int LDS_UTAB = LDS_EPITAB + MOE_MAXU * 2048;
constexpr int LDS_XBW = LDS_UTAB + MOE_MAXU * 32;
constexpr int LDS_BYTES = 147456;
static_assert(LDS_XBW + 32 <= LDS_BYTES, "LDS map");
struct SchedMoe {
    LAS unsigned char* lds; const bf16_t* A; const bf16_t* W; bool gather; size_t w_estride; int w_pnrows, ldb;
    DI void build(const unsigned* cnt, const Entry* list, int npn, int lo, int hi, int first, int stride, int tid) {
        LAS int* ut = (LAS int*)(lds + LDS_UTAB); LAS unsigned* rt = (LAS unsigned*)(lds + LDS_ROWTAB);
        const int lane = tid & 63;
        if (tid < 64) {
            const int c = (int)cnt[lane & 31], ntl = (c + 255) >> 8;
            int inc = ntl;
#pragma unroll
            for (int d = 1; d < 32; d <<= 1) { const int v = __builtin_amdgcn_ds_bpermute(((lane - d) & 63) << 2, inc); if ((lane & 31) >= d) inc += v; }
            const int exc = inc - ntl;
#pragma unroll
            for (int i = 0; i < MOE_MAXU; ++i) {
                const int L = lo + first + i * stride, rtile = L / npn, pn = L % npn;
                const bool hit = (first >= 0) && (L < hi) && (lane < 32) && (rtile >= exc) && (rtile < inc);
                const unsigned long long mask = __ballot(hit);
                int found = 0, e = 0, j = 0, nv = 0;
                if (mask) {
                    found = 1; e = __builtin_ctzll(mask);
                    j = rtile - __builtin_amdgcn_readlane(exc, e); nv = __builtin_amdgcn_readlane(c, e) - 256 * j; nv = nv > 256 ? 256 : nv;
                }
                if (lane == 0) { ut[i * 8 + 0] = found; ut[i * 8 + 1] = e; ut[i * 8 + 2] = nv; ut[i * 8 + 3] = 256 * rtile; ut[i * 8 + 4] = e * LIST_CAP + 256 * j; ut[i * 8 + 5] = pn; }
            }
        }
        __syncthreads();
        if (tid < 256) {
#pragma unroll
            for (int i = 0; i < MOE_MAXU; ++i) {
                if (!ut[i * 8]) continue;
                const int nv = ut[i * 8 + 2], lb = ut[i * 8 + 4];
                Entry en; en.dst = DUMMY_ROW; en.rstd = 0.f; en.w = 0.f; en.tok = 0;
                if (tid < nv) en = list[lb + tid];
                LAS float* et = (LAS float*)(lds + LDS_EPITAB) + (i * 256 + tid) * 2;
                if (gather) { rt[i * 256 + tid] = (unsigned)en.tok; et[0] = en.rstd; et[1] = en.w; }
                else { et[0] = __int_as_float(en.dst); et[1] = 0.f; }
            }
        }
        asm volatile("s_waitcnt vmcnt(0) lgkmcnt(0)" ::: "memory");
        __syncthreads();
    }
    DI bool next(int i, Unit& u) const {
        if (i >= MOE_MAXU) return false;
        const LAS int* ut = (const LAS int*)(lds + LDS_UTAB) + i * 8;
        const int found = __builtin_amdgcn_readfirstlane(ut[0]);
        if (!found) return false;
        u.e = __builtin_amdgcn_readfirstlane(ut[1]); u.nvalid = __builtin_amdgcn_readfirstlane(ut[2]); u.row0 = __builtin_amdgcn_readfirstlane(ut[3]);
        u.lbase = i * 256; u.pn = __builtin_amdgcn_readfirstlane(ut[5]); u.pm = u.row0 >> 8;
        u.A = gather ? A : A + (size_t)u.row0 * DE;
        u.B = W + (size_t)u.e * w_estride + (size_t)u.pn * w_pnrows * ldb;
        return true;
    }
    DI int arow(int ui, const Unit&, int r) const { if (!gather) return r; return (int)((const LAS unsigned*)(lds + LDS_ROWTAB))[ui * 256 + r]; }
};
struct EpiGU {
    bf16_t* hid; LAS unsigned char* lds;
    DI void operator()(const f32x4 (&acc)[2][2][4][2], const Unit& u, int wr, int wc, int fr, int fq) const {
        typedef float f32x2 __attribute__((ext_vector_type(2)));
#pragma unroll
        for (int ai = 0; ai < 2; ++ai)
#pragma unroll
            for (int m = 0; m < 4; ++m) {
                const int r = 128 * ai + 64 * wr + 16 * m + fr;
                const f32x2 rw = *(const LAS f32x2*)(lds + LDS_EPITAB + (u.lbase + r) * 8);
                const float rs = rw[0], w = rw[1];
                unsigned pk[4];
#pragma unroll
                for (int n = 0; n < 2; ++n) {
                    float hv[4];
#pragma unroll
                    for (int e = 0; e < 4; ++e) { const float g = acc[ai][0][m][n][e] * rs, up = acc[ai][1][m][n][e] * rs; hv[e] = g * __builtin_amdgcn_rcpf(1.0f + __builtin_amdgcn_exp2f(-1.4426950408889634f * g)) * up * w; }
                    pk[2 * n] = cvt_pk_bf16(hv[0], hv[1]); pk[2 * n + 1] = cvt_pk_bf16(hv[2], hv[3]);
                }
                u32x4 wv; wv[0] = pk[0]; wv[1] = pk[1]; wv[2] = pk[2]; wv[3] = pk[3];
                *(u32x4*)(hid + (size_t)(u.row0 + r) * DE + 128 * u.pn + 32 * wc + 8 * fq) = wv;
            }
    }
};
struct EpiDown {
    bf16_t* yb; LAS unsigned char* lds;
    DI void operator()(const f32x4 (&acc)[2][2][4][2], const Unit& u, int wr, int wc, int fr, int fq) const {
#pragma unroll
        for (int ai = 0; ai < 2; ++ai)
#pragma unroll
            for (int m = 0; m < 4; ++m) {
                const int r = 128 * ai + 64 * wr + 16 * m + fr;
                const int dst = *(const LAS int*)(lds + LDS_EPITAB + (u.lbase + r) * 8);
                if (dst == DUMMY_ROW) continue;
#pragma unroll
                for (int bj = 0; bj < 2; ++bj) {
                    const f32x4 a = acc[ai][bj][m][0], b = acc[ai][bj][m][1];
                    u32x4 w; w[0] = cvt_pk_bf16(a[0], a[1]); w[1] = cvt_pk_bf16(a[2], a[3]); w[2] = cvt_pk_bf16(b[0], b[1]); w[3] = cvt_pk_bf16(b[2], b[3]);
                    *(u32x4*)(yb + (size_t)dst * DM + 256 * u.pn + 128 * bj + 32 * wc + 8 * fq) = w;
                }
            }
    }
};

DI void ph_poolgemm(LAS unsigned char* lds, int j) {
    LOAD_PARAMS();
    SchedPool S; S.bid = xbid_(); S.diff = (const bf16_t*)(p.ws + WS_DIFF); S.w = (const bf16_t*)(p.ws + WS_WPOOL) + (size_t)j * 4 * 65536;
    EpiPool E; E.x = (bf16_t*)(p.ws + WS_XB); E.pb = p.pool_b + j * DM; E.ps = p.pool_scale + j * DM;
    gemm_phase<GCfg<1024, 256, 256, 128, false>>(lds, S, E);
}
DI void ph_qkv(LAS unsigned char* lds, int j) {
    LOAD_PARAMS();
    SchedDense S; S.bid = xbid_(); S.A = (const bf16_t*)(p.ws + WS_XB1); S.B = (const bf16_t*)(p.ws + WS_WQKV) + (size_t)j * 3072 * 1024; S.npn = 12; S.ldb = 1024;
    EpiQKV E; E.q = (bf16_t*)(p.ws + WS_Q); E.rstd = (const float*)(p.ws + WS_RSTD); E.qg = p.sb_qg + j * HD; E.kg = p.sb_kg + j * HD;
    gemm_phase<GCfg<1024, 1024, 1024, 32, true>>(lds, S, E);
}
DI void ph_wo(LAS unsigned char* lds, int j) {
    LOAD_PARAMS();
    SchedDense S; S.bid = xbid_(); S.A = (const bf16_t*)(p.ws + WS_O); S.B = (const bf16_t*)(p.ws + WS_WO) + (size_t)j * 1024 * 1024; S.npn = 4; S.ldb = 1024;
    EpiWo E; E.x = (bf16_t*)(p.ws + WS_XB1);
    gemm_phase<GCfg<1024, 1024, 1024, 128, false>>(lds, S, E);
}
struct MoePlan { int NT, R1, nB, D1; };
DI MoePlan moe_plan(const unsigned* cnt) {
    const int lane = tid_() & 63;
    int nt = ((int)cnt[lane & 31] + 255) >> 8;
#pragma unroll
    for (int o = 1; o < 32; o <<= 1) nt += __builtin_amdgcn_ds_bpermute((lane ^ o) << 2, nt);
    nt = __builtin_amdgcn_readfirstlane(nt);
    MoePlan m; m.NT = nt; const int G = gridDim.x; m.R1 = nt < G / 2 ? nt : G / 2;
    const int late = 2 * (nt - m.R1); m.nB = late < G ? late : G;
    const int cap = 2 * (G - m.nB); m.D1 = 4 * m.R1 < cap ? 4 * m.R1 : cap;
    return m;
}
DI void ph_gu(LAS unsigned char* lds, int li, int stage, const MoePlan m) {
    LOAD_PARAMS();
    const Entry* list = (const Entry*)(p.ws + WS_LIST);
    const unsigned* cnt = (const unsigned*)(p.ws + WS_CTL) + CW_CNT + 32 * li;
    const int bid = xbid_();
    if (stage == 2 || (stage == 1 && bid >= m.nB)) return;
    SchedMoe S; S.lds = lds; S.A = (const bf16_t*)(p.ws + ((li & 1) ? WS_XB1 : WS_XB));
    S.W = (const bf16_t*)(p.ws + WS_WGU) + (size_t)li * NE * 512 * 1024; S.gather = true; S.w_estride = (size_t)512 * 1024; S.w_pnrows = 128; S.ldb = 1024;
    const int lo = stage == 0 ? 0 : 2 * m.R1, hi = stage == 0 ? 2 * m.R1 : 2 * m.NT, G = gridDim.x;
    EpiGU E; E.hid = (bf16_t*)(p.ws + WS_HID); E.lds = lds;
    for (int first = bid; lo + first < hi; first += MOE_MAXU * G) {
        S.build(cnt, list, 2, lo, hi, first, G, tid_());
        gemm_phase<GCfg<1024, 1024, 1024, 256, false>>(lds, S, E);
        __syncthreads();
    }
}
DI void ph_down(LAS unsigned char* lds, int li, int stage, const MoePlan m) {
    LOAD_PARAMS();
    const Entry* list = (const Entry*)(p.ws + WS_LIST);
    const unsigned* cnt = (const unsigned*)(p.ws + WS_CTL) + CW_CNT + 32 * li;
    const int bid = xbid_(), G = gridDim.x;
    if (stage == 0 || (stage == 1 && bid < m.nB)) return;
    SchedMoe S; S.lds = lds; S.A = (const bf16_t*)(p.ws + WS_HID);
    S.W = (const bf16_t*)(p.ws + WS_WD) + (size_t)li * NE * 1024 * 256; S.gather = false; S.w_estride = (size_t)1024 * 256; S.w_pnrows = 256; S.ldb = 256;
    const int lo = stage == 1 ? 0 : m.D1, hi = stage == 1 ? m.D1 : 4 * m.NT, stride = stage == 1 ? G - m.nB : G;
    EpiDown E; E.yb = (bf16_t*)(p.ws + WS_YBUF); E.lds = lds;
    for (int first = stage == 1 ? bid - m.nB : bid; lo + first < hi; first += MOE_MAXU * stride) {
        S.build(cnt, list, 4, lo, hi, first, stride, tid_());
        gemm_phase<GCfg<256, 256, 256, 128, false>>(lds, S, E);
        __syncthreads();
    }
}
DI MoePlan moe_layer_plan(int li) {
    LOAD_PARAMS();
    return moe_plan((const unsigned*)(p.ws + WS_CTL) + CW_CNT + 32 * li);
}

#define XB_TMO      128
#define XB_XCNT(j)  (256  + 64 * (j))
#define XB_XSUB(j)  (1280 + 64 * (j))
#define XB_XGEN(j)  (2304 + 64 * (j))
#define XB_TOP      3328
#define XB_TOPGEN   3392
#define XCD_BAR_WORDS 3456
#define XB_XGENR(j, r) (3456 + 64 * (4 * (j) + (r)))
#define XB_SPIN_CAP (1u << 18)

__device__ __forceinline__ unsigned xb_ld(unsigned* p)              { return __hip_atomic_load(p, __ATOMIC_RELAXED, __HIP_MEMORY_SCOPE_AGENT); }
__device__ __forceinline__ unsigned xb_add(unsigned* p, unsigned v) { return __hip_atomic_fetch_add(p, v, __ATOMIC_RELAXED, __HIP_MEMORY_SCOPE_AGENT); }
__device__ __forceinline__ unsigned xb_xcc_id() { return (unsigned)__builtin_amdgcn_s_getreg((3 << 11) | 20) & 0xFu; }
#define XB_SPIN(cond, bar) do { unsigned _sp = 0; while (cond) { __builtin_amdgcn_s_sleep(1); \
    if ((++_sp & 255u) == 0u) { if (xb_ld(&(bar)[XB_TMO])) break; if (_sp > XB_SPIN_CAP) { atomicAdd(&(bar)[XB_TMO], 1u); break; } } } } while (0)

struct XcdBarrier {
    unsigned* bar; unsigned x;
    volatile LAS unsigned* st;
};

__device__ __forceinline__ XcdBarrier xcd_barrier_post(unsigned* bar, volatile LAS unsigned* st) {
    XcdBarrier b; b.bar = bar; b.x = xb_xcc_id(); b.st = st;
    if (threadIdx.x == 0) (void)xb_add(&bar[XB_XCNT(b.x)], 1u);
    return b;
}
__device__ __forceinline__ void xcd_barrier_complete(unsigned* bar, unsigned x, unsigned& nloc, unsigned& nx) {
    const unsigned G = gridDim.x * gridDim.y * gridDim.z;
    unsigned sum, cnt, mine, sp = 0u;
    for (;;) {
        sum = 0u; cnt = 0u; mine = 0u;
#pragma unroll
        for (unsigned j = 0; j < 16; ++j) { const unsigned c = xb_ld(&bar[XB_XCNT(j)]); sum += c; cnt += (c > 0u) ? 1u : 0u; mine = (j == x) ? c : mine; }
        if (sum == G) break;
        __builtin_amdgcn_s_sleep(1);
        if ((++sp & 255u) == 0u) { if (xb_ld(&bar[XB_TMO])) break; if (sp > XB_SPIN_CAP) { atomicAdd(&bar[XB_TMO], 1u); break; } }
    }
    nloc = mine > 0u ? mine : 1u; nx = cnt > 0u ? cnt : 1u;
}

__device__ __forceinline__ void xcd_barrier(const XcdBarrier& b) {
    asm volatile("s_waitcnt vmcnt(0)" ::: "memory");
    __syncthreads();
    if (threadIdx.x == 0) {
        unsigned* bar = b.bar; unsigned bx = b.x;
        asm volatile("" : "+s"(bar), "+s"(bx));
        __builtin_amdgcn_s_waitcnt(0);
        unsigned nloc = b.st[0], nx = b.st[1];
        if (nloc == 0u) { xcd_barrier_complete(bar, bx, nloc, nx); b.st[0] = nloc; b.st[1] = nx; }
        const unsigned old = xb_add(&bar[XB_XSUB(bx)], 1u);
        const unsigned gen = old / nloc;
        if (old + 1u == (gen + 1u) * nloc) {
            __builtin_amdgcn_fence(__ATOMIC_RELEASE, "agent");
            asm volatile("s_waitcnt vmcnt(0)" ::: "memory");
            const unsigned og = xb_add(&bar[XB_TOP], 1u);
            const unsigned tg = og / nx;
            if (og + 1u == (tg + 1u) * nx) xb_add(&bar[XB_TOPGEN], 1u);
            else XB_SPIN(xb_ld(&bar[XB_TOPGEN]) == tg, bar);
            __builtin_amdgcn_fence(__ATOMIC_ACQUIRE, "agent");
            xb_add(&bar[XB_XGEN(bx)], 1u);
            asm volatile("s_waitcnt vmcnt(0)" ::: "memory");
        } else {
            XB_SPIN(xb_ld(&bar[XB_XGEN(bx)]) == gen, bar);
            __builtin_amdgcn_fence(__ATOMIC_ACQUIRE, "agent");
            asm volatile("s_waitcnt vmcnt(0)" ::: "memory");
        }
    }
    __syncthreads();
}
constexpr int CW_BAR = 4096;

DI int cvt_claim(LAS unsigned char* smem, unsigned* ctl, int n, int tid) {
    volatile LAS unsigned* st = (volatile LAS unsigned*)(smem + LDS_XBW);
    if (tid == 0) { const unsigned d = xb_add(ctl + CW_CVT, (unsigned)n); st[4] = d; st[5] = d + (unsigned)n; }
    __syncthreads();
    const int d = (int)st[4];
    __syncthreads();
    return __builtin_amdgcn_readfirstlane(d);
}
DI void cvt_work(LAS unsigned char* smem, int n) {
    volatile LAS unsigned* st = (volatile LAS unsigned*)(smem + LDS_XBW);
    if (st[5] >= (unsigned)CVT_DTOTAL) return;
    LOAD_PARAMS();
    const int tid = tid_();
    const int d = cvt_claim(smem, (unsigned*)(p.ws + WS_CTL), n, tid);
    if (d < CVT_DTOTAL) cvt_run(smem, p, 1, d, (d + n < CVT_DTOTAL) ? d + n : CVT_DTOTAL, 0, 1, tid);
}
DI void cvt_require(LAS unsigned char* smem, int req) {
    volatile LAS unsigned* st = (volatile LAS unsigned*)(smem + LDS_XBW);
    __syncthreads();
    if (st[5] >= (unsigned)req) return;
    LOAD_PARAMS();
    unsigned* ctl = (unsigned*)(p.ws + WS_CTL);
    const int tid = tid_();
    for (;;) {
        __syncthreads();
        if (tid == 0) { const unsigned c = xb_ld(ctl + CW_CVT); if (c > st[5]) st[5] = c; }
        __syncthreads();
        if (st[5] >= (unsigned)req) break;
        const int d = cvt_claim(smem, ctl, 2, tid);
        if (d < CVT_DTOTAL) cvt_run(smem, p, 1, d, (d + 2 < CVT_DTOTAL) ? d + 2 : CVT_DTOTAL, 0, 1, tid);
    }
}
__device__ __forceinline__ void grid_sync(const XcdBarrier& b, LAS unsigned char* smem, int req) {
    if (req > 0) cvt_require(smem, req);
    asm volatile("s_waitcnt vmcnt(0)" ::: "memory");
    __syncthreads();
    if (threadIdx.x == 0) {
        unsigned* bar = b.bar; unsigned bx = b.x;
        asm volatile("" : "+s"(bar), "+s"(bx));
        __builtin_amdgcn_s_waitcnt(0);
        unsigned nloc = b.st[0], nx = b.st[1];
        if (nloc == 0u) { xcd_barrier_complete(bar, bx, nloc, nx); b.st[0] = nloc; b.st[1] = nx; }
        const unsigned old = xb_add(&bar[XB_XSUB(bx)], 1u);
        const unsigned gen = old / nloc;
        unsigned role;
        if (old + 1u == (gen + 1u) * nloc) {
            __builtin_amdgcn_fence(__ATOMIC_RELEASE, "agent");
            asm volatile("s_waitcnt vmcnt(0)" ::: "memory");
            const unsigned og = xb_add(&bar[XB_TOP], 1u);
            const unsigned tg = og / nx;
            if (og + 1u == (tg + 1u) * nx) xb_add(&bar[XB_TOPGEN], 1u);
            else XB_SPIN(xb_ld(&bar[XB_TOPGEN]) == tg, bar);
            __builtin_amdgcn_fence(__ATOMIC_ACQUIRE, "agent");
#pragma unroll
            for (unsigned r = 0; r < 4u; ++r) xb_add(&bar[XB_XGENR(bx, r)], 1u);
            asm volatile("s_waitcnt vmcnt(0)" ::: "memory");
            role = 2u;
        } else role = ((old - gen * nloc) < nloc / 2u) ? 1u : 0u;
        b.st[2] = role; b.st[3] = gen; b.st[6] = (old - gen * nloc) & 3u;
    }
    __syncthreads();
    const unsigned role = b.st[2];
    if (role == 1u) cvt_work(smem, 2);
    if (threadIdx.x == 0 && role != 2u) {
        unsigned* bar = b.bar; unsigned bx = b.x;
        asm volatile("" : "+s"(bar), "+s"(bx));
        const unsigned gen = b.st[3], rep = b.st[6];
        XB_SPIN(xb_ld(&bar[XB_XGENR(bx, rep)]) == gen, bar);
        __builtin_amdgcn_fence(__ATOMIC_ACQUIRE, "agent");
        asm volatile("s_waitcnt vmcnt(0)" ::: "memory");
    }
    __syncthreads();
}

extern __shared__ __attribute__((aligned(16))) unsigned char smem_raw[];
__global__ void __launch_bounds__(NTHR, 2) fwd(Params pk) {
    LAS unsigned char* smem = (LAS unsigned char*)smem_raw;
    if (threadIdx.x < 8) ((LAS unsigned*)(smem + LDS_XBW))[threadIdx.x] = 0u;
    __syncthreads();
    XcdBarrier bar;
    { LOAD_PARAMS(); bar = xcd_barrier_post((unsigned*)(p.ws + WS_CTL) + CW_BAR, (volatile LAS unsigned*)(smem + LDS_XBW)); }
    ph_prologue(smem);
    __syncthreads();
    for (int i = 0; i < DEPTH; ++i) {
        const int j = i >> 1;
        if ((i & 1) == 0) {
            ph_poolfuse(smem, j, i == 0);
            grid_sync(bar, smem, 0);
            ph_poolgemm(smem, j);
            grid_sync(bar, smem, 0);
        } else {
            ph_combine<false>(0);
            grid_sync(bar, smem, i == 1 ? CVT_E1 : CVT_E4);
            ph_qkv(smem, j);
            grid_sync(bar, smem, 0);
            ph_attn(smem);
            grid_sync(bar, smem, 0);
            ph_wo(smem, j);
            grid_sync(bar, smem, 0);
        }
        ph_router(smem, i);
        grid_sync(bar, smem, i == 0 ? CVT_E0 : (i == 1 ? CVT_E2 : (i == 2 ? CVT_E3 : CVT_E5)));
        const MoePlan mp = moe_layer_plan(i);
        for (int st = 0; st < 3; ++st) {
            const int ns2 = 4 * mp.NT - mp.D1;
            if (st == 2 && ns2 <= 0 && i == DEPTH - 1) break;
            ph_gu(smem, i, st, mp);
            ph_down(smem, i, st, mp);
            if (st == 1 && xbid_() >= mp.nB) cvt_work(smem, 1);
            if (st == 2 && xbid_() >= ns2) cvt_work(smem, 3);
            grid_sync(bar, smem, 0);
        }
    }
    ph_combine<true>(1);
}

extern "C" void kernel_launch(void* const* d_in, const int* in_sizes, int n_in, void* d_out, int out_size, void* d_ws, size_t ws_size, hipStream_t stream) {
    if (ws_size < WS_NEED || n_in < 18) return;
    Params p{};
    p.x_in = (const float*)d_in[0]; p.pool_norm = (const float*)d_in[1]; p.pool_w = (const float*)d_in[2]; p.pool_b = (const float*)d_in[3]; p.pool_scale = (const float*)d_in[4];
    p.sb_norm = (const float*)d_in[5]; p.sb_wqkv = (const float*)d_in[6]; p.sb_qg = (const float*)d_in[7]; p.sb_kg = (const float*)d_in[8]; p.sb_wo = (const float*)d_in[9];
    p.moe_norm = (const float*)d_in[10]; p.moe_wg = (const float*)d_in[11]; p.moe_bg = (const float*)d_in[12]; p.moe_wr = (const float*)d_in[13]; p.moe_br = (const float*)d_in[14];
    p.moe_wgate = (const float*)d_in[15]; p.moe_wup = (const float*)d_in[16]; p.moe_wdown = (const float*)d_in[17];
    p.x = (float*)d_out; p.ws = (unsigned char*)d_ws;
    static int grid = 0;
    if (!grid) {
        int dev = 0, cus = 0, per_cu = 0;
        if (hipGetDevice(&dev) != hipSuccess || hipDeviceGetAttribute(&cus, hipDeviceAttributeMultiprocessorCount, dev) != hipSuccess) { grid = -1; return; }
        if (hipFuncSetAttribute((const void*)fwd, hipFuncAttributeMaxDynamicSharedMemorySize, LDS_BYTES) != hipSuccess) { grid = -1; return; }
        if (hipOccupancyMaxActiveBlocksPerMultiprocessor(&per_cu, (const void*)fwd, NTHR, LDS_BYTES) != hipSuccess || per_cu < 1) { (void)hipGetLastError(); }
        grid = cus;
    }
    if (grid <= 0) return;
    (void)hipMemsetAsync((char*)d_ws + WS_CTL, 0, CTL_BYTES, stream);
    hipLaunchKernelGGL(fwd, dim3(grid), dim3(NTHR), LDS_BYTES, stream, p);
}
```

```cpp
#include <hip/hip_runtime.h>
#include <stdint.h>

#define DI __device__ __forceinline__
#define LAS __attribute__((address_space(3)))
typedef unsigned short bf16_t;
typedef short bf16x8 __attribute__((ext_vector_type(8)));
typedef float f32x4 __attribute__((ext_vector_type(4)));
typedef float f32x16 __attribute__((ext_vector_type(16)));
typedef unsigned u32x4 __attribute__((ext_vector_type(4)));
typedef unsigned u32x2 __attribute__((ext_vector_type(2)));

constexpr int T = 16384, DM = 1024, SEQ = 8192, NH = 16, HD = 64, DEPTH = 4, NE = 32, DE = 256;
constexpr float EPS = 1e-6f;
constexpr int NTHR = 512, NWAVE = 8;
constexpr int LIST_CAP = 16384;
constexpr int DUMMY_ROW = 2 * T;

constexpr size_t MiB = 1u << 20;
constexpr size_t WS_CTL = 0, CTL_BYTES = 1 * MiB;
constexpr size_t WS_WQKV = 1 * MiB;
constexpr size_t WS_WO = 13 * MiB;
constexpr size_t WS_WPOOL = 17 * MiB;
constexpr size_t WS_RSTD = 18 * MiB;
constexpr size_t WS_WRH = 19 * MiB, WS_WRL = WS_WRH + 512 * 1024;
constexpr size_t WS_WGU = 20 * MiB;
constexpr size_t WS_WD = 148 * MiB;
constexpr size_t WS_XB = 212 * MiB;
constexpr size_t WS_XB1 = 384 * MiB;
constexpr size_t WS_NEED = 416 * MiB;
constexpr size_t WS_LIST = 244 * MiB;
constexpr size_t WS_Q = 256 * MiB;
constexpr size_t WS_DIFF = WS_Q;
constexpr size_t WS_K = 288 * MiB, WS_V = 320 * MiB, WS_O = 352 * MiB;
constexpr size_t WS_YBUF = 288 * MiB;
constexpr size_t WS_HID = 354 * MiB;
constexpr size_t WS_END = 384 * MiB;
static_assert(WS_V - WS_K == WS_K - WS_Q, "Q, K, V equally spaced");
static_assert(WS_YBUF + (size_t)(2 * T + 1) * DM * 2 <= WS_HID, "ybuf");
static_assert(WS_HID + (size_t)(2 * T + NE * 256) * DE * 2 <= WS_END, "hid");
constexpr int CW_CNT = 1024;

struct Entry { int dst; float rstd; float w; int tok; };

struct Params {
    const float* x_in; const float* pool_norm; const float* pool_w; const float* pool_b; const float* pool_scale;
    const float* sb_norm; const float* sb_wqkv; const float* sb_qg; const float* sb_kg; const float* sb_wo;
    const float* moe_norm; const float* moe_wg; const float* moe_bg; const float* moe_wr; const float* moe_br;
    const float* moe_wgate; const float* moe_wup; const float* moe_wdown;
    float* x;
    unsigned char* ws;
};

typedef const unsigned long long __attribute__((address_space(4)))* KArgPtr;
#define GP(T, i) ((T*)(T __attribute__((address_space(1)))*)q[i])
DI Params load_params() {
    KArgPtr q = (KArgPtr)__builtin_amdgcn_kernarg_segment_ptr(); asm volatile("" : "+s"(q));
    Params p;
    p.x_in = GP(const float, 0); p.pool_norm = GP(const float, 1); p.pool_w = GP(const float, 2); p.pool_b = GP(const float, 3); p.pool_scale = GP(const float, 4);
    p.sb_norm = GP(const float, 5); p.sb_wqkv = GP(const float, 6); p.sb_qg = GP(const float, 7); p.sb_kg = GP(const float, 8); p.sb_wo = GP(const float, 9);
    p.moe_norm = GP(const float, 10); p.moe_wg = GP(const float, 11); p.moe_bg = GP(const float, 12); p.moe_wr = GP(const float, 13); p.moe_br = GP(const float, 14);
    p.moe_wgate = GP(const float, 15); p.moe_wup = GP(const float, 16); p.moe_wdown = GP(const float, 17);
    p.x = GP(float, 18); p.ws = GP(unsigned char, 19);
    return p;
}
#define LOAD_PARAMS() const Params p = load_params()
DI int tid_() { int t = threadIdx.x; asm volatile("" : "+v"(t)); return t; }
DI int bid_() { int b = blockIdx.x; asm volatile("" : "+s"(b)); return b; }
DI int xbid_() { const int b = bid_(), G = gridDim.x; return (G % 8 == 0) ? (b % 8) * (G / 8) + b / 8 : b; }

DI unsigned cvt_pk_bf16(float lo, float hi) { unsigned r; asm volatile("v_cvt_pk_bf16_f32 %0, %1, %2" : "=v"(r) : "v"(lo), "v"(hi)); return r; }
DI float bf_lo(unsigned u) { return __uint_as_float(u << 16); }
DI float bf_hi(unsigned u) { return __uint_as_float(u & 0xffff0000u); }
DI float shflx(float v, int lane, int m) { return __int_as_float(__builtin_amdgcn_ds_bpermute((lane ^ m) << 2, __float_as_int(v))); }
DI float wave_sum(float v, int lane) {
#pragma unroll
    for (int o = 32; o >= 1; o >>= 1) v += shflx(v, lane, o);
    return v;
}
DI int perm32(int rho) { const int n = rho >> 4, i = rho & 15; return 8 * (i >> 2) + 4 * n + (i & 3); }

struct CvtTile { const float* src; bf16_t* dst; const float* scale; int K, N; };
DI CvtTile cvt_locate(const Params& p, int g) {
    int K, N, sdiv = 1; const float* sb; bf16_t* db; const float* scb = nullptr; size_t sms, dms;
    if (g < 384) { K = 1024; N = 3072; sb = p.sb_wqkv; db = (bf16_t*)(p.ws + WS_WQKV); scb = p.sb_norm; sms = (size_t)1024 * 3072; dms = sms; }
    else if ((g -= 384) < 128) { K = 1024; N = 1024; sb = p.sb_wo; db = (bf16_t*)(p.ws + WS_WO); sms = (size_t)1024 * 1024; dms = sms; }
    else if ((g -= 128) < 32) { K = 256; N = 256; sb = p.pool_w; db = (bf16_t*)(p.ws + WS_WPOOL); sms = 65536; dms = 65536; }
    else if ((g -= 32) < 2048) { K = 1024; N = 256; sb = p.moe_wgate; db = (bf16_t*)(p.ws + WS_WGU); scb = p.moe_norm; sdiv = 32; sms = (size_t)1024 * 256; dms = (size_t)512 * 1024; }
    else if ((g -= 2048) < 2048) { K = 1024; N = 256; sb = p.moe_wup; db = (bf16_t*)(p.ws + WS_WGU) + (size_t)256 * 1024; scb = p.moe_norm; sdiv = 32; sms = (size_t)1024 * 256; dms = (size_t)512 * 1024; }
    else { g -= 2048; K = 256; N = 1024; sb = p.moe_wdown; db = (bf16_t*)(p.ws + WS_WD); sms = (size_t)256 * 1024; dms = sms; }
    const int tn = N / 256, per = (K / 64) * tn, mat = g / per, rem = g % per, k0 = (rem / tn) * 64, n0 = (rem % tn) * 256;
    CvtTile t; t.K = K; t.N = N;
    t.src = sb + (size_t)mat * sms + (size_t)k0 * N + n0;
    t.dst = db + (size_t)mat * dms + (size_t)n0 * K + k0;
    t.scale = scb ? scb + (size_t)(mat / sdiv) * K + k0 : nullptr;
    return t;
}
constexpr int CVT_TILES = 384 + 128 + 32 + 2048 + 2048 + 2048;
constexpr int CVT_NONMOE = 384 + 128 + 32, CVT_L0PRO = 1088;
constexpr int CVT_PRO = 32 + CVT_L0PRO;
constexpr int CVT_E0 = 1536 - CVT_L0PRO, CVT_E1 = CVT_E0 + 192 + 64, CVT_E2 = CVT_E1 + 1536, CVT_E3 = CVT_E2 + 1536, CVT_E4 = CVT_E3 + 192 + 64, CVT_E5 = CVT_E4 + 1536;
constexpr int CVT_DTOTAL = CVT_E5;
constexpr int CW_CVT = 512;
DI int cvt_moe_tile(int L, int u) { return CVT_NONMOE + (u / 512) * 2048 + 512 * L + (u % 512); }
DI int cvt_map(int mode, int q) {
    if (mode == 0) return q < 32 ? 512 + q : cvt_moe_tile(0, q - 32);
    if (q < CVT_E0) return cvt_moe_tile(0, CVT_L0PRO + q);
    if (q < CVT_E0 + 192) return q - CVT_E0;
    if (q < CVT_E1) return 384 + (q - CVT_E0 - 192);
    if (q < CVT_E2) return cvt_moe_tile(1, q - CVT_E1);
    if (q < CVT_E3) return cvt_moe_tile(2, q - CVT_E2);
    if (q < CVT_E3 + 192) return 192 + (q - CVT_E3);
    if (q < CVT_E4) return 448 + (q - CVT_E3 - 192);
    return cvt_moe_tile(3, q - CVT_E4);
}
DI void cvt_run(LAS unsigned char* ldsb, const Params& p, int mode, int lo, int hi, int first, int stride, int tid) {
    LAS float* lds = (LAS float*)ldsb;
    const int n4 = tid & 63, kq = tid >> 6;
    f32x4 regs[8]; float scl[8];
    int q = lo + first;
    CvtTile cur{};
    if (q < hi) {
        cur = cvt_locate(p, cvt_map(mode, q));
#pragma unroll
        for (int i = 0; i < 8; ++i) { regs[i] = __builtin_nontemporal_load((const f32x4*)(cur.src + (size_t)(kq + 8 * i) * cur.N + 4 * n4)); scl[i] = cur.scale ? cur.scale[kq + 8 * i] : 1.0f; }
    }
    for (; q < hi; q += stride) {
        __syncthreads();
#pragma unroll
        for (int i = 0; i < 8; ++i) { const int k = kq + 8 * i; *(LAS f32x4*)(lds + k * 256 + ((4 * n4) ^ (4 * ((k >> 3) & 7)))) = regs[i] * scl[i]; }
        __syncthreads();
        const CvtTile now = cur;
        if (q + stride < hi) {
            cur = cvt_locate(p, cvt_map(mode, q + stride));
#pragma unroll
            for (int i = 0; i < 8; ++i) { regs[i] = __builtin_nontemporal_load((const f32x4*)(cur.src + (size_t)(kq + 8 * i) * cur.N + 4 * n4)); scl[i] = cur.scale ? cur.scale[kq + 8 * i] : 1.0f; }
        }
#pragma unroll
        for (int it = 0; it < 4; ++it) {
            const int qq = tid + 512 * it, ko = qq & 7, n = qq >> 3;
            float v[8];
#pragma unroll
            for (int j = 0; j < 8; ++j) v[j] = lds[(8 * ko + j) * 256 + (n ^ (4 * ko))];
            u32x4 w; w[0] = cvt_pk_bf16(v[0], v[1]); w[1] = cvt_pk_bf16(v[2], v[3]); w[2] = cvt_pk_bf16(v[4], v[5]); w[3] = cvt_pk_bf16(v[6], v[7]);
            __builtin_nontemporal_store(w, (u32x4*)(now.dst + (size_t)n * now.K + 8 * ko));
        }
    }
    __syncthreads();
}
DI void ph_prologue(LAS unsigned char* ldsb) {
    LOAD_PARAMS();
    const int tid = tid_(), bid = bid_();
    cvt_run(ldsb, p, 0, 0, CVT_PRO, bid, gridDim.x, tid);
    bf16_t* wh = (bf16_t*)(p.ws + WS_WRH); bf16_t* wl = (bf16_t*)(p.ws + WS_WRL);
    for (int idx = bid * NTHR + tid; idx < DEPTH * 48 * DM; idx += gridDim.x * NTHR) {
        const int l = idx / (48 * DM), n = (idx / DM) % 48, k = idx % DM;
        float v = 0.f;
        if (n < 4) v = p.moe_wg[((size_t)l * DM + k) * 4 + n]; else if (n < 36) v = p.moe_wr[((size_t)l * DM + k) * 32 + (n - 4)];
        v *= p.moe_norm[l * DM + k];
        const unsigned h = cvt_pk_bf16(v, 0.f), lo = cvt_pk_bf16(v - bf_lo(h), 0.f);
        wh[idx] = (bf16_t)(h & 0xffffu); wl[idx] = (bf16_t)(lo & 0xffffu);
    }
}

DI void unpack8(const u32x4 u, float (&f)[8]) {
#pragma unroll
    for (int i = 0; i < 4; ++i) { f[2 * i] = bf_lo(u[i]); f[2 * i + 1] = bf_hi(u[i]); }
}
template <bool FINAL>
DI void ph_combine(int src_buf) {
    LOAD_PARAMS();
    const int tid = tid_(), bid = bid_(), wid = tid >> 6, lane = tid & 63;
    const bf16_t* xs = (const bf16_t*)(p.ws + (src_buf ? WS_XB1 : WS_XB));
    bf16_t* xd = (bf16_t*)(p.ws + (src_buf ? WS_XB : WS_XB1));
    const bf16_t* yb = (const bf16_t*)(p.ws + WS_YBUF);
    float* rstd = (float*)(p.ws + WS_RSTD);
    for (int t = bid * NWAVE + wid; t < T; t += gridDim.x * NWAVE) {
        float ss = 0.f;
#pragma unroll
        for (int i = 0; i < 2; ++i) {
            const size_t o = (size_t)t * DM + lane * 8 + 512 * i;
            float a[8], b[8], c[8];
            unpack8(*(const u32x4*)(xs + o), a); unpack8(*(const u32x4*)(yb + o), b); unpack8(*(const u32x4*)(yb + (size_t)T * DM + o), c);
#pragma unroll
            for (int e = 0; e < 8; ++e) a[e] += b[e] + c[e];
            if (FINAL) {
                __builtin_nontemporal_store((f32x4){a[0], a[1], a[2], a[3]}, (f32x4*)(p.x + o)); __builtin_nontemporal_store((f32x4){a[4], a[5], a[6], a[7]}, (f32x4*)(p.x + o + 4));
            } else {
                u32x4 w; w[0] = cvt_pk_bf16(a[0], a[1]); w[1] = cvt_pk_bf16(a[2], a[3]); w[2] = cvt_pk_bf16(a[4], a[5]); w[3] = cvt_pk_bf16(a[6], a[7]);
                *(u32x4*)(xd + o) = w;
                float r[8]; unpack8(w, r);
#pragma unroll
                for (int e = 0; e < 8; ++e) ss += r[e] * r[e];
            }
        }
        if (!FINAL) { ss = wave_sum(ss, lane); if (lane == 0) rstd[t] = rsqrtf(ss * (1.0f / DM) + EPS); }
    }
}

constexpr int PF_ROWS = 47, PF_TOK = 32;
DI void ph_poolfuse(LAS unsigned char* ldsb, int j, bool first) {
    LOAD_PARAMS();
    const int tid = tid_(), bid = bid_(), wid = tid >> 6, lane = tid & 63;
    const bf16_t* xs = (const bf16_t*)(p.ws + WS_XB1);
    bf16_t* xd = (bf16_t*)(p.ws + WS_XB);
    const bf16_t* yb = (const bf16_t*)(p.ws + WS_YBUF);
    const float* gain = p.pool_norm + j * DM;
    bf16_t* diff = (bf16_t*)(p.ws + WS_DIFF);
    LAS unsigned char* ht = ldsb;
    for (int tix = 0; tix < 2 * ((T / (2 * PF_TOK) - bid + (int)gridDim.x - 1) / (int)gridDim.x); ++tix) {
        const int tile = 2 * (bid + (tix >> 1) * (int)gridDim.x) + (tix & 1);
        const int t0 = tile * PF_TOK, s0 = t0 & (SEQ - 1);
        const bool reuse = (tix & 1) != 0;
        if (reuse) {
            for (int q = tid; q < 15 * 128; q += NTHR) { const int r = q >> 7, c = (q & 127) * 16; *(LAS u32x4*)(ht + r * 2048 + c) = *(const LAS u32x4*)(ht + (32 + r) * 2048 + c); }
            __syncthreads();
        }
        for (int rr = (reuse ? 15 : 0) + wid; rr < PF_ROWS; rr += NWAVE) {
            const int t = t0 - 15 + rr;
            if (s0 == 0 && rr < 15) {
#pragma unroll
                for (int i = 0; i < 2; ++i) *(LAS u32x4*)(ht + rr * 2048 + (lane * 8 + 512 * i) * 2) = (u32x4){0u, 0u, 0u, 0u};
                continue;
            }
            float v[2][8]; u32x4 w[2]; float ss = 0.f;
#pragma unroll
            for (int i = 0; i < 2; ++i) {
                const size_t o = (size_t)t * DM + lane * 8 + 512 * i;
                if (first) {
                    const f32x4 a = *(const f32x4*)(p.x_in + o), b = *(const f32x4*)(p.x_in + o + 4);
#pragma unroll
                    for (int e = 0; e < 4; ++e) { v[i][e] = a[e]; v[i][4 + e] = b[e]; }
                } else {
                    float b[8], c[8];
                    unpack8(*(const u32x4*)(xs + o), v[i]); unpack8(*(const u32x4*)(yb + o), b); unpack8(*(const u32x4*)(yb + (size_t)T * DM + o), c);
#pragma unroll
                    for (int e = 0; e < 8; ++e) v[i][e] += b[e] + c[e];
                }
                w[i][0] = cvt_pk_bf16(v[i][0], v[i][1]); w[i][1] = cvt_pk_bf16(v[i][2], v[i][3]); w[i][2] = cvt_pk_bf16(v[i][4], v[i][5]); w[i][3] = cvt_pk_bf16(v[i][6], v[i][7]);
                if (rr >= 15) *(u32x4*)(xd + o) = w[i];
                unpack8(w[i], v[i]);
#pragma unroll
                for (int e = 0; e < 8; ++e) ss += v[i][e] * v[i][e];
            }
            ss = wave_sum(ss, lane);
            const float rs = rsqrtf(ss * (1.0f / DM) + EPS);
#pragma unroll
            for (int i = 0; i < 2; ++i) {
                u32x4 hw; hw[0] = cvt_pk_bf16(v[i][0] * rs, v[i][1] * rs); hw[1] = cvt_pk_bf16(v[i][2] * rs, v[i][3] * rs); hw[2] = cvt_pk_bf16(v[i][4] * rs, v[i][5] * rs); hw[3] = cvt_pk_bf16(v[i][6] * rs, v[i][7] * rs);
                *(LAS u32x4*)(ht + rr * 2048 + (lane * 8 + 512 * i) * 2) = hw;
            }
        }
        __syncthreads();
        {
            const int c = 2 * tid, win = 2 << (c >> 8);
            const float g0 = gain[c], g1 = gain[c + 1];
            float S0 = 0.f, S1 = 0.f;
            const LAS unsigned char* col = ht + c * 2;
#pragma unroll 4
            for (int rr = 0; rr < PF_ROWS; ++rr) {
                const unsigned hv = *(const LAS unsigned*)(col + rr * 2048);
                const float h0 = bf_lo(hv), h1 = bf_hi(hv);
                S0 += h0; S1 += h1;
                if (rr >= win) { const unsigned ov = *(const LAS unsigned*)(col + (rr - win) * 2048); S0 -= bf_lo(ov); S1 -= bf_hi(ov); }
                if (rr >= 15) {
                    const int s = s0 + rr - 15;
                    const float inv = 1.0f / (float)((s + 1 < win) ? s + 1 : win);
                    *(unsigned*)(diff + (size_t)(t0 + rr - 15) * DM + c) = cvt_pk_bf16((S0 * inv - h0) * g0, (S1 * inv - h1) * g1);
                }
            }
        }
        __syncthreads();
    }
}

struct Unit { const bf16_t* A; const bf16_t* B; int pm, pn, e, nvalid, row0, lbase; };
template <int LDA_, int LDB_, int K_, int BH_, bool HEADMAP_> struct GCfg { static constexpr int LDA = LDA_, LDB = LDB_, K = K_, BH = BH_; static constexpr bool HEADMAP = HEADMAP_; };

constexpr int BK = 64, HTB = 128 * BK * 2  , STAGE_BYTES = 8 * HTB;
DI int lds_byte(int r, int c) { const int st = (r >> 4) * 2 + (c >> 5), rr = r & 15, cc = c & 31, ob = rr * 64 + cc * 2; return st * 1024 + (ob ^ (((ob >> 9) & 1) << 5)); }
DI void stage_rc(int b, int& R, int& C) { const int st = b / 1024, sb = b % 1024, swz = sb ^ (((sb >> 9) & 1) << 5); R = (st >> 1) * 16 + swz / 64; C = (st & 1) * 32 + (swz % 64) / 2; }

template <class Cfg, class Sched, class Epi>
DI void gemm_phase(LAS unsigned char* lds, const Sched& S, const Epi& E) {
    const int tid = tid_(), wid = __builtin_amdgcn_readfirstlane(tid >> 6), lane = tid & 63, wr = wid >> 2, wc = wid & 3, fr = lane & 15, fq = lane >> 4;
    constexpr int nt = Cfg::K / BK;
    static_assert(Cfg::K % 128 == 0 && Cfg::K >= 256, "K");
    unsigned voffA[2][2], voffB[2];
    int R0, C0, R1, C1; stage_rc(tid * 16, R0, C0); stage_rc(tid * 16 + 8192, R1, C1);
    voffB[0] = (unsigned)(((Cfg::HEADMAP ? 64 * (R0 >> 5) : (R0 & ~31)) + perm32(R0 & 31)) * Cfg::LDB + C0) * 2u;
    voffB[1] = (unsigned)(((Cfg::HEADMAP ? 64 * (R1 >> 5) : (R1 & ~31)) + perm32(R1 & 31)) * Cfg::LDB + C1) * 2u;
    constexpr size_t kstep = (size_t)(BK * 2);
    constexpr size_t bhstep = (size_t)Cfg::BH * Cfg::LDB * 2;
    const unsigned ldsw = (unsigned)wid * 1024u;
    const int aoff = lds_byte(wr * 64 + fr, fq * 8), boff = lds_byte(wc * 32 + fr, fq * 8);
#define PG8_SA(b, h) (((b) * 2 + (h)) * HTB)
#define PG8_SB(b, h) ((4 + (b) * 2 + (h)) * HTB)
#define PG8_STAGE(bufoff, gbase, voff) do { _Pragma("unroll") for (int _i = 0; _i < 2; ++_i) \
        __builtin_amdgcn_global_load_lds((const unsigned*)((const char*)(gbase) + (voff)[_i]), (LAS unsigned*)(lds + (bufoff) + ldsw + _i * 8192), 16, 0, 0); } while (0)
#define PG8_LDA(dst, b, h) do { _Pragma("unroll") for (int m = 0; m < 4; ++m) _Pragma("unroll") for (int k = 0; k < 2; ++k) dst[m][k] = *(const LAS bf16x8*)(lds + PG8_SA(b, h) + aoff + m * 2048 + k * 1024); } while (0)
#define PG8_LDB(dst, b, h) do { _Pragma("unroll") for (int n = 0; n < 2; ++n) _Pragma("unroll") for (int k = 0; k < 2; ++k) dst[n][k] = *(const LAS bf16x8*)(lds + PG8_SB(b, h) + boff + n * 2048 + k * 1024); } while (0)
#define PG8_MMA(ai, bj, At, Bt) do { __builtin_amdgcn_s_setprio(1); _Pragma("unroll") for (int m = 0; m < 4; ++m) _Pragma("unroll") for (int n = 0; n < 2; ++n) _Pragma("unroll") for (int k = 0; k < 2; ++k) \
        acc[ai][bj][m][n] = __builtin_amdgcn_mfma_f32_16x16x32_bf16(Bt[n][k], At[m][k], acc[ai][bj][m][n], 0, 0, 0); __builtin_amdgcn_s_setprio(0); } while (0)
#define PG8_WAIT_V(n) asm volatile("s_waitcnt vmcnt(" #n ")" ::: "memory")
#define PG8_WAIT_L(n) asm volatile("s_waitcnt lgkmcnt(" #n ")" ::: "memory")
#define PG8_BAR __builtin_amdgcn_s_barrier()
#define PG8_SCHED __builtin_amdgcn_sched_barrier(0)
#define PG8_AROWS(uidx, un) do { voffA[0][0] = (unsigned)S.arow(uidx, un, R0) * (unsigned)(Cfg::LDA * 2) + (unsigned)(C0 * 2); voffA[0][1] = (unsigned)S.arow(uidx, un, R1) * (unsigned)(Cfg::LDA * 2) + (unsigned)(C1 * 2); \
        voffA[1][0] = (unsigned)S.arow(uidx, un, 128 + R0) * (unsigned)(Cfg::LDA * 2) + (unsigned)(C0 * 2); voffA[1][1] = (unsigned)S.arow(uidx, un, 128 + R1) * (unsigned)(Cfg::LDA * 2) + (unsigned)(C1 * 2); } while (0)
    Unit cur, nxt; int ui = 0;
    if (!S.next(0, cur)) return;
    f32x4 acc[2][2][4][2];
#pragma unroll
    for (int a = 0; a < 2; ++a)
#pragma unroll
        for (int b = 0; b < 2; ++b)
#pragma unroll
            for (int m = 0; m < 4; ++m)
#pragma unroll
                for (int n = 0; n < 2; ++n) acc[a][b][m][n] = (f32x4){0.f, 0.f, 0.f, 0.f};
    bf16x8 At[4][2], B0[2][2], B1[2][2];
    PG8_AROWS(0, cur);
    const char* cA = (const char*)cur.A; const char* cB = (const char*)cur.B;
    PG8_STAGE(PG8_SB(0, 0), cB, voffB); PG8_STAGE(PG8_SB(0, 1), cB + bhstep, voffB); PG8_STAGE(PG8_SA(0, 0), cA, voffA[0]); PG8_STAGE(PG8_SA(0, 1), cA, voffA[1]);
    if (wr == 1) PG8_BAR;
    PG8_WAIT_V(2); PG8_BAR;
    PG8_STAGE(PG8_SB(1, 0), cB + kstep, voffB); PG8_STAGE(PG8_SA(1, 0), cA + kstep, voffA[0]); PG8_STAGE(PG8_SB(1, 1), cB + bhstep + kstep, voffB);
    PG8_WAIT_V(6); PG8_BAR;
    for (;;) {
        const bool has_next = S.next(ui + 1, nxt);
        const char* nA = has_next ? (const char*)nxt.A : cA; const char* nB = has_next ? (const char*)nxt.B : cB;
#pragma unroll 1
        for (int t = 0; t < nt; t += 2) {
            const bool last = (t == nt - 2);
            const char* a1 = cA + (size_t)(t + 1) * kstep;
            const char* a2 = last ? nA : cA + (size_t)(t + 2) * kstep; const char* b2 = last ? nB : cB + (size_t)(t + 2) * kstep;
            const char* a3 = a2 + kstep; const char* b3 = b2 + kstep;
            PG8_LDB(B0, 0, 0); PG8_LDB(B1, 0, 1); PG8_SCHED; PG8_LDA(At, 0, 0); PG8_STAGE(PG8_SA(1, 1), a1, voffA[1]);
            if (last && has_next) PG8_AROWS(ui + 1, nxt);
            PG8_WAIT_V(8); PG8_WAIT_L(0); PG8_BAR; PG8_MMA(0, 0, At, B0); PG8_MMA(0, 1, At, B1); PG8_BAR; PG8_SCHED;
            PG8_LDA(At, 0, 1); PG8_STAGE(PG8_SB(0, 0), b2, voffB); PG8_STAGE(PG8_SB(0, 1), b2 + bhstep, voffB); PG8_STAGE(PG8_SA(0, 0), a2, voffA[0]);
            PG8_WAIT_V(8); PG8_WAIT_L(0); PG8_BAR; PG8_MMA(1, 0, At, B0); PG8_MMA(1, 1, At, B1); PG8_BAR; PG8_SCHED;
            PG8_LDB(B0, 1, 0); PG8_LDB(B1, 1, 1); PG8_SCHED; PG8_LDA(At, 1, 0); PG8_STAGE(PG8_SA(0, 1), a2, voffA[1]);
            PG8_WAIT_V(8); PG8_WAIT_L(0); PG8_BAR; PG8_MMA(0, 0, At, B0); PG8_MMA(0, 1, At, B1); PG8_BAR; PG8_SCHED;
            PG8_LDA(At, 1, 1); PG8_STAGE(PG8_SB(1, 0), b3, voffB); PG8_STAGE(PG8_SB(1, 1), b3 + bhstep, voffB); PG8_STAGE(PG8_SA(1, 0), a3, voffA[0]);
            PG8_WAIT_V(8); PG8_WAIT_L(0); PG8_BAR; PG8_MMA(1, 0, At, B0); PG8_MMA(1, 1, At, B1); PG8_BAR; PG8_SCHED;
        }
        if (wr == 0) PG8_BAR;
        E(acc, cur, wr, wc, fr, fq);
        if (!has_next) break;
#pragma unroll
        for (int a = 0; a < 2; ++a)
#pragma unroll
            for (int b = 0; b < 2; ++b)
#pragma unroll
                for (int m = 0; m < 4; ++m)
#pragma unroll
                    for (int n = 0; n < 2; ++n) acc[a][b][m][n] = (f32x4){0.f, 0.f, 0.f, 0.f};
        cur = nxt; cA = nA; cB = nB; ++ui;
        if (wr == 1) PG8_BAR;
    }
    PG8_WAIT_V(0);
    PG8_BAR;
#undef PG8_SA
#undef PG8_SB
#undef PG8_STAGE
#undef PG8_LDA
#undef PG8_LDB
#undef PG8_MMA
#undef PG8_WAIT_V
#undef PG8_WAIT_L
#undef PG8_BAR
#undef PG8_SCHED
#undef PG8_AROWS
}

struct SchedPool {
    const bf16_t* diff; const bf16_t* w; int bid;
    DI bool next(int i, Unit& u) const { const int L = i * gridDim.x + bid; if (L >= 256) return false; u.pm = L >> 2; u.pn = L & 3; u.A = diff + 256 * u.pn; u.B = w + (size_t)u.pn * 65536; return true; }
    DI int arow(int, const Unit& u, int r) const { return u.pm * 256 + r; }
};
struct SchedDense {
    const bf16_t* A; const bf16_t* B; int npn, ldb, bid;
    DI bool next(int i, Unit& u) const { const int L = i * gridDim.x + bid; if (L >= 64 * npn) return false; u.pm = L / npn; u.pn = L % npn; u.A = A; u.B = B + (size_t)u.pn * 256 * ldb; return true; }
    DI int arow(int, const Unit& u, int r) const { return u.pm * 256 + r; }
};

struct EpiPool {
    bf16_t* x; const float* pb; const float* ps;
    DI void operator()(const f32x4 (&acc)[2][2][4][2], const Unit& u, int wr, int wc, int fr, int fq) const {
        f32x4 bb[2][2], sc[2][2];
#pragma unroll
        for (int bj = 0; bj < 2; ++bj) {
            const int c = 256 * u.pn + 128 * bj + 32 * wc + 8 * fq;
            bb[bj][0] = *(const f32x4*)(pb + c); bb[bj][1] = *(const f32x4*)(pb + c + 4); sc[bj][0] = *(const f32x4*)(ps + c); sc[bj][1] = *(const f32x4*)(ps + c + 4);
        }
#pragma unroll
        for (int ai = 0; ai < 2; ++ai) {
            u32x4 xin[4][2];
#pragma unroll
            for (int m = 0; m < 4; ++m)
#pragma unroll
                for (int bj = 0; bj < 2; ++bj)
                    xin[m][bj] = *(const u32x4*)(x + (size_t)(u.pm * 256 + 128 * ai + 64 * wr + 16 * m + fr) * DM + 256 * u.pn + 128 * bj + 32 * wc + 8 * fq);
            asm volatile("" ::: "memory");
#pragma unroll
            for (int m = 0; m < 4; ++m) {
                const int t = u.pm * 256 + 128 * ai + 64 * wr + 16 * m + fr;
#pragma unroll
                for (int bj = 0; bj < 2; ++bj) {
                    const int c = 256 * u.pn + 128 * bj + 32 * wc + 8 * fq;
                    float xv[8]; unpack8(xin[m][bj], xv);
                    const f32x4 v0 = (acc[ai][bj][m][0] + bb[bj][0]) * sc[bj][0];
                    const f32x4 v1 = (acc[ai][bj][m][1] + bb[bj][1]) * sc[bj][1];
                    u32x4 w; w[0] = cvt_pk_bf16(xv[0] + v0[0], xv[1] + v0[1]); w[1] = cvt_pk_bf16(xv[2] + v0[2], xv[3] + v0[3]); w[2] = cvt_pk_bf16(xv[4] + v1[0], xv[5] + v1[1]); w[3] = cvt_pk_bf16(xv[6] + v1[2], xv[7] + v1[3]);
                    *(u32x4*)(x + (size_t)t * DM + c) = w;
                }
            }
        }
    }
};
struct EpiWo {
    bf16_t* x;
    DI void operator()(const f32x4 (&acc)[2][2][4][2], const Unit& u, int wr, int wc, int fr, int fq) const {
#pragma unroll
        for (int ai = 0; ai < 2; ++ai) {
            u32x4 xin[4][2];
#pragma unroll
            for (int m = 0; m < 4; ++m)
#pragma unroll
                for (int bj = 0; bj < 2; ++bj)
                    xin[m][bj] = *(const u32x4*)(x + (size_t)(u.pm * 256 + 128 * ai + 64 * wr + 16 * m + fr) * DM + 256 * u.pn + 128 * bj + 32 * wc + 8 * fq);
            asm volatile("" ::: "memory");
#pragma unroll
            for (int m = 0; m < 4; ++m) {
                const int t = u.pm * 256 + 128 * ai + 64 * wr + 16 * m + fr;
#pragma unroll
                for (int bj = 0; bj < 2; ++bj) {
                    const int c = 256 * u.pn + 128 * bj + 32 * wc + 8 * fq;
                    float xv[8]; unpack8(xin[m][bj], xv);
                    const f32x4 v0 = acc[ai][bj][m][0], v1 = acc[ai][bj][m][1];
                    u32x4 w; w[0] = cvt_pk_bf16(xv[0] + v0[0], xv[1] + v0[1]); w[1] = cvt_pk_bf16(xv[2] + v0[2], xv[3] + v0[3]); w[2] = cvt_pk_bf16(xv[4] + v1[0], xv[5] + v1[1]); w[3] = cvt_pk_bf16(xv[6] + v1[2], xv[7] + v1[3]);
                    *(u32x4*)(x + (size_t)t * DM + c) = w;
                }
            }
        }
    }
};
struct EpiQKV {
    bf16_t* q; const float* rstd; const float* qg; const float* kg;
    DI void operator()(const f32x4 (&acc)[2][2][4][2], const Unit& u, int wr, int wc, int fr, int fq) const {
        const int which = u.pn >> 2, head = (u.pn & 3) * 4 + wc;
        bf16_t* out = q + (size_t)which * ((WS_K - WS_Q) / 2);
        const float* gn = which == 0 ? qg : kg;
        const float post = which == 0 ? 0.125f * 1.4426950408889634f : 1.0f;
        f32x4 g[2][2];
#pragma unroll
        for (int bj = 0; bj < 2; ++bj)
#pragma unroll
            for (int n = 0; n < 2; ++n) g[bj][n] = (which < 2) ? *(const f32x4*)(gn + 32 * bj + 8 * fq + 4 * n) * post : (f32x4){1.f, 1.f, 1.f, 1.f};
        float rsv[2][4];
#pragma unroll
        for (int ai = 0; ai < 2; ++ai)
#pragma unroll
            for (int m = 0; m < 4; ++m) rsv[ai][m] = rstd[u.pm * 256 + 128 * ai + 64 * wr + 16 * m + fr];
#pragma unroll
        for (int ai = 0; ai < 2; ++ai)
#pragma unroll
            for (int m = 0; m < 4; ++m) {
                const int t = u.pm * 256 + 128 * ai + 64 * wr + 16 * m + fr;
                const float rs = rsv[ai][m];
                f32x4 v4[2][2]; float ss = 0.f;
#pragma unroll
                for (int bj = 0; bj < 2; ++bj)
#pragma unroll
                    for (int n = 0; n < 2; ++n) { v4[bj][n] = acc[ai][bj][m][n] * rs; const f32x4 s = v4[bj][n] * v4[bj][n]; ss += (s[0] + s[1]) + (s[2] + s[3]); }
                ss += shflx(ss, fr + 16 * fq, 16); ss += shflx(ss, fr + 16 * fq, 32);
                const float r2 = (which < 2) ? rsqrtf(ss * (1.0f / HD) + EPS) : 1.0f;
#pragma unroll
                for (int bj = 0; bj < 2; ++bj) {
                    const f32x4 a = v4[bj][0] * r2 * g[bj][0], b = v4[bj][1] * r2 * g[bj][1];
                    u32x4 w; w[0] = cvt_pk_bf16(a[0], a[1]); w[1] = cvt_pk_bf16(a[2], a[3]); w[2] = cvt_pk_bf16(b[0], b[1]); w[3] = cvt_pk_bf16(b[2], b[3]);
                    *(u32x4*)(out + (size_t)t * DM + head * HD + 32 * bj + 8 * fq) = w;
                }
            }
    }
};

typedef short v4i16_t __attribute__((ext_vector_type(4)));
constexpr int AT_VPITCH = 192;
constexpr int AT_VTILE = 32 * AT_VPITCH;
DI void ph_attn(LAS unsigned char* ldsb) {
    LOAD_PARAMS();
    const int tid = tid_(), bid = bid_(), wid = tid >> 6, lane = tid & 63, l31 = lane & 31, h2 = lane >> 5;
    const bf16_t* Q = (const bf16_t*)(p.ws + WS_Q); const bf16_t* K = (const bf16_t*)(p.ws + WS_K); const bf16_t* V = (const bf16_t*)(p.ws + WS_V);
    bf16_t* O = (bf16_t*)(p.ws + WS_O);
    LAS unsigned char* vl = ldsb + wid * AT_VTILE;
    LAS unsigned char* vw = vl + (lane >> 3) * AT_VPITCH + (lane & 7) * 16;
    const LAS unsigned char* vr = vl + (4 * h2 + ((lane & 15) >> 2)) * AT_VPITCH + (16 * ((lane >> 4) & 1) + 4 * (lane & 3)) * 2;
    for (int it = 0; it < 4 * ((2 * NH * 256 / 32 - bid + (int)gridDim.x - 1) / (int)gridDim.x); ++it) {
        const int chunk = bid + (it >> 2) * gridDim.x, k32 = (it & 3) * 8 + wid;
        const int b = chunk >> 7, h = k32 >> 1, qb = 2 * (chunk & 127) + (k32 & 1);
        const size_t tb = (size_t)b * SEQ;
        const int q0 = qb * 32;
        bf16x8 qf[4];
#pragma unroll
        for (int s = 0; s < 4; ++s) qf[s] = *(const bf16x8*)(Q + (tb + q0 + l31) * DM + h * HD + 16 * s + 8 * h2);
        f32x16 o0, o1;
#pragma unroll
        for (int r = 0; r < 16; ++r) { o0[r] = 0.f; o1[r] = 0.f; }
        float R = 1.f;
        const bf16_t* kp = K + (tb + q0 + l31) * DM + h * HD + 8 * h2;
        const bf16_t* vp = V + (tb + q0 + (lane >> 3)) * DM + h * HD + (lane & 7) * 8;
        bf16x8 kn[4], kq[4]; u32x4 vn[4], vq[4];
#pragma unroll
        for (int s = 0; s < 4; ++s) { kn[s] = *(const bf16x8*)(kp + 16 * s); vn[s] = *(const u32x4*)(vp + (size_t)8 * s * DM); }
        if (qb > 0) {
            kp -= (size_t)32 * DM; vp -= (size_t)32 * DM;
#pragma unroll
            for (int s = 0; s < 4; ++s) { kq[s] = *(const bf16x8*)(kp + 16 * s); vq[s] = *(const u32x4*)(vp + (size_t)8 * s * DM); }
        }
        for (int kt = qb; kt >= 0; --kt) {
            bf16x8 kf[4];
#pragma unroll
            for (int s = 0; s < 4; ++s) { kf[s] = kn[s]; *(LAS u32x4*)(vw + 8 * s * AT_VPITCH) = vn[s]; kn[s] = kq[s]; vn[s] = vq[s]; }
            if (kt > 1) {
                kp -= (size_t)32 * DM; vp -= (size_t)32 * DM;
#pragma unroll
                for (int s = 0; s < 4; ++s) { kq[s] = *(const bf16x8*)(kp + 16 * s); vq[s] = *(const u32x4*)(vp + (size_t)8 * s * DM); }
            }
            f32x16 z;
#pragma unroll
            for (int r = 0; r < 16; ++r) z[r] = 0.f;
#pragma unroll
            for (int s = 0; s < 4; ++s) z = __builtin_amdgcn_mfma_f32_32x32x16_bf16(kf[s], qf[s], z, 0, 0, 0);
            float kp_[16], gs[4], ot[4];
#pragma unroll
            for (int r = 0; r < 16; ++r) kp_[r] = __builtin_amdgcn_rcpf(1.0f + __builtin_amdgcn_exp2f(z[r]));
            if (kt == qb) {
#pragma unroll
                for (int r = 0; r < 16; ++r) { const int kl = (r & 3) + 8 * (r >> 2) + 4 * h2; kp_[r] = (kl < l31) ? kp_[r] : 1.0f; }
            }
#pragma unroll
            for (int bb = 0; bb < 4; ++bb) { gs[bb] = (kp_[4 * bb] * kp_[4 * bb + 1]) * (kp_[4 * bb + 2] * kp_[4 * bb + 3]); ot[bb] = shflx(gs[bb], lane, 32); }
            const float tot_own = (gs[0] * gs[1]) * (gs[2] * gs[3]);
            const float tot_oth = (ot[0] * ot[1]) * (ot[2] * ot[3]);
            float later[4];
            {
                float own_tail = 1.f, oth_tail = 1.f;
#pragma unroll
                for (int bb = 3; bb >= 0; --bb) {
                    later[bb] = own_tail * oth_tail * (h2 == 0 ? ot[bb] : 1.f);
                    own_tail *= gs[bb]; oth_tail *= ot[bb];
                }
            }
            float a[16];
#pragma unroll
            for (int bb = 0; bb < 4; ++bb) {
                const float x3 = R * later[bb];
                const float x2 = x3 * kp_[4 * bb + 3], x1 = x2 * kp_[4 * bb + 2], x0 = x1 * kp_[4 * bb + 1];
                a[4 * bb] = x0 - x0 * kp_[4 * bb]; a[4 * bb + 1] = x1 - x1 * kp_[4 * bb + 1]; a[4 * bb + 2] = x2 - x2 * kp_[4 * bb + 2]; a[4 * bb + 3] = x3 - x3 * kp_[4 * bb + 3];
            }
            R *= (h2 == 0) ? (tot_own * tot_oth) : (tot_oth * tot_own);
#pragma unroll
            for (int s = 0; s < 2; ++s) {
                u32x4 pw;
#pragma unroll
                for (int i = 0; i < 4; ++i) pw[i] = cvt_pk_bf16(a[8 * s + 2 * i], a[8 * s + 2 * i + 1]);
                const bf16x8 pa = __builtin_bit_cast(bf16x8, pw);
#pragma unroll
                for (int db = 0; db < 2; ++db) {
                    const v4i16_t lo4 = __builtin_amdgcn_ds_read_tr16_b64_v4i16((LAS v4i16_t*)(vr + (16 * s) * AT_VPITCH + 64 * db));
                    const v4i16_t hi4 = __builtin_amdgcn_ds_read_tr16_b64_v4i16((LAS v4i16_t*)(vr + (16 * s + 8) * AT_VPITCH + 64 * db));
                    bf16x8 vf; vf[0] = lo4[0]; vf[1] = lo4[1]; vf[2] = lo4[2]; vf[3] = lo4[3]; vf[4] = hi4[0]; vf[5] = hi4[1]; vf[6] = hi4[2]; vf[7] = hi4[3];
                    if (db == 0) o0 = __builtin_amdgcn_mfma_f32_32x32x16_bf16(vf, pa, o0, 0, 0, 0);
                    else o1 = __builtin_amdgcn_mfma_f32_32x32x16_bf16(vf, pa, o1, 0, 0, 0);
                }
            }
            if (__all(R < 1.0e-36f)) break;
        }
#pragma unroll
        for (int db = 0; db < 2; ++db)
#pragma unroll
            for (int rb = 0; rb < 4; ++rb) {
                const f32x16& o = db == 0 ? o0 : o1;
                u32x2 w; w[0] = cvt_pk_bf16(o[4 * rb], o[4 * rb + 1]); w[1] = cvt_pk_bf16(o[4 * rb + 2], o[4 * rb + 3]);
                *(u32x2*)(O + (tb + q0 + l31) * DM + h * HD + 32 * db + 8 * rb + 4 * h2) = w;
            }
    }
}

constexpr int RT_PART = 0;
constexpr int RT_SSQ = RT_PART + 4 * 64 * 52 * 4;
constexpr int RT_LCNT = RT_SSQ + 4 * 64 * 4;
constexpr int RT_GB = RT_LCNT + 128;
DI void ph_router(LAS unsigned char* lds, int li) {
    LOAD_PARAMS();
    const bf16_t* xcur = (const bf16_t*)(p.ws + ((li & 1) ? WS_XB1 : WS_XB));
    const int tid = tid_(), bid = bid_(), wid = tid >> 6, lane = tid & 63, fr = lane & 15, fq = lane >> 4;
    const bf16_t* wh = (const bf16_t*)(p.ws + WS_WRH) + (size_t)li * 48 * DM;
    const bf16_t* wl = (const bf16_t*)(p.ws + WS_WRL) + (size_t)li * 48 * DM;
    const float* bg = p.moe_bg + li * 4;
    const float* br = p.moe_br + li * 32;
    unsigned* cnt = (unsigned*)(p.ws + WS_CTL) + CW_CNT + 32 * li;
    Entry* list = (Entry*)(p.ws + WS_LIST);
    LAS float* part = (LAS float*)(lds + RT_PART); LAS float* ssq = (LAS float*)(lds + RT_SSQ);
    LAS int* lcnt = (LAS int*)(lds + RT_LCNT); LAS int* gb = (LAS int*)(lds + RT_GB);
    const int th = wid & 1, kq = wid >> 1;
    for (int chunk = bid; chunk < T / 64; chunk += gridDim.x) {
        const int t = chunk * 64 + th * 32 + fr;
        const bf16_t* xr = xcur + (size_t)t * DM + kq * 256 + fq * 8;
        const bf16_t* whr = wh + (size_t)fr * DM + kq * 256 + fq * 8;
        const bf16_t* wlr = wl + (size_t)fr * DM + kq * 256 + fq * 8;
        f32x4 acc[2][3]; float ss[2] = {0.f, 0.f};
#pragma unroll
        for (int b = 0; b < 2; ++b)
#pragma unroll
            for (int nb = 0; nb < 3; ++nb) acc[b][nb] = (f32x4){0.f, 0.f, 0.f, 0.f};
#pragma unroll 4
        for (int ks = 0; ks < 8; ++ks) {
            bf16x8 xh[2];
#pragma unroll
            for (int b = 0; b < 2; ++b) {
                const u32x4 xw = *(const u32x4*)(xr + (size_t)b * 16 * DM + ks * 32);
                float xf[8]; unpack8(xw, xf);
#pragma unroll
                for (int e = 0; e < 8; ++e) ss[b] += xf[e] * xf[e];
                xh[b] = __builtin_bit_cast(bf16x8, xw);
            }
#pragma unroll
            for (int nb = 0; nb < 3; ++nb) {
                const bf16x8 wH = *(const bf16x8*)(whr + (size_t)nb * 16 * DM + ks * 32), wL = *(const bf16x8*)(wlr + (size_t)nb * 16 * DM + ks * 32);
#pragma unroll
                for (int b = 0; b < 2; ++b) {
                    acc[b][nb] = __builtin_amdgcn_mfma_f32_16x16x32_bf16(wH, xh[b], acc[b][nb], 0, 0, 0);
                    acc[b][nb] = __builtin_amdgcn_mfma_f32_16x16x32_bf16(wL, xh[b], acc[b][nb], 0, 0, 0);
                }
            }
        }
#pragma unroll
        for (int b = 0; b < 2; ++b) {
            float sv = ss[b]; sv += shflx(sv, lane, 16); sv += shflx(sv, lane, 32);
            const int tl = th * 32 + 16 * b + fr;
#pragma unroll
            for (int nb = 0; nb < 3; ++nb) *(LAS f32x4*)(part + (kq * 64 + tl) * 52 + 16 * nb + 4 * fq) = acc[b][nb];
            if (fq == 0) ssq[kq * 64 + tl] = sv;
        }
        if (tid < 32) lcnt[tid] = 0;
        __syncthreads();
        int ea = 0, eb = 0, la = 0, lb = 0; float w1 = 0.f, w2 = 0.f, rs = 0.f;
        if (tid < 64) {
            rs = rsqrtf(((ssq[tid] + ssq[64 + tid]) + (ssq[128 + tid] + ssq[192 + tid])) * (1.0f / DM) + EPS);
            float lg[36];
#pragma unroll
            for (int q = 0; q < 9; ++q) {
                const f32x4 u0 = *(const LAS f32x4*)(part + tid * 52 + 4 * q), u1 = *(const LAS f32x4*)(part + (64 + tid) * 52 + 4 * q);
                const f32x4 u2 = *(const LAS f32x4*)(part + (128 + tid) * 52 + 4 * q), u3 = *(const LAS f32x4*)(part + (192 + tid) * 52 + 4 * q);
#pragma unroll
                for (int e = 0; e < 4; ++e) lg[4 * q + e] = ((u0[e] + u1[e]) + (u2[e] + u3[e])) * rs;
            }
            float gl[4];
#pragma unroll
            for (int n = 0; n < 4; ++n) gl[n] = lg[n] + bg[n];
            int g = 0; float gm = gl[0];
#pragma unroll
            for (int n = 1; n < 4; ++n) if (gl[n] > gm) { gm = gl[n]; g = n; }
            float den = 0.f;
#pragma unroll
            for (int n = 0; n < 4; ++n) den += __expf(gl[n] - gm);
            const float gprob = 1.0f / den;
            float el[8];
#pragma unroll
            for (int n = 0; n < 8; ++n) {
                float v = 0.f;
#pragma unroll
                for (int gg = 0; gg < 4; ++gg) v = (g == gg) ? lg[4 + 8 * gg + n] + br[8 * gg + n] : v;
                el[n] = v;
            }
            int e1 = 0; float m1 = el[0];
#pragma unroll
            for (int n = 1; n < 8; ++n) if (el[n] > m1) { m1 = el[n]; e1 = n; }
            int e2 = -1; float m2 = -3.0e38f;
#pragma unroll
            for (int n = 0; n < 8; ++n) if (n != e1 && (e2 < 0 || el[n] > m2)) { m2 = el[n]; e2 = n; }
            const float ex = __expf(m2 - m1);
            w1 = gprob / (1.0f + ex); w2 = gprob * ex / (1.0f + ex);
            ea = 8 * g + e1; eb = 8 * g + e2;
            la = __hip_atomic_fetch_add(lcnt + ea, 1, __ATOMIC_RELAXED, __HIP_MEMORY_SCOPE_WORKGROUP);
            lb = __hip_atomic_fetch_add(lcnt + eb, 1, __ATOMIC_RELAXED, __HIP_MEMORY_SCOPE_WORKGROUP);
        }
        __syncthreads();
        if (tid < 32) { const int c = lcnt[tid]; gb[tid] = c ? (int)atomicAdd(&cnt[tid], (unsigned)c) : 0; }
        __syncthreads();
        if (tid < 64) {
            const int tt = chunk * 64 + tid;
            Entry A; A.dst = tt; A.rstd = rs; A.w = w1; A.tok = tt;
            Entry B; B.dst = T + tt; B.rstd = rs; B.w = w2; B.tok = tt;
            list[(size_t)ea * LIST_CAP + gb[ea] + la] = A;
            list[(size_t)eb * LIST_CAP + gb[eb] + lb] = B;
        }
        __syncthreads();
    }
}

constexpr int MOE_MAXU = 4;
constexpr int LDS_ROWTAB = STAGE_BYTES;
constexpr int LDS_EPITAB = LDS_ROWTAB + MOE_MAXU * 1024;
constexpr int LDS_UTAB = LDS_EPITAB + MOE_MAXU * 2048;
constexpr int LDS_XBW = LDS_UTAB + MOE_MAXU * 32;
constexpr int LDS_BYTES = 147456;
static_assert(LDS_XBW + 32 <= LDS_BYTES, "LDS map");
struct SchedMoe {
    LAS unsigned char* lds; const bf16_t* A; const bf16_t* W; bool gather; size_t w_estride; int w_pnrows, ldb;
    DI void build(const unsigned* cnt, const Entry* list, int npn, int lo, int hi, int first, int stride, int tid) {
        LAS int* ut = (LAS int*)(lds + LDS_UTAB); LAS unsigned* rt = (LAS unsigned*)(lds + LDS_ROWTAB);
        const int lane = tid & 63;
        if (tid < 64) {
            const int c = (int)cnt[lane & 31], ntl = (c + 255) >> 8;
            int inc = ntl;
#pragma unroll
            for (int d = 1; d < 32; d <<= 1) { const int v = __builtin_amdgcn_ds_bpermute(((lane - d) & 63) << 2, inc); if ((lane & 31) >= d) inc += v; }
            const int exc = inc - ntl;
#pragma unroll
            for (int i = 0; i < MOE_MAXU; ++i) {
                const int L = lo + first + i * stride, rtile = L / npn, pn = L % npn;
                const bool hit = (first >= 0) && (L < hi) && (lane < 32) && (rtile >= exc) && (rtile < inc);
                const unsigned long long mask = __ballot(hit);
                int found = 0, e = 0, j = 0, nv = 0;
                if (mask) {
                    found = 1; e = __builtin_ctzll(mask);
                    j = rtile - __builtin_amdgcn_readlane(exc, e); nv = __builtin_amdgcn_readlane(c, e) - 256 * j; nv = nv > 256 ? 256 : nv;
                }
                if (lane == 0) { ut[i * 8 + 0] = found; ut[i * 8 + 1] = e; ut[i * 8 + 2] = nv; ut[i * 8 + 3] = 256 * rtile; ut[i * 8 + 4] = e * LIST_CAP + 256 * j; ut[i * 8 + 5] = pn; }
            }
        }
        __syncthreads();
        if (tid < 256) {
#pragma unroll
            for (int i = 0; i < MOE_MAXU; ++i) {
                if (!ut[i * 8]) continue;
                const int nv = ut[i * 8 + 2], lb = ut[i * 8 + 4];
                Entry en; en.dst = DUMMY_ROW; en.rstd = 0.f; en.w = 0.f; en.tok = 0;
                if (tid < nv) en = list[lb + tid];
                LAS float* et = (LAS float*)(lds + LDS_EPITAB) + (i * 256 + tid) * 2;
                if (gather) { rt[i * 256 + tid] = (unsigned)en.tok; et[0] = en.rstd; et[1] = en.w; }
                else { et[0] = __int_as_float(en.dst); et[1] = 0.f; }
            }
        }
        asm volatile("s_waitcnt vmcnt(0) lgkmcnt(0)" ::: "memory");
        __syncthreads();
    }
    DI bool next(int i, Unit& u) const {
        if (i >= MOE_MAXU) return false;
        const LAS int* ut = (const LAS int*)(lds + LDS_UTAB) + i * 8;
        const int found = __builtin_amdgcn_readfirstlane(ut[0]);
        if (!found) return false;
        u.e = __builtin_amdgcn_readfirstlane(ut[1]); u.nvalid = __builtin_amdgcn_readfirstlane(ut[2]); u.row0 = __builtin_amdgcn_readfirstlane(ut[3]);
        u.lbase = i * 256; u.pn = __builtin_amdgcn_readfirstlane(ut[5]); u.pm = u.row0 >> 8;
        u.A = gather ? A : A + (size_t)u.row0 * DE;
        u.B = W + (size_t)u.e * w_estride + (size_t)u.pn * w_pnrows * ldb;
        return true;
    }
    DI int arow(int ui, const Unit&, int r) const { if (!gather) return r; return (int)((const LAS unsigned*)(lds + LDS_ROWTAB))[ui * 256 + r]; }
};
struct EpiGU {
    bf16_t* hid; LAS unsigned char* lds;
    DI void operator()(const f32x4 (&acc)[2][2][4][2], const Unit& u, int wr, int wc, int fr, int fq) const {
        typedef float f32x2 __attribute__((ext_vector_type(2)));
#pragma unroll
        for (int ai = 0; ai < 2; ++ai)
#pragma unroll
            for (int m = 0; m < 4; ++m) {
                const int r = 128 * ai + 64 * wr + 16 * m + fr;
                const f32x2 rw = *(const LAS f32x2*)(lds + LDS_EPITAB + (u.lbase + r) * 8);
                const float rs = rw[0], w = rw[1];
                unsigned pk[4];
#pragma unroll
                for (int n = 0; n < 2; ++n) {
                    float hv[4];
#pragma unroll
                    for (int e = 0; e < 4; ++e) { const float g = acc[ai][0][m][n][e] * rs, up = acc[ai][1][m][n][e] * rs; hv[e] = g * __builtin_amdgcn_rcpf(1.0f + __builtin_amdgcn_exp2f(-1.4426950408889634f * g)) * up * w; }
                    pk[2 * n] = cvt_pk_bf16(hv[0], hv[1]); pk[2 * n + 1] = cvt_pk_bf16(hv[2], hv[3]);
                }
                u32x4 wv; wv[0] = pk[0]; wv[1] = pk[1]; wv[2] = pk[2]; wv[3] = pk[3];
                *(u32x4*)(hid + (size_t)(u.row0 + r) * DE + 128 * u.pn + 32 * wc + 8 * fq) = wv;
            }
    }
};
struct EpiDown {
    bf16_t* yb; LAS unsigned char* lds;
    DI void operator()(const f32x4 (&acc)[2][2][4][2], const Unit& u, int wr, int wc, int fr, int fq) const {
#pragma unroll
        for (int ai = 0; ai < 2; ++ai)
#pragma unroll
            for (int m = 0; m < 4; ++m) {
                const int r = 128 * ai + 64 * wr + 16 * m + fr;
                const int dst = *(const LAS int*)(lds + LDS_EPITAB + (u.lbase + r) * 8);
                if (dst == DUMMY_ROW) continue;
#pragma unroll
                for (int bj = 0; bj < 2; ++bj) {
                    const f32x4 a = acc[ai][bj][m][0], b = acc[ai][bj][m][1];
                    u32x4 w; w[0] = cvt_pk_bf16(a[0], a[1]); w[1] = cvt_pk_bf16(a[2], a[3]); w[2] = cvt_pk_bf16(b[0], b[1]); w[3] = cvt_pk_bf16(b[2], b[3]);
                    *(u32x4*)(yb + (size_t)dst * DM + 256 * u.pn + 128 * bj + 32 * wc + 8 * fq) = w;
                }
            }
    }
};

DI void ph_poolgemm(LAS unsigned char* lds, int j) {
    LOAD_PARAMS();
    SchedPool S; S.bid = xbid_(); S.diff = (const bf16_t*)(p.ws + WS_DIFF); S.w = (const bf16_t*)(p.ws + WS_WPOOL) + (size_t)j * 4 * 65536;
    EpiPool E; E.x = (bf16_t*)(p.ws + WS_XB); E.pb = p.pool_b + j * DM; E.ps = p.pool_scale + j * DM;
    gemm_phase<GCfg<1024, 256, 256, 128, false>>(lds, S, E);
}
DI void ph_qkv(LAS unsigned char* lds, int j) {
    LOAD_PARAMS();
    SchedDense S; S.bid = xbid_(); S.A = (const bf16_t*)(p.ws + WS_XB1); S.B = (const bf16_t*)(p.ws + WS_WQKV) + (size_t)j * 3072 * 1024; S.npn = 12; S.ldb = 1024;
    EpiQKV E; E.q = (bf16_t*)(p.ws + WS_Q); E.rstd = (const float*)(p.ws + WS_RSTD); E.qg = p.sb_qg + j * HD; E.kg = p.sb_kg + j * HD;
    gemm_phase<GCfg<1024, 1024, 1024, 32, true>>(lds, S, E);
}
DI void ph_wo(LAS unsigned char* lds, int j) {
    LOAD_PARAMS();
    SchedDense S; S.bid = xbid_(); S.A = (const bf16_t*)(p.ws + WS_O); S.B = (const bf16_t*)(p.ws + WS_WO) + (size_t)j * 1024 * 1024; S.npn = 4; S.ldb = 1024;
    EpiWo E; E.x = (bf16_t*)(p.ws + WS_XB1);
    gemm_phase<GCfg<1024, 1024, 1024, 128, false>>(lds, S, E);
}
struct MoePlan { int NT, R1, nB, D1; };
DI MoePlan moe_plan(const unsigned* cnt) {
    const int lane = tid_() & 63;
    int nt = ((int)cnt[lane & 31] + 255) >> 8;
#pragma unroll
    for (int o = 1; o < 32; o <<= 1) nt += __builtin_amdgcn_ds_bpermute((lane ^ o) << 2, nt);
    nt = __builtin_amdgcn_readfirstlane(nt);
    MoePlan m; m.NT = nt; const int G = gridDim.x; m.R1 = nt < G / 2 ? nt : G / 2;
    const int late = 2 * (nt - m.R1); m.nB = late < G ? late : G;
    const int cap = 2 * (G - m.nB); m.D1 = 4 * m.R1 < cap ? 4 * m.R1 : cap;
    return m;
}
DI void ph_gu(LAS unsigned char* lds, int li, int stage, const MoePlan m) {
    LOAD_PARAMS();
    const Entry* list = (const Entry*)(p.ws + WS_LIST);
    const unsigned* cnt = (const unsigned*)(p.ws + WS_CTL) + CW_CNT + 32 * li;
    const int bid = xbid_();
    if (stage == 2 || (stage == 1 && bid >= m.nB)) return;
    SchedMoe S; S.lds = lds; S.A = (const bf16_t*)(p.ws + ((li & 1) ? WS_XB1 : WS_XB));
    S.W = (const bf16_t*)(p.ws + WS_WGU) + (size_t)li * NE * 512 * 1024; S.gather = true; S.w_estride = (size_t)512 * 1024; S.w_pnrows = 128; S.ldb = 1024;
    const int lo = stage == 0 ? 0 : 2 * m.R1, hi = stage == 0 ? 2 * m.R1 : 2 * m.NT, G = gridDim.x;
    EpiGU E; E.hid = (bf16_t*)(p.ws + WS_HID); E.lds = lds;
    for (int first = bid; lo + first < hi; first += MOE_MAXU * G) {
        S.build(cnt, list, 2, lo, hi, first, G, tid_());
        gemm_phase<GCfg<1024, 1024, 1024, 256, false>>(lds, S, E);
        __syncthreads();
    }
}
DI void ph_down(LAS unsigned char* lds, int li, int stage, const MoePlan m) {
    LOAD_PARAMS();
    const Entry* list = (const Entry*)(p.ws + WS_LIST);
    const unsigned* cnt = (const unsigned*)(p.ws + WS_CTL) + CW_CNT + 32 * li;
    const int bid = xbid_(), G = gridDim.x;
    if (stage == 0 || (stage == 1 && bid < m.nB)) return;
    SchedMoe S; S.lds = lds; S.A = (const bf16_t*)(p.ws + WS_HID);
    S.W = (const bf16_t*)(p.ws + WS_WD) + (size_t)li * NE * 1024 * 256; S.gather = false; S.w_estride = (size_t)1024 * 256; S.w_pnrows = 256; S.ldb = 256;
    const int lo = stage == 1 ? 0 : m.D1, hi = stage == 1 ? m.D1 : 4 * m.NT, stride = stage == 1 ? G - m.nB : G;
    EpiDown E; E.yb = (bf16_t*)(p.ws + WS_YBUF); E.lds = lds;
    for (int first = stage == 1 ? bid - m.nB : bid; lo + first < hi; first += MOE_MAXU * stride) {
        S.build(cnt, list, 4, lo, hi, first, stride, tid_());
        gemm_phase<GCfg<256, 256, 256, 128, false>>(lds, S, E);
        __syncthreads();
    }
}
DI MoePlan moe_layer_plan(int li) {
    LOAD_PARAMS();
    return moe_plan((const unsigned*)(p.ws + WS_CTL) + CW_CNT + 32 * li);
}

#define XB_TMO      128
#define XB_XCNT(j)  (256  + 64 * (j))
#define XB_XSUB(j)  (1280 + 64 * (j))
#define XB_XGEN(j)  (2304 + 64 * (j))
#define XB_TOP      3328
#define XB_TOPGEN   3392
#define XCD_BAR_WORDS 3456
#define XB_XGENR(j, r) (3456 + 64 * (4 * (j) + (r)))
#define XB_SPIN_CAP (1u << 18)

__device__ __forceinline__ unsigned xb_ld(unsigned* p)              { return __hip_atomic_load(p, __ATOMIC_RELAXED, __HIP_MEMORY_SCOPE_AGENT); }
__device__ __forceinline__ unsigned xb_add(unsigned* p, unsigned v) { return __hip_atomic_fetch_add(p, v, __ATOMIC_RELAXED, __HIP_MEMORY_SCOPE_AGENT); }
__device__ __forceinline__ unsigned xb_xcc_id() { return (unsigned)__builtin_amdgcn_s_getreg((3 << 11) | 20) & 0xFu; }
#define XB_SPIN(cond, bar) do { unsigned _sp = 0; while (cond) { __builtin_amdgcn_s_sleep(1); \
    if ((++_sp & 255u) == 0u) { if (xb_ld(&(bar)[XB_TMO])) break; if (_sp > XB_SPIN_CAP) { atomicAdd(&(bar)[XB_TMO], 1u); break; } } } } while (0)

struct XcdBarrier {
    unsigned* bar; unsigned x;
    volatile LAS unsigned* st;
};

__device__ __forceinline__ XcdBarrier xcd_barrier_post(unsigned* bar, volatile LAS unsigned* st) {
    XcdBarrier b; b.bar = bar; b.x = xb_xcc_id(); b.st = st;
    if (threadIdx.x == 0) (void)xb_add(&bar[XB_XCNT(b.x)], 1u);
    return b;
}
__device__ __forceinline__ void xcd_barrier_complete(unsigned* bar, unsigned x, unsigned& nloc, unsigned& nx) {
    const unsigned G = gridDim.x * gridDim.y * gridDim.z;
    unsigned sum, cnt, mine, sp = 0u;
    for (;;) {
        sum = 0u; cnt = 0u; mine = 0u;
#pragma unroll
        for (unsigned j = 0; j < 16; ++j) { const unsigned c = xb_ld(&bar[XB_XCNT(j)]); sum += c; cnt += (c > 0u) ? 1u : 0u; mine = (j == x) ? c : mine; }
        if (sum == G) break;
        __builtin_amdgcn_s_sleep(1);
        if ((++sp & 255u) == 0u) { if (xb_ld(&bar[XB_TMO])) break; if (sp > XB_SPIN_CAP) { atomicAdd(&bar[XB_TMO], 1u); break; } }
    }
    nloc = mine > 0u ? mine : 1u; nx = cnt > 0u ? cnt : 1u;
}

__device__ __forceinline__ void xcd_barrier(const XcdBarrier& b) {
    asm volatile("s_waitcnt vmcnt(0)" ::: "memory");
    __syncthreads();
    if (threadIdx.x == 0) {
        unsigned* bar = b.bar; unsigned bx = b.x;
        asm volatile("" : "+s"(bar), "+s"(bx));
        __builtin_amdgcn_s_waitcnt(0);
        unsigned nloc = b.st[0], nx = b.st[1];
        if (nloc == 0u) { xcd_barrier_complete(bar, bx, nloc, nx); b.st[0] = nloc; b.st[1] = nx; }
        const unsigned old = xb_add(&bar[XB_XSUB(bx)], 1u);
        const unsigned gen = old / nloc;
        if (old + 1u == (gen + 1u) * nloc) {
            __builtin_amdgcn_fence(__ATOMIC_RELEASE, "agent");
            asm volatile("s_waitcnt vmcnt(0)" ::: "memory");
            const unsigned og = xb_add(&bar[XB_TOP], 1u);
            const unsigned tg = og / nx;
            if (og + 1u == (tg + 1u) * nx) xb_add(&bar[XB_TOPGEN], 1u);
            else XB_SPIN(xb_ld(&bar[XB_TOPGEN]) == tg, bar);
            __builtin_amdgcn_fence(__ATOMIC_ACQUIRE, "agent");
            xb_add(&bar[XB_XGEN(bx)], 1u);
            asm volatile("s_waitcnt vmcnt(0)" ::: "memory");
        } else {
            XB_SPIN(xb_ld(&bar[XB_XGEN(bx)]) == gen, bar);
            __builtin_amdgcn_fence(__ATOMIC_ACQUIRE, "agent");
            asm volatile("s_waitcnt vmcnt(0)" ::: "memory");
        }
    }
    __syncthreads();
}
constexpr int CW_BAR = 4096;

DI int cvt_claim(LAS unsigned char* smem, unsigned* ctl, int n, int tid) {
    volatile LAS unsigned* st = (volatile LAS unsigned*)(smem + LDS_XBW);
    if (tid == 0) { const unsigned d = xb_add(ctl + CW_CVT, (unsigned)n); st[4] = d; st[5] = d + (unsigned)n; }
    __syncthreads();
    const int d = (int)st[4];
    __syncthreads();
    return __builtin_amdgcn_readfirstlane(d);
}
DI void cvt_work(LAS unsigned char* smem, int n) {
    volatile LAS unsigned* st = (volatile LAS unsigned*)(smem + LDS_XBW);
    if (st[5] >= (unsigned)CVT_DTOTAL) return;
    LOAD_PARAMS();
    const int tid = tid_();
    const int d = cvt_claim(smem, (unsigned*)(p.ws + WS_CTL), n, tid);
    if (d < CVT_DTOTAL) cvt_run(smem, p, 1, d, (d + n < CVT_DTOTAL) ? d + n : CVT_DTOTAL, 0, 1, tid);
}
DI void cvt_require(LAS unsigned char* smem, int req) {
    volatile LAS unsigned* st = (volatile LAS unsigned*)(smem + LDS_XBW);
    __syncthreads();
    if (st[5] >= (unsigned)req) return;
    LOAD_PARAMS();
    unsigned* ctl = (unsigned*)(p.ws + WS_CTL);
    const int tid = tid_();
    for (;;) {
        __syncthreads();
        if (tid == 0) { const unsigned c = xb_ld(ctl + CW_CVT); if (c > st[5]) st[5] = c; }
        __syncthreads();
        if (st[5] >= (unsigned)req) break;
        const int d = cvt_claim(smem, ctl, 2, tid);
        if (d < CVT_DTOTAL) cvt_run(smem, p, 1, d, (d + 2 < CVT_DTOTAL) ? d + 2 : CVT_DTOTAL, 0, 1, tid);
    }
}
__device__ __forceinline__ void grid_sync(const XcdBarrier& b, LAS unsigned char* smem, int req) {
    if (req > 0) cvt_require(smem, req);
    asm volatile("s_waitcnt vmcnt(0)" ::: "memory");
    __syncthreads();
    if (threadIdx.x == 64) asm volatile("buffer_inv sc1" ::: "memory");
    if (threadIdx.x == 0) {
        unsigned* bar = b.bar; unsigned bx = b.x;
        asm volatile("" : "+s"(bar), "+s"(bx));
        unsigned nloc = b.st[0], nx = b.st[1];
        if (nloc == 0u) { xcd_barrier_complete(bar, bx, nloc, nx); b.st[0] = nloc; b.st[1] = nx; }
        const unsigned old = xb_add(&bar[XB_XSUB(bx)], 1u);
        const unsigned gen = old / nloc;
        unsigned role;
        if (old + 1u == (gen + 1u) * nloc) {
            __builtin_amdgcn_fence(__ATOMIC_RELEASE, "agent");
            asm volatile("s_waitcnt vmcnt(0)" ::: "memory");
            const unsigned og = xb_add(&bar[XB_TOP], 1u);
            const unsigned tg = og / nx;
            if (og + 1u == (tg + 1u) * nx) xb_add(&bar[XB_TOPGEN], 1u);
            else XB_SPIN(xb_ld(&bar[XB_TOPGEN]) == tg, bar);
#pragma unroll
            for (unsigned r = 0; r < 4u; ++r) xb_add(&bar[XB_XGENR(bx, r)], 1u);
            asm volatile("s_waitcnt vmcnt(0)" ::: "memory");
            role = 2u;
        } else role = ((old - gen * nloc) < nloc / 2u) ? 1u : 0u;
        b.st[2] = role; b.st[3] = gen; b.st[6] = (old - gen * nloc) & 3u;
    }
    __syncthreads();
    const unsigned role = b.st[2];
    if (role == 1u) cvt_work(smem, 2);
    if (threadIdx.x == 0 && role != 2u) {
        unsigned* bar = b.bar; unsigned bx = b.x;
        asm volatile("" : "+s"(bar), "+s"(bx));
        const unsigned gen = b.st[3], rep = b.st[6];
        XB_SPIN(xb_ld(&bar[XB_XGENR(bx, rep)]) == gen, bar);
    }
    asm volatile("s_waitcnt vmcnt(0)" ::: "memory");
    __syncthreads();
}

extern __shared__ __attribute__((aligned(16))) unsigned char smem_raw[];
__global__ void __launch_bounds__(NTHR, 2) fwd(Params pk) {
    LAS unsigned char* smem = (LAS unsigned char*)smem_raw;
    if (threadIdx.x < 8) ((LAS unsigned*)(smem + LDS_XBW))[threadIdx.x] = 0u;
    __syncthreads();
    XcdBarrier bar;
    { LOAD_PARAMS(); bar = xcd_barrier_post((unsigned*)(p.ws + WS_CTL) + CW_BAR, (volatile LAS unsigned*)(smem + LDS_XBW)); }
    ph_prologue(smem);
    __syncthreads();
    for (int i = 0; i < DEPTH; ++i) {
        const int j = i >> 1;
        if ((i & 1) == 0) {
            ph_poolfuse(smem, j, i == 0);
            grid_sync(bar, smem, 0);
            ph_poolgemm(smem, j);
            grid_sync(bar, smem, 0);
        } else {
            ph_combine<false>(0);
            grid_sync(bar, smem, i == 1 ? CVT_E1 : CVT_E4);
            ph_qkv(smem, j);
            grid_sync(bar, smem, 0);
            ph_attn(smem);
            grid_sync(bar, smem, 0);
            ph_wo(smem, j);
            grid_sync(bar, smem, 0);
        }
        ph_router(smem, i);
        grid_sync(bar, smem, i == 0 ? CVT_E0 : (i == 1 ? CVT_E2 : (i == 2 ? CVT_E3 : CVT_E5)));
        const MoePlan mp = moe_layer_plan(i);
        for (int st = 0; st < 3; ++st) {
            const int ns2 = 4 * mp.NT - mp.D1;
            if (st == 2 && ns2 <= 0 && i == DEPTH - 1) break;
            ph_gu(smem, i, st, mp);
            ph_down(smem, i, st, mp);
            if (st == 1 && xbid_() >= mp.nB) cvt_work(smem, 1);
            if (st == 2 && xbid_() >= ns2) cvt_work(smem, 3);
            grid_sync(bar, smem, 0);
        }
    }
    ph_combine<true>(1);
}

extern "C" void kernel_launch(void* const* d_in, const int* in_sizes, int n_in, void* d_out, int out_size, void* d_ws, size_t ws_size, hipStream_t stream) {
    if (ws_size < WS_NEED || n_in < 18) return;
    Params p{};
    p.x_in = (const float*)d_in[0]; p.pool_norm = (const float*)d_in[1]; p.pool_w = (const float*)d_in[2]; p.pool_b = (const float*)d_in[3]; p.pool_scale = (const float*)d_in[4];
    p.sb_norm = (const float*)d_in[5]; p.sb_wqkv = (const float*)d_in[6]; p.sb_qg = (const float*)d_in[7]; p.sb_kg = (const float*)d_in[8]; p.sb_wo = (const float*)d_in[9];
    p.moe_norm = (const float*)d_in[10]; p.moe_wg = (const float*)d_in[11]; p.moe_bg = (const float*)d_in[12]; p.moe_wr = (const float*)d_in[13]; p.moe_br = (const float*)d_in[14];
    p.moe_wgate = (const float*)d_in[15]; p.moe_wup = (const float*)d_in[16]; p.moe_wdown = (const float*)d_in[17];
    p.x = (float*)d_out; p.ws = (unsigned char*)d_ws;
    static int grid = 0;
    if (!grid) {
        int dev = 0, cus = 0, per_cu = 0;
        if (hipGetDevice(&dev) != hipSuccess || hipDeviceGetAttribute(&cus, hipDeviceAttributeMultiprocessorCount, dev) != hipSuccess) { grid = -1; return; }
        if (hipFuncSetAttribute((const void*)fwd, hipFuncAttributeMaxDynamicSharedMemorySize, LDS_BYTES) != hipSuccess) { grid = -1; return; }
        if (hipOccupancyMaxActiveBlocksPerMultiprocessor(&per_cu, (const void*)fwd, NTHR, LDS_BYTES) != hipSuccess || per_cu < 1) { (void)hipGetLastError(); }
        grid = cus;
    }
    if (grid <= 0) return;
    (void)hipMemsetAsync((char*)d_ws + WS_CTL, 0, CTL_BYTES, stream);
    hipLaunchKernelGGL(fwd, dim3(grid), dim3(NTHR), LDS_BYTES, stream, p);
}
```
